# Optimizing an MI355X kernel written in HIP

```python
import math
import jax
import jax.numpy as jnp
from jax import lax
import numpy as np


D_MODEL = 1024
BATCH = 8
SEQ = 4096
DEPTH = 1

MEM_LEN = 256
CONV_CH = D_MODEL
CONV_K = 3
POOL_WINDOWS = (2, 4, 8, 16)
N_POOL_GROUPS = 4
POOL_GROUP_DIM = D_MODEL // N_POOL_GROUPS
POOL_WIDTH = N_POOL_GROUPS * POOL_GROUP_DIM
X_HEADS = 4
X_HEAD_DIM = D_MODEL // X_HEADS
X_WIDTH = X_HEADS * X_HEAD_DIM
N_BRANCH = 3
IN_SPLITS = (CONV_CH, 2 * CONV_CH, 3 * CONV_CH, 3 * CONV_CH + POOL_WIDTH, 3 * CONV_CH + POOL_WIDTH + X_WIDTH)
IN_COLS = 3 * CONV_CH + POOL_WIDTH + X_WIDTH + N_BRANCH * D_MODEL
N_GROUPS = 8
EXPERTS_PER_GROUP = 8
N_EXPERTS = N_GROUPS * EXPERTS_PER_GROUP
TOP_K = 2
D_EXPERT = D_MODEL // 2
MOE_BLOCK = 128
ALPHA = (2.0 * DEPTH) ** 0.25
BETA = (8.0 * DEPTH) ** -0.25
LN_EPS = 1e-5

kernel_name = 'hybrid_conv_pool_memory_hmoe'


def layer_norm(x, g, b):
    xf = x.astype(jnp.float32)
    mu = jnp.mean(xf, axis=-1, keepdims=True)
    var = jnp.mean(jnp.square(xf - mu), axis=-1, keepdims=True)
    y = (xf - mu) * lax.rsqrt(var + LN_EPS)
    return (y * g.astype(jnp.float32) + b.astype(jnp.float32)).astype(x.dtype)


def short_conv_branch(b_gate, c_gate, h, conv_w, w_conv_out):
    u = c_gate * h
    v = lax.conv_general_dilated(
        u, conv_w[:, None, :].astype(u.dtype), window_strides=(1,), padding=[(CONV_K - 1, 0)],
        dimension_numbers=('NWC', 'WIO', 'NWC'), feature_group_count=CONV_CH)
    return jnp.einsum('bsc,cd->bsd', b_gate * v, w_conv_out)


def multiscale_pool_branch(p, w_pool, pool_scale):
    bn, s, _ = p.shape
    pf = p.reshape(bn, s, N_POOL_GROUPS, POOL_GROUP_DIM).astype(jnp.float32)
    cs = jnp.cumsum(pf, axis=1)
    cs = jnp.concatenate([jnp.zeros_like(cs[:, :1]), cs], axis=1)
    pos = jnp.arange(1, s + 1, dtype=jnp.float32)
    means = []
    for gi, w in enumerate(POOL_WINDOWS):
        upper = cs[:, 1:, gi]
        lower = jnp.concatenate([jnp.zeros_like(cs[:, :w - 1, gi]), cs[:, :s - w + 1, gi]], axis=1)
        count = jnp.minimum(pos, float(w))[None, :, None]
        means.append((upper - lower) / count)
    d = (jnp.stack(means, axis=2) - pf).astype(p.dtype)
    y = jnp.einsum('bsgc,gcd->bsgd', d, w_pool).reshape(bn, s, POOL_WIDTH)
    return y * pool_scale


def memory_cross_attention(q, mem, w_kv, w_xo):
    bn, s, _ = q.shape
    m = mem.shape[1]
    kv = jnp.einsum('bmd,de->bme', mem, w_kv)
    k, v = jnp.split(kv, 2, axis=-1)
    qh = q.reshape(bn, s, X_HEADS, X_HEAD_DIM)
    kh = k.reshape(bn, m, X_HEADS, X_HEAD_DIM)
    vh = v.reshape(bn, m, X_HEADS, X_HEAD_DIM)
    sc = jnp.einsum('bshd,bmhd->bhsm', qh, kh).astype(jnp.float32) * (X_HEAD_DIM ** -0.5)
    a = jax.nn.softmax(sc, axis=-1).astype(q.dtype)
    o = jnp.einsum('bhsm,bmhd->bshd', a, vh).reshape(bn, s, X_WIDTH)
    return jnp.einsum('bse,ed->bsd', o, w_xo)


def hybrid_mixer(x, mem, w_in, b_gate, conv_w, w_conv_out, w_pool, pool_scale, w_kv, w_xo, w_o):
    bn, s, _ = x.shape
    z = jnp.einsum('bsd,de->bse', x, w_in)
    cb, cc, ch, pz, q, gz = jnp.split(z, IN_SPLITS, axis=-1)
    gates = jax.nn.sigmoid((gz + b_gate).astype(jnp.float32)).astype(x.dtype).reshape(bn, s, N_BRANCH, D_MODEL)
    y_conv = short_conv_branch(cb, cc, ch, conv_w, w_conv_out)
    y_pool = multiscale_pool_branch(pz, w_pool, pool_scale)
    y_mem = memory_cross_attention(q, mem, w_kv, w_xo)
    merged = gates[:, :, 0] * y_conv + gates[:, :, 1] * y_pool + gates[:, :, 2] * y_mem
    return jnp.einsum('bsd,de->bse', merged, w_o)


def hierarchical_moe(x, w_rg, b_rg, w_re, b_re, w_up, w_down):
    bn, s, d = x.shape
    n = bn * s
    xt = x.reshape(n, d)
    g_prob = jax.nn.softmax(jnp.einsum('nd,dg->ng', xt, w_rg).astype(jnp.float32) + b_rg.astype(jnp.float32), axis=-1)
    g_sel = jnp.argmax(g_prob, axis=-1)
    g_w = jnp.take_along_axis(g_prob, g_sel[:, None], axis=-1)
    e_all = (jnp.einsum('nd,de->ne', xt, w_re).astype(jnp.float32) + b_re.astype(jnp.float32)).reshape(n, N_GROUPS, EXPERTS_PER_GROUP)
    e_logits = jnp.take_along_axis(e_all, g_sel[:, None, None], axis=1)[:, 0]
    top_l, top_i = lax.top_k(e_logits, TOP_K)
    top_w = jax.nn.softmax(top_l, axis=-1) * g_w
    expert_id = (g_sel[:, None] * EXPERTS_PER_GROUP + top_i).reshape(-1)
    a_n = n * TOP_K
    n_blocks = (a_n + N_EXPERTS * (MOE_BLOCK - 1) + MOE_BLOCK - 1) // MOE_BLOCK
    p_rows = n_blocks * MOE_BLOCK
    order = jnp.argsort(expert_id)
    sorted_e = expert_id[order]
    counts = jnp.bincount(expert_id, length=N_EXPERTS)
    starts = jnp.cumsum(counts) - counts
    padded = (counts + MOE_BLOCK - 1) // MOE_BLOCK * MOE_BLOCK
    pends = jnp.cumsum(padded)
    pstarts = pends - padded
    dest_sorted = pstarts[sorted_e] + (jnp.arange(a_n) - starts[sorted_e])
    dest = jnp.zeros((a_n,), dtype=dest_sorted.dtype).at[order].set(dest_sorted)
    tok = jnp.arange(a_n) // TOP_K
    x_buf = jnp.zeros((p_rows, d), dtype=x.dtype).at[dest].set(xt[tok])
    block_e = jnp.minimum(jnp.searchsorted(pends, jnp.arange(n_blocks) * MOE_BLOCK, side='right'), N_EXPERTS - 1)

    def expert_block(args):
        xb, e = args
        hg, hv = jnp.split(xb @ w_up[e], 2, axis=-1)
        return (jax.nn.silu(hg) * hv) @ w_down[e]

    y_buf = lax.map(expert_block, (x_buf.reshape(n_blocks, MOE_BLOCK, d), block_e))
    y_assign = y_buf.reshape(p_rows, d)[dest].reshape(n, TOP_K, d)
    y = jnp.einsum('nkd,nk->nd', y_assign, top_w.astype(x.dtype))
    return y.reshape(bn, s, d)


def setup_inputs(seed: int = 0) -> dict:
    key = jax.random.key(seed)
    ks = jax.random.split(key, 24)
    L = DEPTH
    nrm = lambda k, shape: jax.random.normal(k, shape, dtype=jnp.float32)
    return {
        'x': nrm(ks[0], (BATCH, SEQ, D_MODEL)),
        'mem': nrm(ks[1], (BATCH, MEM_LEN, D_MODEL)),
        'w_in': nrm(ks[2], (L, D_MODEL, IN_COLS)) * D_MODEL ** -0.5,
        'b_gate': 0.1 * nrm(ks[3], (L, N_BRANCH * D_MODEL)),
        'conv_w': nrm(ks[4], (L, CONV_K, CONV_CH)) * CONV_K ** -0.5,
        'w_conv_out': nrm(ks[5], (L, CONV_CH, D_MODEL)) * CONV_CH ** -0.5,
        'w_pool': nrm(ks[6], (L, N_POOL_GROUPS, POOL_GROUP_DIM, POOL_GROUP_DIM)) * POOL_GROUP_DIM ** -0.5,
        'pool_scale': 1.0 + 0.1 * nrm(ks[7], (L, POOL_WIDTH)),
        'w_kv': nrm(ks[8], (L, D_MODEL, 2 * X_WIDTH)) * D_MODEL ** -0.5,
        'w_xo': nrm(ks[9], (L, X_WIDTH, D_MODEL)) * X_WIDTH ** -0.5,
        'w_o': nrm(ks[10], (L, D_MODEL, D_MODEL)) * (D_MODEL ** -0.5 * BETA),
        'ln1_g': 1.0 + 0.02 * nrm(ks[11], (L, D_MODEL)),
        'ln1_b': 0.02 * nrm(ks[12], (L, D_MODEL)),
        'w_router_group': nrm(ks[13], (L, D_MODEL, N_GROUPS)) * D_MODEL ** -0.5,
        'b_router_group': 0.01 * nrm(ks[14], (L, N_GROUPS)),
        'w_router_expert': nrm(ks[15], (L, D_MODEL, N_EXPERTS)) * D_MODEL ** -0.5,
        'b_router_expert': 0.01 * nrm(ks[16], (L, N_EXPERTS)),
        'w_up': nrm(ks[17], (L, N_EXPERTS, D_MODEL, 2 * D_EXPERT)) * D_MODEL ** -0.5,
        'w_down': nrm(ks[18], (L, N_EXPERTS, D_EXPERT, D_MODEL)) * (D_EXPERT ** -0.5 * BETA),
        'ln2_g': 1.0 + 0.02 * nrm(ks[19], (L, D_MODEL)),
        'ln2_b': 0.02 * nrm(ks[20], (L, D_MODEL)),
    }


def reference(x, mem, w_in, b_gate, conv_w, w_conv_out, w_pool, pool_scale, w_kv, w_xo, w_o, ln1_g, ln1_b,
              w_router_group, b_router_group, w_router_expert, b_router_expert, w_up, w_down, ln2_g, ln2_b):
    h = x
    for l in range(DEPTH):
        mix = hybrid_mixer(h, mem, w_in[l], b_gate[l], conv_w[l], w_conv_out[l], w_pool[l], pool_scale[l],
                           w_kv[l], w_xo[l], w_o[l])
        h = layer_norm(ALPHA * h + mix, ln1_g[l], ln1_b[l])
        ffn = hierarchical_moe(h, w_router_group[l], b_router_group[l], w_router_expert[l], b_router_expert[l],
                               w_up[l], w_down[l])
        h = layer_norm(ALPHA * h + ffn, ln2_g[l], ln2_b[l])
    return h
```

```cpp
#include <hip/hip_runtime.h>
#include <hip/hip_cooperative_groups.h>
#include <cstdio>
#include <cstdint>
namespace cg = cooperative_groups;

#ifndef MK_ONE_LAUNCH
#define MK_ONE_LAUNCH 0
#endif

namespace pg8 {
#define PG8_LAS __attribute__((address_space(3)))
typedef unsigned short bf16_t;
typedef short bf16x8 __attribute__((ext_vector_type(8)));
typedef float f32x4 __attribute__((ext_vector_type(4)));
typedef float f32x2 __attribute__((ext_vector_type(2)));
typedef unsigned u32x4 __attribute__((ext_vector_type(4)));
typedef unsigned u32x2 __attribute__((ext_vector_type(2)));
constexpr int BM = 256, BK = 64, HALF = 128, HTB = HALF * BK * 2  , STAGE_BYTES = 8 * HTB, NXCD = 8, WGM = 8;

__host__ __device__ __forceinline__ int lds_byte(int r, int c) { const int st = (r >> 4) * 2 + (c >> 5), rr = r & 15, cc = c & 31, ob = rr * 64 + cc * 2; return st * 1024 + (ob ^ (((ob >> 9) & 1) << 5)); }
__host__ __device__ __forceinline__ void stage_rc(int b, int& R, int& C) { const int st = b / 1024, sb = b % 1024, swz = sb ^ (((sb >> 9) & 1) << 5); R = (st >> 1) * 16 + swz / 64; C = (st & 1) * 32 + (swz % 64) / 2; }
__host__ __device__ __forceinline__ int perm32(int rho) { const int n = rho >> 4, i = rho & 15; return 8 * (i >> 2) + 4 * n + (i & 3); }

struct Unit { int pm, pn; const char* a; const char* b; };

__device__ __forceinline__ void tile_of(int L, int nM, int nN, int& pm, int& pn) {
    const int nwg = nM * nN; int wgid = L;
    { const int q = nwg / NXCD, r = nwg % NXCD, xcd = wgid % NXCD, off = wgid / NXCD; wgid = (xcd < r ? xcd * (q + 1) : r * (q + 1) + (xcd - r) * q) + off; }
    const int nig = WGM * nN, gid = wgid / nig, fm = gid * WGM, gsz = (nM - fm) < WGM ? (nM - fm) : WGM;
    pm = fm + ((wgid % nig) % gsz); pn = (wgid % nig) / gsz;
}
struct StaticOrder {
    int nM, nN, G, c; const char* A; const char* B; size_t tA, tB, aN;
    __device__ __forceinline__ bool next(int i, Unit& u) const {
        const long L = (long)i * G + c; if (L >= (long)nM * nN) return false;
        tile_of((int)L, nM, nN, u.pm, u.pn);
        u.a = A + (size_t)u.pm * tA + (size_t)u.pn * aN; u.b = B + (size_t)u.pn * tB; return true;
    }
};
struct MoeOrder {
    int nM, nN, G, c; const char* A; const char* B; size_t tA, tB, eB; const int* tile_expert;
    __device__ __forceinline__ bool next(int i, Unit& u) const {
        const long L = (long)i * G + c; if (L >= (long)nM * nN) return false;
        tile_of((int)L, nM, nN, u.pm, u.pn);
        const int e = __builtin_amdgcn_readfirstlane(tile_expert[u.pm]);
        u.a = A + (size_t)u.pm * tA; u.b = B + (size_t)e * eB + (size_t)u.pn * tB; return true;
    }
};

__device__ __forceinline__ unsigned cvt_pk_bf16(float lo, float hi) { unsigned r; asm volatile("v_cvt_pk_bf16_f32 %0, %1, %2" : "=v"(r) : "v"(lo), "v"(hi)); return r; }
__device__ __forceinline__ float bf_lo(unsigned w) { return __uint_as_float(w << 16); }
__device__ __forceinline__ float bf_hi(unsigned w) { return __uint_as_float(w & 0xffff0000u); }

template <class Epi, class Sched, bool ALIGN_EPI = false, bool SP2 = false>
__device__ __forceinline__ void gemm_phase(PG8_LAS unsigned char* lds, const int K, const int lda, const int ldb, const Sched& S, const Epi& E) {
    const int tid = threadIdx.x, wid = __builtin_amdgcn_readfirstlane(tid >> 6), lane = tid & 63, wr = wid >> 2, wc = wid & 3, fr = lane & 15, fq = lane >> 4;
    const int nt = K / BK;
    unsigned voffA[2], voffB[2];
#pragma unroll
    for (int i = 0; i < 2; ++i) { int R, C; stage_rc(tid * 16 + i * 8192, R, C); const int Rb = Epi::PERM ? ((R & ~31) + perm32(R & 31)) : R;
        voffA[i] = (unsigned)(R * lda + C) * 2u; voffB[i] = (unsigned)(Rb * ldb + C) * 2u; }
    const size_t kstep = (size_t)(BK * 2);
    const size_t hstepA = (size_t)HALF * lda * 2, hstepB = (size_t)HALF * ldb * 2;
    const unsigned ldsw = (unsigned)wid * 1024u;
    const int aoff = lds_byte(wr * 64 + fr, fq * 8), boff = lds_byte(wc * 32 + fr, fq * 8);
#define PG8_SA(b, h) (((b) * 2 + (h)) * HTB)
#define PG8_SB(b, h) ((4 + (b) * 2 + (h)) * HTB)
#define PG8_STAGE(bufoff, gbase, voff) do { _Pragma("unroll") for (int _i = 0; _i < 2; ++_i) \
        __builtin_amdgcn_global_load_lds((const unsigned*)((const char*)(gbase) + (voff)[_i]), (PG8_LAS unsigned*)(lds + (bufoff) + ldsw + _i * 8192), 16, 0, 0); } while (0)
#define PG8_LDA(dst, b, h) do { _Pragma("unroll") for (int m = 0; m < 4; ++m) _Pragma("unroll") for (int k = 0; k < 2; ++k) dst[m][k] = *(const PG8_LAS bf16x8*)(lds + PG8_SA(b, h) + aoff + m * 2048 + k * 1024); } while (0)
#define PG8_LDB(dst, b, h) do { _Pragma("unroll") for (int n = 0; n < 2; ++n) _Pragma("unroll") for (int k = 0; k < 2; ++k) dst[n][k] = *(const PG8_LAS bf16x8*)(lds + PG8_SB(b, h) + boff + n * 2048 + k * 1024); } while (0)
#define PG8_MMA(ai, bj, At, Bt) do { __builtin_amdgcn_s_setprio(1); _Pragma("unroll") for (int m = 0; m < 4; ++m) _Pragma("unroll") for (int n = 0; n < 2; ++n) _Pragma("unroll") for (int k = 0; k < 2; ++k) \
        acc[ai][bj][m][n] = __builtin_amdgcn_mfma_f32_16x16x32_bf16(Bt[n][k], At[m][k], acc[ai][bj][m][n], 0, 0, 0); __builtin_amdgcn_s_setprio(0); } while (0)
#define PG8_WAIT_V(n) asm volatile("s_waitcnt vmcnt(" #n ")" ::: "memory")
#define PG8_WAIT_L(n) asm volatile("s_waitcnt lgkmcnt(" #n ")" ::: "memory")
#define PG8_BAR __builtin_amdgcn_s_barrier()
#define PG8_SCHED __builtin_amdgcn_sched_barrier(0)
    Unit cur, nxt; int ui = 0;
    if (!S.next(0, cur)) return;
    f32x4 acc[2][2][4][2];
#pragma unroll
    for (int a = 0; a < 2; ++a)
#pragma unroll
        for (int b = 0; b < 2; ++b)
#pragma unroll
            for (int m = 0; m < 4; ++m)
#pragma unroll
                for (int n = 0; n < 2; ++n) acc[a][b][m][n] = (f32x4){0.f, 0.f, 0.f, 0.f};
    bf16x8 At[4][2], B0[2][2], B1[2][2];
    const char* cA = cur.a; const char* cB = cur.b;
    if constexpr (SP2) {
        PG8_STAGE(PG8_SB(0, 0), cB, voffB); PG8_STAGE(PG8_SB(0, 1), cB + hstepB, voffB); PG8_STAGE(PG8_SA(0, 0), cA, voffA); PG8_STAGE(PG8_SA(0, 1), cA + hstepA, voffA);
        if (wr == 1) PG8_BAR;
        PG8_WAIT_V(2); PG8_BAR;
        PG8_STAGE(PG8_SB(1, 0), cB + kstep, voffB); PG8_STAGE(PG8_SA(1, 0), cA + kstep, voffA); PG8_STAGE(PG8_SB(1, 1), cB + hstepB + kstep, voffB);
        PG8_WAIT_V(6); PG8_BAR;
    } else {
        PG8_STAGE(PG8_SB(0, 0), cB, voffB); PG8_STAGE(PG8_SA(0, 0), cA, voffA); PG8_STAGE(PG8_SB(0, 1), cB + hstepB, voffB); PG8_STAGE(PG8_SA(0, 1), cA + hstepA, voffA);
        if (wr == 1) PG8_BAR;
        PG8_WAIT_V(4); PG8_BAR;
        PG8_STAGE(PG8_SB(1, 0), cB + kstep, voffB); PG8_STAGE(PG8_SA(1, 0), cA + kstep, voffA); PG8_STAGE(PG8_SB(1, 1), cB + hstepB + kstep, voffB);
        PG8_WAIT_V(6); PG8_BAR;
    }
    for (;;) {
        const bool has_next = S.next(ui + 1, nxt);
        const char* nA = has_next ? nxt.a : cA; const char* nB = has_next ? nxt.b : cB;
        for (int t = 0; t < nt; t += 2) {
            const bool last = (t == nt - 2);
            const char* a1 = cA + (size_t)(t + 1) * kstep;
            const char* a2 = last ? nA : cA + (size_t)(t + 2) * kstep; const char* b2 = last ? nB : cB + (size_t)(t + 2) * kstep;
            const char* a3 = a2 + kstep; const char* b3 = b2 + kstep;
            if constexpr (SP2) {
            PG8_LDB(B0, 0, 0); PG8_LDB(B1, 0, 1); PG8_SCHED; PG8_LDA(At, 0, 0); PG8_STAGE(PG8_SA(1, 1), a1 + hstepA, voffA);
            PG8_WAIT_V(8); PG8_WAIT_L(0); PG8_BAR; PG8_MMA(0, 0, At, B0); PG8_MMA(0, 1, At, B1); PG8_BAR; PG8_SCHED;
            PG8_LDA(At, 0, 1); PG8_STAGE(PG8_SB(0, 0), b2, voffB); PG8_STAGE(PG8_SB(0, 1), b2 + hstepB, voffB); PG8_STAGE(PG8_SA(0, 0), a2, voffA);
            PG8_WAIT_V(8); PG8_WAIT_L(0); PG8_BAR; PG8_MMA(1, 0, At, B0); PG8_MMA(1, 1, At, B1); PG8_BAR; PG8_SCHED;
            PG8_LDB(B0, 1, 0); PG8_LDB(B1, 1, 1); PG8_SCHED; PG8_LDA(At, 1, 0); PG8_STAGE(PG8_SA(0, 1), a2 + hstepA, voffA);
            PG8_WAIT_V(8); PG8_WAIT_L(0); PG8_BAR; PG8_MMA(0, 0, At, B0); PG8_MMA(0, 1, At, B1); PG8_BAR; PG8_SCHED;
            PG8_LDA(At, 1, 1); PG8_STAGE(PG8_SB(1, 0), b3, voffB); PG8_STAGE(PG8_SB(1, 1), b3 + hstepB, voffB); PG8_STAGE(PG8_SA(1, 0), a3, voffA);
            PG8_WAIT_V(8); PG8_WAIT_L(0); PG8_BAR; PG8_MMA(1, 0, At, B0); PG8_MMA(1, 1, At, B1); PG8_BAR; PG8_SCHED;
            } else {
            PG8_LDB(B0, 0, 0); PG8_SCHED; PG8_LDA(At, 0, 0); PG8_STAGE(PG8_SA(1, 1), a1 + hstepA, voffA);
            PG8_WAIT_L(8); PG8_BAR; PG8_WAIT_L(0); PG8_MMA(0, 0, At, B0); PG8_BAR; PG8_SCHED;
            PG8_LDB(B1, 0, 1); PG8_STAGE(PG8_SB(0, 0), b2, voffB);
            PG8_BAR; PG8_WAIT_L(0); PG8_MMA(0, 1, At, B1); PG8_BAR;
            PG8_LDA(At, 0, 1); PG8_STAGE(PG8_SA(0, 0), a2, voffA);
            PG8_BAR; PG8_WAIT_L(0); PG8_MMA(1, 0, At, B0); PG8_BAR; PG8_SCHED;
            PG8_STAGE(PG8_SB(0, 1), b2 + hstepB, voffB);
            PG8_WAIT_V(6); PG8_BAR; PG8_MMA(1, 1, At, B1); PG8_BAR;
            PG8_LDB(B0, 1, 0); PG8_SCHED; PG8_LDA(At, 1, 0); PG8_STAGE(PG8_SA(0, 1), a2 + hstepA, voffA);
            PG8_WAIT_L(8); PG8_BAR; PG8_WAIT_L(0); PG8_MMA(0, 0, At, B0); PG8_BAR; PG8_SCHED;
            PG8_LDB(B1, 1, 1); PG8_STAGE(PG8_SB(1, 0), b3, voffB);
            PG8_BAR; PG8_WAIT_L(0); PG8_MMA(0, 1, At, B1); PG8_BAR;
            PG8_LDA(At, 1, 1); PG8_STAGE(PG8_SA(1, 0), a3, voffA);
            PG8_BAR; PG8_WAIT_L(0); PG8_MMA(1, 0, At, B0); PG8_BAR; PG8_SCHED;
            PG8_STAGE(PG8_SB(1, 1), b3 + hstepB, voffB);
            PG8_WAIT_V(6); PG8_BAR; PG8_MMA(1, 1, At, B1); PG8_BAR;
            }
        }
        if constexpr (ALIGN_EPI) { if (wr == 0) PG8_BAR; }
        E(acc, cur, wr, wc, fr, fq);
        if (!has_next) break;
#pragma unroll
        for (int a = 0; a < 2; ++a)
#pragma unroll
            for (int b = 0; b < 2; ++b)
#pragma unroll
                for (int m = 0; m < 4; ++m)
#pragma unroll
                    for (int n = 0; n < 2; ++n) acc[a][b][m][n] = (f32x4){0.f, 0.f, 0.f, 0.f};
        cur = nxt; cA = nA; cB = nB; ++ui;
        if constexpr (ALIGN_EPI) { if (wr == 1) PG8_BAR; }
    }
    PG8_WAIT_V(0);
    if constexpr (!ALIGN_EPI) { if (wr == 0) PG8_BAR; }
    PG8_BAR;
#undef PG8_SA
#undef PG8_SB
#undef PG8_STAGE
#undef PG8_LDA
#undef PG8_LDB
#undef PG8_MMA
#undef PG8_WAIT_V
#undef PG8_WAIT_L
#undef PG8_BAR
#undef PG8_SCHED
}
}
using pg8::bf16_t; using pg8::f32x4; using pg8::f32x2; using pg8::u32x4; using pg8::u32x2; using pg8::Unit; using pg8::cvt_pk_bf16; using pg8::bf_lo; using pg8::bf_hi;
#define LAS __attribute__((address_space(3)))

constexpr int D = 1024, BATCH = 8, SEQ = 4096, NTOK = BATCH * SEQ, MEMLEN = 256, NMEM = BATCH * MEMLEN;
constexpr int INCOLS = 8192, GATE0 = 5120;
constexpr int NEXP = 64, DEXP = 512, NGRP = 8, EPG = 8;
constexpr int NASSIGN = NTOK * 2, PMAX_TILES = 320, PMAX = PMAX_TILES * 256;
constexpr float ALPHA = 1.189207115002721f;
constexpr float LN_EPS = 1e-5f;
constexpr int NWAVES = 8, NTHR = 512;

constexpr size_t MiB = 1u << 20;
constexpr size_t WS_CTL = 0, CTL_ZERO_BYTES = 1 * MiB;
constexpr size_t WS_WIN = 1 * MiB, WS_WKV = 17 * MiB, WS_WC = 21 * MiB, WS_WXO = 23 * MiB, WS_WO = 25 * MiB, WS_WP = 27 * MiB, WS_WR = 28 * MiB;
constexpr size_t WS_WUP = 29 * MiB, WS_WDN = 157 * MiB, WS_MISC = 221 * MiB;
constexpr size_t WS_Z = 224 * MiB;
constexpr size_t WS_XB = 736 * MiB, WS_MEMB = 800 * MiB, WS_KV = 804 * MiB, WS_ACONV = 812 * MiB, WS_DPOOL = 876 * MiB, WS_MERGED = 940 * MiB;
constexpr size_t WS_O = WS_XB;
constexpr size_t WS_H1 = 224 * MiB;
constexpr size_t WS_H1B = 480 * MiB;
constexpr size_t WS_XBUF = 544 * MiB;
constexpr size_t WS_ACT = 736 * MiB;
constexpr size_t WS_YBUF = 816 * MiB;
constexpr size_t WS_END = 1004 * MiB;
constexpr size_t MS_TOKE = 0, MS_TOKPOS = MS_TOKE + NASSIGN * 4, MS_TOKW = MS_TOKPOS + NASSIGN * 4, MS_TOKDEST = MS_TOKW + NASSIGN * 4, MS_TILEE = MS_TOKDEST + NASSIGN * 4, MS_PSTART = MS_TILEE + 4096, MS_NTILES = MS_PSTART + 1024;
constexpr int CW_COUNTS = 1024;
constexpr int CW_BAR = 4096;

constexpr int LDS_BYTES = 147456;

struct Params { const float* in[21]; float* out; unsigned char* ws; int ph_lo, ph_hi; };
enum { I_X = 0, I_MEM, I_WIN, I_BGATE, I_CONVW, I_WCONV, I_WPOOL, I_PSCALE, I_WKV, I_WXO, I_WO, I_LN1G, I_LN1B, I_WRG, I_BRG, I_WRE, I_BRE, I_WUP, I_WDN, I_LN2G, I_LN2B };

__device__ __forceinline__ unsigned f2bf(float f) { unsigned u = __float_as_uint(f); return (u + 0x7fffu + ((u >> 16) & 1u)) >> 16; }
__device__ __forceinline__ unsigned pk2(float lo, float hi) { return f2bf(lo) | (f2bf(hi) << 16); }
__device__ __forceinline__ float wave_sum(float v) {
#pragma unroll
    for (int o = 1; o < 64; o <<= 1) v += __shfl_xor(v, o);
    return v;
}
__device__ __forceinline__ float sigmoidf_(float x) { return __builtin_amdgcn_rcpf(1.0f + __expf(-x)); }

struct EpiBf16 {
    static constexpr bool PERM = true;
    bf16_t* O; int ldc; const float* bias; int gate_pn; int gate_col0;
    __device__ __forceinline__ void operator()(const f32x4 (&acc)[2][2][4][2], const Unit& u, int wr, int wc, int fr, int fq) const {
        const int row0 = u.pm * 256 + wr * 64 + fr, col0 = u.pn * 256 + wc * 32 + 8 * fq;
        const bool gate = u.pn >= gate_pn;
        f32x4 bv[2][2];
#pragma unroll
        for (int bj = 0; bj < 2; ++bj)
#pragma unroll
            for (int n = 0; n < 2; ++n) bv[bj][n] = gate ? *(const f32x4*)(bias + (col0 - gate_col0) + bj * 128 + 4 * n) : (f32x4){0.f, 0.f, 0.f, 0.f};
#pragma unroll
        for (int ai = 0; ai < 2; ++ai)
#pragma unroll
            for (int m = 0; m < 4; ++m) { bf16_t* rowp = O + (size_t)(row0 + ai * 128 + m * 16) * ldc + col0;
#pragma unroll
                for (int bj = 0; bj < 2; ++bj) { f32x4 v0 = acc[ai][bj][m][0] + bv[bj][0], v1 = acc[ai][bj][m][1] + bv[bj][1];
                    if (gate) {
#pragma unroll
                        for (int j = 0; j < 4; ++j) { v0[j] = sigmoidf_(v0[j]); v1[j] = sigmoidf_(v1[j]); } }
                    u32x4 w; w.x = cvt_pk_bf16(v0[0], v0[1]); w.y = cvt_pk_bf16(v0[2], v0[3]); w.z = cvt_pk_bf16(v1[0], v1[1]); w.w = cvt_pk_bf16(v1[2], v1[3]);
                    *(u32x4*)(rowp + bj * 128) = w; } }
    }
};
template <int MODE> struct EpiMerge {
    static constexpr bool PERM = true;
    bf16_t* Mg; const bf16_t* Z; int gcol0; const float* scale;
    __device__ __forceinline__ void operator()(const f32x4 (&acc)[2][2][4][2], const Unit& u, int wr, int wc, int fr, int fq) const {
        const int row0 = u.pm * 256 + wr * 64 + fr, col0 = u.pn * 256 + wc * 32 + 8 * fq;
        f32x4 sv[2][2];
#pragma unroll
        for (int bj = 0; bj < 2; ++bj)
#pragma unroll
            for (int n = 0; n < 2; ++n) sv[bj][n] = scale ? *(const f32x4*)(scale + col0 + bj * 128 + 4 * n) : (f32x4){1.f, 1.f, 1.f, 1.f};
#pragma unroll
        for (int ai = 0; ai < 2; ++ai)
#pragma unroll
            for (int m = 0; m < 4; ++m) { const size_t row = (size_t)(row0 + ai * 128 + m * 16);
#pragma unroll
                for (int bj = 0; bj < 2; ++bj) {
                    const u32x4 g = *(const u32x4*)(Z + row * INCOLS + gcol0 + col0 + bj * 128);
                    f32x4 v0 = acc[ai][bj][m][0] * sv[bj][0], v1 = acc[ai][bj][m][1] * sv[bj][1];
                    v0[0] *= bf_lo(g.x); v0[1] *= bf_hi(g.x); v0[2] *= bf_lo(g.y); v0[3] *= bf_hi(g.y);
                    v1[0] *= bf_lo(g.z); v1[1] *= bf_hi(g.z); v1[2] *= bf_lo(g.w); v1[3] *= bf_hi(g.w);
                    u32x4* mp = (u32x4*)(Mg + row * D + col0 + bj * 128);
                    if (MODE) { const u32x4 o = *mp;
                        v0[0] += bf_lo(o.x); v0[1] += bf_hi(o.x); v0[2] += bf_lo(o.y); v0[3] += bf_hi(o.y);
                        v1[0] += bf_lo(o.z); v1[1] += bf_hi(o.z); v1[2] += bf_lo(o.w); v1[3] += bf_hi(o.w); }
                    u32x4 w; w.x = cvt_pk_bf16(v0[0], v0[1]); w.y = cvt_pk_bf16(v0[2], v0[3]); w.z = cvt_pk_bf16(v1[0], v1[1]); w.w = cvt_pk_bf16(v1[2], v1[3]);
                    *mp = w; } }
    }
};
struct EpiResF32 {
    static constexpr bool PERM = false;
    float* O; const float* base; float alpha;
    __device__ __forceinline__ void operator()(const f32x4 (&acc)[2][2][4][2], const Unit& u, int wr, int wc, int fr, int fq) const {
        const int row0 = u.pm * 256 + wr * 64 + fr, col0 = u.pn * 256 + wc * 32 + 4 * fq;
#pragma unroll
        for (int ai = 0; ai < 2; ++ai)
#pragma unroll
            for (int m = 0; m < 4; ++m) { const size_t off = (size_t)(row0 + ai * 128 + m * 16) * D + col0;
#pragma unroll
                for (int bj = 0; bj < 2; ++bj)
#pragma unroll
                    for (int n = 0; n < 2; ++n) { const f32x4 bs = *(const f32x4*)(base + off + bj * 128 + n * 16); *(f32x4*)(O + off + bj * 128 + n * 16) = bs * alpha + acc[ai][bj][m][n]; } }
    }
};
struct EpiAct {
    static constexpr bool PERM = true;
    bf16_t* O;
    __device__ __forceinline__ void operator()(const f32x4 (&acc)[2][2][4][2], const Unit& u, int wr, int wc, int fr, int fq) const {
        const int row0 = u.pm * 256 + wr * 64 + fr, col0 = u.pn * 128 + wc * 32 + 8 * fq;
#pragma unroll
        for (int ai = 0; ai < 2; ++ai)
#pragma unroll
            for (int m = 0; m < 4; ++m) { bf16_t* rowp = O + (size_t)(row0 + ai * 128 + m * 16) * DEXP + col0;
                f32x4 r0, r1;
#pragma unroll
                for (int j = 0; j < 4; ++j) { const float g0 = acc[ai][0][m][0][j], g1 = acc[ai][0][m][1][j];
                    r0[j] = g0 * sigmoidf_(g0) * acc[ai][1][m][0][j]; r1[j] = g1 * sigmoidf_(g1) * acc[ai][1][m][1][j]; }
                u32x4 w; w.x = cvt_pk_bf16(r0[0], r0[1]); w.y = cvt_pk_bf16(r0[2], r0[3]); w.z = cvt_pk_bf16(r1[0], r1[1]); w.w = cvt_pk_bf16(r1[2], r1[3]);
                *(u32x4*)rowp = w; }
    }
};

struct Frame {
    LAS unsigned char* lds; int tid, lane, wave, G, bid;
    const Params* p;
};

__device__ __forceinline__ void transpose_item(const float* W, int ldw, int k0, int n0, bf16_t* WT, int ldt, int drow0, int dcol0, LAS float* scr, int lane) {
#pragma unroll 8
    for (int i = 0; i < 32; ++i) { const int kk = 2 * i + (lane >> 5); scr[kk * 33 + (lane & 31)] = W[(size_t)(k0 + kk) * ldw + n0 + (lane & 31)]; }
    asm volatile("s_waitcnt lgkmcnt(0)" ::: "memory");
    const int c = lane & 7;
#pragma unroll
    for (int j = 0; j < 4; ++j) { const int n = (lane >> 3) + 8 * j; const LAS float* s = scr + (8 * c) * 33 + n;
        u32x4 o; o.x = pk2(s[0 * 33], s[1 * 33]); o.y = pk2(s[2 * 33], s[3 * 33]); o.z = pk2(s[4 * 33], s[5 * 33]); o.w = pk2(s[6 * 33], s[7 * 33]);
        *(u32x4*)(WT + (size_t)(drow0 + n) * ldt + dcol0 + 8 * c) = o; }
    asm volatile("s_waitcnt lgkmcnt(0)" ::: "memory");
}

__device__ __forceinline__ void phase_prep(const Frame& F) {
    const Params& P = *F.p; unsigned char* ws = P.ws;
    LAS float* scr = (LAS float*)(F.lds + F.wave * 16384);
    const int gw = F.bid * NWAVES + F.wave, NGW = F.G * NWAVES;
    constexpr int I_IN = 16 * 256, I_SQ = 16 * 32, I_KV = 16 * 64, I_P = 4 * 4 * 8, I_UP = NEXP * 16 * 32, I_DN = NEXP * 8 * 32;
    constexpr int NIT = I_IN + 3 * I_SQ + I_KV + I_P + I_UP + I_DN;
    for (int it = gw; it < NIT; it += NGW) {
        int r = it;
        if (r < I_IN) { const int kb = r / 256, nb = r % 256; transpose_item(P.in[I_WIN], INCOLS, 64 * kb, 32 * nb, (bf16_t*)(ws + WS_WIN), D, 32 * nb, 64 * kb, scr, F.lane); continue; } r -= I_IN;
        if (r < I_SQ) { const int kb = r / 32, nb = r % 32; transpose_item(P.in[I_WCONV], D, 64 * kb, 32 * nb, (bf16_t*)(ws + WS_WC), D, 32 * nb, 64 * kb, scr, F.lane); continue; } r -= I_SQ;
        if (r < I_SQ) { const int kb = r / 32, nb = r % 32; transpose_item(P.in[I_WXO], D, 64 * kb, 32 * nb, (bf16_t*)(ws + WS_WXO), D, 32 * nb, 64 * kb, scr, F.lane); continue; } r -= I_SQ;
        if (r < I_SQ) { const int kb = r / 32, nb = r % 32; transpose_item(P.in[I_WO], D, 64 * kb, 32 * nb, (bf16_t*)(ws + WS_WO), D, 32 * nb, 64 * kb, scr, F.lane); continue; } r -= I_SQ;
        if (r < I_KV) { const int kb = r / 64, nb = r % 64; transpose_item(P.in[I_WKV], 2 * D, 64 * kb, 32 * nb, (bf16_t*)(ws + WS_WKV), D, 32 * nb, 64 * kb, scr, F.lane); continue; } r -= I_KV;
        if (r < I_P) { const int g = r / 32, q = r % 32, kb = q / 8, nb = q % 8;
            transpose_item(P.in[I_WPOOL] + (size_t)g * 65536, 256, 64 * kb, 32 * nb, (bf16_t*)(ws + WS_WP) + (size_t)g * 65536, 256, 32 * nb, 64 * kb, scr, F.lane); continue; } r -= I_P;
        if (r < I_UP) { const int e = r / 512, q = r % 512, kb = q / 32, nb = q % 32; const int n0 = 32 * nb;
            const int j0 = n0 & 511, drow = (j0 >> 7) * 256 + (n0 >= 512 ? 128 : 0) + (j0 & 127);
            transpose_item(P.in[I_WUP] + (size_t)e * D * D, D, 64 * kb, n0, (bf16_t*)(ws + WS_WUP) + (size_t)e * D * D, D, drow, 64 * kb, scr, F.lane); continue; } r -= I_UP;
        { const int e = r / 256, q = r % 256, kb = q / 32, nb = q % 32;
            transpose_item(P.in[I_WDN] + (size_t)e * DEXP * D, D, 64 * kb, 32 * nb, (bf16_t*)(ws + WS_WDN) + (size_t)e * D * DEXP, DEXP, 32 * nb, 64 * kb, scr, F.lane); }
    }
    const size_t gt = (size_t)F.bid * NTHR + F.tid, NGT = (size_t)F.G * NTHR;
    { const f32x4* src = (const f32x4*)P.in[I_X]; u32x4* dst = (u32x4*)(ws + WS_XB);
      for (size_t i = gt; i < (size_t)NTOK * D / 8; i += NGT) { const f32x4 a = src[2 * i], b = src[2 * i + 1]; u32x4 o; o.x = pk2(a[0], a[1]); o.y = pk2(a[2], a[3]); o.z = pk2(b[0], b[1]); o.w = pk2(b[2], b[3]); dst[i] = o; } }
    { const f32x4* src = (const f32x4*)P.in[I_MEM]; u32x4* dst = (u32x4*)(ws + WS_MEMB);
      for (size_t i = gt; i < (size_t)NMEM * D / 8; i += NGT) { const f32x4 a = src[2 * i], b = src[2 * i + 1]; u32x4 o; o.x = pk2(a[0], a[1]); o.y = pk2(a[2], a[3]); o.z = pk2(b[0], b[1]); o.w = pk2(b[2], b[3]); dst[i] = o; } }
    { float* wr = (float*)(ws + WS_WR);
      for (size_t i = gt; i < (size_t)72 * D; i += NGT) { const int o = (int)(i / D), k = (int)(i % D); wr[i] = o < 8 ? P.in[I_WRG][(size_t)k * 8 + o] : P.in[I_WRE][(size_t)k * 64 + (o - 8)]; } }
}

__device__ __forceinline__ void phase_convpool(const Frame& F) {
    const Params& P = *F.p; unsigned char* ws = P.ws;
    const bf16_t* Z = (const bf16_t*)(ws + WS_Z); bf16_t* AC = (bf16_t*)(ws + WS_ACONV); bf16_t* DP = (bf16_t*)(ws + WS_DPOOL);
    const float* cw = P.in[I_CONVW];
    const size_t gt = (size_t)F.bid * NTHR + F.tid, NGT = (size_t)F.G * NTHR;
    for (size_t i = gt; i < (size_t)NTOK * (D / 8); i += NGT) {
        const int t = (int)(i >> 7), c0 = (int)(i & 127) * 8, s = t & (SEQ - 1);
        const bf16_t* zr = Z + (size_t)t * INCOLS;
        float v[8];
#pragma unroll
        for (int j = 0; j < 8; ++j) v[j] = 0.f;
#pragma unroll
        for (int d = 0; d < 3; ++d) {
            if (s - 2 + d >= 0) {
                const bf16_t* zz = zr - (size_t)(2 - d) * INCOLS;
                const u32x4 cc = *(const u32x4*)(zz + D + c0), hh = *(const u32x4*)(zz + 2 * D + c0);
                const f32x4 w0 = *(const f32x4*)(cw + d * D + c0), w1 = *(const f32x4*)(cw + d * D + c0 + 4);
                v[0] += w0[0] * bf_lo(cc.x) * bf_lo(hh.x); v[1] += w0[1] * bf_hi(cc.x) * bf_hi(hh.x); v[2] += w0[2] * bf_lo(cc.y) * bf_lo(hh.y); v[3] += w0[3] * bf_hi(cc.y) * bf_hi(hh.y);
                v[4] += w1[0] * bf_lo(cc.z) * bf_lo(hh.z); v[5] += w1[1] * bf_hi(cc.z) * bf_hi(hh.z); v[6] += w1[2] * bf_lo(cc.w) * bf_lo(hh.w); v[7] += w1[3] * bf_hi(cc.w) * bf_hi(hh.w);
            }
        }
        { const u32x4 bb = *(const u32x4*)(zr + c0);
          u32x4 o; o.x = pk2(v[0] * bf_lo(bb.x), v[1] * bf_hi(bb.x)); o.y = pk2(v[2] * bf_lo(bb.y), v[3] * bf_hi(bb.y)); o.z = pk2(v[4] * bf_lo(bb.z), v[5] * bf_hi(bb.z)); o.w = pk2(v[6] * bf_lo(bb.w), v[7] * bf_hi(bb.w));
          *(u32x4*)(AC + (size_t)t * D + c0) = o; }
        const int gi = c0 >> 8, w = 2 << gi, cnt = (s + 1) < w ? (s + 1) : w;
        float a[8];
#pragma unroll
        for (int j = 0; j < 8; ++j) a[j] = 0.f;
        const u32x4 p0 = *(const u32x4*)(zr + 3 * D + c0);
        for (int d = 0; d < cnt; ++d) {
            const u32x4 pp = *(const u32x4*)(zr - (size_t)d * INCOLS + 3 * D + c0);
            a[0] += bf_lo(pp.x); a[1] += bf_hi(pp.x); a[2] += bf_lo(pp.y); a[3] += bf_hi(pp.y); a[4] += bf_lo(pp.z); a[5] += bf_hi(pp.z); a[6] += bf_lo(pp.w); a[7] += bf_hi(pp.w);
        }
        const float inv = 1.0f / (float)cnt;
        u32x4 o; o.x = pk2(a[0] * inv - bf_lo(p0.x), a[1] * inv - bf_hi(p0.x)); o.y = pk2(a[2] * inv - bf_lo(p0.y), a[3] * inv - bf_hi(p0.y));
        o.z = pk2(a[4] * inv - bf_lo(p0.z), a[5] * inv - bf_hi(p0.z)); o.w = pk2(a[6] * inv - bf_lo(p0.w), a[7] * inv - bf_hi(p0.w));
        *(u32x4*)(DP + (size_t)t * D + c0) = o;
    }
}

__device__ __forceinline__ void phase_attn_naive(const Frame& F) {
    const Params& P = *F.p; unsigned char* ws = P.ws;
    const bf16_t* Z = (const bf16_t*)(ws + WS_Z); const bf16_t* KV = (const bf16_t*)(ws + WS_KV); bf16_t* O = (bf16_t*)(ws + WS_O);
    LAS float* qs = (LAS float*)F.lds;
    LAS float* sc = qs + 8 * 256;
    const int tid = F.tid, half = tid >> 8, m = tid & 255;
    for (int uidx = F.bid; uidx < (NTOK / 8) * 4; uidx += F.G) {
        const int h = uidx & 3, t0 = (uidx >> 2) * 8, b = t0 / SEQ;
        __syncthreads();
        for (int i = tid; i < 8 * 256; i += NTHR) { const int q = i >> 8, d = i & 255; qs[i] = __uint_as_float((unsigned)Z[(size_t)(t0 + q) * INCOLS + 4 * D + h * 256 + d] << 16); }
        __syncthreads();
        { const bf16_t* kr = KV + (size_t)(b * MEMLEN + m) * (2 * D) + h * 256;
          float s0 = 0.f, s1 = 0.f, s2 = 0.f, s3 = 0.f; const LAS float* q0 = qs + (half * 4) * 256;
          for (int d8 = 0; d8 < 32; ++d8) { const u32x4 kk = *(const u32x4*)(kr + d8 * 8);
              const float k0 = bf_lo(kk.x), k1 = bf_hi(kk.x), k2 = bf_lo(kk.y), k3 = bf_hi(kk.y), k4 = bf_lo(kk.z), k5 = bf_hi(kk.z), k6 = bf_lo(kk.w), k7 = bf_hi(kk.w);
              const LAS float* qq = q0 + d8 * 8;
              s0 += k0 * qq[0] + k1 * qq[1] + k2 * qq[2] + k3 * qq[3] + k4 * qq[4] + k5 * qq[5] + k6 * qq[6] + k7 * qq[7]; qq += 256;
              s1 += k0 * qq[0] + k1 * qq[1] + k2 * qq[2] + k3 * qq[3] + k4 * qq[4] + k5 * qq[5] + k6 * qq[6] + k7 * qq[7]; qq += 256;
              s2 += k0 * qq[0] + k1 * qq[1] + k2 * qq[2] + k3 * qq[3] + k4 * qq[4] + k5 * qq[5] + k6 * qq[6] + k7 * qq[7]; qq += 256;
              s3 += k0 * qq[0] + k1 * qq[1] + k2 * qq[2] + k3 * qq[3] + k4 * qq[4] + k5 * qq[5] + k6 * qq[6] + k7 * qq[7]; }
          LAS float* so = sc + (half * 4) * 256 + m; so[0] = s0 * 0.0625f; so[256] = s1 * 0.0625f; so[512] = s2 * 0.0625f; so[768] = s3 * 0.0625f; }
        __syncthreads();
        { LAS float* sr = sc + F.wave * 256; float v0 = sr[F.lane], v1 = sr[F.lane + 64], v2 = sr[F.lane + 128], v3 = sr[F.lane + 192];
          float mx = fmaxf(fmaxf(v0, v1), fmaxf(v2, v3));
#pragma unroll
          for (int o = 1; o < 64; o <<= 1) mx = fmaxf(mx, __shfl_xor(mx, o));
          v0 = __expf(v0 - mx); v1 = __expf(v1 - mx); v2 = __expf(v2 - mx); v3 = __expf(v3 - mx);
          const float inv = 1.0f / wave_sum(v0 + v1 + v2 + v3);
          sr[F.lane] = v0 * inv; sr[F.lane + 64] = v1 * inv; sr[F.lane + 128] = v2 * inv; sr[F.lane + 192] = v3 * inv; }
        __syncthreads();
        { const bf16_t* vr = KV + (size_t)(b * MEMLEN) * (2 * D) + D + h * 256 + m; const LAS float* pr = sc + (half * 4) * 256;
          float o0 = 0.f, o1 = 0.f, o2 = 0.f, o3 = 0.f;
          for (int k = 0; k < 256; ++k) { const float vv = __uint_as_float((unsigned)vr[(size_t)k * (2 * D)] << 16); o0 += pr[k] * vv; o1 += pr[256 + k] * vv; o2 += pr[512 + k] * vv; o3 += pr[768 + k] * vv; }
          bf16_t* op = O + (size_t)(t0 + half * 4) * D + h * 256 + m;
          op[0] = (bf16_t)f2bf(o0); op[D] = (bf16_t)f2bf(o1); op[2 * D] = (bf16_t)f2bf(o2); op[3 * D] = (bf16_t)f2bf(o3); }
    }
    __syncthreads();
}

__device__ __forceinline__ void phase_ln1_router(const Frame& F) {
    const Params& P = *F.p; unsigned char* ws = P.ws;
    float* H1 = (float*)(ws + WS_H1); bf16_t* H1B = (bf16_t*)(ws + WS_H1B); const float* WR = (const float*)(ws + WS_WR);
    unsigned* ctl = (unsigned*)(ws + WS_CTL);
    int* tok_e = (int*)(ws + WS_MISC + MS_TOKE); int* tok_pos = (int*)(ws + WS_MISC + MS_TOKPOS); float* tok_w = (float*)(ws + WS_MISC + MS_TOKW);
    LAS float* lg = (LAS float*)(F.lds + F.wave * 512);
    const int gw = F.bid * NWAVES + F.wave, NGW = F.G * NWAVES, lane = F.lane;
    const float* g1 = P.in[I_LN1G]; const float* b1 = P.in[I_LN1B];
    for (int row = gw; row < NTOK; row += NGW) {
        f32x4* xr = (f32x4*)(H1 + (size_t)row * D) + lane;
        f32x4 v[4]; float s = 0.f;
#pragma unroll
        for (int j = 0; j < 4; ++j) { v[j] = xr[64 * j]; s += (v[j][0] + v[j][1]) + (v[j][2] + v[j][3]); }
        const float mean = wave_sum(s) * (1.f / D); float s2 = 0.f;
#pragma unroll
        for (int j = 0; j < 4; ++j) { v[j] = v[j] - mean; s2 += (v[j][0] * v[j][0] + v[j][1] * v[j][1]) + (v[j][2] * v[j][2] + v[j][3] * v[j][3]); }
        const float rstd = 1.f / sqrtf(wave_sum(s2) * (1.f / D) + LN_EPS);
#pragma unroll
        for (int j = 0; j < 4; ++j) { const f32x4 gg = *((const f32x4*)g1 + lane + 64 * j), bb = *((const f32x4*)b1 + lane + 64 * j); v[j] = v[j] * rstd * gg + bb; xr[64 * j] = v[j];
            u32x2 o; o.x = pk2(v[j][0], v[j][1]); o.y = pk2(v[j][2], v[j][3]); *((u32x2*)(H1B + (size_t)row * D) + lane + 64 * j) = o; }
        for (int o = 0; o < 72; ++o) { const f32x4* wr = (const f32x4*)(WR + (size_t)o * D) + lane; float a = 0.f;
#pragma unroll
            for (int j = 0; j < 4; ++j) { const f32x4 w = wr[64 * j]; a += (v[j][0] * w[0] + v[j][1] * w[1]) + (v[j][2] * w[2] + v[j][3] * w[3]); }
            a = wave_sum(a); if (lane == 0) lg[o] = a; }
        asm volatile("s_waitcnt lgkmcnt(0)" ::: "memory");
        if (lane == 0) {
            const float* brg = P.in[I_BRG]; const float* bre = P.in[I_BRE];
            int gs = 0; float gm = lg[0] + brg[0];
            for (int i = 1; i < 8; ++i) { const float x = lg[i] + brg[i]; if (x > gm) { gm = x; gs = i; } }
            float den = 0.f; for (int i = 0; i < 8; ++i) den += __expf(lg[i] + brg[i] - gm);
            const float gwt = 1.0f / den;
            int i1 = 0; float l1 = lg[8 + gs * 8] + bre[gs * 8];
            for (int i = 1; i < 8; ++i) { const float x = lg[8 + gs * 8 + i] + bre[gs * 8 + i]; if (x > l1) { l1 = x; i1 = i; } }
            int i2 = -1; float l2 = 0.f;
            for (int i = 0; i < 8; ++i) { if (i == i1) continue; const float x = lg[8 + gs * 8 + i] + bre[gs * 8 + i]; if (i2 < 0 || x > l2) { l2 = x; i2 = i; } }
            const float e2 = __expf(l2 - l1), w1 = gwt / (1.0f + e2), w2 = gwt * e2 / (1.0f + e2);
            const int ea = gs * 8 + i1, eb = gs * 8 + i2;
            const int pa = (int)atomicAdd(ctl + CW_COUNTS + ea, 1u), pb = (int)atomicAdd(ctl + CW_COUNTS + eb, 1u);
            tok_e[2 * row] = ea; tok_e[2 * row + 1] = eb; tok_pos[2 * row] = pa; tok_pos[2 * row + 1] = pb; tok_w[2 * row] = w1; tok_w[2 * row + 1] = w2;
        }
    }
}

__device__ __forceinline__ void phase_scan(const Frame& F) {
    const Params& P = *F.p; unsigned char* ws = P.ws;
    if (F.bid == 0 && F.tid == 0) {
        const unsigned* cnt = (const unsigned*)(ws + WS_CTL) + CW_COUNTS;
        int* tile_e = (int*)(ws + WS_MISC + MS_TILEE); int* pstart = (int*)(ws + WS_MISC + MS_PSTART); int* ntl = (int*)(ws + WS_MISC + MS_NTILES);
        int run = 0;
        for (int e = 0; e < NEXP; ++e) { const int c = (int)__hip_atomic_load(cnt + e, __ATOMIC_RELAXED, __HIP_MEMORY_SCOPE_AGENT); pstart[e] = run * 256; const int nte = (c + 255) / 256; for (int k = 0; k < nte; ++k) tile_e[run + k] = e; run += nte; }
        ntl[0] = run;
    }
}

__device__ __forceinline__ void phase_gather(const Frame& F) {
    const Params& P = *F.p; unsigned char* ws = P.ws;
    const int* tok_e = (const int*)(ws + WS_MISC + MS_TOKE); const int* tok_pos = (const int*)(ws + WS_MISC + MS_TOKPOS); int* tok_dest = (int*)(ws + WS_MISC + MS_TOKDEST);
    const int* pstart = (const int*)(ws + WS_MISC + MS_PSTART);
    const bf16_t* H1B = (const bf16_t*)(ws + WS_H1B); bf16_t* XB = (bf16_t*)(ws + WS_XBUF);
    const int gw = F.bid * NWAVES + F.wave, NGW = F.G * NWAVES;
    for (int a = gw; a < NASSIGN; a += NGW) {
        const int dest = pstart[tok_e[a]] + tok_pos[a];
        const u32x4* src = (const u32x4*)(H1B + (size_t)(a >> 1) * D) + F.lane; u32x4* dst = (u32x4*)(XB + (size_t)dest * D) + F.lane;
        dst[0] = src[0]; dst[64] = src[64];
        if (F.lane == 0) tok_dest[a] = dest;
    }
}

__device__ __forceinline__ void phase_combine(const Frame& F) {
    const Params& P = *F.p; unsigned char* ws = P.ws;
    const float* H1 = (const float*)(ws + WS_H1); const bf16_t* YB = (const bf16_t*)(ws + WS_YBUF);
    const int* tok_dest = (const int*)(ws + WS_MISC + MS_TOKDEST); const float* tok_w = (const float*)(ws + WS_MISC + MS_TOKW);
    const int gw = F.bid * NWAVES + F.wave, NGW = F.G * NWAVES, lane = F.lane;
    const float* g2 = P.in[I_LN2G]; const float* b2 = P.in[I_LN2B];
    for (int row = gw; row < NTOK; row += NGW) {
        const int d0 = tok_dest[2 * row], d1 = tok_dest[2 * row + 1]; const float w0 = tok_w[2 * row], w1 = tok_w[2 * row + 1];
        const f32x4* xr = (const f32x4*)(H1 + (size_t)row * D) + lane;
        const u32x2* y0 = (const u32x2*)(YB + (size_t)d0 * D) + lane; const u32x2* y1 = (const u32x2*)(YB + (size_t)d1 * D) + lane;
        f32x4 v[4]; float s = 0.f;
#pragma unroll
        for (int j = 0; j < 4; ++j) { const f32x4 x = xr[64 * j]; const u32x2 a = y0[64 * j], b = y1[64 * j];
            v[j][0] = ALPHA * x[0] + (w0 * bf_lo(a.x) + w1 * bf_lo(b.x)); v[j][1] = ALPHA * x[1] + (w0 * bf_hi(a.x) + w1 * bf_hi(b.x));
            v[j][2] = ALPHA * x[2] + (w0 * bf_lo(a.y) + w1 * bf_lo(b.y)); v[j][3] = ALPHA * x[3] + (w0 * bf_hi(a.y) + w1 * bf_hi(b.y));
            s += (v[j][0] + v[j][1]) + (v[j][2] + v[j][3]); }
        const float mean = wave_sum(s) * (1.f / D); float s2 = 0.f;
#pragma unroll
        for (int j = 0; j < 4; ++j) { v[j] = v[j] - mean; s2 += (v[j][0] * v[j][0] + v[j][1] * v[j][1]) + (v[j][2] * v[j][2] + v[j][3] * v[j][3]); }
        const float rstd = 1.f / sqrtf(wave_sum(s2) * (1.f / D) + LN_EPS);
        f32x4* orow = (f32x4*)(P.out + (size_t)row * D) + lane;
#pragma unroll
        for (int j = 0; j < 4; ++j) { const f32x4 gg = *((const f32x4*)g2 + lane + 64 * j), bb = *((const f32x4*)b2 + lane + 64 * j); orow[64 * j] = v[j] * rstd * gg + bb; }
    }
}

constexpr int NPHASE = 15;
__global__ void __launch_bounds__(NTHR, 2) fwd_kernel(Params prm) {
    extern __shared__ __attribute__((aligned(16))) unsigned char lds_raw[];
    Frame F; F.lds = (LAS unsigned char*)lds_raw; F.tid = threadIdx.x; F.lane = F.tid & 63; F.wave = __builtin_amdgcn_readfirstlane(F.tid >> 6); F.G = gridDim.x; F.bid = blockIdx.x; F.p = &prm;
    unsigned char* ws = prm.ws;
    const int lo = prm.ph_lo, hi = prm.ph_hi;
#define IN(k) (lo <= (k) && (k) < hi)
#define SEAM(k) do { if (IN(k) && IN((k) + 1)) { cg::this_grid().sync(); } } while (0)
    const bf16_t* Zc = (const bf16_t*)(ws + WS_Z);

    if (IN(0)) { phase_prep(F); } SEAM(0);
    if (IN(1)) {
        pg8::StaticOrder S{NTOK / 256, INCOLS / 256, F.G, F.bid, (const char*)(ws + WS_XB), (const char*)(ws + WS_WIN), (size_t)256 * D * 2, (size_t)256 * D * 2, 0};
        EpiBf16 E{(bf16_t*)(ws + WS_Z), INCOLS, prm.in[I_BGATE], GATE0 / 256, GATE0};
        pg8::gemm_phase<EpiBf16, pg8::StaticOrder, true, true>(F.lds, D, D, D, S, E);
    } SEAM(1);
    if (IN(2)) {
        pg8::StaticOrder S{NMEM / 256, 2 * D / 256, F.G, F.bid, (const char*)(ws + WS_MEMB), (const char*)(ws + WS_WKV), (size_t)256 * D * 2, (size_t)256 * D * 2, 0};
        EpiBf16 E{(bf16_t*)(ws + WS_KV), 2 * D, nullptr, 1 << 30, 0};
        pg8::gemm_phase<EpiBf16, pg8::StaticOrder, true, true>(F.lds, D, D, D, S, E);
    } SEAM(2);
    if (IN(3)) { phase_convpool(F); } SEAM(3);
    if (IN(4)) { phase_attn_naive(F); } SEAM(4);
    if (IN(5)) {
        pg8::StaticOrder S{NTOK / 256, D / 256, F.G, F.bid, (const char*)(ws + WS_ACONV), (const char*)(ws + WS_WC), (size_t)256 * D * 2, (size_t)256 * D * 2, 0};
        EpiMerge<0> E{(bf16_t*)(ws + WS_MERGED), Zc, GATE0, nullptr};
        pg8::gemm_phase<EpiMerge<0>, pg8::StaticOrder, true, true>(F.lds, D, D, D, S, E);
    } SEAM(5);
    if (IN(6)) {
        pg8::StaticOrder S{NTOK / 256, D / 256, F.G, F.bid, (const char*)(ws + WS_DPOOL), (const char*)(ws + WS_WP), (size_t)256 * D * 2, (size_t)256 * 256 * 2, (size_t)256 * 2};
        EpiMerge<1> E{(bf16_t*)(ws + WS_MERGED), Zc, GATE0 + D, prm.in[I_PSCALE]};
        pg8::gemm_phase<EpiMerge<1>, pg8::StaticOrder, true, true>(F.lds, 256, D, 256, S, E);
    } SEAM(6);
    if (IN(7)) {
        pg8::StaticOrder S{NTOK / 256, D / 256, F.G, F.bid, (const char*)(ws + WS_O), (const char*)(ws + WS_WXO), (size_t)256 * D * 2, (size_t)256 * D * 2, 0};
        EpiMerge<1> E{(bf16_t*)(ws + WS_MERGED), Zc, GATE0 + 2 * D, nullptr};
        pg8::gemm_phase<EpiMerge<1>, pg8::StaticOrder, true, true>(F.lds, D, D, D, S, E);
    } SEAM(7);
    if (IN(8)) {
        pg8::StaticOrder S{NTOK / 256, D / 256, F.G, F.bid, (const char*)(ws + WS_MERGED), (const char*)(ws + WS_WO), (size_t)256 * D * 2, (size_t)256 * D * 2, 0};
        EpiResF32 E{(float*)(ws + WS_H1), prm.in[I_X], ALPHA};
        pg8::gemm_phase<EpiResF32, pg8::StaticOrder, true, true>(F.lds, D, D, D, S, E);
    } SEAM(8);
    if (IN(9)) { phase_ln1_router(F); } SEAM(9);
    if (IN(10)) { phase_scan(F); } SEAM(10);
    if (IN(11)) { phase_gather(F); } SEAM(11);
    if (IN(12)) {
        const int ntl = *(const int*)(ws + WS_MISC + MS_NTILES);
        pg8::MoeOrder S{ntl, 4, F.G, F.bid, (const char*)(ws + WS_XBUF), (const char*)(ws + WS_WUP), (size_t)256 * D * 2, (size_t)256 * D * 2, (size_t)D * D * 2, (const int*)(ws + WS_MISC + MS_TILEE)};
        EpiAct E{(bf16_t*)(ws + WS_ACT)};
        pg8::gemm_phase<EpiAct, pg8::MoeOrder, true, true>(F.lds, D, D, D, S, E);
    } SEAM(12);
    if (IN(13)) {
        const int ntl = *(const int*)(ws + WS_MISC + MS_NTILES);
        pg8::MoeOrder S{ntl, 4, F.G, F.bid, (const char*)(ws + WS_ACT), (const char*)(ws + WS_WDN), (size_t)256 * DEXP * 2, (size_t)256 * DEXP * 2, (size_t)D * DEXP * 2, (const int*)(ws + WS_MISC + MS_TILEE)};
        EpiBf16 E{(bf16_t*)(ws + WS_YBUF), D, nullptr, 1 << 30, 0};
        pg8::gemm_phase<EpiBf16, pg8::MoeOrder, true, true>(F.lds, DEXP, DEXP, DEXP, S, E);
    } SEAM(13);
    if (IN(14)) { phase_combine(F); }
#undef IN
#undef SEAM
}

extern "C" void kernel_launch(void* const* d_in, const int* in_sizes, int n_in, void* d_out, int out_size, void* d_ws, size_t ws_size, hipStream_t stream) {
    static int grid = 0;
    if (grid == 0) {
        if (n_in != 21 || out_size != NTOK * D || ws_size < WS_END) { fprintf(stderr, "kernel_launch: unexpected shapes (n_in %d out %d ws %zu, need ws >= %zu)\n", n_in, out_size, ws_size, (size_t)WS_END); grid = -1; return; }
        int dev = 0, cus = 0, per_cu = 0;
        if (hipGetDevice(&dev) != hipSuccess || hipDeviceGetAttribute(&cus, hipDeviceAttributeMultiprocessorCount, dev) != hipSuccess) { grid = -1; return; }
        if (hipFuncSetAttribute((const void*)fwd_kernel, hipFuncAttributeMaxDynamicSharedMemorySize, LDS_BYTES) != hipSuccess) { fprintf(stderr, "kernel_launch: hipFuncSetAttribute failed\n"); grid = -1; return; }
        if (hipOccupancyMaxActiveBlocksPerMultiprocessor(&per_cu, (const void*)fwd_kernel, NTHR, LDS_BYTES) != hipSuccess || per_cu < 1) { fprintf(stderr, "kernel_launch: occupancy query says %d\n", per_cu); (void)hipGetLastError(); per_cu = 1; }
        grid = cus * 1;
        fprintf(stderr, "kernel_launch: cus %d per_cu %d grid %d\n", cus, per_cu, grid);
    }
    if (grid < 0) return;
    (void)hipMemsetAsync((char*)d_ws + WS_CTL, 0, CTL_ZERO_BYTES, stream);
    Params a{};
    for (int i = 0; i < 21; ++i) a.in[i] = (const float*)d_in[i];
    a.out = (float*)d_out; a.ws = (unsigned char*)d_ws;
#if MK_ONE_LAUNCH
    a.ph_lo = 0; a.ph_hi = NPHASE;
    void* args[] = {&a};
    hipError_t e = hipLaunchCooperativeKernel((const void*)fwd_kernel, dim3(grid), dim3(NTHR), args, LDS_BYTES, stream);
    if (e != hipSuccess) fprintf(stderr, "cooperative launch failed: %s (grid %d)\n", hipGetErrorString(e), grid);
#else
    for (int ph = 0; ph < NPHASE; ++ph) {
        a.ph_lo = ph; a.ph_hi = ph + 1;
        hipLaunchKernelGGL(fwd_kernel, dim3(grid), dim3(NTHR), LDS_BYTES, stream, a);
    }
#endif
}
```

```cpp
#include <hip/hip_runtime.h>
#include <hip/hip_cooperative_groups.h>
#include <cstdio>
#include <cstdint>
namespace cg = cooperative_groups;

#ifndef MK_ONE_LAUNCH
#define MK_ONE_LAUNCH 1
#endif

namespace pg8 {
#define PG8_LAS __attribute__((address_space(3)))
typedef unsigned short bf16_t;
typedef short bf16x8 __attribute__((ext_vector_type(8)));
typedef float f32x4 __attribute__((ext_vector_type(4)));
typedef float f32x2 __attribute__((ext_vector_type(2)));
typedef unsigned u32x4 __attribute__((ext_vector_type(4)));
typedef unsigned u32x2 __attribute__((ext_vector_type(2)));
constexpr int BM = 256, BK = 64, HALF = 128, HTB = HALF * BK * 2  , STAGE_BYTES = 8 * HTB, NXCD = 8, WGM = 8;

__host__ __device__ __forceinline__ int lds_byte(int r, int c) { const int st = (r >> 4) * 2 + (c >> 5), rr = r & 15, cc = c & 31, ob = rr * 64 + cc * 2; return st * 1024 + (ob ^ (((ob >> 9) & 1) << 5)); }
__host__ __device__ __forceinline__ void stage_rc(int b, int& R, int& C) { const int st = b / 1024, sb = b % 1024, swz = sb ^ (((sb >> 9) & 1) << 5); R = (st >> 1) * 16 + swz / 64; C = (st & 1) * 32 + (swz % 64) / 2; }
__host__ __device__ __forceinline__ int perm32(int rho) { const int n = rho >> 4, i = rho & 15; return 8 * (i >> 2) + 4 * n + (i & 3); }

struct Unit { int pm, pn; const char* a; const char* b; };

__device__ __forceinline__ void tile_of(int L, int nM, int nN, int& pm, int& pn) {
    const int nwg = nM * nN; int wgid = L;
    { const int q = nwg / NXCD, r = nwg % NXCD, xcd = wgid % NXCD, off = wgid / NXCD; wgid = (xcd < r ? xcd * (q + 1) : r * (q + 1) + (xcd - r) * q) + off; }
    const int nig = WGM * nN, gid = wgid / nig, fm = gid * WGM, gsz = (nM - fm) < WGM ? (nM - fm) : WGM;
    pm = fm + ((wgid % nig) % gsz); pn = (wgid % nig) / gsz;
}
struct StaticOrder {
    int nM, nN, G, c; const char* A; const char* B; size_t tA, tB, aN;
    __device__ __forceinline__ bool next(int i, Unit& u) const {
        const long L = (long)i * G + c; if (L >= (long)nM * nN) return false;
        tile_of((int)L, nM, nN, u.pm, u.pn);
        u.a = A + (size_t)u.pm * tA + (size_t)u.pn * aN; u.b = B + (size_t)u.pn * tB; return true;
    }
};
struct MoeOrder {
    int nM, nN, G, c; const char* A; const char* B; size_t tA, tB, eB; const int* tile_expert;
    __device__ __forceinline__ bool next(int i, Unit& u) const {
        const long L = (long)i * G + c; if (L >= (long)nM * nN) return false;
        tile_of((int)L, nM, nN, u.pm, u.pn);
        const int e = __builtin_amdgcn_readfirstlane(tile_expert[u.pm]);
        u.a = A + (size_t)u.pm * tA; u.b = B + (size_t)e * eB + (size_t)u.pn * tB; return true;
    }
};

__device__ __forceinline__ unsigned cvt_pk_bf16(float lo, float hi) { unsigned r; asm volatile("v_cvt_pk_bf16_f32 %0, %1, %2" : "=v"(r) : "v"(lo), "v"(hi)); return r; }
__device__ __forceinline__ float bf_lo(unsigned w) { return __uint_as_float(w << 16); }
__device__ __forceinline__ float bf_hi(unsigned w) { return __uint_as_float(w & 0xffff0000u); }

template <class Epi, class Sched, bool ALIGN_EPI = false, bool SP2 = false>
__device__ __forceinline__ void gemm_phase(PG8_LAS unsigned char* lds, const int K, const int lda, const int ldb, const Sched& S, const Epi& E) {
    const int tid = threadIdx.x, wid = __builtin_amdgcn_readfirstlane(tid >> 6), lane = tid & 63, wr = wid >> 2, wc = wid & 3, fr = lane & 15, fq = lane >> 4;
    const int nt = K / BK;
    unsigned voffA[2], voffB[2];
#pragma unroll
    for (int i = 0; i < 2; ++i) { int R, C; stage_rc(tid * 16 + i * 8192, R, C); const int Rb = Epi::PERM ? ((R & ~31) + perm32(R & 31)) : R;
        voffA[i] = (unsigned)(R * lda + C) * 2u; voffB[i] = (unsigned)(Rb * ldb + C) * 2u; }
    const size_t kstep = (size_t)(BK * 2);
    const size_t hstepA = (size_t)HALF * lda * 2, hstepB = (size_t)HALF * ldb * 2;
    const unsigned ldsw = (unsigned)wid * 1024u;
    const int aoff = lds_byte(wr * 64 + fr, fq * 8), boff = lds_byte(wc * 32 + fr, fq * 8);
#define PG8_SA(b, h) (((b) * 2 + (h)) * HTB)
#define PG8_SB(b, h) ((4 + (b) * 2 + (h)) * HTB)
#define PG8_STAGE(bufoff, gbase, voff) do { _Pragma("unroll") for (int _i = 0; _i < 2; ++_i) \
        __builtin_amdgcn_global_load_lds((const unsigned*)((const char*)(gbase) + (voff)[_i]), (PG8_LAS unsigned*)(lds + (bufoff) + ldsw + _i * 8192), 16, 0, 0); } while (0)
#define PG8_LDA(dst, b, h) do { _Pragma("unroll") for (int m = 0; m < 4; ++m) _Pragma("unroll") for (int k = 0; k < 2; ++k) dst[m][k] = *(const PG8_LAS bf16x8*)(lds + PG8_SA(b, h) + aoff + m * 2048 + k * 1024); } while (0)
#define PG8_LDB(dst, b, h) do { _Pragma("unroll") for (int n = 0; n < 2; ++n) _Pragma("unroll") for (int k = 0; k < 2; ++k) dst[n][k] = *(const PG8_LAS bf16x8*)(lds + PG8_SB(b, h) + boff + n * 2048 + k * 1024); } while (0)
#define PG8_MMA(ai, bj, At, Bt) do { __builtin_amdgcn_s_setprio(1); _Pragma("unroll") for (int m = 0; m < 4; ++m) _Pragma("unroll") for (int n = 0; n < 2; ++n) _Pragma("unroll") for (int k = 0; k < 2; ++k) \
        acc[ai][bj][m][n] = __builtin_amdgcn_mfma_f32_16x16x32_bf16(Bt[n][k], At[m][k], acc[ai][bj][m][n], 0, 0, 0); __builtin_amdgcn_s_setprio(0); } while (0)
#define PG8_WAIT_V(n) asm volatile("s_waitcnt vmcnt(" #n ")" ::: "memory")
#define PG8_WAIT_L(n) asm volatile("s_waitcnt lgkmcnt(" #n ")" ::: "memory")
#define PG8_BAR __builtin_amdgcn_s_barrier()
#define PG8_SCHED __builtin_amdgcn_sched_barrier(0)
    Unit cur, nxt; int ui = 0;
    if (!S.next(0, cur)) return;
    f32x4 acc[2][2][4][2];
#pragma unroll
    for (int a = 0; a < 2; ++a)
#pragma unroll
        for (int b = 0; b < 2; ++b)
#pragma unroll
            for (int m = 0; m < 4; ++m)
#pragma unroll
                for (int n = 0; n < 2; ++n) acc[a][b][m][n] = (f32x4){0.f, 0.f, 0.f, 0.f};
    bf16x8 At[4][2], B0[2][2], B1[2][2];
    const char* cA = cur.a; const char* cB = cur.b;
    if constexpr (SP2) {
        PG8_STAGE(PG8_SB(0, 0), cB, voffB); PG8_STAGE(PG8_SB(0, 1), cB + hstepB, voffB); PG8_STAGE(PG8_SA(0, 0), cA, voffA); PG8_STAGE(PG8_SA(0, 1), cA + hstepA, voffA);
        if (wr == 1) PG8_BAR;
        PG8_WAIT_V(2); PG8_BAR;
        PG8_STAGE(PG8_SB(1, 0), cB + kstep, voffB); PG8_STAGE(PG8_SA(1, 0), cA + kstep, voffA); PG8_STAGE(PG8_SB(1, 1), cB + hstepB + kstep, voffB);
        PG8_WAIT_V(6); PG8_BAR;
    } else {
        PG8_STAGE(PG8_SB(0, 0), cB, voffB); PG8_STAGE(PG8_SA(0, 0), cA, voffA); PG8_STAGE(PG8_SB(0, 1), cB + hstepB, voffB); PG8_STAGE(PG8_SA(0, 1), cA + hstepA, voffA);
        if (wr == 1) PG8_BAR;
        PG8_WAIT_V(4); PG8_BAR;
        PG8_STAGE(PG8_SB(1, 0), cB + kstep, voffB); PG8_STAGE(PG8_SA(1, 0), cA + kstep, voffA); PG8_STAGE(PG8_SB(1, 1), cB + hstepB + kstep, voffB);
        PG8_WAIT_V(6); PG8_BAR;
    }
    for (;;) {
        const bool has_next = S.next(ui + 1, nxt);
        const char* nA = has_next ? nxt.a : cA; const char* nB = has_next ? nxt.b : cB;
        for (int t = 0; t < nt; t += 2) {
            const bool last = (t == nt - 2);
            const char* a1 = cA + (size_t)(t + 1) * kstep;
            const char* a2 = last ? nA : cA + (size_t)(t + 2) * kstep; const char* b2 = last ? nB : cB + (size_t)(t + 2) * kstep;
            const char* a3 = a2 + kstep; const char* b3 = b2 + kstep;
            if constexpr (SP2) {
            PG8_LDB(B0, 0, 0); PG8_LDB(B1, 0, 1); PG8_SCHED; PG8_LDA(At, 0, 0); PG8_STAGE(PG8_SA(1, 1), a1 + hstepA, voffA);
            PG8_WAIT_V(8); PG8_WAIT_L(0); PG8_BAR; PG8_MMA(0, 0, At, B0); PG8_MMA(0, 1, At, B1); PG8_BAR; PG8_SCHED;
            PG8_LDA(At, 0, 1); PG8_STAGE(PG8_SB(0, 0), b2, voffB); PG8_STAGE(PG8_SB(0, 1), b2 + hstepB, voffB); PG8_STAGE(PG8_SA(0, 0), a2, voffA);
            PG8_WAIT_V(8); PG8_WAIT_L(0); PG8_BAR; PG8_MMA(1, 0, At, B0); PG8_MMA(1, 1, At, B1); PG8_BAR; PG8_SCHED;
            PG8_LDB(B0, 1, 0); PG8_LDB(B1, 1, 1); PG8_SCHED; PG8_LDA(At, 1, 0); PG8_STAGE(PG8_SA(0, 1), a2 + hstepA, voffA);
            PG8_WAIT_V(8); PG8_WAIT_L(0); PG8_BAR; PG8_MMA(0, 0, At, B0); PG8_MMA(0, 1, At, B1); PG8_BAR; PG8_SCHED;
            PG8_LDA(At, 1, 1); PG8_STAGE(PG8_SB(1, 0), b3, voffB); PG8_STAGE(PG8_SB(1, 1), b3 + hstepB, voffB); PG8_STAGE(PG8_SA(1, 0), a3, voffA);
            PG8_WAIT_V(8); PG8_WAIT_L(0); PG8_BAR; PG8_MMA(1, 0, At, B0); PG8_MMA(1, 1, At, B1); PG8_BAR; PG8_SCHED;
            } else {
            PG8_LDB(B0, 0, 0); PG8_SCHED; PG8_LDA(At, 0, 0); PG8_STAGE(PG8_SA(1, 1), a1 + hstepA, voffA);
            PG8_WAIT_L(8); PG8_BAR; PG8_WAIT_L(0); PG8_MMA(0, 0, At, B0); PG8_BAR; PG8_SCHED;
            PG8_LDB(B1, 0, 1); PG8_STAGE(PG8_SB(0, 0), b2, voffB);
            PG8_BAR; PG8_WAIT_L(0); PG8_MMA(0, 1, At, B1); PG8_BAR;
            PG8_LDA(At, 0, 1); PG8_STAGE(PG8_SA(0, 0), a2, voffA);
            PG8_BAR; PG8_WAIT_L(0); PG8_MMA(1, 0, At, B0); PG8_BAR; PG8_SCHED;
            PG8_STAGE(PG8_SB(0, 1), b2 + hstepB, voffB);
            PG8_WAIT_V(6); PG8_BAR; PG8_MMA(1, 1, At, B1); PG8_BAR;
            PG8_LDB(B0, 1, 0); PG8_SCHED; PG8_LDA(At, 1, 0); PG8_STAGE(PG8_SA(0, 1), a2 + hstepA, voffA);
            PG8_WAIT_L(8); PG8_BAR; PG8_WAIT_L(0); PG8_MMA(0, 0, At, B0); PG8_BAR; PG8_SCHED;
            PG8_LDB(B1, 1, 1); PG8_STAGE(PG8_SB(1, 0), b3, voffB);
            PG8_BAR; PG8_WAIT_L(0); PG8_MMA(0, 1, At, B1); PG8_BAR;
            PG8_LDA(At, 1, 1); PG8_STAGE(PG8_SA(1, 0), a3, voffA);
            PG8_BAR; PG8_WAIT_L(0); PG8_MMA(1, 0, At, B0); PG8_BAR; PG8_SCHED;
            PG8_STAGE(PG8_SB(1, 1), b3 + hstepB, voffB);
            PG8_WAIT_V(6); PG8_BAR; PG8_MMA(1, 1, At, B1); PG8_BAR;
            }
        }
        if constexpr (ALIGN_EPI) { if (wr == 0) PG8_BAR; }
        E(acc, cur, wr, wc, fr, fq);
        if (!has_next) break;
#pragma unroll
        for (int a = 0; a < 2; ++a)
#pragma unroll
            for (int b = 0; b < 2; ++b)
#pragma unroll
                for (int m = 0; m < 4; ++m)
#pragma unroll
                    for (int n = 0; n < 2; ++n) acc[a][b][m][n] = (f32x4){0.f, 0.f, 0.f, 0.f};
        cur = nxt; cA = nA; cB = nB; ++ui;
        if constexpr (ALIGN_EPI) { if (wr == 1) PG8_BAR; }
    }
    PG8_WAIT_V(0);
    if constexpr (!ALIGN_EPI) { if (wr == 0) PG8_BAR; }
    PG8_BAR;
#undef PG8_SA
#undef PG8_SB
#undef PG8_STAGE
#undef PG8_LDA
#undef PG8_LDB
#undef PG8_MMA
#undef PG8_WAIT_V
#undef PG8_WAIT_L
#undef PG8_BAR
#undef PG8_SCHED
}
}
using pg8::bf16_t; using pg8::f32x4; using pg8::f32x2; using pg8::u32x4; using pg8::u32x2; using pg8::Unit; using pg8::cvt_pk_bf16; using pg8::bf_lo; using pg8::bf_hi;
#define LAS __attribute__((address_space(3)))

constexpr int D = 1024, BATCH = 8, SEQ = 4096, NTOK = BATCH * SEQ, MEMLEN = 256, NMEM = BATCH * MEMLEN;
constexpr int INCOLS = 8192, GATE0 = 5120;
constexpr int NEXP = 64, DEXP = 512, NGRP = 8, EPG = 8;
constexpr int NASSIGN = NTOK * 2, PMAX_TILES = 320, PMAX = PMAX_TILES * 256;
constexpr float ALPHA = 1.189207115002721f;
constexpr float LN_EPS = 1e-5f;
constexpr int NWAVES = 8, NTHR = 512;

constexpr size_t MiB = 1u << 20;
constexpr size_t WS_CTL = 0, CTL_ZERO_BYTES = 1 * MiB;
constexpr size_t WS_WIN = 1 * MiB, WS_WKV = 17 * MiB, WS_WC = 21 * MiB, WS_WXO = 23 * MiB, WS_WO = 25 * MiB, WS_WP = 27 * MiB, WS_WR = 28 * MiB;
constexpr size_t WS_WUP = 29 * MiB, WS_WDN = 157 * MiB, WS_MISC = 221 * MiB;
constexpr size_t WS_Z = 224 * MiB;
constexpr size_t WS_XB = 736 * MiB, WS_MEMB = 800 * MiB, WS_KV = 804 * MiB, WS_ACONV = 812 * MiB, WS_DPOOL = 876 * MiB, WS_MERGED = 940 * MiB;
constexpr size_t WS_O = WS_XB;
constexpr size_t WS_H1 = 224 * MiB;
constexpr size_t WS_H1B = 480 * MiB;
constexpr size_t WS_XBUF = 544 * MiB;
constexpr size_t WS_ACT = 736 * MiB;
constexpr size_t WS_YBUF = 816 * MiB;
constexpr size_t WS_END = 1004 * MiB;
constexpr size_t MS_TOKE = 0, MS_TOKPOS = MS_TOKE + NASSIGN * 4, MS_TOKW = MS_TOKPOS + NASSIGN * 4, MS_TOKDEST = MS_TOKW + NASSIGN * 4, MS_TILEE = MS_TOKDEST + NASSIGN * 4, MS_PSTART = MS_TILEE + 4096, MS_NTILES = MS_PSTART + 1024;
constexpr int CW_COUNTS = 1024;
constexpr int CW_BAR = 4096;

constexpr int LDS_BYTES = 147456;

struct Params { const float* in[21]; float* out; unsigned char* ws; int ph_lo, ph_hi; };
enum { I_X = 0, I_MEM, I_WIN, I_BGATE, I_CONVW, I_WCONV, I_WPOOL, I_PSCALE, I_WKV, I_WXO, I_WO, I_LN1G, I_LN1B, I_WRG, I_BRG, I_WRE, I_BRE, I_WUP, I_WDN, I_LN2G, I_LN2B };

__device__ __forceinline__ unsigned f2bf(float f) { unsigned u = __float_as_uint(f); return (u + 0x7fffu + ((u >> 16) & 1u)) >> 16; }
__device__ __forceinline__ unsigned pk2(float lo, float hi) { return f2bf(lo) | (f2bf(hi) << 16); }
__device__ __forceinline__ float wave_sum(float v) {
#pragma unroll
    for (int o = 1; o < 64; o <<= 1) v += __shfl_xor(v, o);
    return v;
}
__device__ __forceinline__ float sigmoidf_(float x) { return __builtin_amdgcn_rcpf(1.0f + __expf(-x)); }

struct EpiBf16 {
    static constexpr bool PERM = true;
    bf16_t* O; int ldc; const float* bias; int gate_pn; int gate_col0;
    __device__ __forceinline__ void operator()(const f32x4 (&acc)[2][2][4][2], const Unit& u, int wr, int wc, int fr, int fq) const {
        const int row0 = u.pm * 256 + wr * 64 + fr, col0 = u.pn * 256 + wc * 32 + 8 * fq;
        const bool gate = u.pn >= gate_pn;
        f32x4 bv[2][2];
#pragma unroll
        for (int bj = 0; bj < 2; ++bj)
#pragma unroll
            for (int n = 0; n < 2; ++n) bv[bj][n] = gate ? *(const f32x4*)(bias + (col0 - gate_col0) + bj * 128 + 4 * n) : (f32x4){0.f, 0.f, 0.f, 0.f};
#pragma unroll
        for (int ai = 0; ai < 2; ++ai)
#pragma unroll
            for (int m = 0; m < 4; ++m) { bf16_t* rowp = O + (size_t)(row0 + ai * 128 + m * 16) * ldc + col0;
#pragma unroll
                for (int bj = 0; bj < 2; ++bj) { f32x4 v0 = acc[ai][bj][m][0] + bv[bj][0], v1 = acc[ai][bj][m][1] + bv[bj][1];
                    if (gate) {
#pragma unroll
                        for (int j = 0; j < 4; ++j) { v0[j] = sigmoidf_(v0[j]); v1[j] = sigmoidf_(v1[j]); } }
                    u32x4 w; w.x = cvt_pk_bf16(v0[0], v0[1]); w.y = cvt_pk_bf16(v0[2], v0[3]); w.z = cvt_pk_bf16(v1[0], v1[1]); w.w = cvt_pk_bf16(v1[2], v1[3]);
                    *(u32x4*)(rowp + bj * 128) = w; } }
    }
};
template <int MODE> struct EpiMerge {
    static constexpr bool PERM = true;
    bf16_t* Mg; const bf16_t* Z; int gcol0; const float* scale;
    __device__ __forceinline__ void operator()(const f32x4 (&acc)[2][2][4][2], const Unit& u, int wr, int wc, int fr, int fq) const {
        const int row0 = u.pm * 256 + wr * 64 + fr, col0 = u.pn * 256 + wc * 32 + 8 * fq;
        f32x4 sv[2][2];
#pragma unroll
        for (int bj = 0; bj < 2; ++bj)
#pragma unroll
            for (int n = 0; n < 2; ++n) sv[bj][n] = scale ? *(const f32x4*)(scale + col0 + bj * 128 + 4 * n) : (f32x4){1.f, 1.f, 1.f, 1.f};
#pragma unroll
        for (int ai = 0; ai < 2; ++ai)
#pragma unroll
            for (int m = 0; m < 4; ++m) { const size_t row = (size_t)(row0 + ai * 128 + m * 16);
#pragma unroll
                for (int bj = 0; bj < 2; ++bj) {
                    const u32x4 g = *(const u32x4*)(Z + row * INCOLS + gcol0 + col0 + bj * 128);
                    f32x4 v0 = acc[ai][bj][m][0] * sv[bj][0], v1 = acc[ai][bj][m][1] * sv[bj][1];
                    v0[0] *= bf_lo(g.x); v0[1] *= bf_hi(g.x); v0[2] *= bf_lo(g.y); v0[3] *= bf_hi(g.y);
                    v1[0] *= bf_lo(g.z); v1[1] *= bf_hi(g.z); v1[2] *= bf_lo(g.w); v1[3] *= bf_hi(g.w);
                    u32x4* mp = (u32x4*)(Mg + row * D + col0 + bj * 128);
                    if (MODE) { const u32x4 o = *mp;
                        v0[0] += bf_lo(o.x); v0[1] += bf_hi(o.x); v0[2] += bf_lo(o.y); v0[3] += bf_hi(o.y);
                        v1[0] += bf_lo(o.z); v1[1] += bf_hi(o.z); v1[2] += bf_lo(o.w); v1[3] += bf_hi(o.w); }
                    u32x4 w; w.x = cvt_pk_bf16(v0[0], v0[1]); w.y = cvt_pk_bf16(v0[2], v0[3]); w.z = cvt_pk_bf16(v1[0], v1[1]); w.w = cvt_pk_bf16(v1[2], v1[3]);
                    *mp = w; } }
    }
};
struct EpiResF32 {
    static constexpr bool PERM = false;
    float* O; const float* base; float alpha;
    __device__ __forceinline__ void operator()(const f32x4 (&acc)[2][2][4][2], const Unit& u, int wr, int wc, int fr, int fq) const {
        const int row0 = u.pm * 256 + wr * 64 + fr, col0 = u.pn * 256 + wc * 32 + 4 * fq;
#pragma unroll
        for (int ai = 0; ai < 2; ++ai)
#pragma unroll
            for (int m = 0; m < 4; ++m) { const size_t off = (size_t)(row0 + ai * 128 + m * 16) * D + col0;
#pragma unroll
                for (int bj = 0; bj < 2; ++bj)
#pragma unroll
                    for (int n = 0; n < 2; ++n) { const f32x4 bs = *(const f32x4*)(base + off + bj * 128 + n * 16); *(f32x4*)(O + off + bj * 128 + n * 16) = bs * alpha + acc[ai][bj][m][n]; } }
    }
};
struct EpiAct {
    static constexpr bool PERM = true;
    bf16_t* O;
    __device__ __forceinline__ void operator()(const f32x4 (&acc)[2][2][4][2], const Unit& u, int wr, int wc, int fr, int fq) const {
        const int row0 = u.pm * 256 + wr * 64 + fr, col0 = u.pn * 128 + wc * 32 + 8 * fq;
#pragma unroll
        for (int ai = 0; ai < 2; ++ai)
#pragma unroll
            for (int m = 0; m < 4; ++m) { bf16_t* rowp = O + (size_t)(row0 + ai * 128 + m * 16) * DEXP + col0;
                f32x4 r0, r1;
#pragma unroll
                for (int j = 0; j < 4; ++j) { const float g0 = acc[ai][0][m][0][j], g1 = acc[ai][0][m][1][j];
                    r0[j] = g0 * sigmoidf_(g0) * acc[ai][1][m][0][j]; r1[j] = g1 * sigmoidf_(g1) * acc[ai][1][m][1][j]; }
                u32x4 w; w.x = cvt_pk_bf16(r0[0], r0[1]); w.y = cvt_pk_bf16(r0[2], r0[3]); w.z = cvt_pk_bf16(r1[0], r1[1]); w.w = cvt_pk_bf16(r1[2], r1[3]);
                *(u32x4*)rowp = w; }
    }
};

struct Frame {
    LAS unsigned char* lds; int tid, lane, wave, G, bid;
    const Params* p;
};

__device__ __forceinline__ void transpose_item(const float* W, int ldw, int k0, int n0, bf16_t* WT, int ldt, int drow0, int dcol0, LAS float* scr, int lane) {
#pragma unroll 8
    for (int i = 0; i < 32; ++i) { const int kk = 2 * i + (lane >> 5); scr[kk * 33 + (lane & 31)] = W[(size_t)(k0 + kk) * ldw + n0 + (lane & 31)]; }
    asm volatile("s_waitcnt lgkmcnt(0)" ::: "memory");
    const int c = lane & 7;
#pragma unroll
    for (int j = 0; j < 4; ++j) { const int n = (lane >> 3) + 8 * j; const LAS float* s = scr + (8 * c) * 33 + n;
        u32x4 o; o.x = pk2(s[0 * 33], s[1 * 33]); o.y = pk2(s[2 * 33], s[3 * 33]); o.z = pk2(s[4 * 33], s[5 * 33]); o.w = pk2(s[6 * 33], s[7 * 33]);
        *(u32x4*)(WT + (size_t)(drow0 + n) * ldt + dcol0 + 8 * c) = o; }
    asm volatile("s_waitcnt lgkmcnt(0)" ::: "memory");
}

__device__ __forceinline__ void phase_prep(const Frame& F) {
    const Params& P = *F.p; unsigned char* ws = P.ws;
    LAS float* scr = (LAS float*)(F.lds + F.wave * 16384);
    const int gw = F.bid * NWAVES + F.wave, NGW = F.G * NWAVES;
    constexpr int I_IN = 16 * 256, I_SQ = 16 * 32, I_KV = 16 * 64, I_P = 4 * 4 * 8, I_UP = NEXP * 16 * 32, I_DN = NEXP * 8 * 32;
    constexpr int NIT = I_IN + 3 * I_SQ + I_KV + I_P + I_UP + I_DN;
    for (int it = gw; it < NIT; it += NGW) {
        int r = it;
        if (r < I_IN) { const int kb = r / 256, nb = r % 256; transpose_item(P.in[I_WIN], INCOLS, 64 * kb, 32 * nb, (bf16_t*)(ws + WS_WIN), D, 32 * nb, 64 * kb, scr, F.lane); continue; } r -= I_IN;
        if (r < I_SQ) { const int kb = r / 32, nb = r % 32; transpose_item(P.in[I_WCONV], D, 64 * kb, 32 * nb, (bf16_t*)(ws + WS_WC), D, 32 * nb, 64 * kb, scr, F.lane); continue; } r -= I_SQ;
        if (r < I_SQ) { const int kb = r / 32, nb = r % 32; transpose_item(P.in[I_WXO], D, 64 * kb, 32 * nb, (bf16_t*)(ws + WS_WXO), D, 32 * nb, 64 * kb, scr, F.lane); continue; } r -= I_SQ;
        if (r < I_SQ) { const int kb = r / 32, nb = r % 32; transpose_item(P.in[I_WO], D, 64 * kb, 32 * nb, (bf16_t*)(ws + WS_WO), D, 32 * nb, 64 * kb, scr, F.lane); continue; } r -= I_SQ;
        if (r < I_KV) { const int kb = r / 64, nb = r % 64; transpose_item(P.in[I_WKV], 2 * D, 64 * kb, 32 * nb, (bf16_t*)(ws + WS_WKV), D, 32 * nb, 64 * kb, scr, F.lane); continue; } r -= I_KV;
        if (r < I_P) { const int g = r / 32, q = r % 32, kb = q / 8, nb = q % 8;
            transpose_item(P.in[I_WPOOL] + (size_t)g * 65536, 256, 64 * kb, 32 * nb, (bf16_t*)(ws + WS_WP) + (size_t)g * 65536, 256, 32 * nb, 64 * kb, scr, F.lane); continue; } r -= I_P;
        if (r < I_UP) { const int e = r / 512, q = r % 512, kb = q / 32, nb = q % 32; const int n0 = 32 * nb;
            const int j0 = n0 & 511, drow = (j0 >> 7) * 256 + (n0 >= 512 ? 128 : 0) + (j0 & 127);
            transpose_item(P.in[I_WUP] + (size_t)e * D * D, D, 64 * kb, n0, (bf16_t*)(ws + WS_WUP) + (size_t)e * D * D, D, drow, 64 * kb, scr, F.lane); continue; } r -= I_UP;
        { const int e = r / 256, q = r % 256, kb = q / 32, nb = q % 32;
            transpose_item(P.in[I_WDN] + (size_t)e * DEXP * D, D, 64 * kb, 32 * nb, (bf16_t*)(ws + WS_WDN) + (size_t)e * D * DEXP, DEXP, 32 * nb, 64 * kb, scr, F.lane); }
    }
    const size_t gt = (size_t)F.bid * NTHR + F.tid, NGT = (size_t)F.G * NTHR;
    { const f32x4* src = (const f32x4*)P.in[I_X]; u32x4* dst = (u32x4*)(ws + WS_XB);
      for (size_t i = gt; i < (size_t)NTOK * D / 8; i += NGT) { const f32x4 a = src[2 * i], b = src[2 * i + 1]; u32x4 o; o.x = pk2(a[0], a[1]); o.y = pk2(a[2], a[3]); o.z = pk2(b[0], b[1]); o.w = pk2(b[2], b[3]); dst[i] = o; } }
    { const f32x4* src = (const f32x4*)P.in[I_MEM]; u32x4* dst = (u32x4*)(ws + WS_MEMB);
      for (size_t i = gt; i < (size_t)NMEM * D / 8; i += NGT) { const f32x4 a = src[2 * i], b = src[2 * i + 1]; u32x4 o; o.x = pk2(a[0], a[1]); o.y = pk2(a[2], a[3]); o.z = pk2(b[0], b[1]); o.w = pk2(b[2], b[3]); dst[i] = o; } }
    { float* wr = (float*)(ws + WS_WR);
      for (size_t i = gt; i < (size_t)72 * D; i += NGT) { const int o = (int)(i / D), k = (int)(i % D); wr[i] = o < 8 ? P.in[I_WRG][(size_t)k * 8 + o] : P.in[I_WRE][(size_t)k * 64 + (o - 8)]; } }
}

__device__ __forceinline__ void phase_convpool(const Frame& F) {
    const Params& P = *F.p; unsigned char* ws = P.ws;
    const bf16_t* Z = (const bf16_t*)(ws + WS_Z); bf16_t* AC = (bf16_t*)(ws + WS_ACONV); bf16_t* DP = (bf16_t*)(ws + WS_DPOOL);
    const float* cw = P.in[I_CONVW];
    const size_t gt = (size_t)F.bid * NTHR + F.tid, NGT = (size_t)F.G * NTHR;
    for (size_t i = gt; i < (size_t)NTOK * (D / 8); i += NGT) {
        const int t = (int)(i >> 7), c0 = (int)(i & 127) * 8, s = t & (SEQ - 1);
        const bf16_t* zr = Z + (size_t)t * INCOLS;
        float v[8];
#pragma unroll
        for (int j = 0; j < 8; ++j) v[j] = 0.f;
#pragma unroll
        for (int d = 0; d < 3; ++d) {
            if (s - 2 + d >= 0) {
                const bf16_t* zz = zr - (size_t)(2 - d) * INCOLS;
                const u32x4 cc = *(const u32x4*)(zz + D + c0), hh = *(const u32x4*)(zz + 2 * D + c0);
                const f32x4 w0 = *(const f32x4*)(cw + d * D + c0), w1 = *(const f32x4*)(cw + d * D + c0 + 4);
                v[0] += w0[0] * bf_lo(cc.x) * bf_lo(hh.x); v[1] += w0[1] * bf_hi(cc.x) * bf_hi(hh.x); v[2] += w0[2] * bf_lo(cc.y) * bf_lo(hh.y); v[3] += w0[3] * bf_hi(cc.y) * bf_hi(hh.y);
                v[4] += w1[0] * bf_lo(cc.z) * bf_lo(hh.z); v[5] += w1[1] * bf_hi(cc.z) * bf_hi(hh.z); v[6] += w1[2] * bf_lo(cc.w) * bf_lo(hh.w); v[7] += w1[3] * bf_hi(cc.w) * bf_hi(hh.w);
            }
        }
        { const u32x4 bb = *(const u32x4*)(zr + c0);
          u32x4 o; o.x = pk2(v[0] * bf_lo(bb.x), v[1] * bf_hi(bb.x)); o.y = pk2(v[2] * bf_lo(bb.y), v[3] * bf_hi(bb.y)); o.z = pk2(v[4] * bf_lo(bb.z), v[5] * bf_hi(bb.z)); o.w = pk2(v[6] * bf_lo(bb.w), v[7] * bf_hi(bb.w));
          *(u32x4*)(AC + (size_t)t * D + c0) = o; }
        const int gi = c0 >> 8, w = 2 << gi, cnt = (s + 1) < w ? (s + 1) : w;
        float a[8];
#pragma unroll
        for (int j = 0; j < 8; ++j) a[j] = 0.f;
        const u32x4 p0 = *(const u32x4*)(zr + 3 * D + c0);
        for (int d = 0; d < cnt; ++d) {
            const u32x4 pp = *(const u32x4*)(zr - (size_t)d * INCOLS + 3 * D + c0);
            a[0] += bf_lo(pp.x); a[1] += bf_hi(pp.x); a[2] += bf_lo(pp.y); a[3] += bf_hi(pp.y); a[4] += bf_lo(pp.z); a[5] += bf_hi(pp.z); a[6] += bf_lo(pp.w); a[7] += bf_hi(pp.w);
        }
        const float inv = 1.0f / (float)cnt;
        u32x4 o; o.x = pk2(a[0] * inv - bf_lo(p0.x), a[1] * inv - bf_hi(p0.x)); o.y = pk2(a[2] * inv - bf_lo(p0.y), a[3] * inv - bf_hi(p0.y));
        o.z = pk2(a[4] * inv - bf_lo(p0.z), a[5] * inv - bf_hi(p0.z)); o.w = pk2(a[6] * inv - bf_lo(p0.w), a[7] * inv - bf_hi(p0.w));
        *(u32x4*)(DP + (size_t)t * D + c0) = o;
    }
}

__device__ __forceinline__ void phase_attn_naive(const Frame& F) {
    const Params& P = *F.p; unsigned char* ws = P.ws;
    const bf16_t* Z = (const bf16_t*)(ws + WS_Z); const bf16_t* KV = (const bf16_t*)(ws + WS_KV); bf16_t* O = (bf16_t*)(ws + WS_O);
    LAS float* qs = (LAS float*)F.lds;
    LAS float* sc = qs + 8 * 256;
    const int tid = F.tid, half = tid >> 8, m = tid & 255;
    for (int uidx = F.bid; uidx < (NTOK / 8) * 4; uidx += F.G) {
        const int h = uidx & 3, t0 = (uidx >> 2) * 8, b = t0 / SEQ;
        __syncthreads();
        for (int i = tid; i < 8 * 256; i += NTHR) { const int q = i >> 8, d = i & 255; qs[i] = __uint_as_float((unsigned)Z[(size_t)(t0 + q) * INCOLS + 4 * D + h * 256 + d] << 16); }
        __syncthreads();
        { const bf16_t* kr = KV + (size_t)(b * MEMLEN + m) * (2 * D) + h * 256;
          float s0 = 0.f, s1 = 0.f, s2 = 0.f, s3 = 0.f; const LAS float* q0 = qs + (half * 4) * 256;
          for (int d8 = 0; d8 < 32; ++d8) { const u32x4 kk = *(const u32x4*)(kr + d8 * 8);
              const float k0 = bf_lo(kk.x), k1 = bf_hi(kk.x), k2 = bf_lo(kk.y), k3 = bf_hi(kk.y), k4 = bf_lo(kk.z), k5 = bf_hi(kk.z), k6 = bf_lo(kk.w), k7 = bf_hi(kk.w);
              const LAS float* qq = q0 + d8 * 8;
              s0 += k0 * qq[0] + k1 * qq[1] + k2 * qq[2] + k3 * qq[3] + k4 * qq[4] + k5 * qq[5] + k6 * qq[6] + k7 * qq[7]; qq += 256;
              s1 += k0 * qq[0] + k1 * qq[1] + k2 * qq[2] + k3 * qq[3] + k4 * qq[4] + k5 * qq[5] + k6 * qq[6] + k7 * qq[7]; qq += 256;
              s2 += k0 * qq[0] + k1 * qq[1] + k2 * qq[2] + k3 * qq[3] + k4 * qq[4] + k5 * qq[5] + k6 * qq[6] + k7 * qq[7]; qq += 256;
              s3 += k0 * qq[0] + k1 * qq[1] + k2 * qq[2] + k3 * qq[3] + k4 * qq[4] + k5 * qq[5] + k6 * qq[6] + k7 * qq[7]; }
          LAS float* so = sc + (half * 4) * 256 + m; so[0] = s0 * 0.0625f; so[256] = s1 * 0.0625f; so[512] = s2 * 0.0625f; so[768] = s3 * 0.0625f; }
        __syncthreads();
        { LAS float* sr = sc + F.wave * 256; float v0 = sr[F.lane], v1 = sr[F.lane + 64], v2 = sr[F.lane + 128], v3 = sr[F.lane + 192];
          float mx = fmaxf(fmaxf(v0, v1), fmaxf(v2, v3));
#pragma unroll
          for (int o = 1; o < 64; o <<= 1) mx = fmaxf(mx, __shfl_xor(mx, o));
          v0 = __expf(v0 - mx); v1 = __expf(v1 - mx); v2 = __expf(v2 - mx); v3 = __expf(v3 - mx);
          const float inv = 1.0f / wave_sum(v0 + v1 + v2 + v3);
          sr[F.lane] = v0 * inv; sr[F.lane + 64] = v1 * inv; sr[F.lane + 128] = v2 * inv; sr[F.lane + 192] = v3 * inv; }
        __syncthreads();
        { const bf16_t* vr = KV + (size_t)(b * MEMLEN) * (2 * D) + D + h * 256 + m; const LAS float* pr = sc + (half * 4) * 256;
          float o0 = 0.f, o1 = 0.f, o2 = 0.f, o3 = 0.f;
          for (int k = 0; k < 256; ++k) { const float vv = __uint_as_float((unsigned)vr[(size_t)k * (2 * D)] << 16); o0 += pr[k] * vv; o1 += pr[256 + k] * vv; o2 += pr[512 + k] * vv; o3 += pr[768 + k] * vv; }
          bf16_t* op = O + (size_t)(t0 + half * 4) * D + h * 256 + m;
          op[0] = (bf16_t)f2bf(o0); op[D] = (bf16_t)f2bf(o1); op[2 * D] = (bf16_t)f2bf(o2); op[3 * D] = (bf16_t)f2bf(o3); }
    }
    __syncthreads();
}

__device__ __forceinline__ void phase_ln1_router(const Frame& F) {
    const Params& P = *F.p; unsigned char* ws = P.ws;
    float* H1 = (float*)(ws + WS_H1); bf16_t* H1B = (bf16_t*)(ws + WS_H1B); const float* WR = (const float*)(ws + WS_WR);
    unsigned* ctl = (unsigned*)(ws + WS_CTL);
    int* tok_e = (int*)(ws + WS_MISC + MS_TOKE); int* tok_pos = (int*)(ws + WS_MISC + MS_TOKPOS); float* tok_w = (float*)(ws + WS_MISC + MS_TOKW);
    LAS float* lg = (LAS float*)(F.lds + F.wave * 512);
    const int gw = F.bid * NWAVES + F.wave, NGW = F.G * NWAVES, lane = F.lane;
    const float* g1 = P.in[I_LN1G]; const float* b1 = P.in[I_LN1B];
    for (int row = gw; row < NTOK; row += NGW) {
        f32x4* xr = (f32x4*)(H1 + (size_t)row * D) + lane;
        f32x4 v[4]; float s = 0.f;
#pragma unroll
        for (int j = 0; j < 4; ++j) { v[j] = xr[64 * j]; s += (v[j][0] + v[j][1]) + (v[j][2] + v[j][3]); }
        const float mean = wave_sum(s) * (1.f / D); float s2 = 0.f;
#pragma unroll
        for (int j = 0; j < 4; ++j) { v[j] = v[j] - mean; s2 += (v[j][0] * v[j][0] + v[j][1] * v[j][1]) + (v[j][2] * v[j][2] + v[j][3] * v[j][3]); }
        const float rstd = 1.f / sqrtf(wave_sum(s2) * (1.f / D) + LN_EPS);
#pragma unroll
        for (int j = 0; j < 4; ++j) { const f32x4 gg = *((const f32x4*)g1 + lane + 64 * j), bb = *((const f32x4*)b1 + lane + 64 * j); v[j] = v[j] * rstd * gg + bb; xr[64 * j] = v[j];
            u32x2 o; o.x = pk2(v[j][0], v[j][1]); o.y = pk2(v[j][2], v[j][3]); *((u32x2*)(H1B + (size_t)row * D) + lane + 64 * j) = o; }
        for (int o = 0; o < 72; ++o) { const f32x4* wr = (const f32x4*)(WR + (size_t)o * D) + lane; float a = 0.f;
#pragma unroll
            for (int j = 0; j < 4; ++j) { const f32x4 w = wr[64 * j]; a += (v[j][0] * w[0] + v[j][1] * w[1]) + (v[j][2] * w[2] + v[j][3] * w[3]); }
            a = wave_sum(a); if (lane == 0) lg[o] = a; }
        asm volatile("s_waitcnt lgkmcnt(0)" ::: "memory");
        if (lane == 0) {
            const float* brg = P.in[I_BRG]; const float* bre = P.in[I_BRE];
            int gs = 0; float gm = lg[0] + brg[0];
            for (int i = 1; i < 8; ++i) { const float x = lg[i] + brg[i]; if (x > gm) { gm = x; gs = i; } }
            float den = 0.f; for (int i = 0; i < 8; ++i) den += __expf(lg[i] + brg[i] - gm);
            const float gwt = 1.0f / den;
            int i1 = 0; float l1 = lg[8 + gs * 8] + bre[gs * 8];
            for (int i = 1; i < 8; ++i) { const float x = lg[8 + gs * 8 + i] + bre[gs * 8 + i]; if (x > l1) { l1 = x; i1 = i; } }
            int i2 = -1; float l2 = 0.f;
            for (int i = 0; i < 8; ++i) { if (i == i1) continue; const float x = lg[8 + gs * 8 + i] + bre[gs * 8 + i]; if (i2 < 0 || x > l2) { l2 = x; i2 = i; } }
            const float e2 = __expf(l2 - l1), w1 = gwt / (1.0f + e2), w2 = gwt * e2 / (1.0f + e2);
            const int ea = gs * 8 + i1, eb = gs * 8 + i2;
            const int pa = (int)atomicAdd(ctl + CW_COUNTS + ea, 1u), pb = (int)atomicAdd(ctl + CW_COUNTS + eb, 1u);
            tok_e[2 * row] = ea; tok_e[2 * row + 1] = eb; tok_pos[2 * row] = pa; tok_pos[2 * row + 1] = pb; tok_w[2 * row] = w1; tok_w[2 * row + 1] = w2;
        }
    }
}

__device__ __forceinline__ void phase_scan(const Frame& F) {
    const Params& P = *F.p; unsigned char* ws = P.ws;
    if (F.bid == 0 && F.tid == 0) {
        const unsigned* cnt = (const unsigned*)(ws + WS_CTL) + CW_COUNTS;
        int* tile_e = (int*)(ws + WS_MISC + MS_TILEE); int* pstart = (int*)(ws + WS_MISC + MS_PSTART); int* ntl = (int*)(ws + WS_MISC + MS_NTILES);
        int run = 0;
        for (int e = 0; e < NEXP; ++e) { const int c = (int)__hip_atomic_load(cnt + e, __ATOMIC_RELAXED, __HIP_MEMORY_SCOPE_AGENT); pstart[e] = run * 256; const int nte = (c + 255) / 256; for (int k = 0; k < nte; ++k) tile_e[run + k] = e; run += nte; }
        ntl[0] = run;
    }
}

__device__ __forceinline__ void phase_gather(const Frame& F) {
    const Params& P = *F.p; unsigned char* ws = P.ws;
    const int* tok_e = (const int*)(ws + WS_MISC + MS_TOKE); const int* tok_pos = (const int*)(ws + WS_MISC + MS_TOKPOS); int* tok_dest = (int*)(ws + WS_MISC + MS_TOKDEST);
    const int* pstart = (const int*)(ws + WS_MISC + MS_PSTART);
    const bf16_t* H1B = (const bf16_t*)(ws + WS_H1B); bf16_t* XB = (bf16_t*)(ws + WS_XBUF);
    const int gw = F.bid * NWAVES + F.wave, NGW = F.G * NWAVES;
    for (int a = gw; a < NASSIGN; a += NGW) {
        const int dest = pstart[tok_e[a]] + tok_pos[a];
        const u32x4* src = (const u32x4*)(H1B + (size_t)(a >> 1) * D) + F.lane; u32x4* dst = (u32x4*)(XB + (size_t)dest * D) + F.lane;
        dst[0] = src[0]; dst[64] = src[64];
        if (F.lane == 0) tok_dest[a] = dest;
    }
}

__device__ __forceinline__ void phase_combine(const Frame& F) {
    const Params& P = *F.p; unsigned char* ws = P.ws;
    const float* H1 = (const float*)(ws + WS_H1); const bf16_t* YB = (const bf16_t*)(ws + WS_YBUF);
    const int* tok_dest = (const int*)(ws + WS_MISC + MS_TOKDEST); const float* tok_w = (const float*)(ws + WS_MISC + MS_TOKW);
    const int gw = F.bid * NWAVES + F.wave, NGW = F.G * NWAVES, lane = F.lane;
    const float* g2 = P.in[I_LN2G]; const float* b2 = P.in[I_LN2B];
    for (int row = gw; row < NTOK; row += NGW) {
        const int d0 = tok_dest[2 * row], d1 = tok_dest[2 * row + 1]; const float w0 = tok_w[2 * row], w1 = tok_w[2 * row + 1];
        const f32x4* xr = (const f32x4*)(H1 + (size_t)row * D) + lane;
        const u32x2* y0 = (const u32x2*)(YB + (size_t)d0 * D) + lane; const u32x2* y1 = (const u32x2*)(YB + (size_t)d1 * D) + lane;
        f32x4 v[4]; float s = 0.f;
#pragma unroll
        for (int j = 0; j < 4; ++j) { const f32x4 x = xr[64 * j]; const u32x2 a = y0[64 * j], b = y1[64 * j];
            v[j][0] = ALPHA * x[0] + (w0 * bf_lo(a.x) + w1 * bf_lo(b.x)); v[j][1] = ALPHA * x[1] + (w0 * bf_hi(a.x) + w1 * bf_hi(b.x));
            v[j][2] = ALPHA * x[2] + (w0 * bf_lo(a.y) + w1 * bf_lo(b.y)); v[j][3] = ALPHA * x[3] + (w0 * bf_hi(a.y) + w1 * bf_hi(b.y));
            s += (v[j][0] + v[j][1]) + (v[j][2] + v[j][3]); }
        const float mean = wave_sum(s) * (1.f / D); float s2 = 0.f;
#pragma unroll
        for (int j = 0; j < 4; ++j) { v[j] = v[j] - mean; s2 += (v[j][0] * v[j][0] + v[j][1] * v[j][1]) + (v[j][2] * v[j][2] + v[j][3] * v[j][3]); }
        const float rstd = 1.f / sqrtf(wave_sum(s2) * (1.f / D) + LN_EPS);
        f32x4* orow = (f32x4*)(P.out + (size_t)row * D) + lane;
#pragma unroll
        for (int j = 0; j < 4; ++j) { const f32x4 gg = *((const f32x4*)g2 + lane + 64 * j), bb = *((const f32x4*)b2 + lane + 64 * j); orow[64 * j] = v[j] * rstd * gg + bb; }
    }
}

constexpr int NPHASE = 15;
__global__ void __launch_bounds__(NTHR, 2) fwd_kernel(Params prm) {
    extern __shared__ __attribute__((aligned(16))) unsigned char lds_raw[];
    Frame F; F.lds = (LAS unsigned char*)lds_raw; F.tid = threadIdx.x; F.lane = F.tid & 63; F.wave = __builtin_amdgcn_readfirstlane(F.tid >> 6); F.G = gridDim.x; F.bid = blockIdx.x; F.p = &prm;
    unsigned char* ws = prm.ws;
    const int lo = prm.ph_lo, hi = prm.ph_hi;
#define IN(k) (lo <= (k) && (k) < hi)
#define SEAM(k) do { if (IN(k) && IN((k) + 1)) { cg::this_grid().sync(); } } while (0)
    const bf16_t* Zc = (const bf16_t*)(ws + WS_Z);

    if (IN(0)) { phase_prep(F); } SEAM(0);
    if (IN(1)) {
        pg8::StaticOrder S{NTOK / 256, INCOLS / 256, F.G, F.bid, (const char*)(ws + WS_XB), (const char*)(ws + WS_WIN), (size_t)256 * D * 2, (size_t)256 * D * 2, 0};
        EpiBf16 E{(bf16_t*)(ws + WS_Z), INCOLS, prm.in[I_BGATE], GATE0 / 256, GATE0};
        pg8::gemm_phase<EpiBf16, pg8::StaticOrder, true, true>(F.lds, D, D, D, S, E);
    } SEAM(1);
    if (IN(2)) {
        pg8::StaticOrder S{NMEM / 256, 2 * D / 256, F.G, F.bid, (const char*)(ws + WS_MEMB), (const char*)(ws + WS_WKV), (size_t)256 * D * 2, (size_t)256 * D * 2, 0};
        EpiBf16 E{(bf16_t*)(ws + WS_KV), 2 * D, nullptr, 1 << 30, 0};
        pg8::gemm_phase<EpiBf16, pg8::StaticOrder, true, true>(F.lds, D, D, D, S, E);
    } SEAM(2);
    if (IN(3)) { phase_convpool(F); } SEAM(3);
    if (IN(4)) { phase_attn_naive(F); } SEAM(4);
    if (IN(5)) {
        pg8::StaticOrder S{NTOK / 256, D / 256, F.G, F.bid, (const char*)(ws + WS_ACONV), (const char*)(ws + WS_WC), (size_t)256 * D * 2, (size_t)256 * D * 2, 0};
        EpiMerge<0> E{(bf16_t*)(ws + WS_MERGED), Zc, GATE0, nullptr};
        pg8::gemm_phase<EpiMerge<0>, pg8::StaticOrder, true, true>(F.lds, D, D, D, S, E);
    } SEAM(5);
    if (IN(6)) {
        pg8::StaticOrder S{NTOK / 256, D / 256, F.G, F.bid, (const char*)(ws + WS_DPOOL), (const char*)(ws + WS_WP), (size_t)256 * D * 2, (size_t)256 * 256 * 2, (size_t)256 * 2};
        EpiMerge<1> E{(bf16_t*)(ws + WS_MERGED), Zc, GATE0 + D, prm.in[I_PSCALE]};
        pg8::gemm_phase<EpiMerge<1>, pg8::StaticOrder, true, true>(F.lds, 256, D, 256, S, E);
    } SEAM(6);
    if (IN(7)) {
        pg8::StaticOrder S{NTOK / 256, D / 256, F.G, F.bid, (const char*)(ws + WS_O), (const char*)(ws + WS_WXO), (size_t)256 * D * 2, (size_t)256 * D * 2, 0};
        EpiMerge<1> E{(bf16_t*)(ws + WS_MERGED), Zc, GATE0 + 2 * D, nullptr};
        pg8::gemm_phase<EpiMerge<1>, pg8::StaticOrder, true, true>(F.lds, D, D, D, S, E);
    } SEAM(7);
    if (IN(8)) {
        pg8::StaticOrder S{NTOK / 256, D / 256, F.G, F.bid, (const char*)(ws + WS_MERGED), (const char*)(ws + WS_WO), (size_t)256 * D * 2, (size_t)256 * D * 2, 0};
        EpiResF32 E{(float*)(ws + WS_H1), prm.in[I_X], ALPHA};
        pg8::gemm_phase<EpiResF32, pg8::StaticOrder, true, true>(F.lds, D, D, D, S, E);
    } SEAM(8);
    if (IN(9)) { phase_ln1_router(F); } SEAM(9);
    if (IN(10)) { phase_scan(F); } SEAM(10);
    if (IN(11)) { phase_gather(F); } SEAM(11);
    if (IN(12)) {
        const int ntl = *(const int*)(ws + WS_MISC + MS_NTILES);
        pg8::MoeOrder S{ntl, 4, F.G, F.bid, (const char*)(ws + WS_XBUF), (const char*)(ws + WS_WUP), (size_t)256 * D * 2, (size_t)256 * D * 2, (size_t)D * D * 2, (const int*)(ws + WS_MISC + MS_TILEE)};
        EpiAct E{(bf16_t*)(ws + WS_ACT)};
        pg8::gemm_phase<EpiAct, pg8::MoeOrder, true, true>(F.lds, D, D, D, S, E);
    } SEAM(12);
    if (IN(13)) {
        const int ntl = *(const int*)(ws + WS_MISC + MS_NTILES);
        pg8::MoeOrder S{ntl, 4, F.G, F.bid, (const char*)(ws + WS_ACT), (const char*)(ws + WS_WDN), (size_t)256 * DEXP * 2, (size_t)256 * DEXP * 2, (size_t)D * DEXP * 2, (const int*)(ws + WS_MISC + MS_TILEE)};
        EpiBf16 E{(bf16_t*)(ws + WS_YBUF), D, nullptr, 1 << 30, 0};
        pg8::gemm_phase<EpiBf16, pg8::MoeOrder, true, true>(F.lds, DEXP, DEXP, DEXP, S, E);
    } SEAM(13);
    if (IN(14)) { phase_combine(F); }
#undef IN
#undef SEAM
}

extern "C" void kernel_launch(void* const* d_in, const int* in_sizes, int n_in, void* d_out, int out_size, void* d_ws, size_t ws_size, hipStream_t stream) {
    static int grid = 0;
    if (grid == 0) {
        if (n_in != 21 || out_size != NTOK * D || ws_size < WS_END) { fprintf(stderr, "kernel_launch: unexpected shapes (n_in %d out %d ws %zu, need ws >= %zu)\n", n_in, out_size, ws_size, (size_t)WS_END); grid = -1; return; }
        int dev = 0, cus = 0, per_cu = 0;
        if (hipGetDevice(&dev) != hipSuccess || hipDeviceGetAttribute(&cus, hipDeviceAttributeMultiprocessorCount, dev) != hipSuccess) { grid = -1; return; }
        if (hipFuncSetAttribute((const void*)fwd_kernel, hipFuncAttributeMaxDynamicSharedMemorySize, LDS_BYTES) != hipSuccess) { fprintf(stderr, "kernel_launch: hipFuncSetAttribute failed\n"); grid = -1; return; }
        if (hipOccupancyMaxActiveBlocksPerMultiprocessor(&per_cu, (const void*)fwd_kernel, NTHR, LDS_BYTES) != hipSuccess || per_cu < 1) { fprintf(stderr, "kernel_launch: occupancy query says %d\n", per_cu); (void)hipGetLastError(); per_cu = 1; }
        grid = cus * 1;
        fprintf(stderr, "kernel_launch: cus %d per_cu %d grid %d\n", cus, per_cu, grid);
    }
    if (grid < 0) return;
    (void)hipMemsetAsync((char*)d_ws + WS_CTL, 0, CTL_ZERO_BYTES, stream);
    Params a{};
    for (int i = 0; i < 21; ++i) a.in[i] = (const float*)d_in[i];
    a.out = (float*)d_out; a.ws = (unsigned char*)d_ws;
#if MK_ONE_LAUNCH
    a.ph_lo = 0; a.ph_hi = NPHASE;
    void* args[] = {&a};
    hipError_t e = hipLaunchCooperativeKernel((const void*)fwd_kernel, dim3(grid), dim3(NTHR), args, LDS_BYTES, stream);
    if (e != hipSuccess) fprintf(stderr, "cooperative launch failed: %s (grid %d)\n", hipGetErrorString(e), grid);
#else
    for (int ph = 0; ph < NPHASE; ++ph) {
        a.ph_lo = ph; a.ph_hi = ph + 1;
        hipLaunchKernelGGL(fwd_kernel, dim3(grid), dim3(NTHR), LDS_BYTES, stream, a);
    }
#endif
}
```

```cpp
#include <hip/hip_runtime.h>
#include <hip/hip_cooperative_groups.h>
#include <cstdio>
#include <cstdint>
namespace cg = cooperative_groups;

#ifndef PROBE_PH
#define PROBE_PH -1
#endif
#ifndef STAG_G1
#define STAG_G1 0
#endif
#ifndef MK_ONE_LAUNCH
#define MK_ONE_LAUNCH 1
#endif

namespace pg8 {
#define PG8_LAS __attribute__((address_space(3)))
#define PG8_GAS __attribute__((address_space(1)))
typedef unsigned short bf16_t;
typedef short bf16x8 __attribute__((ext_vector_type(8)));
typedef float f32x4 __attribute__((ext_vector_type(4)));
typedef float f32x2 __attribute__((ext_vector_type(2)));
typedef unsigned u32x4 __attribute__((ext_vector_type(4)));
typedef unsigned u32x2 __attribute__((ext_vector_type(2)));
constexpr int BM = 256, BK = 64, HALF = 128, HTB = HALF * BK * 2  , STAGE_BYTES = 8 * HTB, NXCD = 8, WGM = 4;

__host__ __device__ __forceinline__ int lds_byte(int r, int c) { const int st = (r >> 4) * 2 + (c >> 5), rr = r & 15, cc = c & 31, ob = rr * 64 + cc * 2; return st * 1024 + (ob ^ (((ob >> 9) & 1) << 5)); }
__host__ __device__ __forceinline__ void stage_rc(int b, int& R, int& C) { const int st = b / 1024, sb = b % 1024, swz = sb ^ (((sb >> 9) & 1) << 5); R = (st >> 1) * 16 + swz / 64; C = (st & 1) * 32 + (swz % 64) / 2; }
__host__ __device__ __forceinline__ int perm32(int rho) { const int n = rho >> 4, i = rho & 15; return 8 * (i >> 2) + 4 * n + (i & 3); }

struct Unit { int pm, pn, kind; const char* a; const char* b; int nt, seg, fin; };

__device__ __forceinline__ void tile_of(int L, int nM, int nN, int& pm, int& pn) {
    const int nwg = nM * nN; int wgid = L;
    { const int q = nwg / NXCD, r = nwg % NXCD, xcd = wgid % NXCD, off = wgid / NXCD; wgid = (xcd < r ? xcd * (q + 1) : r * (q + 1) + (xcd - r) * q) + off; }
    const int nig = WGM * nN, gid = wgid / nig, fm = gid * WGM, gsz = (nM - fm) < WGM ? (nM - fm) : WGM;
    pm = fm + ((wgid % nig) % gsz); pn = (wgid % nig) / gsz;
}
struct StaticOrder {
    int nM, nN, G, c; const char* A; const char* B; size_t tA, tB, aN;
    __device__ __forceinline__ bool next(int i, Unit& u) const {
        const long L = (long)i * G + c; if (L >= (long)nM * nN) return false;
        tile_of((int)L, nM, nN, u.pm, u.pn); u.kind = 0;
        u.a = A + (size_t)u.pm * tA + (size_t)u.pn * aN; u.b = B + (size_t)u.pn * tB; return true;
    }
};
struct MoeOrder {
    int nM, nN, G, c; const char* A; const char* B; size_t tA, tB, eB; const int* tile_expert;
    __device__ __forceinline__ bool next(int i, Unit& u) const {
        const long L = (long)i * G + c; if (L >= (long)nM * nN) return false;
        tile_of((int)L, nM, nN, u.pm, u.pn); u.kind = 0;
        const int e = __builtin_amdgcn_readfirstlane(tile_expert[u.pm]);
        u.a = A + (size_t)u.pm * tA; u.b = B + (size_t)e * eB + (size_t)u.pn * tB; return true;
    }
};

struct SegOrder {
    int nM, nN, G, c; const char* A; const char* A2; const char* A3; const char* B; size_t tA, tB, aN2;
    __device__ __forceinline__ bool next(int i, Unit& u) const {
        const int iu = i / 3, seg = i - 3 * iu;
        const long L = (long)iu * G + c; if (L >= (long)nM * nN) return false;
        tile_of((int)L, nM, nN, u.pm, u.pn); u.kind = 0; u.seg = seg; u.fin = (seg == 2); u.nt = (seg == 1) ? 4 : 16;
        u.a = (seg == 0 ? A : (seg == 1 ? A2 + (size_t)u.pn * aN2 : A3)) + (size_t)u.pm * tA;
        u.b = B + (size_t)u.pn * tB + (size_t)(seg == 0 ? 0 : (seg == 1 ? 1024 : 1280)) * 2; return true;
    }
};
struct KVOrder {
    int G, c; const char* memb; const char* wkv;
    __device__ __forceinline__ bool next(int i, Unit& u) const {
        const int L = i * G + c; if (L >= 64) return false;
        if (L < 32) { u.pm = L >> 2; u.pn = L & 3; u.kind = 0; u.a = memb + (size_t)u.pm * 256 * 2048; u.b = wkv + (size_t)u.pn * 256 * 2048; }
        else { const int j = L - 32; u.pm = j; u.pn = 0; u.kind = 1; u.a = wkv + (size_t)(1024 + (j & 3) * 256) * 2048; u.b = memb + (size_t)(j >> 2) * 256 * 2048; }
        return true;
    }
};

__device__ __forceinline__ unsigned cvt_pk_bf16(float lo, float hi) { unsigned r; asm volatile("v_cvt_pk_bf16_f32 %0, %1, %2" : "=v"(r) : "v"(lo), "v"(hi)); return r; }
__device__ __forceinline__ float bf_lo(unsigned w) { return __uint_as_float(w << 16); }
__device__ __forceinline__ float bf_hi(unsigned w) { return __uint_as_float(w & 0xffff0000u); }

typedef int i32x4 __attribute__((ext_vector_type(4)));
typedef int i32x8 __attribute__((ext_vector_type(8)));
typedef float f32x32 __attribute__((ext_vector_type(32)));
__device__ __forceinline__ i32x8 pg8_cat(const bf16x8 lo, const bf16x8 hi) { const i32x4 a = __builtin_bit_cast(i32x4, lo), b = __builtin_bit_cast(i32x4, hi); return __builtin_shufflevector(a, b, 0, 1, 2, 3, 4, 5, 6, 7); }
template <class Epi, class Sched, bool ALIGN_EPI = false, bool SP2 = false, int MODE = 0>
__device__ __forceinline__ void gemm_phase(PG8_LAS unsigned char* lds, const int K, const int lda, const int ldb, const Sched& S, const Epi& E) {
    const int tid = threadIdx.x, wid = __builtin_amdgcn_readfirstlane(tid >> 6), lane = tid & 63, wr = wid >> 2, wc = wid & 3, fr = lane & 15, fq = lane >> 4;
    constexpr bool FP8 = (MODE == 1), INT8 = (MODE == 2);
    const int nt = K / BK; constexpr int NST = Epi::NST;
    unsigned voffA[2], voffB[2];
#pragma unroll
    for (int i = 0; i < 2; ++i) { int R, C; stage_rc(tid * 16 + i * 8192, R, C); const int Rb = Epi::PERM ? ((R & ~31) + perm32(R & 31)) : R;
        voffA[i] = (unsigned)(R * lda + C) * 2u; voffB[i] = (unsigned)(Rb * ldb + C) * 2u; }
    const size_t kstep = (size_t)(BK * 2);
    const size_t hstepA = (size_t)HALF * lda * 2, hstepB = (size_t)HALF * ldb * 2;
    const unsigned ldsw = (unsigned)wid * 1024u;
    const int aoff = lds_byte(wr * 64 + fr, fq * 8), boff = lds_byte(wc * 32 + fr, fq * 8);
#define PG8_SA(b, h) (((b) * 2 + (h)) * HTB)
#define PG8_SB(b, h) ((4 + (b) * 2 + (h)) * HTB)
#define PG8_STAGE(bufoff, gbase, voff) do { _Pragma("unroll") for (int _i = 0; _i < 2; ++_i) \
        __builtin_amdgcn_global_load_lds((const PG8_GAS unsigned*)((const PG8_GAS char*)(gbase) + (voff)[_i]), (PG8_LAS unsigned*)(lds + (bufoff) + ldsw + _i * 8192), 16, 0, 0); } while (0)
#define PG8_LDA(dst, b, h) do { if constexpr (FP8) { _Pragma("unroll") for (int m = 0; m < 4; ++m) dst##8[m] = pg8_cat(*(const PG8_LAS bf16x8*)(lds + PG8_SA(b, h) + aoff + m * 2048), *(const PG8_LAS bf16x8*)(lds + PG8_SA(b, h) + aoff + m * 2048 + 1024)); } \
        else { _Pragma("unroll") for (int m = 0; m < 4; ++m) _Pragma("unroll") for (int k = 0; k < 2; ++k) dst[m][k] = *(const PG8_LAS bf16x8*)(lds + PG8_SA(b, h) + aoff + m * 2048 + k * 1024); } } while (0)
#define PG8_LDB(dst, b, h) do { if constexpr (FP8) { _Pragma("unroll") for (int n = 0; n < 2; ++n) dst##8[n] = pg8_cat(*(const PG8_LAS bf16x8*)(lds + PG8_SB(b, h) + boff + n * 2048), *(const PG8_LAS bf16x8*)(lds + PG8_SB(b, h) + boff + n * 2048 + 1024)); } \
        else { _Pragma("unroll") for (int n = 0; n < 2; ++n) _Pragma("unroll") for (int k = 0; k < 2; ++k) dst[n][k] = *(const PG8_LAS bf16x8*)(lds + PG8_SB(b, h) + boff + n * 2048 + k * 1024); } } while (0)
#define PG8_MMA(ai, bj, At, Bt) do { __builtin_amdgcn_s_setprio(1); \
        if constexpr (FP8) { _Pragma("unroll") for (int m = 0; m < 4; ++m) _Pragma("unroll") for (int n = 0; n < 2; ++n) { \
            const f32x4 _c = (f32x4){accv[ai][bj][(m * 2 + n) * 4], accv[ai][bj][(m * 2 + n) * 4 + 1], accv[ai][bj][(m * 2 + n) * 4 + 2], accv[ai][bj][(m * 2 + n) * 4 + 3]}; \
            const f32x4 _d = __builtin_amdgcn_mfma_scale_f32_16x16x128_f8f6f4(Bt##8[n], At##8[m], _c, 0, 0, 0, 0x7f7f7f7f, 0, 0x7f7f7f7f); \
            _Pragma("unroll") for (int _j = 0; _j < 4; ++_j) accv[ai][bj][(m * 2 + n) * 4 + _j] = _d[_j]; } } \
        else if constexpr (INT8) { _Pragma("unroll") for (int m = 0; m < 4; ++m) _Pragma("unroll") for (int n = 0; n < 2; ++n) _Pragma("unroll") for (int k = 0; k < 2; ++k) \
            acc[ai][bj][m][n] = __builtin_bit_cast(f32x4, __builtin_amdgcn_mfma_i32_16x16x64_i8(__builtin_bit_cast(i32x4, Bt[n][k]), __builtin_bit_cast(i32x4, At[m][k]), __builtin_bit_cast(i32x4, acc[ai][bj][m][n]), 0, 0, 0)); } \
        else { _Pragma("unroll") for (int m = 0; m < 4; ++m) _Pragma("unroll") for (int n = 0; n < 2; ++n) _Pragma("unroll") for (int k = 0; k < 2; ++k) \
            acc[ai][bj][m][n] = __builtin_amdgcn_mfma_f32_16x16x32_bf16(Bt[n][k], At[m][k], acc[ai][bj][m][n], 0, 0, 0); } \
        __builtin_amdgcn_s_setprio(0); } while (0)
#define PG8_WAIT_V(n) asm volatile("s_waitcnt vmcnt(" #n ")" ::: "memory")
#define PG8_WAIT_VN(n) asm volatile("s_waitcnt vmcnt(%0)" :: "n"(n) : "memory")
#define PG8_WAIT_L(n) asm volatile("s_waitcnt lgkmcnt(" #n ")" ::: "memory")
#define PG8_BAR __builtin_amdgcn_s_barrier()
#define PG8_SCHED __builtin_amdgcn_sched_barrier(0)
    Unit cur, nxt; int ui = 0;
    if (!S.next(0, cur)) return;
    f32x4 acc[2][2][4][2];
#pragma unroll
    for (int a = 0; a < 2; ++a)
#pragma unroll
        for (int b = 0; b < 2; ++b)
#pragma unroll
            for (int m = 0; m < 4; ++m)
#pragma unroll
                for (int n = 0; n < 2; ++n) acc[a][b][m][n] = (f32x4){0.f, 0.f, 0.f, 0.f};
    bf16x8 At[4][2], B0[2][2], B1[2][2]; i32x8 At8[4], B08[2], B18[2]; f32x32 accv[2][2];
    if constexpr (FP8) {
#pragma unroll
        for (int a = 0; a < 2; ++a)
#pragma unroll
            for (int b = 0; b < 2; ++b)
#pragma unroll
                for (int j = 0; j < 32; ++j) accv[a][b][j] = 0.f; }
    const char* cA = cur.a; const char* cB = cur.b;
    if constexpr (SP2) {
        PG8_STAGE(PG8_SB(0, 0), cB, voffB); PG8_STAGE(PG8_SB(0, 1), cB + hstepB, voffB); PG8_STAGE(PG8_SA(0, 0), cA, voffA); PG8_STAGE(PG8_SA(0, 1), cA + hstepA, voffA);
        if (wr == 1) PG8_BAR;
        PG8_WAIT_V(2); PG8_BAR;
        PG8_STAGE(PG8_SB(1, 0), cB + kstep, voffB); PG8_STAGE(PG8_SA(1, 0), cA + kstep, voffA); PG8_STAGE(PG8_SB(1, 1), cB + hstepB + kstep, voffB);
        PG8_WAIT_V(6); PG8_BAR;
    } else {
        PG8_STAGE(PG8_SB(0, 0), cB, voffB); PG8_STAGE(PG8_SA(0, 0), cA, voffA); PG8_STAGE(PG8_SB(0, 1), cB + hstepB, voffB); PG8_STAGE(PG8_SA(0, 1), cA + hstepA, voffA);
        if (wr == 1) PG8_BAR;
        PG8_WAIT_V(4); PG8_BAR;
        PG8_STAGE(PG8_SB(1, 0), cB + kstep, voffB); PG8_STAGE(PG8_SA(1, 0), cA + kstep, voffA); PG8_STAGE(PG8_SB(1, 1), cB + hstepB + kstep, voffB);
        PG8_WAIT_V(6); PG8_BAR;
    }
    for (;;) {
        const bool has_next = S.next(ui + 1, nxt);
        const char* nA = has_next ? nxt.a : cA; const char* nB = has_next ? nxt.b : cB;
        int ntc = nt; if constexpr (Epi::SEG) ntc = cur.nt;
        if constexpr (Epi::PREF) E.prefetch(cur, lds + 131072 + 1024 + wid * 256, tid);
#pragma nounroll
        for (int t = 0; t < ntc; t += 2) {
            const bool last = (t == ntc - 2);
            const char* a1 = cA + (size_t)(t + 1) * kstep;
            const char* a2 = last ? nA : cA + (size_t)(t + 2) * kstep; const char* b2 = last ? nB : cB + (size_t)(t + 2) * kstep;
            const char* a3 = a2 + kstep; const char* b3 = b2 + kstep;
            if constexpr (SP2) {
            const bool fresh = !FP8 && (NST > 0) && (t == 0) && (ui > 0);
            PG8_LDB(B0, 0, 0); PG8_LDB(B1, 0, 1); PG8_SCHED; PG8_LDA(At, 0, 0); PG8_STAGE(PG8_SA(1, 1), a1 + hstepA, voffA);
            if (fresh) PG8_WAIT_VN(8 + NST); else PG8_WAIT_V(8);
            PG8_WAIT_L(0); PG8_BAR; PG8_MMA(0, 0, At, B0); PG8_MMA(0, 1, At, B1); PG8_BAR; PG8_SCHED;
            PG8_LDA(At, 0, 1); PG8_STAGE(PG8_SB(0, 0), b2, voffB); PG8_STAGE(PG8_SB(0, 1), b2 + hstepB, voffB); PG8_STAGE(PG8_SA(0, 0), a2, voffA);
            if (fresh) PG8_WAIT_VN(8 + NST); else PG8_WAIT_V(8);
            PG8_WAIT_L(0); PG8_BAR; PG8_MMA(1, 0, At, B0); PG8_MMA(1, 1, At, B1); PG8_BAR; PG8_SCHED;
            PG8_LDB(B0, 1, 0); PG8_LDB(B1, 1, 1); PG8_SCHED; PG8_LDA(At, 1, 0); PG8_STAGE(PG8_SA(0, 1), a2 + hstepA, voffA);
            PG8_WAIT_V(8); PG8_WAIT_L(0); PG8_BAR; PG8_MMA(0, 0, At, B0); PG8_MMA(0, 1, At, B1); PG8_BAR; PG8_SCHED;
            PG8_LDA(At, 1, 1); PG8_STAGE(PG8_SB(1, 0), b3, voffB); PG8_STAGE(PG8_SB(1, 1), b3 + hstepB, voffB); PG8_STAGE(PG8_SA(1, 0), a3, voffA);
            PG8_WAIT_V(8); PG8_WAIT_L(0); PG8_BAR; PG8_MMA(1, 0, At, B0); PG8_MMA(1, 1, At, B1); PG8_BAR; PG8_SCHED;
            } else {
            PG8_LDB(B0, 0, 0); PG8_SCHED; PG8_LDA(At, 0, 0); PG8_STAGE(PG8_SA(1, 1), a1 + hstepA, voffA);
            PG8_WAIT_L(8); PG8_BAR; PG8_WAIT_L(0); PG8_MMA(0, 0, At, B0); PG8_BAR; PG8_SCHED;
            PG8_LDB(B1, 0, 1); PG8_STAGE(PG8_SB(0, 0), b2, voffB);
            PG8_BAR; PG8_WAIT_L(0); PG8_MMA(0, 1, At, B1); PG8_BAR;
            PG8_LDA(At, 0, 1); PG8_STAGE(PG8_SA(0, 0), a2, voffA);
            PG8_BAR; PG8_WAIT_L(0); PG8_MMA(1, 0, At, B0); PG8_BAR; PG8_SCHED;
            PG8_STAGE(PG8_SB(0, 1), b2 + hstepB, voffB);
            PG8_WAIT_V(6); PG8_BAR; PG8_MMA(1, 1, At, B1); PG8_BAR;
            PG8_LDB(B0, 1, 0); PG8_SCHED; PG8_LDA(At, 1, 0); PG8_STAGE(PG8_SA(0, 1), a2 + hstepA, voffA);
            PG8_WAIT_L(8); PG8_BAR; PG8_WAIT_L(0); PG8_MMA(0, 0, At, B0); PG8_BAR; PG8_SCHED;
            PG8_LDB(B1, 1, 1); PG8_STAGE(PG8_SB(1, 0), b3, voffB);
            PG8_BAR; PG8_WAIT_L(0); PG8_MMA(0, 1, At, B1); PG8_BAR;
            PG8_LDA(At, 1, 1); PG8_STAGE(PG8_SA(1, 0), a3, voffA);
            PG8_BAR; PG8_WAIT_L(0); PG8_MMA(1, 0, At, B0); PG8_BAR; PG8_SCHED;
            PG8_STAGE(PG8_SB(1, 1), b3 + hstepB, voffB);
            PG8_WAIT_V(6); PG8_BAR; PG8_MMA(1, 1, At, B1); PG8_BAR;
            }
        }
        if constexpr (ALIGN_EPI) { if (wr == 0) PG8_BAR; }
        if constexpr (FP8) {
#pragma unroll
            for (int a = 0; a < 2; ++a)
#pragma unroll
                for (int b = 0; b < 2; ++b)
#pragma unroll
                    for (int m = 0; m < 4; ++m)
#pragma unroll
                        for (int n = 0; n < 2; ++n) { acc[a][b][m][n] = (f32x4){accv[a][b][(m * 2 + n) * 4], accv[a][b][(m * 2 + n) * 4 + 1], accv[a][b][(m * 2 + n) * 4 + 2], accv[a][b][(m * 2 + n) * 4 + 3]}; }
#pragma unroll
            for (int a = 0; a < 2; ++a)
#pragma unroll
                for (int b = 0; b < 2; ++b)
#pragma unroll
                    for (int j = 0; j < 32; ++j) accv[a][b][j] = 0.f; }
        if constexpr (INT8) {
#pragma unroll
            for (int a = 0; a < 2; ++a)
#pragma unroll
                for (int b = 0; b < 2; ++b)
#pragma unroll
                    for (int m = 0; m < 4; ++m)
#pragma unroll
                        for (int n = 0; n < 2; ++n) { const i32x4 iv = __builtin_bit_cast(i32x4, acc[a][b][m][n]); acc[a][b][m][n] = (f32x4){(float)iv[0], (float)iv[1], (float)iv[2], (float)iv[3]}; } }
        bool fin = true;
        if constexpr (Epi::SEG) { fin = cur.fin != 0; if (fin) E(acc, cur, wr, wc, fr, fq); else E.mid(acc, cur, cur.seg + 1, wr, wc, fr, fq); } else E(acc, cur, wr, wc, fr, fq);
        if (!has_next) break;
        if (fin) {
#pragma unroll
        for (int a = 0; a < 2; ++a)
#pragma unroll
            for (int b = 0; b < 2; ++b)
#pragma unroll
                for (int m = 0; m < 4; ++m)
#pragma unroll
                    for (int n = 0; n < 2; ++n) acc[a][b][m][n] = (f32x4){0.f, 0.f, 0.f, 0.f};
        }
        cur = nxt; cA = nA; cB = nB; ++ui;
        if constexpr (ALIGN_EPI) { if (wr == 1) PG8_BAR; }
    }
    PG8_WAIT_V(0);
    if constexpr (!ALIGN_EPI) { if (wr == 0) PG8_BAR; }
    PG8_BAR;
#undef PG8_SA
#undef PG8_SB
#undef PG8_STAGE
#undef PG8_LDA
#undef PG8_LDB
#undef PG8_MMA
#undef PG8_WAIT_V
#undef PG8_WAIT_VN
#undef PG8_WAIT_L
#undef PG8_BAR
#undef PG8_SCHED
}
}
using pg8::bf16_t; using pg8::f32x4; using pg8::f32x2; using pg8::u32x4; using pg8::u32x2; using pg8::Unit; using pg8::cvt_pk_bf16; using pg8::bf_lo; using pg8::bf_hi;
#define LAS __attribute__((address_space(3)))

constexpr int D = 1024, BATCH = 8, SEQ = 4096, NTOK = BATCH * SEQ, MEMLEN = 256, NMEM = BATCH * MEMLEN;
constexpr int INCOLS = 8192, GATE0 = 5120;
constexpr int NEXP = 64, DEXP = 512, NGRP = 8, EPG = 8;
constexpr int NASSIGN = NTOK * 2, PMAX_TILES = 320, PMAX = PMAX_TILES * 256;
constexpr float ALPHA = 1.189207115002721f;
constexpr float LN_EPS = 1e-5f;
constexpr int NWAVES = 8, NTHR = 512;

constexpr size_t MiB = 1u << 20;
constexpr size_t WS_CTL = 0, CTL_ZERO_BYTES = 1 * MiB;
constexpr size_t WS_WIN = 1 * MiB, WS_WKV = 17 * MiB, WS_WCAT = 21 * MiB, WS_WO = 26 * MiB, WS_WR = 28 * MiB;
constexpr int KCAT = 2304;
constexpr size_t WS_WUP = 29 * MiB, WS_WDN = 157 * MiB, WS_MISC = 221 * MiB;
constexpr size_t WS_Z = 224 * MiB;
constexpr size_t WS_XB = 736 * MiB, WS_MEMB = 800 * MiB, WS_KV = 804 * MiB, WS_ACONV = 812 * MiB, WS_DPOOL = 876 * MiB, WS_MERGED = 940 * MiB;
constexpr size_t WS_KB = WS_KV, WS_VT = WS_KV + 4 * MiB;
constexpr size_t WS_XS = WS_MISC + 3 * (MiB / 2), WS_SW = WS_MISC + 7 * (MiB / 4);
constexpr size_t WS_O = WS_XB;
constexpr size_t WS_H1 = 224 * MiB;
constexpr size_t WS_H1B = 480 * MiB;
constexpr size_t WS_XBUF = 544 * MiB;
constexpr size_t WS_H1F8 = 640 * MiB;
constexpr size_t WS_ACT = 736 * MiB;
constexpr size_t WS_YBUF = 816 * MiB;
constexpr size_t WS_END = 1004 * MiB;
constexpr size_t MS_TOKE = 0, MS_TOKPOS = MS_TOKE + NASSIGN * 4, MS_TOKW = MS_TOKPOS + NASSIGN * 4, MS_TOKDEST = MS_TOKW + NASSIGN * 4, MS_TILEE = MS_TOKDEST + NASSIGN * 4, MS_PSTART = MS_TILEE + 4096, MS_NTILES = MS_PSTART + 1024;
constexpr int CW_COUNTS = 1024;
constexpr int CW_BAR = 4096;

constexpr int LDS_BYTES = 147456, MISC_OFF = 131072 + 320;

struct Params { const float* in[21]; float* out; unsigned char* ws; int ph_lo, ph_hi; };
enum { I_X = 0, I_MEM, I_WIN, I_BGATE, I_CONVW, I_WCONV, I_WPOOL, I_PSCALE, I_WKV, I_WXO, I_WO, I_LN1G, I_LN1B, I_WRG, I_BRG, I_WRE, I_BRE, I_WUP, I_WDN, I_LN2G, I_LN2B };

__device__ __forceinline__ unsigned f2bf(float f) { unsigned u = __float_as_uint(f); return (u + 0x7fffu + ((u >> 16) & 1u)) >> 16; }
__device__ __forceinline__ unsigned pk2(float lo, float hi) { return f2bf(lo) | (f2bf(hi) << 16); }
__device__ __forceinline__ float wave_sum(float v) {
#pragma unroll
    for (int o = 1; o < 64; o <<= 1) v += __shfl_xor(v, o);
    return v;
}
__device__ __forceinline__ float sigmoidf_(float x) { return __builtin_amdgcn_rcpf(1.0f + __expf(-x)); }


#define XB_TMO      128
#define XB_XCNT(j)  (256  + 64 * (j))
#define XB_XSUB(j)  (1280 + 64 * (j))
#define XB_XGEN(j)  (2304 + 64 * (j))
#define XB_TOP      3328
#define XB_TOPGEN   3392
#define XCD_BAR_WORDS 3456
#define XB_SPIN_CAP (1u << 18)
__device__ __forceinline__ unsigned xb_ld(unsigned* p)              { return __hip_atomic_load(p, __ATOMIC_RELAXED, __HIP_MEMORY_SCOPE_AGENT); }
__device__ __forceinline__ unsigned xb_add(unsigned* p, unsigned v) { return __hip_atomic_fetch_add(p, v, __ATOMIC_RELAXED, __HIP_MEMORY_SCOPE_AGENT); }
__device__ __forceinline__ unsigned xb_xcc_id() { return (unsigned)__builtin_amdgcn_s_getreg((3 << 11) | 20) & 0xFu; }
#define XB_SPIN(cond, bar) do { unsigned _sp = 0; while (cond) { __builtin_amdgcn_s_sleep(1); \
    if ((++_sp & 255u) == 0u) { if (xb_ld(&(bar)[XB_TMO])) break; if (_sp > XB_SPIN_CAP) { atomicAdd(&(bar)[XB_TMO], 1u); break; } } } } while (0)
struct XcdBarrier { unsigned* bar; unsigned x; volatile LAS unsigned* st; };
__device__ __forceinline__ XcdBarrier xcd_barrier_post(unsigned* bar, volatile LAS unsigned* st) {
    XcdBarrier b; b.bar = bar; b.x = xb_xcc_id(); b.st = st;
    if (threadIdx.x == 0) (void)xb_add(&bar[XB_XCNT(b.x)], 1u);
    return b;
}
__device__ __forceinline__ void xcd_barrier_complete(unsigned* bar, unsigned x, unsigned& nloc, unsigned& nx) {
    const unsigned G = gridDim.x * gridDim.y * gridDim.z;
    unsigned sum, cnt, mine, sp = 0u;
    for (;;) {
        sum = 0u; cnt = 0u; mine = 0u;
#pragma unroll
        for (unsigned j = 0; j < 16; ++j) { const unsigned c = xb_ld(&bar[XB_XCNT(j)]); sum += c; cnt += (c > 0u) ? 1u : 0u; mine = (j == x) ? c : mine; }
        if (sum == G) break;
        __builtin_amdgcn_s_sleep(1);
        if ((++sp & 255u) == 0u) { if (xb_ld(&bar[XB_TMO])) break; if (sp > XB_SPIN_CAP) { atomicAdd(&bar[XB_TMO], 1u); break; } }
    }
    nloc = mine > 0u ? mine : 1u; nx = cnt > 0u ? cnt : 1u;
}
__device__ __forceinline__ void xcd_barrier(const XcdBarrier& b) {
    asm volatile("s_waitcnt vmcnt(0)" ::: "memory");
    __syncthreads();
    if (threadIdx.x == 0) {
        unsigned* bar = b.bar;
        __builtin_amdgcn_s_waitcnt(0);
        unsigned nloc = b.st[0], nx = b.st[1];
        if (nloc == 0u) { xcd_barrier_complete(bar, b.x, nloc, nx); b.st[0] = nloc; b.st[1] = nx; }
        const unsigned old = xb_add(&bar[XB_XSUB(b.x)], 1u);
        const unsigned gen = old / nloc;
        if (old + 1u == (gen + 1u) * nloc) {
            __builtin_amdgcn_fence(__ATOMIC_RELEASE, "agent");
            asm volatile("s_waitcnt vmcnt(0)" ::: "memory");
            const unsigned og = xb_add(&bar[XB_TOP], 1u);
            const unsigned tg = og / nx;
            if (og + 1u == (tg + 1u) * nx) xb_add(&bar[XB_TOPGEN], 1u);
            else XB_SPIN(xb_ld(&bar[XB_TOPGEN]) == tg, bar);
            __builtin_amdgcn_fence(__ATOMIC_ACQUIRE, "agent");
            xb_add(&bar[XB_XGEN(b.x)], 1u);
            asm volatile("s_waitcnt vmcnt(0)" ::: "memory");
        } else {
            XB_SPIN(xb_ld(&bar[XB_XGEN(b.x)]) == gen, bar);
            __builtin_amdgcn_fence(__ATOMIC_ACQUIRE, "agent");
            asm volatile("s_waitcnt vmcnt(0)" ::: "memory");
        }
    }
    __syncthreads();
}

__device__ __forceinline__ void stagger_delay(unsigned ticks) {
    const unsigned long long t0 = __builtin_amdgcn_s_memrealtime();
    while (__builtin_amdgcn_s_memrealtime() - t0 < (unsigned long long)ticks) __builtin_amdgcn_s_sleep(4);
}

template <int LPR> __device__ __forceinline__ void touch_tile(const char* base, size_t pitch, LAS unsigned char* junk, int tid) {
#pragma unroll
    for (int i = 0; i < (256 * LPR) / 512; ++i) { const int ln = i * 512 + tid, r = ln / LPR, c = ln % LPR;
        __builtin_amdgcn_global_load_lds((const PG8_GAS unsigned*)(base + (size_t)r * pitch + c * 128), (LAS unsigned*)junk, 4, 0, 0); }
}

struct EpiBf16 {
    static constexpr bool PERM = true, SEG = false, PREF = false; static constexpr int NST = 8;
    bf16_t* O; int ldc; const float* bias; int gate_pn; int gate_col0; float oscale; int mul_pn0, mul_pn1, mul_col0; const float* rs; const float* cs;
    __device__ __forceinline__ void operator()(const f32x4 (&acc)[2][2][4][2], const Unit& u, int wr, int wc, int fr, int fq) const {
        const int row0 = u.pm * 256 + wr * 64 + fr, col0 = u.pn * 256 + wc * 32 + 8 * fq;
        f32x4 cv[2][2]; float rv[2][4];
#pragma unroll
        for (int bj = 0; bj < 2; ++bj)
#pragma unroll
            for (int n = 0; n < 2; ++n) cv[bj][n] = cs ? *(const f32x4*)(cs + col0 + bj * 128 + 4 * n) : (f32x4){1.f, 1.f, 1.f, 1.f};
#pragma unroll
        for (int ai = 0; ai < 2; ++ai)
#pragma unroll
            for (int m = 0; m < 4; ++m) rv[ai][m] = (rs ? rs[row0 + ai * 128 + m * 16] : 1.0f) * oscale;
        if (u.pn >= mul_pn0 && u.pn < mul_pn1) {
            const int mc = mul_col0 + (u.pn - mul_pn0) * 128 + wc * 32 + 8 * fq;
#pragma unroll
            for (int ai = 0; ai < 2; ++ai)
#pragma unroll
                for (int m = 0; m < 4; ++m) { const float r2 = rv[ai][m] * rv[ai][m];
                    const f32x4 v0 = (acc[ai][0][m][0] * cv[0][0]) * (acc[ai][1][m][0] * cv[1][0]) * r2, v1 = (acc[ai][0][m][1] * cv[0][1]) * (acc[ai][1][m][1] * cv[1][1]) * r2;
                    u32x4 w; w.x = cvt_pk_bf16(v0[0], v0[1]); w.y = cvt_pk_bf16(v0[2], v0[3]); w.z = cvt_pk_bf16(v1[0], v1[1]); w.w = cvt_pk_bf16(v1[2], v1[3]);
                    __builtin_nontemporal_store(w, (u32x4*)(O + (size_t)(row0 + ai * 128 + m * 16) * ldc + mc)); }
            return;
        }
        const bool gate = u.pn >= gate_pn;
        f32x4 bv[2][2];
#pragma unroll
        for (int bj = 0; bj < 2; ++bj)
#pragma unroll
            for (int n = 0; n < 2; ++n) bv[bj][n] = gate ? *(const f32x4*)(bias + (col0 - gate_col0) + bj * 128 + 4 * n) : (f32x4){0.f, 0.f, 0.f, 0.f};
#pragma unroll
        for (int ai = 0; ai < 2; ++ai)
#pragma unroll
            for (int m = 0; m < 4; ++m) { bf16_t* rowp = O + (size_t)(row0 + ai * 128 + m * 16) * ldc + col0;
#pragma unroll
                for (int bj = 0; bj < 2; ++bj) { f32x4 v0 = acc[ai][bj][m][0] * (cv[bj][0] * rv[ai][m]) + bv[bj][0], v1 = acc[ai][bj][m][1] * (cv[bj][1] * rv[ai][m]) + bv[bj][1];
                    if (gate) {
                        unsigned q0 = 0u, q1 = 0u;
#pragma unroll
                        for (int j = 0; j < 4; ++j) { q0 = __builtin_amdgcn_cvt_pk_u8_f32(fmaxf(__builtin_floorf(sigmoidf_(v0[j]) * 255.0f + 0.5f), 1.0f), j, q0); q1 = __builtin_amdgcn_cvt_pk_u8_f32(fmaxf(__builtin_floorf(sigmoidf_(v1[j]) * 255.0f + 0.5f), 1.0f), j, q1); }
                        u32x2 w8; w8.x = q0; w8.y = q1;
                        *(u32x2*)((unsigned char*)(O + (size_t)(row0 + ai * 128 + m * 16) * ldc) + 2 * gate_col0 + (col0 - gate_col0) + bj * 128) = w8;
                        continue; }
                    u32x4 w; w.x = cvt_pk_bf16(v0[0], v0[1]); w.y = cvt_pk_bf16(v0[2], v0[3]); w.z = cvt_pk_bf16(v1[0], v1[1]); w.w = cvt_pk_bf16(v1[2], v1[3]);
                    __builtin_nontemporal_store(w, (u32x4*)(rowp + bj * 128)); } }
    }
};
struct EpiKV {
    static constexpr bool PERM = true, SEG = false, PREF = false; static constexpr int NST = 0;
    bf16_t* KB; bf16_t* VT;
    __device__ __forceinline__ void operator()(const f32x4 (&acc)[2][2][4][2], const Unit& u, int wr, int wc, int fr, int fq) const {
        const int row0 = u.pm * 256 + wr * 64 + fr, col0 = u.pn * 256 + wc * 32 + 8 * fq;
#pragma unroll
        for (int ai = 0; ai < 2; ++ai)
#pragma unroll
            for (int m = 0; m < 4; ++m) { const size_t row = (size_t)(row0 + ai * 128 + m * 16);
#pragma unroll
                for (int bj = 0; bj < 2; ++bj) { const f32x4 v0 = acc[ai][bj][m][0], v1 = acc[ai][bj][m][1];
                    u32x4 w; w.x = cvt_pk_bf16(v0[0], v0[1]); w.y = cvt_pk_bf16(v0[2], v0[3]); w.z = cvt_pk_bf16(v1[0], v1[1]); w.w = cvt_pk_bf16(v1[2], v1[3]);
                    if (u.kind == 0) { *(u32x4*)(KB + row * D + col0 + bj * 128) = w; }
                    else { const int k0 = col0 + bj * 128, base = k0 & ~15, hi8 = (k0 & 8) ? 1 : 0;
                        u32x2 lo2; lo2.x = w.x; lo2.y = w.y; u32x2 hi2; hi2.x = w.z; hi2.y = w.w;
                        *(u32x2*)(VT + row * 256 + base + (hi8 ? 4 : 0)) = lo2; *(u32x2*)(VT + row * 256 + base + (hi8 ? 12 : 8)) = hi2; } } }
    }
};
template <int MODE> struct EpiProbe { static constexpr bool PERM = true, SEG = false, PREF = false; static constexpr int NST = 0;
    bf16_t* O; int flag;
    __device__ __forceinline__ void operator()(const f32x4 (&acc)[2][2][4][2], const Unit& u, int wr, int wc, int fr, int fq) const {
        const int row0 = (MODE == 1 ? 0 : u.pm * 256) + wr * 64 + fr, col0 = (MODE == 1 ? 0 : u.pn * 256) + wc * 32 + 8 * fq;
#pragma unroll
        for (int ai = 0; ai < 2; ++ai)
#pragma unroll
            for (int m = 0; m < 4; ++m) { bf16_t* rowp = O + (size_t)(row0 + ai * 128 + m * 16) * 2048 + col0;
#pragma unroll
                for (int bj = 0; bj < 2; ++bj) { const f32x4 v0 = acc[ai][bj][m][0], v1 = acc[ai][bj][m][1];
                    u32x4 w; w.x = cvt_pk_bf16(v0[0], v0[1]); w.y = cvt_pk_bf16(v0[2], v0[3]); w.z = cvt_pk_bf16(v1[0], v1[1]); w.w = cvt_pk_bf16(v1[2], v1[3]);
                    if (MODE == 1 || flag == 12345) __builtin_nontemporal_store(w, (u32x4*)(rowp + bj * 128)); } }
    }
};
struct EpiNull { static constexpr bool PERM = true, SEG = false, PREF = false; static constexpr int NST = 0;
    __device__ __forceinline__ void operator()(const f32x4 (&acc)[2][2][4][2], const Unit& u, int wr, int wc, int fr, int fq) const {
        float s = 0.f;
#pragma unroll
        for (int ai = 0; ai < 2; ++ai)
#pragma unroll
            for (int bj = 0; bj < 2; ++bj)
#pragma unroll
                for (int m = 0; m < 4; ++m)
#pragma unroll
                    for (int n = 0; n < 2; ++n) s += acc[ai][bj][m][n][0] + acc[ai][bj][m][n][1] + acc[ai][bj][m][n][2] + acc[ai][bj][m][n][3];
        if (s == 123456.789f) *sink = s;
    }
    float* sink;
};
template <int MODE> struct EpiMerge {
    static constexpr bool PERM = true, SEG = false, PREF = false; static constexpr int NST = 0;
    bf16_t* Mg; const bf16_t* Z; int gcol0; const float* scale;
    __device__ __forceinline__ void operator()(const f32x4 (&acc)[2][2][4][2], const Unit& u, int wr, int wc, int fr, int fq) const {
        const int row0 = u.pm * 256 + wr * 64 + fr, col0 = u.pn * 256 + wc * 32 + 8 * fq;
        f32x4 sv[2][2];
#pragma unroll
        for (int bj = 0; bj < 2; ++bj)
#pragma unroll
            for (int n = 0; n < 2; ++n) sv[bj][n] = scale ? *(const f32x4*)(scale + col0 + bj * 128 + 4 * n) : (f32x4){1.f, 1.f, 1.f, 1.f};
#pragma unroll
        for (int ai = 0; ai < 2; ++ai)
#pragma unroll
            for (int m = 0; m < 4; ++m) { const size_t row = (size_t)(row0 + ai * 128 + m * 16);
#pragma unroll
                for (int bj = 0; bj < 2; ++bj) {
                    const u32x4 g = *(const u32x4*)(Z + row * INCOLS + gcol0 + col0 + bj * 128);
                    f32x4 v0 = acc[ai][bj][m][0] * sv[bj][0], v1 = acc[ai][bj][m][1] * sv[bj][1];
                    v0[0] *= bf_lo(g.x); v0[1] *= bf_hi(g.x); v0[2] *= bf_lo(g.y); v0[3] *= bf_hi(g.y);
                    v1[0] *= bf_lo(g.z); v1[1] *= bf_hi(g.z); v1[2] *= bf_lo(g.w); v1[3] *= bf_hi(g.w);
                    u32x4* mp = (u32x4*)(Mg + row * D + col0 + bj * 128);
                    if (MODE) { const u32x4 o = *mp;
                        v0[0] += bf_lo(o.x); v0[1] += bf_hi(o.x); v0[2] += bf_lo(o.y); v0[3] += bf_hi(o.y);
                        v1[0] += bf_lo(o.z); v1[1] += bf_hi(o.z); v1[2] += bf_lo(o.w); v1[3] += bf_hi(o.w); }
                    u32x4 w; w.x = cvt_pk_bf16(v0[0], v0[1]); w.y = cvt_pk_bf16(v0[2], v0[3]); w.z = cvt_pk_bf16(v1[0], v1[1]); w.w = cvt_pk_bf16(v1[2], v1[3]);
                    *mp = w; } }
    }
};
struct EpiMix3 {
    static constexpr bool PERM = true, SEG = true, PREF = false; static constexpr int T1 = 16, T2 = 20, NST = 0;
    bf16_t* Mg; const bf16_t* Z; const float* pscale;
    __device__ __forceinline__ static f32x4 ub4(unsigned w) { return (f32x4){(float)(w & 0xffu), (float)((w >> 8) & 0xffu), (float)((w >> 16) & 0xffu), (float)(w >> 24)}; }
    __device__ __forceinline__ void mid(f32x4 (&acc)[2][2][4][2], const Unit& u, int seg, int wr, int wc, int fr, int fq) const {
        const int row0 = u.pm * 256 + wr * 64 + fr, col0 = u.pn * 256 + wc * 32 + 8 * fq;
        const bool s1 = (seg == 1);
        f32x4 sr[2][2];
#pragma unroll
        for (int bj = 0; bj < 2; ++bj)
#pragma unroll
            for (int n = 0; n < 2; ++n) { const f32x4 ps = *(const f32x4*)(pscale + col0 + bj * 128 + 4 * n);
#pragma unroll
                for (int j = 0; j < 4; ++j) sr[bj][n][j] = s1 ? __builtin_amdgcn_rcpf(ps[j]) : ps[j]; }
        const unsigned char* zb = (const unsigned char*)Z + 2 * GATE0 + col0;
        const unsigned char* zn = zb + (s1 ? 0 : D); const unsigned char* zd = zb + (s1 ? D : 2 * D);
#pragma unroll
        for (int ai = 0; ai < 2; ++ai)
#pragma unroll
            for (int m = 0; m < 4; ++m) { const size_t rb = (size_t)(row0 + ai * 128 + m * 16) * (2 * INCOLS);
#pragma unroll
                for (int bj = 0; bj < 2; ++bj) {
                    const u32x2 gn = *(const u32x2*)(zn + rb + bj * 128), gd = *(const u32x2*)(zd + rb + bj * 128);
                    const f32x4 n0 = ub4(gn.x) * sr[bj][0], n1 = ub4(gn.y) * sr[bj][1], d0 = ub4(gd.x), d1 = ub4(gd.y);
#pragma unroll
                    for (int j = 0; j < 4; ++j) { acc[ai][bj][m][0][j] *= n0[j] * __builtin_amdgcn_rcpf(d0[j]); acc[ai][bj][m][1][j] *= n1[j] * __builtin_amdgcn_rcpf(d1[j]); } }
                asm volatile("" ::: "memory"); }
    }
    __device__ __forceinline__ void operator()(const f32x4 (&acc)[2][2][4][2], const Unit& u, int wr, int wc, int fr, int fq) const {
        const int row0 = u.pm * 256 + wr * 64 + fr, col0 = u.pn * 256 + wc * 32 + 8 * fq;
        const unsigned char* zg = (const unsigned char*)Z + 2 * GATE0 + 2 * D + col0;
#pragma unroll
        for (int ai = 0; ai < 2; ++ai)
#pragma unroll
            for (int m = 0; m < 4; ++m) { const size_t row = (size_t)(row0 + ai * 128 + m * 16);
#pragma unroll
                for (int bj = 0; bj < 2; ++bj) {
                    const u32x2 g = *(const u32x2*)(zg + row * (2 * INCOLS) + bj * 128);
                    const f32x4 v0 = acc[ai][bj][m][0] * (ub4(g.x) * (1.0f / 255.0f)), v1 = acc[ai][bj][m][1] * (ub4(g.y) * (1.0f / 255.0f));
                    u32x4 w; w.x = cvt_pk_bf16(v0[0], v0[1]); w.y = cvt_pk_bf16(v0[2], v0[3]); w.z = cvt_pk_bf16(v1[0], v1[1]); w.w = cvt_pk_bf16(v1[2], v1[3]);
                    *(u32x4*)(Mg + row * D + col0 + bj * 128) = w; } }
    }
};
struct EpiResBf16 {
    static constexpr bool PERM = true, SEG = false, PREF = false; static constexpr int NST = 12;
    bf16_t* O; const float* base; float alpha;
    __device__ __forceinline__ void operator()(const f32x4 (&acc)[2][2][4][2], const Unit& u, int wr, int wc, int fr, int fq) const {
        const int row0 = u.pm * 256 + wr * 64 + fr, col0 = u.pn * 256 + wc * 32 + 8 * fq;
#pragma unroll
        for (int ai = 0; ai < 2; ++ai)
#pragma unroll
            for (int m = 0; m < 4; ++m) { const size_t off = (size_t)(row0 + ai * 128 + m * 16) * D + col0;
#pragma unroll
                for (int bj = 0; bj < 2; ++bj) { const f32x4 b0 = *(const f32x4*)(base + off + bj * 128), b1 = *(const f32x4*)(base + off + bj * 128 + 4);
                    const f32x4 v0 = b0 * alpha + acc[ai][bj][m][0], v1 = b1 * alpha + acc[ai][bj][m][1];
                    u32x4 w; w.x = cvt_pk_bf16(v0[0], v0[1]); w.y = cvt_pk_bf16(v0[2], v0[3]); w.z = cvt_pk_bf16(v1[0], v1[1]); w.w = cvt_pk_bf16(v1[2], v1[3]);
                    *(u32x4*)(O + off + bj * 128) = w; } }
    }
};
struct EpiAct {
    static constexpr bool PERM = true, SEG = false, PREF = false; static constexpr int NST = 6;
    unsigned char* O;
    __device__ __forceinline__ void operator()(const f32x4 (&acc)[2][2][4][2], const Unit& u, int wr, int wc, int fr, int fq) const {
        const int row0 = u.pm * 256 + wr * 64 + fr, col0 = u.pn * 128 + wc * 32 + 8 * fq;
#pragma unroll
        for (int ai = 0; ai < 2; ++ai)
#pragma unroll
            for (int m = 0; m < 4; ++m) { unsigned char* rowp = O + (size_t)(row0 + ai * 128 + m * 16) * DEXP + col0;
                f32x4 r0, r1;
#pragma unroll
                for (int j = 0; j < 4; ++j) { const float g0 = acc[ai][0][m][0][j] * 0.03125f, g1 = acc[ai][0][m][1][j] * 0.03125f;
                    r0[j] = g0 * sigmoidf_(g0) * (acc[ai][1][m][0][j] * 0.03125f); r1[j] = g1 * sigmoidf_(g1) * (acc[ai][1][m][1][j] * 0.03125f); }
                u32x2 w; { int r = __builtin_amdgcn_cvt_pk_fp8_f32(r0[0], r0[1], 0, false); r = __builtin_amdgcn_cvt_pk_fp8_f32(r0[2], r0[3], r, true); w.x = (unsigned)r; }
                { int r = __builtin_amdgcn_cvt_pk_fp8_f32(r1[0], r1[1], 0, false); r = __builtin_amdgcn_cvt_pk_fp8_f32(r1[2], r1[3], r, true); w.y = (unsigned)r; }
                *(u32x2*)rowp = w; }
    }
};

struct Frame {
    LAS unsigned char* lds; int tid, lane, wave, G, bid;
    const Params* p;
};

struct TItem { const float* src; bf16_t* dst; int ldw, ldt, f8; };
constexpr int PREP_NIT = 16 * 256 + 3 * 16 * 32 + 16 * 64 + 4 * 4 * 8 + NEXP * 16 * 32 + NEXP * 8 * 32;
constexpr int PREP_LATE = 6144;
__device__ __forceinline__ bool prep_item(const Params& P, unsigned char* ws, int it, int it_end, TItem& t) {
    constexpr int I_IN = 16 * 256, I_SQ = 16 * 32, I_KV = 16 * 64, I_P = 4 * 4 * 8, I_UP = NEXP * 16 * 32, I_DN = NEXP * 8 * 32;
    constexpr int NIT = I_IN + 3 * I_SQ + I_KV + I_P + I_UP + I_DN; static_assert(NIT == PREP_NIT, "item count");
    if (it >= it_end) return false;
    int r = it;
    if (r < I_IN) { const int kb = r / 256, nb = r % 256, n0 = 32 * nb;
        int drow = n0; if (n0 >= D && n0 < 3 * D) { const int c = (n0 - D) & (D - 1); drow = D + (c >> 7) * 256 + (n0 >= 2 * D ? 128 : 0) + (c & 127); }
        t.src = P.in[I_WIN] + (size_t)(64 * kb) * INCOLS + n0; t.ldw = INCOLS; t.dst = (bf16_t*)(ws + WS_WIN) + (size_t)drow * D + 64 * kb; t.ldt = D; t.f8 = 0; return true; } r -= I_IN;
    if (r < I_SQ) { const int kb = r / 32, nb = r % 32; t.src = P.in[I_WCONV] + (size_t)(64 * kb) * D + 32 * nb; t.ldw = D; t.dst = (bf16_t*)(ws + WS_WCAT) + (size_t)(32 * nb) * KCAT + 64 * kb; t.ldt = KCAT; t.f8 = 0; return true; } r -= I_SQ;
    if (r < I_SQ) { const int kb = r / 32, nb = r % 32; t.src = P.in[I_WXO] + (size_t)(64 * kb) * D + 32 * nb; t.ldw = D; t.dst = (bf16_t*)(ws + WS_WCAT) + (size_t)(32 * nb) * KCAT + 1280 + 64 * kb; t.ldt = KCAT; t.f8 = 0; return true; } r -= I_SQ;
    if (r < I_SQ) { const int kb = r / 32, nb = r % 32; t.src = P.in[I_WO] + (size_t)(64 * kb) * D + 32 * nb; t.ldw = D; t.dst = (bf16_t*)(ws + WS_WO) + (size_t)(32 * nb) * D + 64 * kb; t.ldt = D; t.f8 = 0; return true; } r -= I_SQ;
    if (r < I_KV) { const int kb = r / 64, nb = r % 64; t.src = P.in[I_WKV] + (size_t)(64 * kb) * (2 * D) + 32 * nb; t.ldw = 2 * D; t.dst = (bf16_t*)(ws + WS_WKV) + (size_t)(32 * nb) * D + 64 * kb; t.ldt = D; t.f8 = 0; return true; } r -= I_KV;
    if (r < I_P) { const int g = r / 32, q = r % 32, kb = q / 8, nb = q % 8;
        t.src = P.in[I_WPOOL] + (size_t)g * 65536 + (size_t)(64 * kb) * 256 + 32 * nb; t.ldw = 256; t.dst = (bf16_t*)(ws + WS_WCAT) + (size_t)(g * 256 + 32 * nb) * KCAT + 1024 + 64 * kb; t.ldt = KCAT; t.f8 = 0; return true; } r -= I_P;
    if (r < I_UP) { const int e = r / 512, q = r % 512, kb = q / 32, nb = q % 32; const int n0 = 32 * nb;
        const int j0 = n0 & 511, drow = (j0 >> 7) * 256 + (n0 >= 512 ? 128 : 0) + (j0 & 127);
        t.src = P.in[I_WUP] + (size_t)e * D * D + (size_t)(64 * kb) * D + n0; t.ldw = D; t.dst = (bf16_t*)(ws + WS_WUP + (size_t)e * D * D + (size_t)drow * D + 64 * kb); t.ldt = D; t.f8 = 1; return true; } r -= I_UP;
    { const int e = r / 256, q = r % 256, kb = q / 32, nb = q % 32;
        t.src = P.in[I_WDN] + (size_t)e * DEXP * D + (size_t)(64 * kb) * D + 32 * nb; t.ldw = D; t.dst = (bf16_t*)(ws + WS_WDN + (size_t)e * D * DEXP + (size_t)(32 * nb) * DEXP + 64 * kb); t.ldt = DEXP; t.f8 = 1; return true; }
}
__device__ __forceinline__ void titem_load(const TItem& t, int lane, f32x4 (&v)[8]) {
    const float* s = t.src + (size_t)(lane >> 3) * t.ldw + (lane & 7) * 4;
#pragma unroll
    for (int j = 0; j < 8; ++j) v[j] = *(const f32x4*)(s + (size_t)(8 * j) * t.ldw);
}
__device__ __forceinline__ void titem_finish(const TItem& t, int lane, const f32x4 (&v)[8], LAS float* scr) {
#pragma unroll
    for (int j = 0; j < 8; ++j) { LAS float* d = scr + (8 * j + (lane >> 3)) * 33 + (lane & 7) * 4; d[0] = v[j][0]; d[1] = v[j][1]; d[2] = v[j][2]; d[3] = v[j][3]; }
    asm volatile("s_waitcnt lgkmcnt(0)" ::: "memory");
    if (t.f8) {
        const int c = lane & 3;
#pragma unroll
        for (int j = 0; j < 2; ++j) { const int n = (lane >> 2) + 16 * j; const LAS float* s = scr + (16 * c) * 33 + n;
            u32x4 o;
            { int r = __builtin_amdgcn_cvt_pk_fp8_f32(s[0 * 33] * 32.f, s[1 * 33] * 32.f, 0, false); r = __builtin_amdgcn_cvt_pk_fp8_f32(s[2 * 33] * 32.f, s[3 * 33] * 32.f, r, true); o.x = (unsigned)r; }
            { int r = __builtin_amdgcn_cvt_pk_fp8_f32(s[4 * 33] * 32.f, s[5 * 33] * 32.f, 0, false); r = __builtin_amdgcn_cvt_pk_fp8_f32(s[6 * 33] * 32.f, s[7 * 33] * 32.f, r, true); o.y = (unsigned)r; }
            { int r = __builtin_amdgcn_cvt_pk_fp8_f32(s[8 * 33] * 32.f, s[9 * 33] * 32.f, 0, false); r = __builtin_amdgcn_cvt_pk_fp8_f32(s[10 * 33] * 32.f, s[11 * 33] * 32.f, r, true); o.z = (unsigned)r; }
            { int r = __builtin_amdgcn_cvt_pk_fp8_f32(s[12 * 33] * 32.f, s[13 * 33] * 32.f, 0, false); r = __builtin_amdgcn_cvt_pk_fp8_f32(s[14 * 33] * 32.f, s[15 * 33] * 32.f, r, true); o.w = (unsigned)r; }
            *(u32x4*)((unsigned char*)t.dst + (size_t)n * t.ldt + 16 * c) = o; }
    } else {
    const int c = lane & 7;
#pragma unroll
    for (int j = 0; j < 4; ++j) { const int n = (lane >> 3) + 8 * j; const LAS float* s = scr + (8 * c) * 33 + n;
        u32x4 o; o.x = cvt_pk_bf16(s[0 * 33], s[1 * 33]); o.y = cvt_pk_bf16(s[2 * 33], s[3 * 33]); o.z = cvt_pk_bf16(s[4 * 33], s[5 * 33]); o.w = cvt_pk_bf16(s[6 * 33], s[7 * 33]);
        *(u32x4*)(t.dst + (size_t)n * t.ldt + 8 * c) = o; }
    }
    asm volatile("s_waitcnt lgkmcnt(0)" ::: "memory");
}

__device__ __forceinline__ void prep_win_i8(const Frame& F) {
    const Params& P = *F.p; unsigned char* ws = P.ws;
    LAS float* scr = (LAS float*)(F.lds + F.wave * 16384);
    LAS float* cmx = (LAS float*)(F.lds + 131072 + 8192);
    const int lane = F.lane, c4 = (lane & 7) * 4;
    for (int nb = F.bid; nb < INCOLS / 32; nb += F.G) {
        const int n0 = 32 * nb;
        int drow = n0; if (n0 >= D && n0 < 3 * D) { const int c = (n0 - D) & (D - 1); drow = D + (c >> 7) * 256 + (n0 >= 2 * D ? 128 : 0) + (c & 127); }
        f32x4 va[8], vb[8]; TItem ta, tb;
        ta.src = P.in[I_WIN] + (size_t)(64 * (2 * F.wave)) * INCOLS + n0; ta.ldw = INCOLS; tb.src = ta.src + (size_t)64 * INCOLS; tb.ldw = INCOLS;
        titem_load(ta, lane, va); titem_load(tb, lane, vb);
        f32x4 mx = (f32x4){0.f, 0.f, 0.f, 0.f};
#pragma unroll
        for (int j = 0; j < 8; ++j) { mx = __builtin_elementwise_max(mx, __builtin_elementwise_max(__builtin_elementwise_abs(va[j]), __builtin_elementwise_abs(vb[j]))); }
#pragma unroll
        for (int o = 8; o < 64; o <<= 1) {
#pragma unroll
            for (int q = 0; q < 4; ++q) mx[q] = fmaxf(mx[q], __shfl_xor(mx[q], o)); }
        __syncthreads();
        if (lane < 8) { LAS float* d = cmx + F.wave * 32 + c4; d[0] = mx[0]; d[1] = mx[1]; d[2] = mx[2]; d[3] = mx[3]; }
        __syncthreads();
        if (F.tid < 32) { float m = 0.f;
#pragma unroll
            for (int w = 0; w < 8; ++w) m = fmaxf(m, cmx[w * 32 + F.tid]);
            cmx[256 + F.tid] = m > 0.f ? 127.0f / m : 0.f; ((float*)(ws + WS_SW))[drow + F.tid] = m > 0.f ? m * (1.0f / 127.0f) : 1.0f; }
        __syncthreads();
#pragma unroll
        for (int blk = 0; blk < 2; ++blk) {
#pragma unroll
            for (int j = 0; j < 8; ++j) { const f32x4 x = blk ? vb[j] : va[j]; LAS float* d = scr + (8 * j + (lane >> 3)) * 33 + c4; d[0] = x[0]; d[1] = x[1]; d[2] = x[2]; d[3] = x[3]; }
            asm volatile("s_waitcnt lgkmcnt(0)" ::: "memory");
            const int c = lane & 3;
#pragma unroll
            for (int j = 0; j < 2; ++j) { const int n = (lane >> 2) + 16 * j; const LAS float* s = scr + (16 * c) * 33 + n; const float inv = cmx[256 + n];
                u32x4 o;
#pragma unroll
                for (int g = 0; g < 4; ++g) { o[g] = ((unsigned)(int)__builtin_rintf(s[(4 * g) * 33] * inv) & 0xffu) | (((unsigned)(int)__builtin_rintf(s[(4 * g + 1) * 33] * inv) & 0xffu) << 8) | (((unsigned)(int)__builtin_rintf(s[(4 * g + 2) * 33] * inv) & 0xffu) << 16) | ((unsigned)(int)__builtin_rintf(s[(4 * g + 3) * 33] * inv) << 24); }
                *(u32x4*)(ws + WS_WIN + (size_t)(drow + n) * D + 64 * (2 * F.wave + blk) + 16 * c) = o; }
            asm volatile("s_waitcnt lgkmcnt(0)" ::: "memory");
        }
    }
    __syncthreads();
}

__device__ __forceinline__ void convert_items(const Frame& F, int it0, int it1, int w, int nw) {
    const Params& P = *F.p; unsigned char* ws = P.ws;
    LAS float* scr = (LAS float*)(F.lds + F.wave * 16384);
    TItem cur, nxt; f32x4 va[8], vb[8];
    int it = it0 + w; bool have = prep_item(P, ws, it, it1, cur);
    if (have) titem_load(cur, F.lane, va);
    while (have) {
        const bool hn = prep_item(P, ws, it + nw, it1, nxt);
        if (hn) titem_load(nxt, F.lane, vb);
        titem_finish(cur, F.lane, va, scr);
        if (!hn) break;
        it += 2 * nw;
        have = prep_item(P, ws, it, it1, cur);
        if (have) titem_load(cur, F.lane, va);
        titem_finish(nxt, F.lane, vb, scr);
    }
}

__device__ __forceinline__ void phase_prep(const Frame& F) {
    const Params& P = *F.p; unsigned char* ws = P.ws;
    LAS float* scr = (LAS float*)(F.lds + F.wave * 16384);
    const int gw = F.bid * NWAVES + F.wave, NGW = F.G * NWAVES;
    prep_win_i8(F);
    const size_t gt = (size_t)F.bid * NTHR + F.tid, NGT = (size_t)F.G * NTHR;
    for (int row0 = gw * 4; row0 < NTOK; row0 += NGW * 4) {
        f32x4 v[4][4]; float am[4];
#pragma unroll
        for (int a = 0; a < 4; ++a) { const f32x4* xr = (const f32x4*)(P.in[I_X] + (size_t)(row0 + a) * D) + F.lane;
#pragma unroll
            for (int j = 0; j < 4; ++j) v[a][j] = xr[64 * j]; }
#pragma unroll
        for (int a = 0; a < 4; ++a) { am[a] = 0.f;
#pragma unroll
            for (int j = 0; j < 4; ++j) am[a] = fmaxf(am[a], fmaxf(fmaxf(fabsf(v[a][j][0]), fabsf(v[a][j][1])), fmaxf(fabsf(v[a][j][2]), fabsf(v[a][j][3])))); }
#pragma unroll
        for (int o = 1; o < 64; o <<= 1) {
#pragma unroll
            for (int a = 0; a < 4; ++a) am[a] = fmaxf(am[a], __shfl_xor(am[a], o)); }
#pragma unroll
        for (int a = 0; a < 4; ++a) { const float inv = am[a] > 0.f ? 127.0f / am[a] : 0.f;
            if (F.lane == 0) ((float*)(ws + WS_XS))[row0 + a] = am[a] > 0.f ? am[a] * (1.0f / 127.0f) : 1.0f;
#pragma unroll
            for (int j = 0; j < 4; ++j) { const f32x4 q = v[a][j] * inv;
                const unsigned w = ((unsigned)(int)__builtin_rintf(q[0]) & 0xffu) | (((unsigned)(int)__builtin_rintf(q[1]) & 0xffu) << 8) | (((unsigned)(int)__builtin_rintf(q[2]) & 0xffu) << 16) | ((unsigned)(int)__builtin_rintf(q[3]) << 24);
                *((unsigned*)(ws + WS_XB + (size_t)(row0 + a) * D) + F.lane + 64 * j) = w; } }
    }
    { const f32x4* src = (const f32x4*)P.in[I_MEM]; u32x4* dst = (u32x4*)(ws + WS_MEMB);
      for (size_t i = gt; i < (size_t)NMEM * D / 8; i += NGT) { const f32x4 a = src[2 * i], b = src[2 * i + 1]; u32x4 o; o.x = cvt_pk_bf16(a[0], a[1]); o.y = cvt_pk_bf16(a[2], a[3]); o.z = cvt_pk_bf16(b[0], b[1]); o.w = cvt_pk_bf16(b[2], b[3]); dst[i] = o; } }
    { bf16_t* wr = (bf16_t*)(ws + WS_WR);
      for (size_t i = gt; i < (size_t)80 * D; i += NGT) { const int o = (int)(i / D), k = (int)(i % D); wr[i] = (bf16_t)f2bf(o < 8 ? P.in[I_WRG][(size_t)k * 8 + o] : (o < 72 ? P.in[I_WRE][(size_t)k * 64 + (o - 8)] : 0.f)); } }
    convert_items(F, 16 * 256, PREP_NIT - PREP_LATE, gw, NGW);
}

struct F8 { f32x4 a, b; };
__device__ __forceinline__ F8 up8(const u32x4 v) { F8 r; r.a = (f32x4){bf_lo(v.x), bf_hi(v.x), bf_lo(v.y), bf_hi(v.y)}; r.b = (f32x4){bf_lo(v.z), bf_hi(v.z), bf_lo(v.w), bf_hi(v.w)}; return r; }
__device__ __forceinline__ u32x4 pk8(const F8 v) { u32x4 o; o.x = pk2(v.a[0], v.a[1]); o.y = pk2(v.a[2], v.a[3]); o.z = pk2(v.b[0], v.b[1]); o.w = pk2(v.b[2], v.b[3]); return o; }
__device__ __forceinline__ void phase_convpool(const Frame& F) {
    const Params& P = *F.p; unsigned char* ws = P.ws;
    const bf16_t* __restrict__ Z = (const bf16_t*)(ws + WS_Z); bf16_t* __restrict__ AC = (bf16_t*)(ws + WS_ACONV); bf16_t* __restrict__ DP = (bf16_t*)(ws + WS_DPOOL);
    const float* cw = P.in[I_CONVW];
    const int gt = F.bid * NTHR + F.tid, NGT = F.G * NTHR;
    constexpr int TSEG = 32;
    for (int it = gt; it < (NTOK / TSEG) * (D / 8); it += NGT) {
        const int c0 = (it & 127) * 8, t0 = (it >> 7) * TSEG, s0 = t0 & (SEQ - 1);
        const int gi = c0 >> 8, w = 2 << gi;
        F8 w0, w1, w2;
        w0.a = *(const f32x4*)(cw + c0); w0.b = *(const f32x4*)(cw + c0 + 4); w1.a = *(const f32x4*)(cw + D + c0); w1.b = *(const f32x4*)(cw + D + c0 + 4); w2.a = *(const f32x4*)(cw + 2 * D + c0); w2.b = *(const f32x4*)(cw + 2 * D + c0 + 4);
        const bf16_t* zr0 = Z + (size_t)t0 * INCOLS + c0;
        F8 u1, u2, run;
        u1.a = u1.b = u2.a = u2.b = run.a = run.b = (f32x4){0.f, 0.f, 0.f, 0.f};
        if (s0 > 0) {
            u1 = up8(*(const u32x4*)(zr0 - INCOLS + D)); u2 = up8(*(const u32x4*)(zr0 - 2 * INCOLS + D));
            for (int i = 1; i < w; ++i) { const F8 pp = up8(*(const u32x4*)(zr0 - (size_t)i * INCOLS + 3 * D)); run.a += pp.a; run.b += pp.b; }
        }
        for (int tb = 0; tb < TSEG; tb += 4) {
            u32x4 lcb[4], lcc[4], lp[4], lold[4];
#pragma unroll
            for (int j = 0; j < 4; ++j) { const bf16_t* zr = zr0 + (size_t)(tb + j) * INCOLS;
                lcb[j] = *(const u32x4*)(zr); lcc[j] = *(const u32x4*)(zr + D); lp[j] = *(const u32x4*)(zr + 3 * D);
                lold[j] = (s0 + tb + j - (w - 1) >= 0) ? *(const u32x4*)(zr - (size_t)(w - 1) * INCOLS + 3 * D) : (u32x4){0u, 0u, 0u, 0u}; }
#pragma unroll
            for (int j = 0; j < 4; ++j) {
                const F8 cb = up8(lcb[j]), u0 = up8(lcc[j]);
                F8 v; v.a = (w0.a * u2.a + w1.a * u1.a + w2.a * u0.a) * cb.a; v.b = (w0.b * u2.b + w1.b * u1.b + w2.b * u0.b) * cb.b;
                *(u32x4*)(AC + (size_t)(t0 + tb + j) * D + c0) = pk8(v);
                u2 = u1; u1 = u0;
                const F8 pp = up8(lp[j]), po = up8(lold[j]);
                run.a += pp.a; run.b += pp.b;
                const int s = s0 + tb + j; const int cnt = (s + 1) < w ? (s + 1) : w; const float inv = 1.0f / (float)cnt;
                F8 d; d.a = run.a * inv - pp.a; d.b = run.b * inv - pp.b;
                *(u32x4*)(DP + (size_t)(t0 + tb + j) * D + c0) = pk8(d);
                run.a -= po.a; run.b -= po.b;
            }
        }
    }
}

typedef float f32x16 __attribute__((ext_vector_type(16)));
typedef float f32x2_t __attribute__((ext_vector_type(2))); typedef __bf16 bf16x2_t __attribute__((ext_vector_type(2)));
__device__ __forceinline__ unsigned cvtpk(float lo, float hi) { f32x2_t v = {lo, hi}; bf16x2_t b = __builtin_convertvector(v, bf16x2_t); return __builtin_bit_cast(unsigned, b); }
#define MFMA32(a, b, c) __builtin_amdgcn_mfma_f32_32x32x16_bf16((a), (b), (c), 0, 0, 0)
__device__ __forceinline__ void phase_attn(const Frame& F) {
    const Params& P = *F.p; unsigned char* ws = P.ws;
    const bf16_t* Z = (const bf16_t*)(ws + WS_Z); bf16_t* O = (bf16_t*)(ws + WS_O);
    const int tid = F.tid, lane = F.lane, wave = F.wave, r = lane & 31, hh = lane >> 5;
    const int prow = tid >> 5, pc = (tid & 31) ^ prow;
    LAS unsigned char* lds = F.lds;
    int rb[8];
#pragma unroll
    for (int t = 0; t < 8; ++t) rb[t] = r * 512 + (((2 * t + hh) ^ (r & 15)) << 4);
#define AT_WAIT_BAR(N) asm volatile("s_waitcnt vmcnt(" #N ")\n\ts_barrier" ::: "memory")
#define AT_ISSUE(i) do { const char* _s = ((i) < 8) ? ksrc + (size_t)(32 * (i)) * 2048 : vsrc + (size_t)(32 * ((i) - 8)) * 512; const size_t _rs = ((i) < 8) ? 2048 : 512; \
        _Pragma("unroll") for (int _it = 0; _it < 2; ++_it) \
        __builtin_amdgcn_global_load_lds((const unsigned*)(_s + (size_t)(16 * _it) * _rs), (LAS unsigned*)(lds + ((i) & 3) * 16384 + _it * 8192 + wave * 1024), 16, 0, 0); } while (0)
#define AT_FRAG(slot, s) (*(const LAS pg8::bf16x8*)(lds + rb[(s) & 7] + (slot) * 16384 + ((s) >> 3) * 256))
    for (int ui = F.bid; ui < (NTOK / 256) * 4; ui += F.G) {
        const int h = ui & 3, t0 = (ui >> 2) * 256, b = t0 / SEQ;
        const bf16_t* qrow = Z + (size_t)(t0 + 32 * wave + r) * INCOLS + 4 * D + h * 256 + 8 * hh;
        pg8::bf16x8 qf[16];
#pragma unroll
        for (int s = 0; s < 16; ++s) qf[s] = *(const pg8::bf16x8*)(qrow + 16 * s);
        const char* ksrc = (const char*)(ws + WS_KB) + ((size_t)(b * 256 + prow) * D + h * 256) * 2 + pc * 16;
        const char* vsrc = (const char*)(ws + WS_VT) + ((size_t)(b * D + h * 256 + prow) * 256) * 2 + pc * 16;
        asm volatile("s_barrier" ::: "memory");
        AT_ISSUE(0); AT_ISSUE(1); AT_ISSUE(2);
        f32x16 S[8];
#pragma unroll
        for (int i = 0; i < 8; ++i)
#pragma unroll
            for (int j = 0; j < 16; ++j) S[i][j] = 0.f;
#pragma unroll
        for (int i = 0; i < 8; ++i) {
            AT_WAIT_BAR(4);
            AT_ISSUE(i + 3);
#pragma unroll
            for (int s = 0; s < 16; ++s) {
                const pg8::bf16x8 a = AT_FRAG(i & 3, s);
                S[i] = MFMA32(a, qf[s], S[i]);
                if ((s & 3) == 3) asm volatile("" ::: "memory");
            }
        }
        float mx = S[0][0];
#pragma unroll
        for (int i = 0; i < 8; ++i)
#pragma unroll
            for (int j = 0; j < 16; ++j) mx = fmaxf(mx, S[i][j]);
        mx = fmaxf(mx, __shfl_xor(mx, 32));
        const float c2 = 0.0625f * 1.4426950408889634f;
        float sum = 0.f;
        pg8::bf16x8 pf[8][2];
#pragma unroll
        for (int i = 0; i < 8; ++i) {
#pragma unroll
            for (int j = 0; j < 16; ++j) { const float e = __builtin_amdgcn_exp2f((S[i][j] - mx) * c2); S[i][j] = e; sum += e; }
#pragma unroll
            for (int s2 = 0; s2 < 2; ++s2) { u32x4 w; w.x = cvtpk(S[i][8 * s2], S[i][8 * s2 + 1]); w.y = cvtpk(S[i][8 * s2 + 2], S[i][8 * s2 + 3]); w.z = cvtpk(S[i][8 * s2 + 4], S[i][8 * s2 + 5]); w.w = cvtpk(S[i][8 * s2 + 6], S[i][8 * s2 + 7]);
                pf[i][s2] = __builtin_bit_cast(pg8::bf16x8, w); }
        }
        sum += __shfl_xor(sum, 32);
        const float inv = 1.0f / sum;
        bf16_t* orow = O + (size_t)(t0 + 32 * wave + r) * D + h * 256 + 4 * hh;
#pragma unroll
        for (int i = 8; i < 16; ++i) {
            if (i < 14) AT_WAIT_BAR(4); else if (i == 14) AT_WAIT_BAR(2); else AT_WAIT_BAR(0);
            if (i + 3 < 16) AT_ISSUE(i + 3);
            f32x16 o;
#pragma unroll
            for (int j = 0; j < 16; ++j) o[j] = 0.f;
#pragma unroll
            for (int s = 0; s < 16; ++s) {
                const pg8::bf16x8 a = AT_FRAG(i & 3, s);
                o = MFMA32(a, pf[s >> 1][s & 1], o);
                if ((s & 3) == 3) asm volatile("" ::: "memory");
            }
#pragma unroll
            for (int g = 0; g < 4; ++g) { u32x2 w; w.x = cvtpk(o[4 * g] * inv, o[4 * g + 1] * inv); w.y = cvtpk(o[4 * g + 2] * inv, o[4 * g + 3] * inv);
                *(u32x2*)(orow + 32 * (i - 8) + 8 * g) = w; }
        }
    }
    asm volatile("s_waitcnt vmcnt(0)\n\ts_barrier" ::: "memory");
#undef AT_WAIT_BAR
#undef AT_ISSUE
#undef AT_FRAG
}

__device__ __forceinline__ void phase_ln1_router(const Frame& F) {
    const Params& P = *F.p; unsigned char* ws = P.ws;
    const bf16_t* H1 = (const bf16_t*)(ws + WS_H1); bf16_t* H1B = (bf16_t*)(ws + WS_H1B); const bf16_t* WRB = (const bf16_t*)(ws + WS_WR);
    unsigned* ctl = (unsigned*)(ws + WS_CTL);
    int* tok_e = (int*)(ws + WS_MISC + MS_TOKE); int* tok_pos = (int*)(ws + WS_MISC + MS_TOKPOS); float* tok_w = (float*)(ws + WS_MISC + MS_TOKW);
    LAS float* lg = (LAS float*)(F.lds + F.wave * 5120);
    LAS unsigned* lcnt = (LAS unsigned*)(F.lds + 8 * 5120);
    const int lane = F.lane;
    const float* g1 = P.in[I_LN1G]; const float* b1 = P.in[I_LN1B];
    f32x4 gg[4], bb[4];
#pragma unroll
    for (int j = 0; j < 4; ++j) { gg[j] = *((const f32x4*)g1 + lane + 64 * j); bb[j] = *((const f32x4*)b1 + lane + 64 * j); }
    for (int grp0 = F.bid * NWAVES; grp0 < NTOK / 16; grp0 += F.G * NWAVES) {
        const int row0 = (grp0 + F.wave) * 16;
        if (F.tid < 128) lcnt[F.tid] = 0u;
        for (int rb = 0; rb < 16; rb += 4) {
            f32x4 v[4][4]; float s[4], q[4];
#pragma unroll
            for (int a = 0; a < 4; ++a) { const u32x2* xr = (const u32x2*)(H1 + (size_t)(row0 + rb + a) * D) + lane;
#pragma unroll
                for (int j = 0; j < 4; ++j) { const u32x2 p = xr[64 * j]; v[a][j] = (f32x4){bf_lo(p.x), bf_hi(p.x), bf_lo(p.y), bf_hi(p.y)}; } }
#pragma unroll
            for (int a = 0; a < 4; ++a) { s[a] = 0.f;
#pragma unroll
                for (int j = 0; j < 4; ++j) s[a] += (v[a][j][0] + v[a][j][1]) + (v[a][j][2] + v[a][j][3]); }
#pragma unroll
            for (int o = 1; o < 64; o <<= 1) {
#pragma unroll
                for (int a = 0; a < 4; ++a) s[a] += __shfl_xor(s[a], o); }
#pragma unroll
            for (int a = 0; a < 4; ++a) { const float mean = s[a] * (1.f / D); q[a] = 0.f;
#pragma unroll
                for (int j = 0; j < 4; ++j) { v[a][j] = v[a][j] - mean; q[a] += (v[a][j][0] * v[a][j][0] + v[a][j][1] * v[a][j][1]) + (v[a][j][2] * v[a][j][2] + v[a][j][3] * v[a][j][3]); } }
#pragma unroll
            for (int o = 1; o < 64; o <<= 1) {
#pragma unroll
                for (int a = 0; a < 4; ++a) q[a] += __shfl_xor(q[a], o); }
#pragma unroll
            for (int a = 0; a < 4; ++a) { const float rstd = 1.f / sqrtf(q[a] * (1.f / D) + LN_EPS);
#pragma unroll
                for (int j = 0; j < 4; ++j) { const f32x4 y = v[a][j] * rstd * gg[j] + bb[j];
                    u32x2 o; o.x = cvt_pk_bf16(y[0], y[1]); o.y = cvt_pk_bf16(y[2], y[3]); *((u32x2*)(H1B + (size_t)(row0 + rb + a) * D) + lane + 64 * j) = o;
                    int r8 = __builtin_amdgcn_cvt_pk_fp8_f32(y[0], y[1], 0, false); r8 = __builtin_amdgcn_cvt_pk_fp8_f32(y[2], y[3], r8, true);
                    *((int*)(ws + WS_H1F8 + (size_t)(row0 + rb + a) * D) + lane + 64 * j) = r8; } }
        }
        asm volatile("s_waitcnt vmcnt(0)" ::: "memory");
        f32x4 acc[5];
#pragma unroll
        for (int n = 0; n < 5; ++n) acc[n] = (f32x4){0.f, 0.f, 0.f, 0.f};
        const bf16_t* ap = H1B + (size_t)(row0 + (lane & 15)) * D + 8 * (lane >> 4);
        const bf16_t* bp = WRB + (size_t)(lane & 15) * D + 8 * (lane >> 4);
#pragma unroll 8
        for (int ks = 0; ks < 32; ++ks) {
            const pg8::bf16x8 a = *(const pg8::bf16x8*)(ap + 32 * ks);
#pragma unroll
            for (int n = 0; n < 5; ++n) { const pg8::bf16x8 bw = *(const pg8::bf16x8*)(bp + (size_t)n * 16 * D + 32 * ks); acc[n] = __builtin_amdgcn_mfma_f32_16x16x32_bf16(a, bw, acc[n], 0, 0, 0); }
        }
#pragma unroll
        for (int n = 0; n < 5; ++n)
#pragma unroll
            for (int i = 0; i < 4; ++i) lg[(4 * (lane >> 4) + i) * 80 + 16 * n + (lane & 15)] = acc[n][i];
        __syncthreads();
        int ea = 0, eb = 0; unsigned la = 0, lb = 0; float w1 = 0.f, w2 = 0.f;
        if (lane < 16) {
            const LAS float* l = lg + lane * 80;
            const float* brg = P.in[I_BRG]; const float* bre = P.in[I_BRE];
            int gs = 0; float gm = l[0] + brg[0];
            for (int i = 1; i < 8; ++i) { const float x = l[i] + brg[i]; if (x > gm) { gm = x; gs = i; } }
            float den = 0.f; for (int i = 0; i < 8; ++i) den += __expf(l[i] + brg[i] - gm);
            const float gwt = 1.0f / den;
            int i1 = 0; float l1 = l[8 + gs * 8] + bre[gs * 8];
            for (int i = 1; i < 8; ++i) { const float x = l[8 + gs * 8 + i] + bre[gs * 8 + i]; if (x > l1) { l1 = x; i1 = i; } }
            int i2 = -1; float l2 = 0.f;
            for (int i = 0; i < 8; ++i) { if (i == i1) continue; const float x = l[8 + gs * 8 + i] + bre[gs * 8 + i]; if (i2 < 0 || x > l2) { l2 = x; i2 = i; } }
            const float e2 = __expf(l2 - l1); w1 = gwt / (1.0f + e2); w2 = gwt * e2 / (1.0f + e2);
            ea = gs * 8 + i1; eb = gs * 8 + i2;
            la = atomicAdd((unsigned*)(lcnt + ea), 1u); lb = atomicAdd((unsigned*)(lcnt + eb), 1u);
        }
        __syncthreads();
        if (F.tid < 64) { const unsigned c = lcnt[F.tid]; lcnt[64 + F.tid] = c ? atomicAdd(ctl + CW_COUNTS + F.tid, c) : 0u; }
        __syncthreads();
        if (lane < 16) { const int row = row0 + lane;
            tok_e[2 * row] = ea; tok_e[2 * row + 1] = eb; tok_pos[2 * row] = (int)(lcnt[64 + ea] + la); tok_pos[2 * row + 1] = (int)(lcnt[64 + eb] + lb); tok_w[2 * row] = w1; tok_w[2 * row + 1] = w2; }
        __syncthreads();
    }
}

__device__ __forceinline__ void phase_gather(const Frame& F) {
    const Params& P = *F.p; unsigned char* ws = P.ws;
    const int* tok_e = (const int*)(ws + WS_MISC + MS_TOKE); const int* tok_pos = (const int*)(ws + WS_MISC + MS_TOKPOS); int* tok_dest = (int*)(ws + WS_MISC + MS_TOKDEST);
    const unsigned char* H1F = ws + WS_H1F8; unsigned char* XB = ws + WS_XBUF;
    LAS int* ps = (LAS int*)F.lds;
    if (F.tid == 0) {
        const unsigned* cnt = (const unsigned*)(ws + WS_CTL) + CW_COUNTS;
        int* tile_e = (int*)(ws + WS_MISC + MS_TILEE); int* ntl = (int*)(ws + WS_MISC + MS_NTILES);
        int run = 0;
        for (int e = 0; e < NEXP; ++e) { const int c = (int)cnt[e]; ps[e] = run * 256; const int nte = (c + 255) / 256; if (F.bid == 0) for (int k = 0; k < nte; ++k) tile_e[run + k] = e; run += nte; }
        if (F.bid == 0) ntl[0] = run;
    }
    __syncthreads();
    const int gw = F.bid * NWAVES + F.wave, NGW = F.G * NWAVES;
    for (int a = gw; a < NASSIGN; a += NGW) {
        const int dest = ps[tok_e[a]] + tok_pos[a];
        const u32x4* src = (const u32x4*)(H1F + (size_t)(a >> 1) * D) + F.lane; u32x4* dst = (u32x4*)(XB + (size_t)dest * D) + F.lane;
        dst[0] = src[0];
        if (F.lane == 0) tok_dest[a] = dest;
    }
    __syncthreads();
}

__device__ __forceinline__ void phase_combine(const Frame& F) {
    const Params& P = *F.p; unsigned char* ws = P.ws;
    const bf16_t* H1B = (const bf16_t*)(ws + WS_H1B); const bf16_t* YB = (const bf16_t*)(ws + WS_YBUF);
    const int* tok_dest = (const int*)(ws + WS_MISC + MS_TOKDEST); const float* tok_w = (const float*)(ws + WS_MISC + MS_TOKW);
    const int gw = F.bid * NWAVES + F.wave, NGW = F.G * NWAVES, lane = F.lane;
    const float* g2 = P.in[I_LN2G]; const float* b2 = P.in[I_LN2B];
    for (int row = gw; row < NTOK; row += NGW) {
        const int d0 = tok_dest[2 * row], d1 = tok_dest[2 * row + 1]; const float w0 = tok_w[2 * row], w1 = tok_w[2 * row + 1];
        const u32x2* xr = (const u32x2*)(H1B + (size_t)row * D) + lane;
        const u32x2* y0 = (const u32x2*)(YB + (size_t)d0 * D) + lane; const u32x2* y1 = (const u32x2*)(YB + (size_t)d1 * D) + lane;
        f32x4 v[4]; float s = 0.f;
#pragma unroll
        for (int j = 0; j < 4; ++j) { const u32x2 x = xr[64 * j]; const u32x2 a = y0[64 * j], b = y1[64 * j];
            v[j][0] = ALPHA * bf_lo(x.x) + (w0 * bf_lo(a.x) + w1 * bf_lo(b.x)); v[j][1] = ALPHA * bf_hi(x.x) + (w0 * bf_hi(a.x) + w1 * bf_hi(b.x));
            v[j][2] = ALPHA * bf_lo(x.y) + (w0 * bf_lo(a.y) + w1 * bf_lo(b.y)); v[j][3] = ALPHA * bf_hi(x.y) + (w0 * bf_hi(a.y) + w1 * bf_hi(b.y));
            s += (v[j][0] + v[j][1]) + (v[j][2] + v[j][3]); }
        const float mean = wave_sum(s) * (1.f / D); float s2 = 0.f;
#pragma unroll
        for (int j = 0; j < 4; ++j) { v[j] = v[j] - mean; s2 += (v[j][0] * v[j][0] + v[j][1] * v[j][1]) + (v[j][2] * v[j][2] + v[j][3] * v[j][3]); }
        const float rstd = 1.f / sqrtf(wave_sum(s2) * (1.f / D) + LN_EPS);
        f32x4* orow = (f32x4*)(P.out + (size_t)row * D) + lane;
#pragma unroll
        for (int j = 0; j < 4; ++j) { const f32x4 gg = *((const f32x4*)g2 + lane + 64 * j), bb = *((const f32x4*)b2 + lane + 64 * j); orow[64 * j] = v[j] * rstd * gg + bb; }
    }
}

constexpr int NPHASE = 15;
__global__ void __launch_bounds__(NTHR, 2) fwd_kernel(Params prm) {
    extern __shared__ __attribute__((aligned(16))) unsigned char lds_raw[];
    Frame F; F.lds = (LAS unsigned char*)lds_raw; F.tid = threadIdx.x; F.lane = F.tid & 63; F.wave = __builtin_amdgcn_readfirstlane(F.tid >> 6); F.G = gridDim.x; F.bid = blockIdx.x; F.p = &prm;
    unsigned char* ws = prm.ws;
    const int lo = prm.ph_lo, hi = prm.ph_hi;
    volatile LAS unsigned* MISC = (volatile LAS unsigned*)(F.lds + MISC_OFF);
    if (F.tid < 32) MISC[F.tid] = 0u;
    __syncthreads();
    if (lo < 0) cg::this_grid().sync();
    XcdBarrier bar; bar.bar = (unsigned*)(ws + WS_CTL) + CW_BAR; bar.x = 0; bar.st = nullptr;
    if (hi - lo > 1) bar = xcd_barrier_post((unsigned*)(ws + WS_CTL) + CW_BAR, MISC + 8);
#define IN(k) (lo <= (k) && (k) < hi)
#define SEAM(k) do { if (IN(k) && IN((k) + 1)) { xcd_barrier(bar); } } while (0)
#define PHASE(k, ...) do { if (IN(k)) { __VA_ARGS__ if (PROBE_PH == (k)) { xcd_barrier(bar); __VA_ARGS__ } } SEAM(k); } while (0);
    const bf16_t* Zc = (const bf16_t*)(ws + WS_Z);

    PHASE(0, { phase_prep(F); })
    PHASE(1, {
        pg8::StaticOrder S{NTOK / 256, INCOLS / 256, F.G, F.bid, (const char*)(ws + WS_XB), (const char*)(ws + WS_WIN), (size_t)256 * D, (size_t)256 * D, 0};
        EpiBf16 E{(bf16_t*)(ws + WS_Z), INCOLS, prm.in[I_BGATE], GATE0 / 256, GATE0, 1.0f, 4, 12, D, (const float*)(ws + WS_XS), (const float*)(ws + WS_SW)};
        pg8::gemm_phase<EpiBf16, pg8::StaticOrder, true, true, 2>(F.lds, D / 2, D / 2, D / 2, S, E);
    })
    PHASE(2, {
        pg8::KVOrder S{F.G, F.bid, (const char*)(ws + WS_MEMB), (const char*)(ws + WS_WKV)};
        EpiKV E{(bf16_t*)(ws + WS_KB), (bf16_t*)(ws + WS_VT)};
        pg8::gemm_phase<EpiKV, pg8::KVOrder, true, true>(F.lds, D, D, D, S, E);
        if (F.bid >= 64) convert_items(F, PREP_NIT - PREP_LATE, PREP_NIT, (F.bid - 64) * NWAVES + F.wave, (F.G - 64) * NWAVES);
    })
    PHASE(3, { phase_convpool(F); })
    PHASE(4, { phase_attn(F); })
    PHASE(7, {
        pg8::SegOrder S{NTOK / 256, D / 256, F.G, F.bid, (const char*)(ws + WS_ACONV), (const char*)(ws + WS_DPOOL), (const char*)(ws + WS_O), (const char*)(ws + WS_WCAT), (size_t)256 * D * 2, (size_t)256 * KCAT * 2, (size_t)256 * 2};
        EpiMix3 E{(bf16_t*)(ws + WS_MERGED), Zc, prm.in[I_PSCALE]};
        pg8::gemm_phase<EpiMix3, pg8::SegOrder, true, true>(F.lds, KCAT, D, KCAT, S, E);
    })
    PHASE(8, {
        pg8::StaticOrder S{NTOK / 256, D / 256, F.G, F.bid, (const char*)(ws + WS_MERGED), (const char*)(ws + WS_WO), (size_t)256 * D * 2, (size_t)256 * D * 2, 0};
        EpiResBf16 E{(bf16_t*)(ws + WS_H1), prm.in[I_X], ALPHA};
        pg8::gemm_phase<EpiResBf16, pg8::StaticOrder, true, true>(F.lds, D, D, D, S, E);
    })
    PHASE(9, { phase_ln1_router(F); })
    PHASE(11, { phase_gather(F); })
    PHASE(12, {
        const int ntl = *(const int*)(ws + WS_MISC + MS_NTILES);
        pg8::MoeOrder S{ntl, 4, F.G, F.bid, (const char*)(ws + WS_XBUF), (const char*)(ws + WS_WUP), (size_t)256 * D, (size_t)256 * D, (size_t)D * D, (const int*)(ws + WS_MISC + MS_TILEE)};
        EpiAct E{ws + WS_ACT};
        pg8::gemm_phase<EpiAct, pg8::MoeOrder, true, true, 1>(F.lds, D / 2, D / 2, D / 2, S, E);
    })
    PHASE(13, {
        const int ntl = *(const int*)(ws + WS_MISC + MS_NTILES);
        pg8::MoeOrder S{ntl, 4, F.G, F.bid, (const char*)(ws + WS_ACT), (const char*)(ws + WS_WDN), (size_t)256 * DEXP, (size_t)256 * DEXP, (size_t)D * DEXP, (const int*)(ws + WS_MISC + MS_TILEE)};
        EpiBf16 E{(bf16_t*)(ws + WS_YBUF), D, nullptr, 1 << 30, 0, 0.03125f, 0, 0, 0, nullptr, nullptr};
        pg8::gemm_phase<EpiBf16, pg8::MoeOrder, true, true, 1>(F.lds, DEXP / 2, DEXP / 2, DEXP / 2, S, E);
    })
    PHASE(14, { phase_combine(F); })
#undef IN
#undef SEAM
}

extern "C" void kernel_launch(void* const* d_in, const int* in_sizes, int n_in, void* d_out, int out_size, void* d_ws, size_t ws_size, hipStream_t stream) {
    static int grid = 0;
    if (grid == 0) {
        if (n_in != 21 || out_size != NTOK * D || ws_size < WS_END) { fprintf(stderr, "kernel_launch: unexpected shapes (n_in %d out %d ws %zu, need ws >= %zu)\n", n_in, out_size, ws_size, (size_t)WS_END); grid = -1; return; }
        int dev = 0, cus = 0, per_cu = 0;
        if (hipGetDevice(&dev) != hipSuccess || hipDeviceGetAttribute(&cus, hipDeviceAttributeMultiprocessorCount, dev) != hipSuccess) { grid = -1; return; }
        if (hipFuncSetAttribute((const void*)fwd_kernel, hipFuncAttributeMaxDynamicSharedMemorySize, LDS_BYTES) != hipSuccess) { fprintf(stderr, "kernel_launch: hipFuncSetAttribute failed\n"); grid = -1; return; }
        if (hipOccupancyMaxActiveBlocksPerMultiprocessor(&per_cu, (const void*)fwd_kernel, NTHR, LDS_BYTES) != hipSuccess || per_cu < 1) { fprintf(stderr, "kernel_launch: occupancy query says %d\n", per_cu); (void)hipGetLastError(); per_cu = 1; }
        grid = cus * 1;
        fprintf(stderr, "kernel_launch: cus %d per_cu %d grid %d\n", cus, per_cu, grid);
    }
    if (grid < 0) return;
    (void)hipMemsetAsync((char*)d_ws + WS_CTL, 0, CTL_ZERO_BYTES, stream);
    Params a{};
    for (int i = 0; i < 21; ++i) a.in[i] = (const float*)d_in[i];
    a.out = (float*)d_out; a.ws = (unsigned char*)d_ws;
#if MK_ONE_LAUNCH
    a.ph_lo = 0; a.ph_hi = NPHASE;
    void* args[] = {&a};
    hipError_t e = hipLaunchCooperativeKernel((const void*)fwd_kernel, dim3(grid), dim3(NTHR), args, LDS_BYTES, stream);
    if (e != hipSuccess) fprintf(stderr, "cooperative launch failed: %s (grid %d)\n", hipGetErrorString(e), grid);
#else
    for (int ph = 0; ph < NPHASE; ++ph) {
        a.ph_lo = ph; a.ph_hi = ph + 1;
        hipLaunchKernelGGL(fwd_kernel, dim3(grid), dim3(NTHR), LDS_BYTES, stream, a);
    }
#endif
}
```

```cpp
#include <hip/hip_runtime.h>
#include <hip/hip_cooperative_groups.h>
#include <cstdio>
#include <cstdint>
namespace cg = cooperative_groups;

#ifndef PROBE_PH
#define PROBE_PH -1
#endif
#ifndef STAG_G1
#define STAG_G1 0
#endif
#ifndef MK_ONE_LAUNCH
#define MK_ONE_LAUNCH 1
#endif

namespace pg8 {
#define PG8_LAS __attribute__((address_space(3)))
#define PG8_GAS __attribute__((address_space(1)))
typedef unsigned short bf16_t;
typedef short bf16x8 __attribute__((ext_vector_type(8)));
typedef float f32x4 __attribute__((ext_vector_type(4)));
typedef float f32x2 __attribute__((ext_vector_type(2)));
typedef unsigned u32x4 __attribute__((ext_vector_type(4)));
typedef unsigned u32x2 __attribute__((ext_vector_type(2)));
constexpr int BM = 256, BK = 64, HALF = 128, HTB = HALF * BK * 2  , STAGE_BYTES = 8 * HTB, NXCD = 8, WGM = 4;

__host__ __device__ __forceinline__ int lds_byte(int r, int c) { const int st = (r >> 4) * 2 + (c >> 5), rr = r & 15, cc = c & 31, ob = rr * 64 + cc * 2; return st * 1024 + (ob ^ (((ob >> 9) & 1) << 5)); }
__host__ __device__ __forceinline__ void stage_rc(int b, int& R, int& C) { const int st = b / 1024, sb = b % 1024, swz = sb ^ (((sb >> 9) & 1) << 5); R = (st >> 1) * 16 + swz / 64; C = (st & 1) * 32 + (swz % 64) / 2; }
__host__ __device__ __forceinline__ int perm32(int rho) { const int n = rho >> 4, i = rho & 15; return 8 * (i >> 2) + 4 * n + (i & 3); }

struct Unit { int pm, pn, kind; const char* a; const char* b; int nt, seg, fin; };

__device__ __forceinline__ void tile_of(int L, int nM, int nN, int& pm, int& pn) {
    const int nwg = nM * nN; int wgid = L;
    { const int q = nwg / NXCD, r = nwg % NXCD, xcd = wgid % NXCD, off = wgid / NXCD; wgid = (xcd < r ? xcd * (q + 1) : r * (q + 1) + (xcd - r) * q) + off; }
    const int nig = WGM * nN, gid = wgid / nig, fm = gid * WGM, gsz = (nM - fm) < WGM ? (nM - fm) : WGM;
    pm = fm + ((wgid % nig) % gsz); pn = (wgid % nig) / gsz;
}
struct StaticOrder {
    int nM, nN, G, c; const char* A; const char* B; size_t tA, tB, aN;
    __device__ __forceinline__ bool next(int i, Unit& u) const {
        const long L = (long)i * G + c; if (L >= (long)nM * nN) return false;
        tile_of((int)L, nM, nN, u.pm, u.pn); u.kind = 0;
        u.a = A + (size_t)u.pm * tA + (size_t)u.pn * aN; u.b = B + (size_t)u.pn * tB; return true;
    }
};
struct MoeOrder {
    int nM, nN, G, c; const char* A; const char* B; size_t tA, tB, eB; const int* tile_expert;
    __device__ __forceinline__ bool next(int i, Unit& u) const {
        const long L = (long)i * G + c; if (L >= (long)nM * nN) return false;
        tile_of((int)L, nM, nN, u.pm, u.pn); u.kind = 0;
        const int e = __builtin_amdgcn_readfirstlane(tile_expert[u.pm]); u.kind = e;
        u.a = A + (size_t)u.pm * tA; u.b = B + (size_t)e * eB + (size_t)u.pn * tB; return true;
    }
};

struct SegOrder {
    int nM, nN, G, c; const char* A; const char* A2; const char* A3; const char* B; size_t tA, tB, aN2;
    __device__ __forceinline__ bool next(int i, Unit& u) const {
        const int iu = i / 3, seg = i - 3 * iu;
        const long L = (long)iu * G + c; if (L >= (long)nM * nN) return false;
        tile_of((int)L, nM, nN, u.pm, u.pn); u.kind = 0; u.seg = seg; u.fin = (seg == 2); u.nt = (seg == 1) ? 4 : 16;
        u.a = (seg == 0 ? A : (seg == 1 ? A2 + (size_t)u.pn * aN2 : A3)) + (size_t)u.pm * tA;
        u.b = B + (size_t)u.pn * tB + (size_t)(seg == 0 ? 0 : (seg == 1 ? 1024 : 1280)) * 2; return true;
    }
};
struct KVOrder {
    int G, c; const char* memb; const char* wkv;
    __device__ __forceinline__ bool next(int i, Unit& u) const {
        const int L = i * G + c; if (L >= 64) return false;
        if (L < 32) { u.pm = L >> 2; u.pn = L & 3; u.kind = 0; u.a = memb + (size_t)u.pm * 256 * 2048; u.b = wkv + (size_t)u.pn * 256 * 2048; }
        else { const int j = L - 32; u.pm = j; u.pn = 0; u.kind = 1; u.a = wkv + (size_t)(1024 + (j & 3) * 256) * 2048; u.b = memb + (size_t)(j >> 2) * 256 * 2048; }
        return true;
    }
};

__device__ __forceinline__ unsigned cvt_pk_bf16(float lo, float hi) { unsigned r; asm volatile("v_cvt_pk_bf16_f32 %0, %1, %2" : "=v"(r) : "v"(lo), "v"(hi)); return r; }
__device__ __forceinline__ float bf_lo(unsigned w) { return __uint_as_float(w << 16); }
__device__ __forceinline__ float bf_hi(unsigned w) { return __uint_as_float(w & 0xffff0000u); }

typedef int i32x4 __attribute__((ext_vector_type(4)));
typedef int i32x8 __attribute__((ext_vector_type(8)));
typedef float f32x32 __attribute__((ext_vector_type(32)));
__device__ __forceinline__ i32x8 pg8_cat(const bf16x8 lo, const bf16x8 hi) { const i32x4 a = __builtin_bit_cast(i32x4, lo), b = __builtin_bit_cast(i32x4, hi); return __builtin_shufflevector(a, b, 0, 1, 2, 3, 4, 5, 6, 7); }
template <class Epi, class Sched, bool ALIGN_EPI = false, bool SP2 = false, int MODE = 0>
__device__ __forceinline__ void gemm_phase(PG8_LAS unsigned char* lds, const int K, const int lda, const int ldb, const Sched& S, const Epi& E) {
    const int tid = threadIdx.x, wid = __builtin_amdgcn_readfirstlane(tid >> 6), lane = tid & 63, wr = wid >> 2, wc = wid & 3, fr = lane & 15, fq = lane >> 4;
    constexpr bool FP8 = (MODE == 1), INT8 = (MODE == 2);
    const int nt = K / BK; constexpr int NST = Epi::NST;
    unsigned voffA[2], voffB[2];
#pragma unroll
    for (int i = 0; i < 2; ++i) { int R, C; stage_rc(tid * 16 + i * 8192, R, C); const int Rb = Epi::PERM ? ((R & ~31) + perm32(R & 31)) : R;
        voffA[i] = (unsigned)(R * lda + C) * 2u; voffB[i] = (unsigned)(Rb * ldb + C) * 2u; }
    const size_t kstep = (size_t)(BK * 2);
    const size_t hstepA = (size_t)HALF * lda * 2, hstepB = (size_t)HALF * ldb * 2;
    const unsigned ldsw = (unsigned)wid * 1024u;
    const int aoff = lds_byte(wr * 64 + fr, fq * 8), boff = lds_byte(wc * 32 + fr, fq * 8);
#define PG8_SA(b, h) (((b) * 2 + (h)) * HTB)
#define PG8_SB(b, h) ((4 + (b) * 2 + (h)) * HTB)
#define PG8_STAGE(bufoff, gbase, voff) do { _Pragma("unroll") for (int _i = 0; _i < 2; ++_i) \
        __builtin_amdgcn_global_load_lds((const PG8_GAS unsigned*)((const PG8_GAS char*)(gbase) + (voff)[_i]), (PG8_LAS unsigned*)(lds + (bufoff) + ldsw + _i * 8192), 16, 0, 0); } while (0)
#define PG8_LDA(dst, b, h) do { if constexpr (FP8) { _Pragma("unroll") for (int m = 0; m < 4; ++m) dst##8[m] = pg8_cat(*(const PG8_LAS bf16x8*)(lds + PG8_SA(b, h) + aoff + m * 2048), *(const PG8_LAS bf16x8*)(lds + PG8_SA(b, h) + aoff + m * 2048 + 1024)); } \
        else { _Pragma("unroll") for (int m = 0; m < 4; ++m) _Pragma("unroll") for (int k = 0; k < 2; ++k) dst[m][k] = *(const PG8_LAS bf16x8*)(lds + PG8_SA(b, h) + aoff + m * 2048 + k * 1024); } } while (0)
#define PG8_LDB(dst, b, h) do { if constexpr (FP8) { _Pragma("unroll") for (int n = 0; n < 2; ++n) dst##8[n] = pg8_cat(*(const PG8_LAS bf16x8*)(lds + PG8_SB(b, h) + boff + n * 2048), *(const PG8_LAS bf16x8*)(lds + PG8_SB(b, h) + boff + n * 2048 + 1024)); } \
        else { _Pragma("unroll") for (int n = 0; n < 2; ++n) _Pragma("unroll") for (int k = 0; k < 2; ++k) dst[n][k] = *(const PG8_LAS bf16x8*)(lds + PG8_SB(b, h) + boff + n * 2048 + k * 1024); } } while (0)
#define PG8_MMA(ai, bj, At, Bt) do { __builtin_amdgcn_s_setprio(1); \
        if constexpr (FP8) { _Pragma("unroll") for (int m = 0; m < 4; ++m) _Pragma("unroll") for (int n = 0; n < 2; ++n) { \
            const f32x4 _c = (f32x4){accv[ai][bj][(m * 2 + n) * 4], accv[ai][bj][(m * 2 + n) * 4 + 1], accv[ai][bj][(m * 2 + n) * 4 + 2], accv[ai][bj][(m * 2 + n) * 4 + 3]}; \
            const f32x4 _d = __builtin_amdgcn_mfma_scale_f32_16x16x128_f8f6f4(Bt##8[n], At##8[m], _c, 0, 0, 0, 0x7f7f7f7f, 0, 0x7f7f7f7f); \
            _Pragma("unroll") for (int _j = 0; _j < 4; ++_j) accv[ai][bj][(m * 2 + n) * 4 + _j] = _d[_j]; } } \
        else if constexpr (INT8) { _Pragma("unroll") for (int m = 0; m < 4; ++m) _Pragma("unroll") for (int n = 0; n < 2; ++n) _Pragma("unroll") for (int k = 0; k < 2; ++k) \
            acc[ai][bj][m][n] = __builtin_bit_cast(f32x4, __builtin_amdgcn_mfma_i32_16x16x64_i8(__builtin_bit_cast(i32x4, Bt[n][k]), __builtin_bit_cast(i32x4, At[m][k]), __builtin_bit_cast(i32x4, acc[ai][bj][m][n]), 0, 0, 0)); } \
        else { _Pragma("unroll") for (int m = 0; m < 4; ++m) _Pragma("unroll") for (int n = 0; n < 2; ++n) _Pragma("unroll") for (int k = 0; k < 2; ++k) \
            acc[ai][bj][m][n] = __builtin_amdgcn_mfma_f32_16x16x32_bf16(Bt[n][k], At[m][k], acc[ai][bj][m][n], 0, 0, 0); } \
        __builtin_amdgcn_s_setprio(0); } while (0)
#define PG8_WAIT_V(n) asm volatile("s_waitcnt vmcnt(" #n ")" ::: "memory")
#define PG8_WAIT_VN(n) asm volatile("s_waitcnt vmcnt(%0)" :: "n"(n) : "memory")
#define PG8_WAIT_L(n) asm volatile("s_waitcnt lgkmcnt(" #n ")" ::: "memory")
#define PG8_BAR __builtin_amdgcn_s_barrier()
#define PG8_SCHED __builtin_amdgcn_sched_barrier(0)
    Unit cur, nxt; int ui = 0;
    if (!S.next(0, cur)) return;
    f32x4 acc[2][2][4][2];
#pragma unroll
    for (int a = 0; a < 2; ++a)
#pragma unroll
        for (int b = 0; b < 2; ++b)
#pragma unroll
            for (int m = 0; m < 4; ++m)
#pragma unroll
                for (int n = 0; n < 2; ++n) acc[a][b][m][n] = (f32x4){0.f, 0.f, 0.f, 0.f};
    bf16x8 At[4][2], B0[2][2], B1[2][2]; i32x8 At8[4], B08[2], B18[2]; f32x32 accv[2][2];
    if constexpr (FP8) {
#pragma unroll
        for (int a = 0; a < 2; ++a)
#pragma unroll
            for (int b = 0; b < 2; ++b)
#pragma unroll
                for (int j = 0; j < 32; ++j) accv[a][b][j] = 0.f; }
    const char* cA = cur.a; const char* cB = cur.b;
    if constexpr (SP2) {
        PG8_STAGE(PG8_SB(0, 0), cB, voffB); PG8_STAGE(PG8_SB(0, 1), cB + hstepB, voffB); PG8_STAGE(PG8_SA(0, 0), cA, voffA); PG8_STAGE(PG8_SA(0, 1), cA + hstepA, voffA);
        if (wr == 1) PG8_BAR;
        PG8_WAIT_V(2); PG8_BAR;
        PG8_STAGE(PG8_SB(1, 0), cB + kstep, voffB); PG8_STAGE(PG8_SA(1, 0), cA + kstep, voffA); PG8_STAGE(PG8_SB(1, 1), cB + hstepB + kstep, voffB);
        PG8_WAIT_V(6); PG8_BAR;
    } else {
        PG8_STAGE(PG8_SB(0, 0), cB, voffB); PG8_STAGE(PG8_SA(0, 0), cA, voffA); PG8_STAGE(PG8_SB(0, 1), cB + hstepB, voffB); PG8_STAGE(PG8_SA(0, 1), cA + hstepA, voffA);
        if (wr == 1) PG8_BAR;
        PG8_WAIT_V(4); PG8_BAR;
        PG8_STAGE(PG8_SB(1, 0), cB + kstep, voffB); PG8_STAGE(PG8_SA(1, 0), cA + kstep, voffA); PG8_STAGE(PG8_SB(1, 1), cB + hstepB + kstep, voffB);
        PG8_WAIT_V(6); PG8_BAR;
    }
    for (;;) {
        const bool has_next = S.next(ui + 1, nxt);
        const char* nA = has_next ? nxt.a : cA; const char* nB = has_next ? nxt.b : cB;
        int ntc = nt; if constexpr (Epi::SEG) ntc = cur.nt;
        if constexpr (Epi::PREF) E.prefetch(cur, lds + 131072 + 1024 + wid * 256, tid);
#pragma nounroll
        for (int t = 0; t < ntc; t += 2) {
            const bool last = (t == ntc - 2);
            const char* a1 = cA + (size_t)(t + 1) * kstep;
            const char* a2 = last ? nA : cA + (size_t)(t + 2) * kstep; const char* b2 = last ? nB : cB + (size_t)(t + 2) * kstep;
            const char* a3 = a2 + kstep; const char* b3 = b2 + kstep;
            if constexpr (SP2) {
            const bool fresh = !FP8 && (NST > 0) && (t == 0) && (ui > 0);
            PG8_LDB(B0, 0, 0); PG8_LDB(B1, 0, 1); PG8_SCHED; PG8_LDA(At, 0, 0); PG8_STAGE(PG8_SA(1, 1), a1 + hstepA, voffA);
            if (fresh) PG8_WAIT_VN(8 + NST); else PG8_WAIT_V(8);
            PG8_WAIT_L(0); PG8_BAR; PG8_MMA(0, 0, At, B0); PG8_MMA(0, 1, At, B1); PG8_BAR; PG8_SCHED;
            PG8_LDA(At, 0, 1); PG8_STAGE(PG8_SB(0, 0), b2, voffB); PG8_STAGE(PG8_SB(0, 1), b2 + hstepB, voffB); PG8_STAGE(PG8_SA(0, 0), a2, voffA);
            if (fresh) PG8_WAIT_VN(8 + NST); else PG8_WAIT_V(8);
            PG8_WAIT_L(0); PG8_BAR; PG8_MMA(1, 0, At, B0); PG8_MMA(1, 1, At, B1); PG8_BAR; PG8_SCHED;
            PG8_LDB(B0, 1, 0); PG8_LDB(B1, 1, 1); PG8_SCHED; PG8_LDA(At, 1, 0); PG8_STAGE(PG8_SA(0, 1), a2 + hstepA, voffA);
            PG8_WAIT_V(8); PG8_WAIT_L(0); PG8_BAR; PG8_MMA(0, 0, At, B0); PG8_MMA(0, 1, At, B1); PG8_BAR; PG8_SCHED;
            PG8_LDA(At, 1, 1); PG8_STAGE(PG8_SB(1, 0), b3, voffB); PG8_STAGE(PG8_SB(1, 1), b3 + hstepB, voffB); PG8_STAGE(PG8_SA(1, 0), a3, voffA);
            PG8_WAIT_V(8); PG8_WAIT_L(0); PG8_BAR; PG8_MMA(1, 0, At, B0); PG8_MMA(1, 1, At, B1); PG8_BAR; PG8_SCHED;
            } else {
            PG8_LDB(B0, 0, 0); PG8_SCHED; PG8_LDA(At, 0, 0); PG8_STAGE(PG8_SA(1, 1), a1 + hstepA, voffA);
            PG8_WAIT_L(8); PG8_BAR; PG8_WAIT_L(0); PG8_MMA(0, 0, At, B0); PG8_BAR; PG8_SCHED;
            PG8_LDB(B1, 0, 1); PG8_STAGE(PG8_SB(0, 0), b2, voffB);
            PG8_BAR; PG8_WAIT_L(0); PG8_MMA(0, 1, At, B1); PG8_BAR;
            PG8_LDA(At, 0, 1); PG8_STAGE(PG8_SA(0, 0), a2, voffA);
            PG8_BAR; PG8_WAIT_L(0); PG8_MMA(1, 0, At, B0); PG8_BAR; PG8_SCHED;
            PG8_STAGE(PG8_SB(0, 1), b2 + hstepB, voffB);
            PG8_WAIT_V(6); PG8_BAR; PG8_MMA(1, 1, At, B1); PG8_BAR;
            PG8_LDB(B0, 1, 0); PG8_SCHED; PG8_LDA(At, 1, 0); PG8_STAGE(PG8_SA(0, 1), a2 + hstepA, voffA);
            PG8_WAIT_L(8); PG8_BAR; PG8_WAIT_L(0); PG8_MMA(0, 0, At, B0); PG8_BAR; PG8_SCHED;
            PG8_LDB(B1, 1, 1); PG8_STAGE(PG8_SB(1, 0), b3, voffB);
            PG8_BAR; PG8_WAIT_L(0); PG8_MMA(0, 1, At, B1); PG8_BAR;
            PG8_LDA(At, 1, 1); PG8_STAGE(PG8_SA(1, 0), a3, voffA);
            PG8_BAR; PG8_WAIT_L(0); PG8_MMA(1, 0, At, B0); PG8_BAR; PG8_SCHED;
            PG8_STAGE(PG8_SB(1, 1), b3 + hstepB, voffB);
            PG8_WAIT_V(6); PG8_BAR; PG8_MMA(1, 1, At, B1); PG8_BAR;
            }
        }
        if constexpr (ALIGN_EPI) { if (wr == 0) PG8_BAR; }
        if constexpr (FP8) {
#pragma unroll
            for (int a = 0; a < 2; ++a)
#pragma unroll
                for (int b = 0; b < 2; ++b)
#pragma unroll
                    for (int m = 0; m < 4; ++m)
#pragma unroll
                        for (int n = 0; n < 2; ++n) { acc[a][b][m][n] = (f32x4){accv[a][b][(m * 2 + n) * 4], accv[a][b][(m * 2 + n) * 4 + 1], accv[a][b][(m * 2 + n) * 4 + 2], accv[a][b][(m * 2 + n) * 4 + 3]}; }
#pragma unroll
            for (int a = 0; a < 2; ++a)
#pragma unroll
                for (int b = 0; b < 2; ++b)
#pragma unroll
                    for (int j = 0; j < 32; ++j) accv[a][b][j] = 0.f; }
        if constexpr (INT8) {
#pragma unroll
            for (int a = 0; a < 2; ++a)
#pragma unroll
                for (int b = 0; b < 2; ++b)
#pragma unroll
                    for (int m = 0; m < 4; ++m)
#pragma unroll
                        for (int n = 0; n < 2; ++n) { const i32x4 iv = __builtin_bit_cast(i32x4, acc[a][b][m][n]); acc[a][b][m][n] = (f32x4){(float)iv[0], (float)iv[1], (float)iv[2], (float)iv[3]}; } }
        bool fin = true;
        if constexpr (Epi::SEG) { fin = cur.fin != 0; if (fin) E(acc, cur, wr, wc, fr, fq); else E.mid(acc, cur, cur.seg + 1, wr, wc, fr, fq); } else E(acc, cur, wr, wc, fr, fq);
        if (!has_next) break;
        if (fin) {
#pragma unroll
        for (int a = 0; a < 2; ++a)
#pragma unroll
            for (int b = 0; b < 2; ++b)
#pragma unroll
                for (int m = 0; m < 4; ++m)
#pragma unroll
                    for (int n = 0; n < 2; ++n) acc[a][b][m][n] = (f32x4){0.f, 0.f, 0.f, 0.f};
        }
        cur = nxt; cA = nA; cB = nB; ++ui;
        if constexpr (ALIGN_EPI) { if (wr == 1) PG8_BAR; }
    }
    PG8_WAIT_V(0);
    if constexpr (!ALIGN_EPI) { if (wr == 0) PG8_BAR; }
    PG8_BAR;
#undef PG8_SA
#undef PG8_SB
#undef PG8_STAGE
#undef PG8_LDA
#undef PG8_LDB
#undef PG8_MMA
#undef PG8_WAIT_V
#undef PG8_WAIT_VN
#undef PG8_WAIT_L
#undef PG8_BAR
#undef PG8_SCHED
}
}
using pg8::bf16_t; using pg8::f32x4; using pg8::f32x2; using pg8::u32x4; using pg8::u32x2; using pg8::Unit; using pg8::cvt_pk_bf16; using pg8::bf_lo; using pg8::bf_hi;
#define LAS __attribute__((address_space(3)))

constexpr int D = 1024, BATCH = 8, SEQ = 4096, NTOK = BATCH * SEQ, MEMLEN = 256, NMEM = BATCH * MEMLEN;
constexpr int INCOLS = 8192, GATE0 = 5120;
constexpr int NEXP = 64, DEXP = 512, NGRP = 8, EPG = 8;
constexpr int NASSIGN = NTOK * 2, PMAX_TILES = 320, PMAX = PMAX_TILES * 256;
constexpr float ALPHA = 1.189207115002721f;
constexpr float LN_EPS = 1e-5f;
constexpr int NWAVES = 8, NTHR = 512;

constexpr size_t MiB = 1u << 20;
constexpr size_t WS_CTL = 0, CTL_ZERO_BYTES = 1 * MiB;
constexpr size_t WS_WIN = 1 * MiB, WS_WKV = 17 * MiB, WS_WCAT = 21 * MiB, WS_WO = 26 * MiB, WS_WR = 28 * MiB;
constexpr int KCAT = 2304;
constexpr size_t WS_WUP = 29 * MiB, WS_WDN = 157 * MiB, WS_MISC = 221 * MiB;
constexpr size_t WS_Z = 224 * MiB;
constexpr size_t WS_XB = 736 * MiB, WS_MEMB = 800 * MiB, WS_KV = 804 * MiB, WS_ACONV = 812 * MiB, WS_DPOOL = 876 * MiB, WS_MERGED = 940 * MiB;
constexpr size_t WS_KB = WS_KV, WS_VT = WS_KV + 4 * MiB;
constexpr size_t WS_XS = WS_MISC + 3 * (MiB / 2), WS_SW = WS_MISC + 7 * (MiB / 4);
constexpr size_t WS_SWU = WS_MISC + 2 * MiB;
constexpr size_t WS_XSB = WS_MISC + 9 * (MiB / 4), WS_H1S = WS_MISC + 21 * (MiB / 8);
constexpr size_t WS_O = WS_XB;
constexpr size_t WS_H1 = 224 * MiB;
constexpr size_t WS_H1B = 480 * MiB;
constexpr size_t WS_XBUF = 544 * MiB;
constexpr size_t WS_H1F8 = 640 * MiB;
constexpr size_t WS_ACT = 736 * MiB;
constexpr size_t WS_YBUF = 816 * MiB;
constexpr size_t WS_END = 1004 * MiB;
constexpr size_t MS_TOKE = 0, MS_TOKPOS = MS_TOKE + NASSIGN * 4, MS_TOKW = MS_TOKPOS + NASSIGN * 4, MS_TOKDEST = MS_TOKW + NASSIGN * 4, MS_TILEE = MS_TOKDEST + NASSIGN * 4, MS_PSTART = MS_TILEE + 4096, MS_NTILES = MS_PSTART + 1024;
constexpr int CW_COUNTS = 1024;
constexpr int CW_CPCTR = 1152;
constexpr int CW_BAR = 4096;

constexpr int LDS_BYTES = 147456, MISC_OFF = 131072 + 320;

struct Params { const float* in[21]; float* out; unsigned char* ws; int ph_lo, ph_hi; };
enum { I_X = 0, I_MEM, I_WIN, I_BGATE, I_CONVW, I_WCONV, I_WPOOL, I_PSCALE, I_WKV, I_WXO, I_WO, I_LN1G, I_LN1B, I_WRG, I_BRG, I_WRE, I_BRE, I_WUP, I_WDN, I_LN2G, I_LN2B };

__device__ __forceinline__ unsigned f2bf(float f) { unsigned u = __float_as_uint(f); return (u + 0x7fffu + ((u >> 16) & 1u)) >> 16; }
__device__ __forceinline__ unsigned pk2(float lo, float hi) { return f2bf(lo) | (f2bf(hi) << 16); }
__device__ __forceinline__ float wave_sum(float v) {
#pragma unroll
    for (int o = 1; o < 64; o <<= 1) v += __shfl_xor(v, o);
    return v;
}
__device__ __forceinline__ float sigmoidf_(float x) { return __builtin_amdgcn_rcpf(1.0f + __expf(-x)); }


#define XB_TMO      128
#define XB_XCNT(j)  (256  + 64 * (j))
#define XB_XSUB(j)  (1280 + 64 * (j))
#define XB_XGEN(j)  (2304 + 64 * (j))
#define XB_TOP      3328
#define XB_TOPGEN   3392
#define XCD_BAR_WORDS 3456
#define XB_SPIN_CAP (1u << 18)
__device__ __forceinline__ unsigned xb_ld(unsigned* p)              { return __hip_atomic_load(p, __ATOMIC_RELAXED, __HIP_MEMORY_SCOPE_AGENT); }
__device__ __forceinline__ unsigned xb_add(unsigned* p, unsigned v) { return __hip_atomic_fetch_add(p, v, __ATOMIC_RELAXED, __HIP_MEMORY_SCOPE_AGENT); }
__device__ __forceinline__ unsigned xb_xcc_id() { return (unsigned)__builtin_amdgcn_s_getreg((3 << 11) | 20) & 0xFu; }
#define XB_SPIN(cond, bar) do { unsigned _sp = 0; while (cond) { __builtin_amdgcn_s_sleep(1); \
    if ((++_sp & 255u) == 0u) { if (xb_ld(&(bar)[XB_TMO])) break; if (_sp > XB_SPIN_CAP) { atomicAdd(&(bar)[XB_TMO], 1u); break; } } } } while (0)
struct XcdBarrier { unsigned* bar; unsigned x; volatile LAS unsigned* st; };
__device__ __forceinline__ XcdBarrier xcd_barrier_post(unsigned* bar, volatile LAS unsigned* st) {
    XcdBarrier b; b.bar = bar; b.x = xb_xcc_id(); b.st = st;
    if (threadIdx.x == 0) (void)xb_add(&bar[XB_XCNT(b.x)], 1u);
    return b;
}
__device__ __forceinline__ void xcd_barrier_complete(unsigned* bar, unsigned x, unsigned& nloc, unsigned& nx) {
    const unsigned G = gridDim.x * gridDim.y * gridDim.z;
    unsigned sum, cnt, mine, sp = 0u;
    for (;;) {
        sum = 0u; cnt = 0u; mine = 0u;
#pragma unroll
        for (unsigned j = 0; j < 16; ++j) { const unsigned c = xb_ld(&bar[XB_XCNT(j)]); sum += c; cnt += (c > 0u) ? 1u : 0u; mine = (j == x) ? c : mine; }
        if (sum == G) break;
        __builtin_amdgcn_s_sleep(1);
        if ((++sp & 255u) == 0u) { if (xb_ld(&bar[XB_TMO])) break; if (sp > XB_SPIN_CAP) { atomicAdd(&bar[XB_TMO], 1u); break; } }
    }
    nloc = mine > 0u ? mine : 1u; nx = cnt > 0u ? cnt : 1u;
}
__device__ __forceinline__ void xcd_barrier(const XcdBarrier& b) {
    asm volatile("s_waitcnt vmcnt(0)" ::: "memory");
    __syncthreads();
    if (threadIdx.x == 0) {
        unsigned* bar = b.bar;
        __builtin_amdgcn_s_waitcnt(0);
        unsigned nloc = b.st[0], nx = b.st[1];
        if (nloc == 0u) { xcd_barrier_complete(bar, b.x, nloc, nx); b.st[0] = nloc; b.st[1] = nx; }
        const unsigned old = xb_add(&bar[XB_XSUB(b.x)], 1u);
        const unsigned gen = old / nloc;
        if (old + 1u == (gen + 1u) * nloc) {
            __builtin_amdgcn_fence(__ATOMIC_RELEASE, "agent");
            asm volatile("s_waitcnt vmcnt(0)" ::: "memory");
            const unsigned og = xb_add(&bar[XB_TOP], 1u);
            const unsigned tg = og / nx;
            if (og + 1u == (tg + 1u) * nx) xb_add(&bar[XB_TOPGEN], 1u);
            else XB_SPIN(xb_ld(&bar[XB_TOPGEN]) == tg, bar);
            __builtin_amdgcn_fence(__ATOMIC_ACQUIRE, "agent");
            xb_add(&bar[XB_XGEN(b.x)], 1u);
            asm volatile("s_waitcnt vmcnt(0)" ::: "memory");
        } else {
            XB_SPIN(xb_ld(&bar[XB_XGEN(b.x)]) == gen, bar);
            __builtin_amdgcn_fence(__ATOMIC_ACQUIRE, "agent");
            asm volatile("s_waitcnt vmcnt(0)" ::: "memory");
        }
    }
    __syncthreads();
}

__device__ __forceinline__ void stagger_delay(unsigned ticks) {
    const unsigned long long t0 = __builtin_amdgcn_s_memrealtime();
    while (__builtin_amdgcn_s_memrealtime() - t0 < (unsigned long long)ticks) __builtin_amdgcn_s_sleep(4);
}

template <int LPR> __device__ __forceinline__ void touch_tile(const char* base, size_t pitch, LAS unsigned char* junk, int tid) {
#pragma unroll
    for (int i = 0; i < (256 * LPR) / 512; ++i) { const int ln = i * 512 + tid, r = ln / LPR, c = ln % LPR;
        __builtin_amdgcn_global_load_lds((const PG8_GAS unsigned*)(base + (size_t)r * pitch + c * 128), (LAS unsigned*)junk, 4, 0, 0); }
}

struct EpiBf16 {
    static constexpr bool PERM = true, SEG = false, PREF = false; static constexpr int NST = 8;
    bf16_t* O; int ldc; const float* bias; int gate_pn; int gate_col0; float oscale; int mul_pn0, mul_pn1, mul_col0; const float* rs; const float* cs;
    __device__ __forceinline__ void operator()(const f32x4 (&acc)[2][2][4][2], const Unit& u, int wr, int wc, int fr, int fq) const {
        const int row0 = u.pm * 256 + wr * 64 + fr, col0 = u.pn * 256 + wc * 32 + 8 * fq;
        f32x4 cv[2][2]; float rv[2][4];
#pragma unroll
        for (int bj = 0; bj < 2; ++bj)
#pragma unroll
            for (int n = 0; n < 2; ++n) cv[bj][n] = cs ? *(const f32x4*)(cs + col0 + bj * 128 + 4 * n) : (f32x4){1.f, 1.f, 1.f, 1.f};
#pragma unroll
        for (int ai = 0; ai < 2; ++ai)
#pragma unroll
            for (int m = 0; m < 4; ++m) rv[ai][m] = (rs ? rs[row0 + ai * 128 + m * 16] : 1.0f) * oscale;
        if (u.pn >= mul_pn0 && u.pn < mul_pn1) {
            const int mc = mul_col0 + (u.pn - mul_pn0) * 128 + wc * 32 + 8 * fq;
#pragma unroll
            for (int ai = 0; ai < 2; ++ai)
#pragma unroll
                for (int m = 0; m < 4; ++m) { const float r2 = rv[ai][m] * rv[ai][m];
                    const f32x4 v0 = (acc[ai][0][m][0] * cv[0][0]) * (acc[ai][1][m][0] * cv[1][0]) * r2, v1 = (acc[ai][0][m][1] * cv[0][1]) * (acc[ai][1][m][1] * cv[1][1]) * r2;
                    u32x4 w; w.x = cvt_pk_bf16(v0[0], v0[1]); w.y = cvt_pk_bf16(v0[2], v0[3]); w.z = cvt_pk_bf16(v1[0], v1[1]); w.w = cvt_pk_bf16(v1[2], v1[3]);
                    __builtin_nontemporal_store(w, (u32x4*)(O + (size_t)(row0 + ai * 128 + m * 16) * ldc + mc)); }
            return;
        }
        const bool gate = u.pn >= gate_pn;
        f32x4 bv[2][2];
#pragma unroll
        for (int bj = 0; bj < 2; ++bj)
#pragma unroll
            for (int n = 0; n < 2; ++n) bv[bj][n] = gate ? *(const f32x4*)(bias + (col0 - gate_col0) + bj * 128 + 4 * n) : (f32x4){0.f, 0.f, 0.f, 0.f};
#pragma unroll
        for (int ai = 0; ai < 2; ++ai)
#pragma unroll
            for (int m = 0; m < 4; ++m) { bf16_t* rowp = O + (size_t)(row0 + ai * 128 + m * 16) * ldc + col0;
#pragma unroll
                for (int bj = 0; bj < 2; ++bj) { f32x4 v0 = acc[ai][bj][m][0] * (cv[bj][0] * rv[ai][m]) + bv[bj][0], v1 = acc[ai][bj][m][1] * (cv[bj][1] * rv[ai][m]) + bv[bj][1];
                    if (gate) {
                        unsigned q0 = 0u, q1 = 0u;
#pragma unroll
                        for (int j = 0; j < 4; ++j) { q0 = __builtin_amdgcn_cvt_pk_u8_f32(fmaxf(__builtin_floorf(sigmoidf_(v0[j]) * 255.0f + 0.5f), 1.0f), j, q0); q1 = __builtin_amdgcn_cvt_pk_u8_f32(fmaxf(__builtin_floorf(sigmoidf_(v1[j]) * 255.0f + 0.5f), 1.0f), j, q1); }
                        u32x2 w8; w8.x = q0; w8.y = q1;
                        *(u32x2*)((unsigned char*)(O + (size_t)(row0 + ai * 128 + m * 16) * ldc) + 2 * gate_col0 + (col0 - gate_col0) + bj * 128) = w8;
                        continue; }
                    u32x4 w; w.x = cvt_pk_bf16(v0[0], v0[1]); w.y = cvt_pk_bf16(v0[2], v0[3]); w.z = cvt_pk_bf16(v1[0], v1[1]); w.w = cvt_pk_bf16(v1[2], v1[3]);
                    __builtin_nontemporal_store(w, (u32x4*)(rowp + bj * 128)); } }
    }
};
struct EpiKV {
    static constexpr bool PERM = true, SEG = false, PREF = false; static constexpr int NST = 0;
    bf16_t* KB; bf16_t* VT;
    __device__ __forceinline__ void operator()(const f32x4 (&acc)[2][2][4][2], const Unit& u, int wr, int wc, int fr, int fq) const {
        const int row0 = u.pm * 256 + wr * 64 + fr, col0 = u.pn * 256 + wc * 32 + 8 * fq;
#pragma unroll
        for (int ai = 0; ai < 2; ++ai)
#pragma unroll
            for (int m = 0; m < 4; ++m) { const size_t row = (size_t)(row0 + ai * 128 + m * 16);
#pragma unroll
                for (int bj = 0; bj < 2; ++bj) { const f32x4 v0 = acc[ai][bj][m][0], v1 = acc[ai][bj][m][1];
                    u32x4 w; w.x = cvt_pk_bf16(v0[0], v0[1]); w.y = cvt_pk_bf16(v0[2], v0[3]); w.z = cvt_pk_bf16(v1[0], v1[1]); w.w = cvt_pk_bf16(v1[2], v1[3]);
                    if (u.kind == 0) { *(u32x4*)(KB + row * D + col0 + bj * 128) = w; }
                    else { const int k0 = col0 + bj * 128, base = k0 & ~15, hi8 = (k0 & 8) ? 1 : 0;
                        u32x2 lo2; lo2.x = w.x; lo2.y = w.y; u32x2 hi2; hi2.x = w.z; hi2.y = w.w;
                        *(u32x2*)(VT + row * 256 + base + (hi8 ? 4 : 0)) = lo2; *(u32x2*)(VT + row * 256 + base + (hi8 ? 12 : 8)) = hi2; } } }
    }
};
template <int MODE> struct EpiProbe { static constexpr bool PERM = true, SEG = false, PREF = false; static constexpr int NST = 0;
    bf16_t* O; int flag;
    __device__ __forceinline__ void operator()(const f32x4 (&acc)[2][2][4][2], const Unit& u, int wr, int wc, int fr, int fq) const {
        const int row0 = (MODE == 1 ? 0 : u.pm * 256) + wr * 64 + fr, col0 = (MODE == 1 ? 0 : u.pn * 256) + wc * 32 + 8 * fq;
#pragma unroll
        for (int ai = 0; ai < 2; ++ai)
#pragma unroll
            for (int m = 0; m < 4; ++m) { bf16_t* rowp = O + (size_t)(row0 + ai * 128 + m * 16) * 2048 + col0;
#pragma unroll
                for (int bj = 0; bj < 2; ++bj) { const f32x4 v0 = acc[ai][bj][m][0], v1 = acc[ai][bj][m][1];
                    u32x4 w; w.x = cvt_pk_bf16(v0[0], v0[1]); w.y = cvt_pk_bf16(v0[2], v0[3]); w.z = cvt_pk_bf16(v1[0], v1[1]); w.w = cvt_pk_bf16(v1[2], v1[3]);
                    if (MODE == 1 || flag == 12345) __builtin_nontemporal_store(w, (u32x4*)(rowp + bj * 128)); } }
    }
};
struct EpiNull { static constexpr bool PERM = true, SEG = false, PREF = false; static constexpr int NST = 0;
    __device__ __forceinline__ void operator()(const f32x4 (&acc)[2][2][4][2], const Unit& u, int wr, int wc, int fr, int fq) const {
        float s = 0.f;
#pragma unroll
        for (int ai = 0; ai < 2; ++ai)
#pragma unroll
            for (int bj = 0; bj < 2; ++bj)
#pragma unroll
                for (int m = 0; m < 4; ++m)
#pragma unroll
                    for (int n = 0; n < 2; ++n) s += acc[ai][bj][m][n][0] + acc[ai][bj][m][n][1] + acc[ai][bj][m][n][2] + acc[ai][bj][m][n][3];
        if (s == 123456.789f) *sink = s;
    }
    float* sink;
};
template <int MODE> struct EpiMerge {
    static constexpr bool PERM = true, SEG = false, PREF = false; static constexpr int NST = 0;
    bf16_t* Mg; const bf16_t* Z; int gcol0; const float* scale;
    __device__ __forceinline__ void operator()(const f32x4 (&acc)[2][2][4][2], const Unit& u, int wr, int wc, int fr, int fq) const {
        const int row0 = u.pm * 256 + wr * 64 + fr, col0 = u.pn * 256 + wc * 32 + 8 * fq;
        f32x4 sv[2][2];
#pragma unroll
        for (int bj = 0; bj < 2; ++bj)
#pragma unroll
            for (int n = 0; n < 2; ++n) sv[bj][n] = scale ? *(const f32x4*)(scale + col0 + bj * 128 + 4 * n) : (f32x4){1.f, 1.f, 1.f, 1.f};
#pragma unroll
        for (int ai = 0; ai < 2; ++ai)
#pragma unroll
            for (int m = 0; m < 4; ++m) { const size_t row = (size_t)(row0 + ai * 128 + m * 16);
#pragma unroll
                for (int bj = 0; bj < 2; ++bj) {
                    const u32x4 g = *(const u32x4*)(Z + row * INCOLS + gcol0 + col0 + bj * 128);
                    f32x4 v0 = acc[ai][bj][m][0] * sv[bj][0], v1 = acc[ai][bj][m][1] * sv[bj][1];
                    v0[0] *= bf_lo(g.x); v0[1] *= bf_hi(g.x); v0[2] *= bf_lo(g.y); v0[3] *= bf_hi(g.y);
                    v1[0] *= bf_lo(g.z); v1[1] *= bf_hi(g.z); v1[2] *= bf_lo(g.w); v1[3] *= bf_hi(g.w);
                    u32x4* mp = (u32x4*)(Mg + row * D + col0 + bj * 128);
                    if (MODE) { const u32x4 o = *mp;
                        v0[0] += bf_lo(o.x); v0[1] += bf_hi(o.x); v0[2] += bf_lo(o.y); v0[3] += bf_hi(o.y);
                        v1[0] += bf_lo(o.z); v1[1] += bf_hi(o.z); v1[2] += bf_lo(o.w); v1[3] += bf_hi(o.w); }
                    u32x4 w; w.x = cvt_pk_bf16(v0[0], v0[1]); w.y = cvt_pk_bf16(v0[2], v0[3]); w.z = cvt_pk_bf16(v1[0], v1[1]); w.w = cvt_pk_bf16(v1[2], v1[3]);
                    *mp = w; } }
    }
};
struct EpiMix3 {
    static constexpr bool PERM = true, SEG = true, PREF = false; static constexpr int T1 = 16, T2 = 20, NST = 0;
    bf16_t* Mg; const bf16_t* Z; const float* pscale; int light;
    __device__ __forceinline__ static f32x4 ub4(unsigned w) { return (f32x4){(float)(w & 0xffu), (float)((w >> 8) & 0xffu), (float)((w >> 16) & 0xffu), (float)(w >> 24)}; }
    __device__ __forceinline__ void mid(f32x4 (&acc)[2][2][4][2], const Unit& u, int seg, int wr, int wc, int fr, int fq) const {
        if (light) {
#pragma unroll
            for (int ai = 0; ai < 2; ++ai)
#pragma unroll
                for (int bj = 0; bj < 2; ++bj)
#pragma unroll
                    for (int m = 0; m < 4; ++m)
#pragma unroll
                        for (int n = 0; n < 2; ++n) acc[ai][bj][m][n] = acc[ai][bj][m][n] * 1.0001f;
            return; }
        const int row0 = u.pm * 256 + wr * 64 + fr, col0 = u.pn * 256 + wc * 32 + 8 * fq;
        const bool s1 = (seg == 1);
        f32x4 sr[2][2];
#pragma unroll
        for (int bj = 0; bj < 2; ++bj)
#pragma unroll
            for (int n = 0; n < 2; ++n) { const f32x4 ps = *(const f32x4*)(pscale + col0 + bj * 128 + 4 * n);
#pragma unroll
                for (int j = 0; j < 4; ++j) sr[bj][n][j] = s1 ? __builtin_amdgcn_rcpf(ps[j]) : ps[j]; }
        const unsigned char* zb = (const unsigned char*)Z + 2 * GATE0 + col0;
        const unsigned char* zn = zb + (s1 ? 0 : D); const unsigned char* zd = zb + (s1 ? D : 2 * D);
#pragma unroll
        for (int ai = 0; ai < 2; ++ai)
#pragma unroll
            for (int m = 0; m < 4; ++m) { const size_t rb = (size_t)(row0 + ai * 128 + m * 16) * (2 * INCOLS);
#pragma unroll
                for (int bj = 0; bj < 2; ++bj) {
                    const u32x2 gn = *(const u32x2*)(zn + rb + bj * 128), gd = *(const u32x2*)(zd + rb + bj * 128);
                    const f32x4 n0 = ub4(gn.x) * sr[bj][0], n1 = ub4(gn.y) * sr[bj][1], d0 = ub4(gd.x), d1 = ub4(gd.y);
#pragma unroll
                    for (int j = 0; j < 4; ++j) { acc[ai][bj][m][0][j] *= n0[j] * __builtin_amdgcn_rcpf(d0[j]); acc[ai][bj][m][1][j] *= n1[j] * __builtin_amdgcn_rcpf(d1[j]); } }
                asm volatile("" ::: "memory"); }
    }
    __device__ __forceinline__ void operator()(const f32x4 (&acc)[2][2][4][2], const Unit& u, int wr, int wc, int fr, int fq) const {
        const int row0 = u.pm * 256 + wr * 64 + fr, col0 = u.pn * 256 + wc * 32 + 8 * fq;
        const unsigned char* zg = (const unsigned char*)Z + 2 * GATE0 + 2 * D + col0;
#pragma unroll
        for (int ai = 0; ai < 2; ++ai)
#pragma unroll
            for (int m = 0; m < 4; ++m) { const size_t row = (size_t)(row0 + ai * 128 + m * 16);
#pragma unroll
                for (int bj = 0; bj < 2; ++bj) {
                    const u32x2 g = *(const u32x2*)(zg + row * (2 * INCOLS) + bj * 128);
                    const f32x4 v0 = acc[ai][bj][m][0] * (ub4(g.x) * (1.0f / 255.0f)), v1 = acc[ai][bj][m][1] * (ub4(g.y) * (1.0f / 255.0f));
                    u32x4 w; w.x = cvt_pk_bf16(v0[0], v0[1]); w.y = cvt_pk_bf16(v0[2], v0[3]); w.z = cvt_pk_bf16(v1[0], v1[1]); w.w = cvt_pk_bf16(v1[2], v1[3]);
                    *(u32x4*)(Mg + row * D + col0 + bj * 128) = w; } }
    }
};
struct EpiResBf16 {
    static constexpr bool PERM = true, SEG = false, PREF = false; static constexpr int NST = 12;
    bf16_t* O; const float* base; float alpha;
    __device__ __forceinline__ void operator()(const f32x4 (&acc)[2][2][4][2], const Unit& u, int wr, int wc, int fr, int fq) const {
        const int row0 = u.pm * 256 + wr * 64 + fr, col0 = u.pn * 256 + wc * 32 + 8 * fq;
#pragma unroll
        for (int ai = 0; ai < 2; ++ai)
#pragma unroll
            for (int m = 0; m < 4; ++m) { const size_t off = (size_t)(row0 + ai * 128 + m * 16) * D + col0;
#pragma unroll
                for (int bj = 0; bj < 2; ++bj) { const f32x4 b0 = *(const f32x4*)(base + off + bj * 128), b1 = *(const f32x4*)(base + off + bj * 128 + 4);
                    const f32x4 v0 = b0 * alpha + acc[ai][bj][m][0], v1 = b1 * alpha + acc[ai][bj][m][1];
                    u32x4 w; w.x = cvt_pk_bf16(v0[0], v0[1]); w.y = cvt_pk_bf16(v0[2], v0[3]); w.z = cvt_pk_bf16(v1[0], v1[1]); w.w = cvt_pk_bf16(v1[2], v1[3]);
                    *(u32x4*)(O + off + bj * 128) = w; } }
    }
};
struct EpiAct {
    static constexpr bool PERM = true, SEG = false, PREF = false; static constexpr int NST = 6;
    unsigned char* O; const float* rs; const float* cs;
    __device__ __forceinline__ void operator()(const f32x4 (&acc)[2][2][4][2], const Unit& u, int wr, int wc, int fr, int fq) const {
        const int row0 = u.pm * 256 + wr * 64 + fr, col0 = u.pn * 128 + wc * 32 + 8 * fq;
        const float* cse = cs + (size_t)u.kind * D + u.pn * 256 + wc * 32 + 8 * fq;
        f32x4 cg[2], cv[2];
#pragma unroll
        for (int n = 0; n < 2; ++n) { cg[n] = *(const f32x4*)(cse + 4 * n); cv[n] = *(const f32x4*)(cse + 128 + 4 * n); }
#pragma unroll
        for (int ai = 0; ai < 2; ++ai)
#pragma unroll
            for (int m = 0; m < 4; ++m) { const int row = row0 + ai * 128 + m * 16; unsigned char* rowp = O + (size_t)row * DEXP + col0; const float r = rs[row];
                f32x4 r0, r1;
#pragma unroll
                for (int j = 0; j < 4; ++j) { const float g0 = acc[ai][0][m][0][j] * (cg[0][j] * r), g1 = acc[ai][0][m][1][j] * (cg[1][j] * r);
                    r0[j] = g0 * sigmoidf_(g0) * (acc[ai][1][m][0][j] * (cv[0][j] * r)); r1[j] = g1 * sigmoidf_(g1) * (acc[ai][1][m][1][j] * (cv[1][j] * r)); }
                u32x2 w; { int q = __builtin_amdgcn_cvt_pk_fp8_f32(r0[0], r0[1], 0, false); q = __builtin_amdgcn_cvt_pk_fp8_f32(r0[2], r0[3], q, true); w.x = (unsigned)q; }
                { int q = __builtin_amdgcn_cvt_pk_fp8_f32(r1[0], r1[1], 0, false); q = __builtin_amdgcn_cvt_pk_fp8_f32(r1[2], r1[3], q, true); w.y = (unsigned)q; }
                *(u32x2*)rowp = w; }
    }
};

struct Frame {
    LAS unsigned char* lds; int tid, lane, wave, G, bid;
    const Params* p;
};

struct TItem { const float* src; bf16_t* dst; int ldw, ldt, f8; };
constexpr int PREP_NIT = 16 * 256 + 3 * 16 * 32 + 16 * 64 + 4 * 4 * 8 + NEXP * 16 * 32 + NEXP * 8 * 32;
constexpr int PREP_LATE = 0;
__device__ __forceinline__ bool prep_item(const Params& P, unsigned char* ws, int it, int it_end, TItem& t) {
    constexpr int I_IN = 16 * 256, I_SQ = 16 * 32, I_KV = 16 * 64, I_P = 4 * 4 * 8, I_UP = NEXP * 16 * 32, I_DN = NEXP * 8 * 32;
    constexpr int NIT = I_IN + 3 * I_SQ + I_KV + I_P + I_UP + I_DN; static_assert(NIT == PREP_NIT, "item count");
    if (it >= it_end) return false;
    int r = it;
    if (r < I_IN) { const int kb = r / 256, nb = r % 256, n0 = 32 * nb;
        int drow = n0; if (n0 >= D && n0 < 3 * D) { const int c = (n0 - D) & (D - 1); drow = D + (c >> 7) * 256 + (n0 >= 2 * D ? 128 : 0) + (c & 127); }
        t.src = P.in[I_WIN] + (size_t)(64 * kb) * INCOLS + n0; t.ldw = INCOLS; t.dst = (bf16_t*)(ws + WS_WIN) + (size_t)drow * D + 64 * kb; t.ldt = D; t.f8 = 0; return true; } r -= I_IN;
    if (r < I_SQ) { const int kb = r / 32, nb = r % 32; t.src = P.in[I_WCONV] + (size_t)(64 * kb) * D + 32 * nb; t.ldw = D; t.dst = (bf16_t*)(ws + WS_WCAT) + (size_t)(32 * nb) * KCAT + 64 * kb; t.ldt = KCAT; t.f8 = 0; return true; } r -= I_SQ;
    if (r < I_SQ) { const int kb = r / 32, nb = r % 32; t.src = P.in[I_WXO] + (size_t)(64 * kb) * D + 32 * nb; t.ldw = D; t.dst = (bf16_t*)(ws + WS_WCAT) + (size_t)(32 * nb) * KCAT + 1280 + 64 * kb; t.ldt = KCAT; t.f8 = 0; return true; } r -= I_SQ;
    if (r < I_SQ) { const int kb = r / 32, nb = r % 32; t.src = P.in[I_WO] + (size_t)(64 * kb) * D + 32 * nb; t.ldw = D; t.dst = (bf16_t*)(ws + WS_WO) + (size_t)(32 * nb) * D + 64 * kb; t.ldt = D; t.f8 = 0; return true; } r -= I_SQ;
    if (r < I_KV) { const int kb = r / 64, nb = r % 64; t.src = P.in[I_WKV] + (size_t)(64 * kb) * (2 * D) + 32 * nb; t.ldw = 2 * D; t.dst = (bf16_t*)(ws + WS_WKV) + (size_t)(32 * nb) * D + 64 * kb; t.ldt = D; t.f8 = 0; return true; } r -= I_KV;
    if (r < I_P) { const int g = r / 32, q = r % 32, kb = q / 8, nb = q % 8;
        t.src = P.in[I_WPOOL] + (size_t)g * 65536 + (size_t)(64 * kb) * 256 + 32 * nb; t.ldw = 256; t.dst = (bf16_t*)(ws + WS_WCAT) + (size_t)(g * 256 + 32 * nb) * KCAT + 1024 + 64 * kb; t.ldt = KCAT; t.f8 = 0; return true; } r -= I_P;
    if (r < I_UP) { const int e = r / 512, q = r % 512, kb = q / 32, nb = q % 32; const int n0 = 32 * nb;
        const int j0 = n0 & 511, drow = (j0 >> 7) * 256 + (n0 >= 512 ? 128 : 0) + (j0 & 127);
        t.src = P.in[I_WUP] + (size_t)e * D * D + (size_t)(64 * kb) * D + n0; t.ldw = D; t.dst = (bf16_t*)(ws + WS_WUP + (size_t)e * D * D + (size_t)drow * D + 64 * kb); t.ldt = D; t.f8 = 1; return true; } r -= I_UP;
    { const int e = r / 256, q = r % 256, kb = q / 32, nb = q % 32;
        t.src = P.in[I_WDN] + (size_t)e * DEXP * D + (size_t)(64 * kb) * D + 32 * nb; t.ldw = D; t.dst = (bf16_t*)(ws + WS_WDN + (size_t)e * D * DEXP + (size_t)(32 * nb) * DEXP + 64 * kb); t.ldt = DEXP; t.f8 = 1; return true; }
}
__device__ __forceinline__ void titem_load(const TItem& t, int lane, f32x4 (&v)[8]) {
    const float* s = t.src + (size_t)(lane >> 3) * t.ldw + (lane & 7) * 4;
#pragma unroll
    for (int j = 0; j < 8; ++j) v[j] = *(const f32x4*)(s + (size_t)(8 * j) * t.ldw);
}
__device__ __forceinline__ void titem_finish(const TItem& t, int lane, const f32x4 (&v)[8], LAS float* scr) {
#pragma unroll
    for (int j = 0; j < 8; ++j) { LAS float* d = scr + (8 * j + (lane >> 3)) * 33 + (lane & 7) * 4; d[0] = v[j][0]; d[1] = v[j][1]; d[2] = v[j][2]; d[3] = v[j][3]; }
    asm volatile("s_waitcnt lgkmcnt(0)" ::: "memory");
    if (t.f8) {
        const int c = lane & 3;
#pragma unroll
        for (int j = 0; j < 2; ++j) { const int n = (lane >> 2) + 16 * j; const LAS float* s = scr + (16 * c) * 33 + n;
            u32x4 o;
            { int r = __builtin_amdgcn_cvt_pk_fp8_f32(s[0 * 33] * 32.f, s[1 * 33] * 32.f, 0, false); r = __builtin_amdgcn_cvt_pk_fp8_f32(s[2 * 33] * 32.f, s[3 * 33] * 32.f, r, true); o.x = (unsigned)r; }
            { int r = __builtin_amdgcn_cvt_pk_fp8_f32(s[4 * 33] * 32.f, s[5 * 33] * 32.f, 0, false); r = __builtin_amdgcn_cvt_pk_fp8_f32(s[6 * 33] * 32.f, s[7 * 33] * 32.f, r, true); o.y = (unsigned)r; }
            { int r = __builtin_amdgcn_cvt_pk_fp8_f32(s[8 * 33] * 32.f, s[9 * 33] * 32.f, 0, false); r = __builtin_amdgcn_cvt_pk_fp8_f32(s[10 * 33] * 32.f, s[11 * 33] * 32.f, r, true); o.z = (unsigned)r; }
            { int r = __builtin_amdgcn_cvt_pk_fp8_f32(s[12 * 33] * 32.f, s[13 * 33] * 32.f, 0, false); r = __builtin_amdgcn_cvt_pk_fp8_f32(s[14 * 33] * 32.f, s[15 * 33] * 32.f, r, true); o.w = (unsigned)r; }
            *(u32x4*)((unsigned char*)t.dst + (size_t)n * t.ldt + 16 * c) = o; }
    } else {
    const int c = lane & 7;
#pragma unroll
    for (int j = 0; j < 4; ++j) { const int n = (lane >> 3) + 8 * j; const LAS float* s = scr + (8 * c) * 33 + n;
        u32x4 o; o.x = cvt_pk_bf16(s[0 * 33], s[1 * 33]); o.y = cvt_pk_bf16(s[2 * 33], s[3 * 33]); o.z = cvt_pk_bf16(s[4 * 33], s[5 * 33]); o.w = cvt_pk_bf16(s[6 * 33], s[7 * 33]);
        *(u32x4*)(t.dst + (size_t)n * t.ldt + 8 * c) = o; }
    }
    asm volatile("s_waitcnt lgkmcnt(0)" ::: "memory");
}

struct WTask { const float* src; int ldw; unsigned char* dst; float* sc; };
__device__ __forceinline__ bool wtask_get(const Params& P, unsigned char* ws, int t, WTask& k) {
    constexpr int T_IN = INCOLS / 32, T_UP = NEXP * (D / 32);
    if (t >= T_IN + T_UP) return false;
    if (t < T_IN) { const int n0 = 32 * t;
        int drow = n0; if (n0 >= D && n0 < 3 * D) { const int c = (n0 - D) & (D - 1); drow = D + (c >> 7) * 256 + (n0 >= 2 * D ? 128 : 0) + (c & 127); }
        k.src = P.in[I_WIN] + n0; k.ldw = INCOLS; k.dst = ws + WS_WIN + (size_t)drow * D; k.sc = (float*)(ws + WS_SW) + drow;
    } else { const int q = t - T_IN, e = q >> 5, n0 = 32 * (q & 31);
        const int j0 = n0 & 511, drow = (j0 >> 7) * 256 + (n0 >= 512 ? 128 : 0) + (j0 & 127);
        k.src = P.in[I_WUP] + (size_t)e * D * D + n0; k.ldw = D; k.dst = ws + WS_WUP + (size_t)e * D * D + (size_t)drow * D; k.sc = (float*)(ws + WS_SWU) + e * D + drow; }
    return true;
}
__device__ __forceinline__ void wtask_load(const Frame& F, const WTask& k, f32x4 (&va)[8], f32x4 (&vb)[8]) {
    TItem ta, tb; ta.src = k.src + (size_t)(64 * (2 * F.wave)) * k.ldw; ta.ldw = k.ldw; tb.src = ta.src + (size_t)64 * k.ldw; tb.ldw = k.ldw;
    titem_load(ta, F.lane, va); titem_load(tb, F.lane, vb);
}
__device__ __forceinline__ void wtask_finish(const Frame& F, const WTask& k, const f32x4 (&va)[8], const f32x4 (&vb)[8]) {
    LAS float* scr = (LAS float*)(F.lds + F.wave * 16384);
    LAS float* cmx = (LAS float*)(F.lds + 131072 + 8192);
    const int lane = F.lane, c4 = (lane & 7) * 4;
    f32x4 mx = (f32x4){0.f, 0.f, 0.f, 0.f};
#pragma unroll
    for (int j = 0; j < 8; ++j) { mx = __builtin_elementwise_max(mx, __builtin_elementwise_max(__builtin_elementwise_abs(va[j]), __builtin_elementwise_abs(vb[j]))); }
#pragma unroll
    for (int o = 8; o < 64; o <<= 1) {
#pragma unroll
        for (int q = 0; q < 4; ++q) mx[q] = fmaxf(mx[q], __shfl_xor(mx[q], o)); }
    __syncthreads();
    if (lane < 8) { LAS float* d = cmx + F.wave * 32 + c4; d[0] = mx[0]; d[1] = mx[1]; d[2] = mx[2]; d[3] = mx[3]; }
    __syncthreads();
    if (F.tid < 32) { float m = 0.f;
#pragma unroll
        for (int w = 0; w < 8; ++w) m = fmaxf(m, cmx[w * 32 + F.tid]);
        cmx[256 + F.tid] = m > 0.f ? 127.0f / m : 0.f; k.sc[F.tid] = m > 0.f ? m * (1.0f / 127.0f) : 1.0f; }
    __syncthreads();
#pragma unroll
    for (int blk = 0; blk < 2; ++blk) {
#pragma unroll
        for (int j = 0; j < 8; ++j) { const f32x4 x = blk ? vb[j] : va[j]; LAS float* d = scr + (8 * j + (lane >> 3)) * 33 + c4; d[0] = x[0]; d[1] = x[1]; d[2] = x[2]; d[3] = x[3]; }
        asm volatile("s_waitcnt lgkmcnt(0)" ::: "memory");
        const int c = lane & 3;
#pragma unroll
        for (int j = 0; j < 2; ++j) { const int n = (lane >> 2) + 16 * j; const LAS float* s = scr + (16 * c) * 33 + n; const float inv = cmx[256 + n];
            u32x4 o;
#pragma unroll
            for (int g = 0; g < 4; ++g) { o[g] = ((unsigned)(int)__builtin_rintf(s[(4 * g) * 33] * inv) & 0xffu) | (((unsigned)(int)__builtin_rintf(s[(4 * g + 1) * 33] * inv) & 0xffu) << 8) | (((unsigned)(int)__builtin_rintf(s[(4 * g + 2) * 33] * inv) & 0xffu) << 16) | ((unsigned)(int)__builtin_rintf(s[(4 * g + 3) * 33] * inv) << 24); }
            *(u32x4*)(k.dst + (size_t)n * D + 64 * (2 * F.wave + blk) + 16 * c) = o; }
        asm volatile("s_waitcnt lgkmcnt(0)" ::: "memory");
    }
}
__device__ __forceinline__ void prep_i8_tasks(const Frame& F) {
    const Params& P = *F.p; unsigned char* ws = P.ws;
    WTask cur, nxt; f32x4 va[8], vb[8], wa[8], wb[8];
    int t = F.bid; bool have = wtask_get(P, ws, t, cur);
    if (have) wtask_load(F, cur, va, vb);
    while (have) {
        const bool hn = wtask_get(P, ws, t + F.G, nxt);
        if (hn) wtask_load(F, nxt, wa, wb);
        wtask_finish(F, cur, va, vb);
        if (!hn) break;
        t += 2 * F.G;
        have = wtask_get(P, ws, t, cur);
        if (have) wtask_load(F, cur, va, vb);
        wtask_finish(F, nxt, wa, wb);
    }
    __syncthreads();
}

__device__ __forceinline__ void convert_items(const Frame& F, int it0, int it1, int w, int nw) {
    const Params& P = *F.p; unsigned char* ws = P.ws;
    LAS float* scr = (LAS float*)(F.lds + F.wave * 16384);
    TItem cur, nxt; f32x4 va[8], vb[8];
    int it = it0 + w; bool have = prep_item(P, ws, it, it1, cur);
    if (have) titem_load(cur, F.lane, va);
    while (have) {
        const bool hn = prep_item(P, ws, it + nw, it1, nxt);
        if (hn) titem_load(nxt, F.lane, vb);
        titem_finish(cur, F.lane, va, scr);
        if (!hn) break;
        it += 2 * nw;
        have = prep_item(P, ws, it, it1, cur);
        if (have) titem_load(cur, F.lane, va);
        titem_finish(nxt, F.lane, vb, scr);
    }
}

__device__ __forceinline__ void phase_prep(const Frame& F) {
    const Params& P = *F.p; unsigned char* ws = P.ws;
    LAS float* scr = (LAS float*)(F.lds + F.wave * 16384);
    const int gw = F.bid * NWAVES + F.wave, NGW = F.G * NWAVES;
    prep_i8_tasks(F);
    const size_t gt = (size_t)F.bid * NTHR + F.tid, NGT = (size_t)F.G * NTHR;
    for (int row0 = gw * 4; row0 < NTOK; row0 += NGW * 4) {
        f32x4 v[4][4]; float am[4];
#pragma unroll
        for (int a = 0; a < 4; ++a) { const f32x4* xr = (const f32x4*)(P.in[I_X] + (size_t)(row0 + a) * D) + F.lane;
#pragma unroll
            for (int j = 0; j < 4; ++j) v[a][j] = xr[64 * j]; }
#pragma unroll
        for (int a = 0; a < 4; ++a) { am[a] = 0.f;
#pragma unroll
            for (int j = 0; j < 4; ++j) am[a] = fmaxf(am[a], fmaxf(fmaxf(fabsf(v[a][j][0]), fabsf(v[a][j][1])), fmaxf(fabsf(v[a][j][2]), fabsf(v[a][j][3])))); }
#pragma unroll
        for (int o = 1; o < 64; o <<= 1) {
#pragma unroll
            for (int a = 0; a < 4; ++a) am[a] = fmaxf(am[a], __shfl_xor(am[a], o)); }
#pragma unroll
        for (int a = 0; a < 4; ++a) { const float inv = am[a] > 0.f ? 127.0f / am[a] : 0.f;
            if (F.lane == 0) ((float*)(ws + WS_XS))[row0 + a] = am[a] > 0.f ? am[a] * (1.0f / 127.0f) : 1.0f;
#pragma unroll
            for (int j = 0; j < 4; ++j) { const f32x4 q = v[a][j] * inv;
                const unsigned w = ((unsigned)(int)__builtin_rintf(q[0]) & 0xffu) | (((unsigned)(int)__builtin_rintf(q[1]) & 0xffu) << 8) | (((unsigned)(int)__builtin_rintf(q[2]) & 0xffu) << 16) | ((unsigned)(int)__builtin_rintf(q[3]) << 24);
                *((unsigned*)(ws + WS_XB + (size_t)(row0 + a) * D) + F.lane + 64 * j) = w; } }
    }
    { const f32x4* src = (const f32x4*)P.in[I_MEM]; u32x4* dst = (u32x4*)(ws + WS_MEMB);
      for (size_t i = gt; i < (size_t)NMEM * D / 8; i += NGT) { const f32x4 a = src[2 * i], b = src[2 * i + 1]; u32x4 o; o.x = cvt_pk_bf16(a[0], a[1]); o.y = cvt_pk_bf16(a[2], a[3]); o.z = cvt_pk_bf16(b[0], b[1]); o.w = cvt_pk_bf16(b[2], b[3]); dst[i] = o; } }
    { bf16_t* wr = (bf16_t*)(ws + WS_WR);
      for (size_t i = gt; i < (size_t)80 * D; i += NGT) { const int o = (int)(i / D), k = (int)(i % D); wr[i] = (bf16_t)f2bf(o < 8 ? P.in[I_WRG][(size_t)k * 8 + o] : (o < 72 ? P.in[I_WRE][(size_t)k * 64 + (o - 8)] : 0.f)); } }
    { constexpr int I0 = 16 * 256, I_UP0 = I0 + 3 * 16 * 32 + 16 * 64 + 4 * 4 * 8, I_DN0 = I_UP0 + NEXP * 16 * 32;
      convert_items(F, I0, I_UP0, gw, NGW); convert_items(F, I_DN0, PREP_NIT, gw, NGW); }
}

struct F8 { f32x4 a, b; };
__device__ __forceinline__ F8 up8(const u32x4 v) { F8 r; r.a = (f32x4){bf_lo(v.x), bf_hi(v.x), bf_lo(v.y), bf_hi(v.y)}; r.b = (f32x4){bf_lo(v.z), bf_hi(v.z), bf_lo(v.w), bf_hi(v.w)}; return r; }
__device__ __forceinline__ u32x4 pk8(const F8 v) { u32x4 o; o.x = pk2(v.a[0], v.a[1]); o.y = pk2(v.a[2], v.a[3]); o.z = pk2(v.b[0], v.b[1]); o.w = pk2(v.b[2], v.b[3]); return o; }
__device__ __forceinline__ void phase_convpool(const Frame& F) {
    const Params& P = *F.p; unsigned char* ws = P.ws;
    const bf16_t* __restrict__ Z = (const bf16_t*)(ws + WS_Z); bf16_t* __restrict__ AC = (bf16_t*)(ws + WS_ACONV); bf16_t* __restrict__ DP = (bf16_t*)(ws + WS_DPOOL);
    const float* cw = P.in[I_CONVW];
    constexpr int TSEG = 16;
    unsigned* ctr = (unsigned*)(ws + WS_CTL) + CW_CPCTR;
    volatile LAS unsigned* slot = (volatile LAS unsigned*)(F.lds + 131072 + 12288);
    for (;;) {
        __syncthreads();
        if (F.tid == 0) slot[0] = atomicAdd(ctr, 1u);
        __syncthreads();
        const unsigned chunk = slot[0];
        if (chunk >= (unsigned)((NTOK / TSEG) * (D / 8) / NTHR)) break;
        const int it = (int)chunk * NTHR + F.tid;
        const int c0 = (it & 127) * 8, t0 = (it >> 7) * TSEG, s0 = t0 & (SEQ - 1);
        const int gi = c0 >> 8, w = 2 << gi;
        F8 w0, w1, w2;
        w0.a = *(const f32x4*)(cw + c0); w0.b = *(const f32x4*)(cw + c0 + 4); w1.a = *(const f32x4*)(cw + D + c0); w1.b = *(const f32x4*)(cw + D + c0 + 4); w2.a = *(const f32x4*)(cw + 2 * D + c0); w2.b = *(const f32x4*)(cw + 2 * D + c0 + 4);
        const bf16_t* zr0 = Z + (size_t)t0 * INCOLS + c0;
        F8 u1, u2, run;
        u1.a = u1.b = u2.a = u2.b = run.a = run.b = (f32x4){0.f, 0.f, 0.f, 0.f};
        if (s0 > 0) {
            u1 = up8(*(const u32x4*)(zr0 - INCOLS + D)); u2 = up8(*(const u32x4*)(zr0 - 2 * INCOLS + D));
            for (int i = 1; i < w; ++i) { const F8 pp = up8(*(const u32x4*)(zr0 - (size_t)i * INCOLS + 3 * D)); run.a += pp.a; run.b += pp.b; }
        }
        for (int tb = 0; tb < TSEG; tb += 4) {
            u32x4 lcb[4], lcc[4], lp[4], lold[4];
#pragma unroll
            for (int j = 0; j < 4; ++j) { const bf16_t* zr = zr0 + (size_t)(tb + j) * INCOLS;
                lcb[j] = *(const u32x4*)(zr); lcc[j] = *(const u32x4*)(zr + D); lp[j] = *(const u32x4*)(zr + 3 * D);
                lold[j] = (s0 + tb + j - (w - 1) >= 0) ? *(const u32x4*)(zr - (size_t)(w - 1) * INCOLS + 3 * D) : (u32x4){0u, 0u, 0u, 0u}; }
#pragma unroll
            for (int j = 0; j < 4; ++j) {
                const F8 cb = up8(lcb[j]), u0 = up8(lcc[j]);
                F8 v; v.a = (w0.a * u2.a + w1.a * u1.a + w2.a * u0.a) * cb.a; v.b = (w0.b * u2.b + w1.b * u1.b + w2.b * u0.b) * cb.b;
                *(u32x4*)(AC + (size_t)(t0 + tb + j) * D + c0) = pk8(v);
                u2 = u1; u1 = u0;
                const F8 pp = up8(lp[j]), po = up8(lold[j]);
                run.a += pp.a; run.b += pp.b;
                const int s = s0 + tb + j; const int cnt = (s + 1) < w ? (s + 1) : w; const float inv = 1.0f / (float)cnt;
                F8 d; d.a = run.a * inv - pp.a; d.b = run.b * inv - pp.b;
                *(u32x4*)(DP + (size_t)(t0 + tb + j) * D + c0) = pk8(d);
                run.a -= po.a; run.b -= po.b;
            }
        }
    }
}

typedef float f32x16 __attribute__((ext_vector_type(16)));
typedef float f32x2_t __attribute__((ext_vector_type(2))); typedef __bf16 bf16x2_t __attribute__((ext_vector_type(2)));
__device__ __forceinline__ unsigned cvtpk(float lo, float hi) { f32x2_t v = {lo, hi}; bf16x2_t b = __builtin_convertvector(v, bf16x2_t); return __builtin_bit_cast(unsigned, b); }
#define MFMA32(a, b, c) __builtin_amdgcn_mfma_f32_32x32x16_bf16((a), (b), (c), 0, 0, 0)
__device__ __forceinline__ void phase_attn(const Frame& F) {
    const Params& P = *F.p; unsigned char* ws = P.ws;
    const bf16_t* Z = (const bf16_t*)(ws + WS_Z); bf16_t* O = (bf16_t*)(ws + WS_O);
    const int tid = F.tid, lane = F.lane, wave = F.wave, r = lane & 31, hh = lane >> 5;
    const int prow = tid >> 5, pc = (tid & 31) ^ prow;
    LAS unsigned char* lds = F.lds;
    int rb[8];
#pragma unroll
    for (int t = 0; t < 8; ++t) rb[t] = r * 512 + (((2 * t + hh) ^ (r & 15)) << 4);
#define AT_WAIT_BAR(N) asm volatile("s_waitcnt vmcnt(" #N ")\n\ts_barrier" ::: "memory")
#define AT_ISSUE(i) do { const char* _s = ((i) < 8) ? ksrc + (size_t)(32 * (i)) * 2048 : vsrc + (size_t)(32 * ((i) - 8)) * 512; const size_t _rs = ((i) < 8) ? 2048 : 512; \
        _Pragma("unroll") for (int _it = 0; _it < 2; ++_it) \
        __builtin_amdgcn_global_load_lds((const unsigned*)(_s + (size_t)(16 * _it) * _rs), (LAS unsigned*)(lds + ((i) & 3) * 16384 + _it * 8192 + wave * 1024), 16, 0, 0); } while (0)
#define AT_FRAG(slot, s) (*(const LAS pg8::bf16x8*)(lds + rb[(s) & 7] + (slot) * 16384 + ((s) >> 3) * 256))
    for (int ui = F.bid; ui < (NTOK / 256) * 4; ui += F.G) {
        const int h = ui & 3, t0 = (ui >> 2) * 256, b = t0 / SEQ;
        const bf16_t* qrow = Z + (size_t)(t0 + 32 * wave + r) * INCOLS + 4 * D + h * 256 + 8 * hh;
        pg8::bf16x8 qf[16];
#pragma unroll
        for (int s = 0; s < 16; ++s) qf[s] = *(const pg8::bf16x8*)(qrow + 16 * s);
        const char* ksrc = (const char*)(ws + WS_KB) + ((size_t)(b * 256 + prow) * D + h * 256) * 2 + pc * 16;
        const char* vsrc = (const char*)(ws + WS_VT) + ((size_t)(b * D + h * 256 + prow) * 256) * 2 + pc * 16;
        asm volatile("s_barrier" ::: "memory");
        AT_ISSUE(0); AT_ISSUE(1); AT_ISSUE(2);
        f32x16 S[8];
#pragma unroll
        for (int i = 0; i < 8; ++i)
#pragma unroll
            for (int j = 0; j < 16; ++j) S[i][j] = 0.f;
#pragma unroll
        for (int i = 0; i < 8; ++i) {
            AT_WAIT_BAR(4);
            AT_ISSUE(i + 3);
#pragma unroll
            for (int s = 0; s < 16; ++s) {
                const pg8::bf16x8 a = AT_FRAG(i & 3, s);
                S[i] = MFMA32(a, qf[s], S[i]);
                if ((s & 15) == 15) asm volatile("" ::: "memory");
            }
        }
        float mx = S[0][0];
#pragma unroll
        for (int i = 0; i < 8; ++i)
#pragma unroll
            for (int j = 0; j < 16; ++j) mx = fmaxf(mx, S[i][j]);
        mx = fmaxf(mx, __shfl_xor(mx, 32));
        const float c2 = 0.0625f * 1.4426950408889634f;
        float sum = 0.f;
        pg8::bf16x8 pf[8][2];
#pragma unroll
        for (int i = 0; i < 8; ++i) {
#pragma unroll
            for (int j = 0; j < 16; ++j) { const float e = __builtin_amdgcn_exp2f((S[i][j] - mx) * c2); S[i][j] = e; sum += e; }
#pragma unroll
            for (int s2 = 0; s2 < 2; ++s2) { u32x4 w; w.x = cvtpk(S[i][8 * s2], S[i][8 * s2 + 1]); w.y = cvtpk(S[i][8 * s2 + 2], S[i][8 * s2 + 3]); w.z = cvtpk(S[i][8 * s2 + 4], S[i][8 * s2 + 5]); w.w = cvtpk(S[i][8 * s2 + 6], S[i][8 * s2 + 7]);
                pf[i][s2] = __builtin_bit_cast(pg8::bf16x8, w); }
        }
        sum += __shfl_xor(sum, 32);
        const float inv = 1.0f / sum;
        bf16_t* orow = O + (size_t)(t0 + 32 * wave + r) * D + h * 256 + 4 * hh;
#pragma unroll
        for (int i = 8; i < 16; ++i) {
            if (i < 14) AT_WAIT_BAR(4); else if (i == 14) AT_WAIT_BAR(2); else AT_WAIT_BAR(0);
            if (i + 3 < 16) AT_ISSUE(i + 3);
            f32x16 o;
#pragma unroll
            for (int j = 0; j < 16; ++j) o[j] = 0.f;
#pragma unroll
            for (int s = 0; s < 16; ++s) {
                const pg8::bf16x8 a = AT_FRAG(i & 3, s);
                o = MFMA32(a, pf[s >> 1][s & 1], o);
                if ((s & 15) == 15) asm volatile("" ::: "memory");
            }
#pragma unroll
            for (int g = 0; g < 4; ++g) { u32x2 w; w.x = cvtpk(o[4 * g] * inv, o[4 * g + 1] * inv); w.y = cvtpk(o[4 * g + 2] * inv, o[4 * g + 3] * inv);
                *(u32x2*)(orow + 32 * (i - 8) + 8 * g) = w; }
        }
    }
    asm volatile("s_waitcnt vmcnt(0)\n\ts_barrier" ::: "memory");
#undef AT_WAIT_BAR
#undef AT_ISSUE
#undef AT_FRAG
}

__device__ __forceinline__ void phase_ln1_router(const Frame& F) {
    const Params& P = *F.p; unsigned char* ws = P.ws;
    const bf16_t* H1 = (const bf16_t*)(ws + WS_H1); bf16_t* H1B = (bf16_t*)(ws + WS_H1B); const bf16_t* WRB = (const bf16_t*)(ws + WS_WR);
    unsigned* ctl = (unsigned*)(ws + WS_CTL);
    int* tok_e = (int*)(ws + WS_MISC + MS_TOKE); int* tok_pos = (int*)(ws + WS_MISC + MS_TOKPOS); float* tok_w = (float*)(ws + WS_MISC + MS_TOKW);
    LAS float* lg = (LAS float*)(F.lds + F.wave * 5120);
    LAS unsigned* lcnt = (LAS unsigned*)(F.lds + 8 * 5120);
    const int lane = F.lane;
    const float* g1 = P.in[I_LN1G]; const float* b1 = P.in[I_LN1B];
    f32x4 gg[4], bb[4];
#pragma unroll
    for (int j = 0; j < 4; ++j) { gg[j] = *((const f32x4*)g1 + lane + 64 * j); bb[j] = *((const f32x4*)b1 + lane + 64 * j); }
    for (int grp0 = F.bid * NWAVES; grp0 < NTOK / 16; grp0 += F.G * NWAVES) {
        const int row0 = (grp0 + F.wave) * 16;
        if (F.tid < 128) lcnt[F.tid] = 0u;
        for (int rb = 0; rb < 16; rb += 4) {
            f32x4 v[4][4]; float s[4], q[4];
#pragma unroll
            for (int a = 0; a < 4; ++a) { const u32x2* xr = (const u32x2*)(H1 + (size_t)(row0 + rb + a) * D) + lane;
#pragma unroll
                for (int j = 0; j < 4; ++j) { const u32x2 p = xr[64 * j]; v[a][j] = (f32x4){bf_lo(p.x), bf_hi(p.x), bf_lo(p.y), bf_hi(p.y)}; } }
#pragma unroll
            for (int a = 0; a < 4; ++a) { s[a] = 0.f;
#pragma unroll
                for (int j = 0; j < 4; ++j) s[a] += (v[a][j][0] + v[a][j][1]) + (v[a][j][2] + v[a][j][3]); }
#pragma unroll
            for (int o = 1; o < 64; o <<= 1) {
#pragma unroll
                for (int a = 0; a < 4; ++a) s[a] += __shfl_xor(s[a], o); }
#pragma unroll
            for (int a = 0; a < 4; ++a) { const float mean = s[a] * (1.f / D); q[a] = 0.f;
#pragma unroll
                for (int j = 0; j < 4; ++j) { v[a][j] = v[a][j] - mean; q[a] += (v[a][j][0] * v[a][j][0] + v[a][j][1] * v[a][j][1]) + (v[a][j][2] * v[a][j][2] + v[a][j][3] * v[a][j][3]); } }
#pragma unroll
            for (int o = 1; o < 64; o <<= 1) {
#pragma unroll
                for (int a = 0; a < 4; ++a) q[a] += __shfl_xor(q[a], o); }
            float am[4];
#pragma unroll
            for (int a = 0; a < 4; ++a) { const float rstd = 1.f / sqrtf(q[a] * (1.f / D) + LN_EPS); am[a] = 0.f;
#pragma unroll
                for (int j = 0; j < 4; ++j) { const f32x4 y = v[a][j] * rstd * gg[j] + bb[j]; v[a][j] = y;
                    am[a] = fmaxf(am[a], fmaxf(fmaxf(fabsf(y[0]), fabsf(y[1])), fmaxf(fabsf(y[2]), fabsf(y[3]))));
                    u32x2 o; o.x = cvt_pk_bf16(y[0], y[1]); o.y = cvt_pk_bf16(y[2], y[3]); *((u32x2*)(H1B + (size_t)(row0 + rb + a) * D) + lane + 64 * j) = o; } }
#pragma unroll
            for (int o = 1; o < 64; o <<= 1) {
#pragma unroll
                for (int a = 0; a < 4; ++a) am[a] = fmaxf(am[a], __shfl_xor(am[a], o)); }
#pragma unroll
            for (int a = 0; a < 4; ++a) { const float inv = am[a] > 0.f ? 127.0f / am[a] : 0.f;
                if (lane == 0) ((float*)(ws + WS_H1S))[row0 + rb + a] = am[a] > 0.f ? am[a] * (1.0f / 127.0f) : 1.0f;
#pragma unroll
                for (int j = 0; j < 4; ++j) { const f32x4 z = v[a][j] * inv;
                    const unsigned w = ((unsigned)(int)__builtin_rintf(z[0]) & 0xffu) | (((unsigned)(int)__builtin_rintf(z[1]) & 0xffu) << 8) | (((unsigned)(int)__builtin_rintf(z[2]) & 0xffu) << 16) | ((unsigned)(int)__builtin_rintf(z[3]) << 24);
                    *((unsigned*)(ws + WS_H1F8 + (size_t)(row0 + rb + a) * D) + lane + 64 * j) = w; } }
        }
        asm volatile("s_waitcnt vmcnt(0)" ::: "memory");
        f32x4 acc[5];
#pragma unroll
        for (int n = 0; n < 5; ++n) acc[n] = (f32x4){0.f, 0.f, 0.f, 0.f};
        const bf16_t* ap = H1B + (size_t)(row0 + (lane & 15)) * D + 8 * (lane >> 4);
        const bf16_t* bp = WRB + (size_t)(lane & 15) * D + 8 * (lane >> 4);
#pragma unroll 8
        for (int ks = 0; ks < 32; ++ks) {
            const pg8::bf16x8 a = *(const pg8::bf16x8*)(ap + 32 * ks);
#pragma unroll
            for (int n = 0; n < 5; ++n) { const pg8::bf16x8 bw = *(const pg8::bf16x8*)(bp + (size_t)n * 16 * D + 32 * ks); acc[n] = __builtin_amdgcn_mfma_f32_16x16x32_bf16(a, bw, acc[n], 0, 0, 0); }
        }
#pragma unroll
        for (int n = 0; n < 5; ++n)
#pragma unroll
            for (int i = 0; i < 4; ++i) lg[(4 * (lane >> 4) + i) * 80 + 16 * n + (lane & 15)] = acc[n][i];
        __syncthreads();
        int ea = 0, eb = 0; unsigned la = 0, lb = 0; float w1 = 0.f, w2 = 0.f;
        if (lane < 16) {
            const LAS float* l = lg + lane * 80;
            const float* brg = P.in[I_BRG]; const float* bre = P.in[I_BRE];
            int gs = 0; float gm = l[0] + brg[0];
            for (int i = 1; i < 8; ++i) { const float x = l[i] + brg[i]; if (x > gm) { gm = x; gs = i; } }
            float den = 0.f; for (int i = 0; i < 8; ++i) den += __expf(l[i] + brg[i] - gm);
            const float gwt = 1.0f / den;
            int i1 = 0; float l1 = l[8 + gs * 8] + bre[gs * 8];
            for (int i = 1; i < 8; ++i) { const float x = l[8 + gs * 8 + i] + bre[gs * 8 + i]; if (x > l1) { l1 = x; i1 = i; } }
            int i2 = -1; float l2 = 0.f;
            for (int i = 0; i < 8; ++i) { if (i == i1) continue; const float x = l[8 + gs * 8 + i] + bre[gs * 8 + i]; if (i2 < 0 || x > l2) { l2 = x; i2 = i; } }
            const float e2 = __expf(l2 - l1); w1 = gwt / (1.0f + e2); w2 = gwt * e2 / (1.0f + e2);
            ea = gs * 8 + i1; eb = gs * 8 + i2;
            la = atomicAdd((unsigned*)(lcnt + ea), 1u); lb = atomicAdd((unsigned*)(lcnt + eb), 1u);
        }
        __syncthreads();
        if (F.tid < 64) { const unsigned c = lcnt[F.tid]; lcnt[64 + F.tid] = c ? atomicAdd(ctl + CW_COUNTS + F.tid, c) : 0u; }
        __syncthreads();
        if (lane < 16) { const int row = row0 + lane;
            tok_e[2 * row] = ea; tok_e[2 * row + 1] = eb; tok_pos[2 * row] = (int)(lcnt[64 + ea] + la); tok_pos[2 * row + 1] = (int)(lcnt[64 + eb] + lb); tok_w[2 * row] = w1; tok_w[2 * row + 1] = w2; }
        __syncthreads();
    }
}

__device__ __forceinline__ void phase_gather(const Frame& F) {
    const Params& P = *F.p; unsigned char* ws = P.ws;
    const int* tok_e = (const int*)(ws + WS_MISC + MS_TOKE); const int* tok_pos = (const int*)(ws + WS_MISC + MS_TOKPOS); int* tok_dest = (int*)(ws + WS_MISC + MS_TOKDEST);
    const unsigned char* H1F = ws + WS_H1F8; unsigned char* XB = ws + WS_XBUF;
    LAS int* ps = (LAS int*)F.lds;
    if (F.tid == 0) {
        const unsigned* cnt = (const unsigned*)(ws + WS_CTL) + CW_COUNTS;
        int* tile_e = (int*)(ws + WS_MISC + MS_TILEE); int* ntl = (int*)(ws + WS_MISC + MS_NTILES);
        int run = 0;
        for (int e = 0; e < NEXP; ++e) { const int c = (int)cnt[e]; ps[e] = run * 256; const int nte = (c + 255) / 256; if (F.bid == 0) for (int k = 0; k < nte; ++k) tile_e[run + k] = e; run += nte; }
        if (F.bid == 0) ntl[0] = run;
    }
    __syncthreads();
    const int gw = F.bid * NWAVES + F.wave, NGW = F.G * NWAVES;
    for (int a = gw; a < NASSIGN; a += NGW) {
        const int dest = ps[tok_e[a]] + tok_pos[a];
        const u32x4* src = (const u32x4*)(H1F + (size_t)(a >> 1) * D) + F.lane; u32x4* dst = (u32x4*)(XB + (size_t)dest * D) + F.lane;
        dst[0] = src[0];
        if (F.lane == 0) { tok_dest[a] = dest; ((float*)(ws + WS_XSB))[dest] = ((const float*)(ws + WS_H1S))[a >> 1]; }
    }
    __syncthreads();
}

__device__ __forceinline__ void phase_combine(const Frame& F) {
    const Params& P = *F.p; unsigned char* ws = P.ws;
    const bf16_t* H1B = (const bf16_t*)(ws + WS_H1B); const bf16_t* YB = (const bf16_t*)(ws + WS_YBUF);
    const int* tok_dest = (const int*)(ws + WS_MISC + MS_TOKDEST); const float* tok_w = (const float*)(ws + WS_MISC + MS_TOKW);
    const int gw = F.bid * NWAVES + F.wave, NGW = F.G * NWAVES, lane = F.lane;
    const float* g2 = P.in[I_LN2G]; const float* b2 = P.in[I_LN2B];
    f32x4 gg[4], bb[4];
#pragma unroll
    for (int j = 0; j < 4; ++j) { gg[j] = *((const f32x4*)g2 + lane + 64 * j); bb[j] = *((const f32x4*)b2 + lane + 64 * j); }
    for (int row0 = gw * 4; row0 < NTOK; row0 += NGW * 4) {
        f32x4 v[4][4]; float s[4], q[4];
        u32x2 lx[4][4], la[4][4], lb[4][4]; float w0[4], w1[4];
#pragma unroll
        for (int a = 0; a < 4; ++a) { const int row = row0 + a; const int d0 = tok_dest[2 * row], d1 = tok_dest[2 * row + 1]; w0[a] = tok_w[2 * row]; w1[a] = tok_w[2 * row + 1];
            const u32x2* xr = (const u32x2*)(H1B + (size_t)row * D) + lane;
            const u32x2* y0 = (const u32x2*)(YB + (size_t)d0 * D) + lane; const u32x2* y1 = (const u32x2*)(YB + (size_t)d1 * D) + lane;
#pragma unroll
            for (int j = 0; j < 4; ++j) { lx[a][j] = xr[64 * j]; la[a][j] = y0[64 * j]; lb[a][j] = y1[64 * j]; } }
#pragma unroll
        for (int a = 0; a < 4; ++a) { s[a] = 0.f;
#pragma unroll
            for (int j = 0; j < 4; ++j) { const u32x2 x = lx[a][j], ya = la[a][j], yb = lb[a][j];
                v[a][j][0] = ALPHA * bf_lo(x.x) + (w0[a] * bf_lo(ya.x) + w1[a] * bf_lo(yb.x)); v[a][j][1] = ALPHA * bf_hi(x.x) + (w0[a] * bf_hi(ya.x) + w1[a] * bf_hi(yb.x));
                v[a][j][2] = ALPHA * bf_lo(x.y) + (w0[a] * bf_lo(ya.y) + w1[a] * bf_lo(yb.y)); v[a][j][3] = ALPHA * bf_hi(x.y) + (w0[a] * bf_hi(ya.y) + w1[a] * bf_hi(yb.y));
                s[a] += (v[a][j][0] + v[a][j][1]) + (v[a][j][2] + v[a][j][3]); } }
#pragma unroll
        for (int o = 1; o < 64; o <<= 1) {
#pragma unroll
            for (int a = 0; a < 4; ++a) s[a] += __shfl_xor(s[a], o); }
#pragma unroll
        for (int a = 0; a < 4; ++a) { const float mean = s[a] * (1.f / D); q[a] = 0.f;
#pragma unroll
            for (int j = 0; j < 4; ++j) { v[a][j] = v[a][j] - mean; q[a] += (v[a][j][0] * v[a][j][0] + v[a][j][1] * v[a][j][1]) + (v[a][j][2] * v[a][j][2] + v[a][j][3] * v[a][j][3]); } }
#pragma unroll
        for (int o = 1; o < 64; o <<= 1) {
#pragma unroll
            for (int a = 0; a < 4; ++a) q[a] += __shfl_xor(q[a], o); }
#pragma unroll
        for (int a = 0; a < 4; ++a) { const float rstd = 1.f / sqrtf(q[a] * (1.f / D) + LN_EPS);
            f32x4* orow = (f32x4*)(P.out + (size_t)(row0 + a) * D) + lane;
#pragma unroll
            for (int j = 0; j < 4; ++j) __builtin_nontemporal_store(v[a][j] * rstd * gg[j] + bb[j], orow + 64 * j); }
    }
}

constexpr int NPHASE = 15;
__global__ void __launch_bounds__(NTHR, 2) fwd_kernel(Params prm) {
    extern __shared__ __attribute__((aligned(16))) unsigned char lds_raw[];
    Frame F; F.lds = (LAS unsigned char*)lds_raw; F.tid = threadIdx.x; F.lane = F.tid & 63; F.wave = __builtin_amdgcn_readfirstlane(F.tid >> 6); F.G = gridDim.x; F.bid = blockIdx.x; F.p = &prm;
    unsigned char* ws = prm.ws;
    const int lo = prm.ph_lo, hi = prm.ph_hi;
    volatile LAS unsigned* MISC = (volatile LAS unsigned*)(F.lds + MISC_OFF);
    if (F.tid < 32) MISC[F.tid] = 0u;
    __syncthreads();
    if (lo < 0) cg::this_grid().sync();
    XcdBarrier bar; bar.bar = (unsigned*)(ws + WS_CTL) + CW_BAR; bar.x = 0; bar.st = nullptr;
    if (hi - lo > 1) bar = xcd_barrier_post((unsigned*)(ws + WS_CTL) + CW_BAR, MISC + 8);
#define IN(k) (lo <= (k) && (k) < hi)
#define SEAM(k) do { if (IN(k) && IN((k) + 1)) { xcd_barrier(bar); } } while (0)
#define PHASE(k, ...) do { if (IN(k)) { __VA_ARGS__ if (PROBE_PH == (k)) { xcd_barrier(bar); __VA_ARGS__ } } SEAM(k); } while (0);
    const bf16_t* Zc = (const bf16_t*)(ws + WS_Z);

    PHASE(0, { phase_prep(F); })
    PHASE(1, {
        pg8::StaticOrder S{NTOK / 256, INCOLS / 256, F.G, F.bid, (const char*)(ws + WS_XB), (const char*)(ws + WS_WIN), (size_t)256 * D, (size_t)256 * D, 0};
        EpiBf16 E{(bf16_t*)(ws + WS_Z), INCOLS, prm.in[I_BGATE], GATE0 / 256, GATE0, 1.0f, 4, 12, D, (const float*)(ws + WS_XS), (const float*)(ws + WS_SW)};
        pg8::gemm_phase<EpiBf16, pg8::StaticOrder, true, true, 2>(F.lds, D / 2, D / 2, D / 2, S, E);
    })
    PHASE(2, {
        pg8::KVOrder S{F.G, F.bid, (const char*)(ws + WS_MEMB), (const char*)(ws + WS_WKV)};
        EpiKV E{(bf16_t*)(ws + WS_KB), (bf16_t*)(ws + WS_VT)};
        pg8::gemm_phase<EpiKV, pg8::KVOrder, true, true>(F.lds, D, D, D, S, E);
        phase_convpool(F);
    })
    PHASE(4, { phase_attn(F); })
    PHASE(7, {
        pg8::SegOrder S{NTOK / 256, D / 256, F.G, F.bid, (const char*)(ws + WS_ACONV), (const char*)(ws + WS_DPOOL), (const char*)(ws + WS_O), (const char*)(ws + WS_WCAT), (size_t)256 * D * 2, (size_t)256 * KCAT * 2, (size_t)256 * 2};
        EpiMix3 E{(bf16_t*)(ws + WS_MERGED), Zc, prm.in[I_PSCALE], 0};
        pg8::gemm_phase<EpiMix3, pg8::SegOrder, true, true>(F.lds, KCAT, D, KCAT, S, E);
        if (PROBE_PH == 207) { xcd_barrier(bar); EpiMix3 E2{(bf16_t*)(ws + WS_XBUF), Zc, prm.in[I_PSCALE], 1}; pg8::gemm_phase<EpiMix3, pg8::SegOrder, true, true>(F.lds, KCAT, D, KCAT, S, E2); }
    })
    PHASE(8, {
        pg8::StaticOrder S{NTOK / 256, D / 256, F.G, F.bid, (const char*)(ws + WS_MERGED), (const char*)(ws + WS_WO), (size_t)256 * D * 2, (size_t)256 * D * 2, 0};
        EpiResBf16 E{(bf16_t*)(ws + WS_H1), prm.in[I_X], ALPHA};
        pg8::gemm_phase<EpiResBf16, pg8::StaticOrder, true, true>(F.lds, D, D, D, S, E);
    })
    PHASE(9, { phase_ln1_router(F); })
    PHASE(11, { phase_gather(F); })
    PHASE(12, {
        const int ntl = *(const int*)(ws + WS_MISC + MS_NTILES);
        pg8::MoeOrder S{ntl, 4, F.G, F.bid, (const char*)(ws + WS_XBUF), (const char*)(ws + WS_WUP), (size_t)256 * D, (size_t)256 * D, (size_t)D * D, (const int*)(ws + WS_MISC + MS_TILEE)};
        EpiAct E{ws + WS_ACT, (const float*)(ws + WS_XSB), (const float*)(ws + WS_SWU)};
        pg8::gemm_phase<EpiAct, pg8::MoeOrder, true, true, 2>(F.lds, D / 2, D / 2, D / 2, S, E);
    })
    PHASE(13, {
        const int ntl = *(const int*)(ws + WS_MISC + MS_NTILES);
        pg8::MoeOrder S{ntl, 4, F.G, F.bid, (const char*)(ws + WS_ACT), (const char*)(ws + WS_WDN), (size_t)256 * DEXP, (size_t)256 * DEXP, (size_t)D * DEXP, (const int*)(ws + WS_MISC + MS_TILEE)};
        EpiBf16 E{(bf16_t*)(ws + WS_YBUF), D, nullptr, 1 << 30, 0, 0.03125f, 0, 0, 0, nullptr, nullptr};
        pg8::gemm_phase<EpiBf16, pg8::MoeOrder, true, true, 1>(F.lds, DEXP / 2, DEXP / 2, DEXP / 2, S, E);
    })
    PHASE(14, { phase_combine(F); })
#undef IN
#undef SEAM
}

extern "C" void kernel_launch(void* const* d_in, const int* in_sizes, int n_in, void* d_out, int out_size, void* d_ws, size_t ws_size, hipStream_t stream) {
    static int grid = 0;
    if (grid == 0) {
        if (n_in != 21 || out_size != NTOK * D || ws_size < WS_END) { fprintf(stderr, "kernel_launch: unexpected shapes (n_in %d out %d ws %zu, need ws >= %zu)\n", n_in, out_size, ws_size, (size_t)WS_END); grid = -1; return; }
        int dev = 0, cus = 0, per_cu = 0;
        if (hipGetDevice(&dev) != hipSuccess || hipDeviceGetAttribute(&cus, hipDeviceAttributeMultiprocessorCount, dev) != hipSuccess) { grid = -1; return; }
        if (hipFuncSetAttribute((const void*)fwd_kernel, hipFuncAttributeMaxDynamicSharedMemorySize, LDS_BYTES) != hipSuccess) { fprintf(stderr, "kernel_launch: hipFuncSetAttribute failed\n"); grid = -1; return; }
        if (hipOccupancyMaxActiveBlocksPerMultiprocessor(&per_cu, (const void*)fwd_kernel, NTHR, LDS_BYTES) != hipSuccess || per_cu < 1) { fprintf(stderr, "kernel_launch: occupancy query says %d\n", per_cu); (void)hipGetLastError(); per_cu = 1; }
        grid = cus * 1;
        fprintf(stderr, "kernel_launch: cus %d per_cu %d grid %d\n", cus, per_cu, grid);
    }
    if (grid < 0) return;
    (void)hipMemsetAsync((char*)d_ws + WS_CTL, 0, CTL_ZERO_BYTES, stream);
    Params a{};
    for (int i = 0; i < 21; ++i) a.in[i] = (const float*)d_in[i];
    a.out = (float*)d_out; a.ws = (unsigned char*)d_ws;
#if MK_ONE_LAUNCH
    a.ph_lo = 0; a.ph_hi = NPHASE;
    void* args[] = {&a};
    hipError_t e = hipLaunchCooperativeKernel((const void*)fwd_kernel, dim3(grid), dim3(NTHR), args, LDS_BYTES, stream);
    if (e != hipSuccess) fprintf(stderr, "cooperative launch failed: %s (grid %d)\n", hipGetErrorString(e), grid);
#else
    for (int ph = 0; ph < NPHASE; ++ph) {
        a.ph_lo = ph; a.ph_hi = ph + 1;
        hipLaunchKernelGGL(fwd_kernel, dim3(grid), dim3(NTHR), LDS_BYTES, stream, a);
    }
#endif
}
```

```cpp
#include <hip/hip_runtime.h>
#include <hip/hip_cooperative_groups.h>
#include <cstdio>
#include <cstdint>
namespace cg = cooperative_groups;

#ifndef PROBE_PH
#define PROBE_PH -1
#endif
#ifndef STAG_G1
#define STAG_G1 0
#endif
#ifndef MK_ONE_LAUNCH
#define MK_ONE_LAUNCH 1
#endif

namespace pg8 {
#define PG8_LAS __attribute__((address_space(3)))
#define PG8_GAS __attribute__((address_space(1)))
typedef unsigned short bf16_t;
typedef short bf16x8 __attribute__((ext_vector_type(8)));
typedef float f32x4 __attribute__((ext_vector_type(4)));
typedef float f32x2 __attribute__((ext_vector_type(2)));
typedef unsigned u32x4 __attribute__((ext_vector_type(4)));
typedef unsigned u32x2 __attribute__((ext_vector_type(2)));
constexpr int BM = 256, BK = 64, HALF = 128, HTB = HALF * BK * 2  , STAGE_BYTES = 8 * HTB, NXCD = 8, WGM = 4;

__host__ __device__ __forceinline__ int lds_byte(int r, int c) { const int st = (r >> 4) * 2 + (c >> 5), rr = r & 15, cc = c & 31, ob = rr * 64 + cc * 2; return st * 1024 + (ob ^ (((ob >> 9) & 1) << 5)); }
__host__ __device__ __forceinline__ void stage_rc(int b, int& R, int& C) { const int st = b / 1024, sb = b % 1024, swz = sb ^ (((sb >> 9) & 1) << 5); R = (st >> 1) * 16 + swz / 64; C = (st & 1) * 32 + (swz % 64) / 2; }
__host__ __device__ __forceinline__ int perm32(int rho) { const int n = rho >> 4, i = rho & 15; return 8 * (i >> 2) + 4 * n + (i & 3); }

struct Unit { int pm, pn, kind; const char* a; const char* b; int nt, seg, fin; };

__device__ __forceinline__ void tile_of(int L, int nM, int nN, int& pm, int& pn) {
    const int nwg = nM * nN; int wgid = L;
    { const int q = nwg / NXCD, r = nwg % NXCD, xcd = wgid % NXCD, off = wgid / NXCD; wgid = (xcd < r ? xcd * (q + 1) : r * (q + 1) + (xcd - r) * q) + off; }
    const int nig = WGM * nN, gid = wgid / nig, fm = gid * WGM, gsz = (nM - fm) < WGM ? (nM - fm) : WGM;
    pm = fm + ((wgid % nig) % gsz); pn = (wgid % nig) / gsz;
}
struct StaticOrder {
    int nM, nN, G, c; const char* A; const char* B; size_t tA, tB, aN;
    __device__ __forceinline__ bool next(int i, Unit& u) const {
        const long L = (long)i * G + c; if (L >= (long)nM * nN) return false;
        tile_of((int)L, nM, nN, u.pm, u.pn); u.kind = 0;
        u.a = A + (size_t)u.pm * tA + (size_t)u.pn * aN; u.b = B + (size_t)u.pn * tB; return true;
    }
};
struct MoeOrder {
    int nM, nN, G, c; const char* A; const char* B; size_t tA, tB, eB; const int* tile_expert;
    __device__ __forceinline__ bool next(int i, Unit& u) const {
        const long L = (long)i * G + c; if (L >= (long)nM * nN) return false;
        tile_of((int)L, nM, nN, u.pm, u.pn); u.kind = 0;
        const int e = __builtin_amdgcn_readfirstlane(tile_expert[u.pm]); u.kind = e;
        u.a = A + (size_t)u.pm * tA; u.b = B + (size_t)e * eB + (size_t)u.pn * tB; return true;
    }
};

struct SegOrder {
    int nM, nN, G, c; const char* A; const char* A2; const char* A3; const char* B; size_t tA, tB, aN2;
    __device__ __forceinline__ bool next(int i, Unit& u) const {
        const int iu = i / 3, seg = i - 3 * iu;
        const long L = (long)iu * G + c; if (L >= (long)nM * nN) return false;
        tile_of((int)L, nM, nN, u.pm, u.pn); u.kind = 0; u.seg = seg; u.fin = (seg == 2); u.nt = (seg == 1) ? 4 : 16;
        u.a = (seg == 0 ? A : (seg == 1 ? A2 + (size_t)u.pn * aN2 : A3)) + (size_t)u.pm * tA;
        u.b = B + (size_t)u.pn * tB + (size_t)(seg == 0 ? 0 : (seg == 1 ? 1024 : 1280)) * 2; return true;
    }
};
struct KVOrder {
    int G, c; const char* memb; const char* wkv;
    __device__ __forceinline__ bool next(int i, Unit& u) const {
        const int L = i * G + c; if (L >= 64) return false;
        if (L < 32) { u.pm = L >> 2; u.pn = L & 3; u.kind = 0; u.a = memb + (size_t)u.pm * 256 * 2048; u.b = wkv + (size_t)u.pn * 256 * 2048; }
        else { const int j = L - 32; u.pm = j; u.pn = 0; u.kind = 1; u.a = wkv + (size_t)(1024 + (j & 3) * 256) * 2048; u.b = memb + (size_t)(j >> 2) * 256 * 2048; }
        return true;
    }
};

__device__ __forceinline__ unsigned cvt_pk_bf16(float lo, float hi) { unsigned r; asm volatile("v_cvt_pk_bf16_f32 %0, %1, %2" : "=v"(r) : "v"(lo), "v"(hi)); return r; }
__device__ __forceinline__ float bf_lo(unsigned w) { return __uint_as_float(w << 16); }
__device__ __forceinline__ float bf_hi(unsigned w) { return __uint_as_float(w & 0xffff0000u); }

typedef int i32x4 __attribute__((ext_vector_type(4)));
typedef int i32x8 __attribute__((ext_vector_type(8)));
typedef float f32x32 __attribute__((ext_vector_type(32)));
__device__ __forceinline__ i32x8 pg8_cat(const bf16x8 lo, const bf16x8 hi) { const i32x4 a = __builtin_bit_cast(i32x4, lo), b = __builtin_bit_cast(i32x4, hi); return __builtin_shufflevector(a, b, 0, 1, 2, 3, 4, 5, 6, 7); }
template <class Epi, class Sched, bool ALIGN_EPI = false, bool SP2 = false, int MODE = 0>
__device__ __forceinline__ void gemm_phase(PG8_LAS unsigned char* lds, const int K, const int lda, const int ldb, const Sched& S, const Epi& E) {
    const int tid = threadIdx.x, wid = __builtin_amdgcn_readfirstlane(tid >> 6), lane = tid & 63, wr = wid >> 2, wc = wid & 3, fr = lane & 15, fq = lane >> 4;
    constexpr bool FP8 = (MODE == 1), INT8 = (MODE == 2);
    const int nt = K / BK; constexpr int NST = Epi::NST;
    unsigned voffA[2], voffB[2];
#pragma unroll
    for (int i = 0; i < 2; ++i) { int R, C; stage_rc(tid * 16 + i * 8192, R, C); const int Rb = Epi::PERM ? ((R & ~31) + perm32(R & 31)) : R;
        voffA[i] = (unsigned)(R * lda + C) * 2u; voffB[i] = (unsigned)(Rb * ldb + C) * 2u; }
    const size_t kstep = (size_t)(BK * 2);
    const size_t hstepA = (size_t)HALF * lda * 2, hstepB = (size_t)HALF * ldb * 2;
    const unsigned ldsw = (unsigned)wid * 1024u;
    const int aoff = lds_byte(wr * 64 + fr, fq * 8), boff = lds_byte(wc * 32 + fr, fq * 8);
#define PG8_SA(b, h) (((b) * 2 + (h)) * HTB)
#define PG8_SB(b, h) ((4 + (b) * 2 + (h)) * HTB)
#define PG8_STAGE(bufoff, gbase, voff) do { _Pragma("unroll") for (int _i = 0; _i < 2; ++_i) \
        __builtin_amdgcn_global_load_lds((const PG8_GAS unsigned*)((const PG8_GAS char*)(gbase) + (voff)[_i]), (PG8_LAS unsigned*)(lds + (bufoff) + ldsw + _i * 8192), 16, 0, 0); } while (0)
#define PG8_LDA(dst, b, h) do { if constexpr (FP8) { _Pragma("unroll") for (int m = 0; m < 4; ++m) dst##8[m] = pg8_cat(*(const PG8_LAS bf16x8*)(lds + PG8_SA(b, h) + aoff + m * 2048), *(const PG8_LAS bf16x8*)(lds + PG8_SA(b, h) + aoff + m * 2048 + 1024)); } \
        else { _Pragma("unroll") for (int m = 0; m < 4; ++m) _Pragma("unroll") for (int k = 0; k < 2; ++k) dst[m][k] = *(const PG8_LAS bf16x8*)(lds + PG8_SA(b, h) + aoff + m * 2048 + k * 1024); } } while (0)
#define PG8_LDB(dst, b, h) do { if constexpr (FP8) { _Pragma("unroll") for (int n = 0; n < 2; ++n) dst##8[n] = pg8_cat(*(const PG8_LAS bf16x8*)(lds + PG8_SB(b, h) + boff + n * 2048), *(const PG8_LAS bf16x8*)(lds + PG8_SB(b, h) + boff + n * 2048 + 1024)); } \
        else { _Pragma("unroll") for (int n = 0; n < 2; ++n) _Pragma("unroll") for (int k = 0; k < 2; ++k) dst[n][k] = *(const PG8_LAS bf16x8*)(lds + PG8_SB(b, h) + boff + n * 2048 + k * 1024); } } while (0)
#define PG8_MMA(ai, bj, At, Bt) do { __builtin_amdgcn_s_setprio(1); \
        if constexpr (FP8) { _Pragma("unroll") for (int m = 0; m < 4; ++m) _Pragma("unroll") for (int n = 0; n < 2; ++n) { \
            const f32x4 _c = (f32x4){accv[ai][bj][(m * 2 + n) * 4], accv[ai][bj][(m * 2 + n) * 4 + 1], accv[ai][bj][(m * 2 + n) * 4 + 2], accv[ai][bj][(m * 2 + n) * 4 + 3]}; \
            const f32x4 _d = __builtin_amdgcn_mfma_scale_f32_16x16x128_f8f6f4(Bt##8[n], At##8[m], _c, 0, 0, 0, 0x7f7f7f7f, 0, 0x7f7f7f7f); \
            _Pragma("unroll") for (int _j = 0; _j < 4; ++_j) accv[ai][bj][(m * 2 + n) * 4 + _j] = _d[_j]; } } \
        else if constexpr (INT8) { _Pragma("unroll") for (int m = 0; m < 4; ++m) _Pragma("unroll") for (int n = 0; n < 2; ++n) _Pragma("unroll") for (int k = 0; k < 2; ++k) \
            acc[ai][bj][m][n] = __builtin_bit_cast(f32x4, __builtin_amdgcn_mfma_i32_16x16x64_i8(__builtin_bit_cast(i32x4, Bt[n][k]), __builtin_bit_cast(i32x4, At[m][k]), __builtin_bit_cast(i32x4, acc[ai][bj][m][n]), 0, 0, 0)); } \
        else { _Pragma("unroll") for (int m = 0; m < 4; ++m) _Pragma("unroll") for (int n = 0; n < 2; ++n) _Pragma("unroll") for (int k = 0; k < 2; ++k) \
            acc[ai][bj][m][n] = __builtin_amdgcn_mfma_f32_16x16x32_bf16(Bt[n][k], At[m][k], acc[ai][bj][m][n], 0, 0, 0); } \
        __builtin_amdgcn_s_setprio(0); } while (0)
#define PG8_WAIT_V(n) asm volatile("s_waitcnt vmcnt(" #n ")" ::: "memory")
#define PG8_WAIT_VN(n) asm volatile("s_waitcnt vmcnt(%0)" :: "n"(n) : "memory")
#define PG8_WAIT_L(n) asm volatile("s_waitcnt lgkmcnt(" #n ")" ::: "memory")
#define PG8_BAR __builtin_amdgcn_s_barrier()
#define PG8_SCHED __builtin_amdgcn_sched_barrier(0)
    Unit cur, nxt; int ui = 0;
    if (!S.next(0, cur)) return;
    f32x4 acc[2][2][4][2];
#pragma unroll
    for (int a = 0; a < 2; ++a)
#pragma unroll
        for (int b = 0; b < 2; ++b)
#pragma unroll
            for (int m = 0; m < 4; ++m)
#pragma unroll
                for (int n = 0; n < 2; ++n) acc[a][b][m][n] = (f32x4){0.f, 0.f, 0.f, 0.f};
    bf16x8 At[4][2], B0[2][2], B1[2][2]; i32x8 At8[4], B08[2], B18[2]; f32x32 accv[2][2];
    if constexpr (FP8) {
#pragma unroll
        for (int a = 0; a < 2; ++a)
#pragma unroll
            for (int b = 0; b < 2; ++b)
#pragma unroll
                for (int j = 0; j < 32; ++j) accv[a][b][j] = 0.f; }
    const char* cA = cur.a; const char* cB = cur.b;
    if constexpr (SP2) {
        PG8_STAGE(PG8_SB(0, 0), cB, voffB); PG8_STAGE(PG8_SB(0, 1), cB + hstepB, voffB); PG8_STAGE(PG8_SA(0, 0), cA, voffA); PG8_STAGE(PG8_SA(0, 1), cA + hstepA, voffA);
        if (wr == 1) PG8_BAR;
        PG8_WAIT_V(2); PG8_BAR;
        PG8_STAGE(PG8_SB(1, 0), cB + kstep, voffB); PG8_STAGE(PG8_SA(1, 0), cA + kstep, voffA); PG8_STAGE(PG8_SB(1, 1), cB + hstepB + kstep, voffB);
        PG8_WAIT_V(6); PG8_BAR;
    } else {
        PG8_STAGE(PG8_SB(0, 0), cB, voffB); PG8_STAGE(PG8_SA(0, 0), cA, voffA); PG8_STAGE(PG8_SB(0, 1), cB + hstepB, voffB); PG8_STAGE(PG8_SA(0, 1), cA + hstepA, voffA);
        if (wr == 1) PG8_BAR;
        PG8_WAIT_V(4); PG8_BAR;
        PG8_STAGE(PG8_SB(1, 0), cB + kstep, voffB); PG8_STAGE(PG8_SA(1, 0), cA + kstep, voffA); PG8_STAGE(PG8_SB(1, 1), cB + hstepB + kstep, voffB);
        PG8_WAIT_V(6); PG8_BAR;
    }
    for (;;) {
        const bool has_next = S.next(ui + 1, nxt);
        const char* nA = has_next ? nxt.a : cA; const char* nB = has_next ? nxt.b : cB;
        int ntc = nt; if constexpr (Epi::SEG) ntc = cur.nt;
        if constexpr (Epi::PREF) E.prefetch(cur, lds + 131072 + 1024 + wid * 256, tid);
#pragma nounroll
        for (int t = 0; t < ntc; t += 2) {
            const bool last = (t == ntc - 2);
            const char* a1 = cA + (size_t)(t + 1) * kstep;
            const char* a2 = last ? nA : cA + (size_t)(t + 2) * kstep; const char* b2 = last ? nB : cB + (size_t)(t + 2) * kstep;
            const char* a3 = a2 + kstep; const char* b3 = b2 + kstep;
            if constexpr (SP2) {
            const bool fresh = !FP8 && (NST > 0) && (t == 0) && (ui > 0);
            PG8_LDB(B0, 0, 0); PG8_LDB(B1, 0, 1); PG8_SCHED; PG8_LDA(At, 0, 0); PG8_STAGE(PG8_SA(1, 1), a1 + hstepA, voffA);
            if (fresh) PG8_WAIT_VN(8 + NST); else PG8_WAIT_V(8);
            PG8_WAIT_L(0); PG8_BAR; PG8_MMA(0, 0, At, B0); PG8_MMA(0, 1, At, B1); PG8_BAR; PG8_SCHED;
            PG8_LDA(At, 0, 1); PG8_STAGE(PG8_SB(0, 0), b2, voffB); PG8_STAGE(PG8_SB(0, 1), b2 + hstepB, voffB); PG8_STAGE(PG8_SA(0, 0), a2, voffA);
            if (fresh) PG8_WAIT_VN(8 + NST); else PG8_WAIT_V(8);
            PG8_WAIT_L(0); PG8_BAR; PG8_MMA(1, 0, At, B0); PG8_MMA(1, 1, At, B1); PG8_BAR; PG8_SCHED;
            PG8_LDB(B0, 1, 0); PG8_LDB(B1, 1, 1); PG8_SCHED; PG8_LDA(At, 1, 0); PG8_STAGE(PG8_SA(0, 1), a2 + hstepA, voffA);
            PG8_WAIT_V(8); PG8_WAIT_L(0); PG8_BAR; PG8_MMA(0, 0, At, B0); PG8_MMA(0, 1, At, B1); PG8_BAR; PG8_SCHED;
            PG8_LDA(At, 1, 1); PG8_STAGE(PG8_SB(1, 0), b3, voffB); PG8_STAGE(PG8_SB(1, 1), b3 + hstepB, voffB); PG8_STAGE(PG8_SA(1, 0), a3, voffA);
            PG8_WAIT_V(8); PG8_WAIT_L(0); PG8_BAR; PG8_MMA(1, 0, At, B0); PG8_MMA(1, 1, At, B1); PG8_BAR; PG8_SCHED;
            } else {
            PG8_LDB(B0, 0, 0); PG8_SCHED; PG8_LDA(At, 0, 0); PG8_STAGE(PG8_SA(1, 1), a1 + hstepA, voffA);
            PG8_WAIT_L(8); PG8_BAR; PG8_WAIT_L(0); PG8_MMA(0, 0, At, B0); PG8_BAR; PG8_SCHED;
            PG8_LDB(B1, 0, 1); PG8_STAGE(PG8_SB(0, 0), b2, voffB);
            PG8_BAR; PG8_WAIT_L(0); PG8_MMA(0, 1, At, B1); PG8_BAR;
            PG8_LDA(At, 0, 1); PG8_STAGE(PG8_SA(0, 0), a2, voffA);
            PG8_BAR; PG8_WAIT_L(0); PG8_MMA(1, 0, At, B0); PG8_BAR; PG8_SCHED;
            PG8_STAGE(PG8_SB(0, 1), b2 + hstepB, voffB);
            PG8_WAIT_V(6); PG8_BAR; PG8_MMA(1, 1, At, B1); PG8_BAR;
            PG8_LDB(B0, 1, 0); PG8_SCHED; PG8_LDA(At, 1, 0); PG8_STAGE(PG8_SA(0, 1), a2 + hstepA, voffA);
            PG8_WAIT_L(8); PG8_BAR; PG8_WAIT_L(0); PG8_MMA(0, 0, At, B0); PG8_BAR; PG8_SCHED;
            PG8_LDB(B1, 1, 1); PG8_STAGE(PG8_SB(1, 0), b3, voffB);
            PG8_BAR; PG8_WAIT_L(0); PG8_MMA(0, 1, At, B1); PG8_BAR;
            PG8_LDA(At, 1, 1); PG8_STAGE(PG8_SA(1, 0), a3, voffA);
            PG8_BAR; PG8_WAIT_L(0); PG8_MMA(1, 0, At, B0); PG8_BAR; PG8_SCHED;
            PG8_STAGE(PG8_SB(1, 1), b3 + hstepB, voffB);
            PG8_WAIT_V(6); PG8_BAR; PG8_MMA(1, 1, At, B1); PG8_BAR;
            }
        }
        if constexpr (ALIGN_EPI) { if (wr == 0) PG8_BAR; }
        if constexpr (FP8) {
#pragma unroll
            for (int a = 0; a < 2; ++a)
#pragma unroll
                for (int b = 0; b < 2; ++b)
#pragma unroll
                    for (int m = 0; m < 4; ++m)
#pragma unroll
                        for (int n = 0; n < 2; ++n) { acc[a][b][m][n] = (f32x4){accv[a][b][(m * 2 + n) * 4], accv[a][b][(m * 2 + n) * 4 + 1], accv[a][b][(m * 2 + n) * 4 + 2], accv[a][b][(m * 2 + n) * 4 + 3]}; }
#pragma unroll
            for (int a = 0; a < 2; ++a)
#pragma unroll
                for (int b = 0; b < 2; ++b)
#pragma unroll
                    for (int j = 0; j < 32; ++j) accv[a][b][j] = 0.f; }
        if constexpr (INT8) {
#pragma unroll
            for (int a = 0; a < 2; ++a)
#pragma unroll
                for (int b = 0; b < 2; ++b)
#pragma unroll
                    for (int m = 0; m < 4; ++m)
#pragma unroll
                        for (int n = 0; n < 2; ++n) { const i32x4 iv = __builtin_bit_cast(i32x4, acc[a][b][m][n]); acc[a][b][m][n] = (f32x4){(float)iv[0], (float)iv[1], (float)iv[2], (float)iv[3]}; } }
        bool fin = true;
        if constexpr (Epi::SEG) { fin = cur.fin != 0; if (fin) E(acc, cur, wr, wc, fr, fq); else E.mid(acc, cur, cur.seg + 1, wr, wc, fr, fq); } else E(acc, cur, wr, wc, fr, fq);
        if (!has_next) break;
        if (fin) {
#pragma unroll
        for (int a = 0; a < 2; ++a)
#pragma unroll
            for (int b = 0; b < 2; ++b)
#pragma unroll
                for (int m = 0; m < 4; ++m)
#pragma unroll
                    for (int n = 0; n < 2; ++n) acc[a][b][m][n] = (f32x4){0.f, 0.f, 0.f, 0.f};
        }
        cur = nxt; cA = nA; cB = nB; ++ui;
        if constexpr (ALIGN_EPI) { if (wr == 1) PG8_BAR; }
    }
    PG8_WAIT_V(0);
    if constexpr (!ALIGN_EPI) { if (wr == 0) PG8_BAR; }
    PG8_BAR;
#undef PG8_SA
#undef PG8_SB
#undef PG8_STAGE
#undef PG8_LDA
#undef PG8_LDB
#undef PG8_MMA
#undef PG8_WAIT_V
#undef PG8_WAIT_VN
#undef PG8_WAIT_L
#undef PG8_BAR
#undef PG8_SCHED
}
}
using pg8::bf16_t; using pg8::f32x4; using pg8::f32x2; using pg8::u32x4; using pg8::u32x2; using pg8::Unit; using pg8::cvt_pk_bf16; using pg8::bf_lo; using pg8::bf_hi;
#define LAS __attribute__((address_space(3)))

constexpr int D = 1024, BATCH = 8, SEQ = 4096, NTOK = BATCH * SEQ, MEMLEN = 256, NMEM = BATCH * MEMLEN;
constexpr int INCOLS = 8192, GATE0 = 5120;
constexpr int NEXP = 64, DEXP = 512, NGRP = 8, EPG = 8;
constexpr int NASSIGN = NTOK * 2, PMAX_TILES = 320, PMAX = PMAX_TILES * 256;
constexpr float ALPHA = 1.189207115002721f;
constexpr float LN_EPS = 1e-5f;
constexpr int NWAVES = 8, NTHR = 512;

constexpr size_t MiB = 1u << 20;
constexpr size_t WS_CTL = 0, CTL_ZERO_BYTES = 1 * MiB;
constexpr size_t WS_WIN = 1 * MiB, WS_WKV = 17 * MiB, WS_WCAT = 21 * MiB, WS_WO = 26 * MiB, WS_WR = 28 * MiB;
constexpr int KCAT = 2304;
constexpr size_t WS_WUP = 29 * MiB, WS_WDN = 157 * MiB, WS_MISC = 221 * MiB;
constexpr size_t WS_Z = 224 * MiB;
constexpr size_t WS_XB = 736 * MiB, WS_MEMB = 800 * MiB, WS_KV = 804 * MiB, WS_ACONV = 812 * MiB, WS_DPOOL = 876 * MiB, WS_MERGED = 940 * MiB;
constexpr size_t WS_KB = WS_KV, WS_VT = WS_KV + 4 * MiB;
constexpr size_t WS_XS = WS_MISC + 3 * (MiB / 2), WS_SW = WS_MISC + 7 * (MiB / 4);
constexpr size_t WS_SWU = WS_MISC + 2 * MiB;
constexpr size_t WS_XSB = WS_MISC + 9 * (MiB / 4), WS_H1S = WS_MISC + 21 * (MiB / 8);
constexpr size_t WS_O = WS_XB;
constexpr size_t WS_H1 = 224 * MiB;
constexpr size_t WS_H1B = 480 * MiB;
constexpr size_t WS_XBUF = 544 * MiB;
constexpr size_t WS_H1F8 = 640 * MiB;
constexpr size_t WS_ACT = 736 * MiB;
constexpr size_t WS_YBUF = 816 * MiB;
constexpr size_t WS_END = 1004 * MiB;
constexpr size_t MS_TOKE = 0, MS_TOKPOS = MS_TOKE + NASSIGN * 4, MS_TOKW = MS_TOKPOS + NASSIGN * 4, MS_TOKDEST = MS_TOKW + NASSIGN * 4, MS_TILEE = MS_TOKDEST + NASSIGN * 4, MS_PSTART = MS_TILEE + 4096, MS_NTILES = MS_PSTART + 1024;
constexpr int CW_COUNTS = 1024;
constexpr int CW_CPCTR = 1152;
constexpr int CW_BAR = 4096;

constexpr int LDS_BYTES = 147456, MISC_OFF = 131072 + 320;

struct Params { const float* in[21]; float* out; unsigned char* ws; int ph_lo, ph_hi; };
enum { I_X = 0, I_MEM, I_WIN, I_BGATE, I_CONVW, I_WCONV, I_WPOOL, I_PSCALE, I_WKV, I_WXO, I_WO, I_LN1G, I_LN1B, I_WRG, I_BRG, I_WRE, I_BRE, I_WUP, I_WDN, I_LN2G, I_LN2B };

__device__ __forceinline__ unsigned f2bf(float f) { unsigned u = __float_as_uint(f); return (u + 0x7fffu + ((u >> 16) & 1u)) >> 16; }
__device__ __forceinline__ unsigned pk2(float lo, float hi) { return f2bf(lo) | (f2bf(hi) << 16); }
__device__ __forceinline__ float wave_sum(float v) {
#pragma unroll
    for (int o = 1; o < 64; o <<= 1) v += __shfl_xor(v, o);
    return v;
}
__device__ __forceinline__ float sigmoidf_(float x) { return __builtin_amdgcn_rcpf(1.0f + __expf(-x)); }


#define XB_TMO      128
#define XB_XCNT(j)  (256  + 64 * (j))
#define XB_XSUB(j)  (1280 + 64 * (j))
#define XB_XGEN(j)  (2304 + 64 * (j))
#define XB_TOP      3328
#define XB_TOPGEN   3392
#define XCD_BAR_WORDS 3456
#define XB_SPIN_CAP (1u << 18)
__device__ __forceinline__ unsigned xb_ld(unsigned* p)              { return __hip_atomic_load(p, __ATOMIC_RELAXED, __HIP_MEMORY_SCOPE_AGENT); }
__device__ __forceinline__ unsigned xb_add(unsigned* p, unsigned v) { return __hip_atomic_fetch_add(p, v, __ATOMIC_RELAXED, __HIP_MEMORY_SCOPE_AGENT); }
__device__ __forceinline__ unsigned xb_xcc_id() { return (unsigned)__builtin_amdgcn_s_getreg((3 << 11) | 20) & 0xFu; }
#define XB_SPIN(cond, bar) do { unsigned _sp = 0; while (cond) { __builtin_amdgcn_s_sleep(1); \
    if ((++_sp & 255u) == 0u) { if (xb_ld(&(bar)[XB_TMO])) break; if (_sp > XB_SPIN_CAP) { atomicAdd(&(bar)[XB_TMO], 1u); break; } } } } while (0)
struct XcdBarrier { unsigned* bar; unsigned x; volatile LAS unsigned* st; };
__device__ __forceinline__ XcdBarrier xcd_barrier_post(unsigned* bar, volatile LAS unsigned* st) {
    XcdBarrier b; b.bar = bar; b.x = xb_xcc_id(); b.st = st;
    if (threadIdx.x == 0) (void)xb_add(&bar[XB_XCNT(b.x)], 1u);
    return b;
}
__device__ __forceinline__ void xcd_barrier_complete(unsigned* bar, unsigned x, unsigned& nloc, unsigned& nx) {
    const unsigned G = gridDim.x * gridDim.y * gridDim.z;
    unsigned sum, cnt, mine, sp = 0u;
    for (;;) {
        sum = 0u; cnt = 0u; mine = 0u;
#pragma unroll
        for (unsigned j = 0; j < 16; ++j) { const unsigned c = xb_ld(&bar[XB_XCNT(j)]); sum += c; cnt += (c > 0u) ? 1u : 0u; mine = (j == x) ? c : mine; }
        if (sum == G) break;
        __builtin_amdgcn_s_sleep(1);
        if ((++sp & 255u) == 0u) { if (xb_ld(&bar[XB_TMO])) break; if (sp > XB_SPIN_CAP) { atomicAdd(&bar[XB_TMO], 1u); break; } }
    }
    nloc = mine > 0u ? mine : 1u; nx = cnt > 0u ? cnt : 1u;
}
__device__ __forceinline__ void xcd_barrier(const XcdBarrier& b) {
    asm volatile("s_waitcnt vmcnt(0)" ::: "memory");
    __syncthreads();
    if (threadIdx.x == 0) {
        unsigned* bar = b.bar;
        __builtin_amdgcn_s_waitcnt(0);
        unsigned nloc = b.st[0], nx = b.st[1];
        if (nloc == 0u) { xcd_barrier_complete(bar, b.x, nloc, nx); b.st[0] = nloc; b.st[1] = nx; }
        const unsigned old = xb_add(&bar[XB_XSUB(b.x)], 1u);
        const unsigned gen = old / nloc;
        if (old + 1u == (gen + 1u) * nloc) {
            __builtin_amdgcn_fence(__ATOMIC_RELEASE, "agent");
            asm volatile("s_waitcnt vmcnt(0)" ::: "memory");
            const unsigned og = xb_add(&bar[XB_TOP], 1u);
            const unsigned tg = og / nx;
            if (og + 1u == (tg + 1u) * nx) xb_add(&bar[XB_TOPGEN], 1u);
            else XB_SPIN(xb_ld(&bar[XB_TOPGEN]) == tg, bar);
            __builtin_amdgcn_fence(__ATOMIC_ACQUIRE, "agent");
            xb_add(&bar[XB_XGEN(b.x)], 1u);
            asm volatile("s_waitcnt vmcnt(0)" ::: "memory");
        } else {
            XB_SPIN(xb_ld(&bar[XB_XGEN(b.x)]) == gen, bar);
            __builtin_amdgcn_fence(__ATOMIC_ACQUIRE, "agent");
            asm volatile("s_waitcnt vmcnt(0)" ::: "memory");
        }
    }
    __syncthreads();
}

__device__ __forceinline__ void stagger_delay(unsigned ticks) {
    const unsigned long long t0 = __builtin_amdgcn_s_memrealtime();
    while (__builtin_amdgcn_s_memrealtime() - t0 < (unsigned long long)ticks) __builtin_amdgcn_s_sleep(4);
}

template <int LPR> __device__ __forceinline__ void touch_tile(const char* base, size_t pitch, LAS unsigned char* junk, int tid) {
#pragma unroll
    for (int i = 0; i < (256 * LPR) / 512; ++i) { const int ln = i * 512 + tid, r = ln / LPR, c = ln % LPR;
        __builtin_amdgcn_global_load_lds((const PG8_GAS unsigned*)(base + (size_t)r * pitch + c * 128), (LAS unsigned*)junk, 4, 0, 0); }
}

struct EpiBf16 {
    static constexpr bool PERM = true, SEG = false, PREF = false; static constexpr int NST = 8;
    bf16_t* O; int ldc; const float* bias; int gate_pn; int gate_col0; float oscale; int mul_pn0, mul_pn1, mul_col0; const float* rs; const float* cs; int f8out;
    __device__ __forceinline__ void operator()(const f32x4 (&acc)[2][2][4][2], const Unit& u, int wr, int wc, int fr, int fq) const {
        const int row0 = u.pm * 256 + wr * 64 + fr, col0 = u.pn * 256 + wc * 32 + 8 * fq;
        f32x4 cv[2][2]; float rv[2][4];
#pragma unroll
        for (int bj = 0; bj < 2; ++bj)
#pragma unroll
            for (int n = 0; n < 2; ++n) cv[bj][n] = cs ? *(const f32x4*)(cs + col0 + bj * 128 + 4 * n) : (f32x4){1.f, 1.f, 1.f, 1.f};
#pragma unroll
        for (int ai = 0; ai < 2; ++ai)
#pragma unroll
            for (int m = 0; m < 4; ++m) rv[ai][m] = (rs ? rs[row0 + ai * 128 + m * 16] : 1.0f) * oscale;
        if (u.pn >= mul_pn0 && u.pn < mul_pn1) {
            const int mc = mul_col0 + (u.pn - mul_pn0) * 128 + wc * 32 + 8 * fq;
#pragma unroll
            for (int ai = 0; ai < 2; ++ai)
#pragma unroll
                for (int m = 0; m < 4; ++m) { const float r2 = rv[ai][m] * rv[ai][m];
                    const f32x4 v0 = (acc[ai][0][m][0] * cv[0][0]) * (acc[ai][1][m][0] * cv[1][0]) * r2, v1 = (acc[ai][0][m][1] * cv[0][1]) * (acc[ai][1][m][1] * cv[1][1]) * r2;
                    u32x4 w; w.x = cvt_pk_bf16(v0[0], v0[1]); w.y = cvt_pk_bf16(v0[2], v0[3]); w.z = cvt_pk_bf16(v1[0], v1[1]); w.w = cvt_pk_bf16(v1[2], v1[3]);
                    __builtin_nontemporal_store(w, (u32x4*)(O + (size_t)(row0 + ai * 128 + m * 16) * ldc + mc)); }
            return;
        }
        const bool gate = u.pn >= gate_pn;
        f32x4 bv[2][2];
#pragma unroll
        for (int bj = 0; bj < 2; ++bj)
#pragma unroll
            for (int n = 0; n < 2; ++n) bv[bj][n] = gate ? *(const f32x4*)(bias + (col0 - gate_col0) + bj * 128 + 4 * n) : (f32x4){0.f, 0.f, 0.f, 0.f};
#pragma unroll
        for (int ai = 0; ai < 2; ++ai)
#pragma unroll
            for (int m = 0; m < 4; ++m) { bf16_t* rowp = O + (size_t)(row0 + ai * 128 + m * 16) * ldc + col0;
#pragma unroll
                for (int bj = 0; bj < 2; ++bj) { f32x4 v0 = acc[ai][bj][m][0] * (cv[bj][0] * rv[ai][m]) + bv[bj][0], v1 = acc[ai][bj][m][1] * (cv[bj][1] * rv[ai][m]) + bv[bj][1];
                    if (gate) {
                        unsigned q0 = 0u, q1 = 0u;
#pragma unroll
                        for (int j = 0; j < 4; ++j) { q0 = __builtin_amdgcn_cvt_pk_u8_f32(fmaxf(__builtin_floorf(sigmoidf_(v0[j]) * 255.0f + 0.5f), 1.0f), j, q0); q1 = __builtin_amdgcn_cvt_pk_u8_f32(fmaxf(__builtin_floorf(sigmoidf_(v1[j]) * 255.0f + 0.5f), 1.0f), j, q1); }
                        u32x2 w8; w8.x = q0; w8.y = q1;
                        *(u32x2*)((unsigned char*)(O + (size_t)(row0 + ai * 128 + m * 16) * ldc) + 2 * gate_col0 + (col0 - gate_col0) + bj * 128) = w8;
                        continue; }
                    if (f8out) { u32x2 w8; { int q = __builtin_amdgcn_cvt_pk_fp8_f32(v0[0], v0[1], 0, false); q = __builtin_amdgcn_cvt_pk_fp8_f32(v0[2], v0[3], q, true); w8.x = (unsigned)q; }
                        { int q = __builtin_amdgcn_cvt_pk_fp8_f32(v1[0], v1[1], 0, false); q = __builtin_amdgcn_cvt_pk_fp8_f32(v1[2], v1[3], q, true); w8.y = (unsigned)q; }
                        *(u32x2*)((unsigned char*)O + (size_t)(row0 + ai * 128 + m * 16) * ldc + col0 + bj * 128) = w8; continue; }
                    u32x4 w; w.x = cvt_pk_bf16(v0[0], v0[1]); w.y = cvt_pk_bf16(v0[2], v0[3]); w.z = cvt_pk_bf16(v1[0], v1[1]); w.w = cvt_pk_bf16(v1[2], v1[3]);
                    __builtin_nontemporal_store(w, (u32x4*)(rowp + bj * 128)); } }
    }
};
struct EpiKV {
    static constexpr bool PERM = true, SEG = false, PREF = false; static constexpr int NST = 0;
    bf16_t* KB; bf16_t* VT;
    __device__ __forceinline__ void operator()(const f32x4 (&acc)[2][2][4][2], const Unit& u, int wr, int wc, int fr, int fq) const {
        const int row0 = u.pm * 256 + wr * 64 + fr, col0 = u.pn * 256 + wc * 32 + 8 * fq;
#pragma unroll
        for (int ai = 0; ai < 2; ++ai)
#pragma unroll
            for (int m = 0; m < 4; ++m) { const size_t row = (size_t)(row0 + ai * 128 + m * 16);
#pragma unroll
                for (int bj = 0; bj < 2; ++bj) { const f32x4 v0 = acc[ai][bj][m][0], v1 = acc[ai][bj][m][1];
                    u32x4 w; w.x = cvt_pk_bf16(v0[0], v0[1]); w.y = cvt_pk_bf16(v0[2], v0[3]); w.z = cvt_pk_bf16(v1[0], v1[1]); w.w = cvt_pk_bf16(v1[2], v1[3]);
                    if (u.kind == 0) { *(u32x4*)(KB + row * D + col0 + bj * 128) = w; }
                    else { const int k0 = col0 + bj * 128, base = k0 & ~15, hi8 = (k0 & 8) ? 1 : 0;
                        u32x2 lo2; lo2.x = w.x; lo2.y = w.y; u32x2 hi2; hi2.x = w.z; hi2.y = w.w;
                        *(u32x2*)(VT + row * 256 + base + (hi8 ? 4 : 0)) = lo2; *(u32x2*)(VT + row * 256 + base + (hi8 ? 12 : 8)) = hi2; } } }
    }
};
template <int MODE> struct EpiProbe { static constexpr bool PERM = true, SEG = false, PREF = false; static constexpr int NST = 0;
    bf16_t* O; int flag;
    __device__ __forceinline__ void operator()(const f32x4 (&acc)[2][2][4][2], const Unit& u, int wr, int wc, int fr, int fq) const {
        const int row0 = (MODE == 1 ? 0 : u.pm * 256) + wr * 64 + fr, col0 = (MODE == 1 ? 0 : u.pn * 256) + wc * 32 + 8 * fq;
#pragma unroll
        for (int ai = 0; ai < 2; ++ai)
#pragma unroll
            for (int m = 0; m < 4; ++m) { bf16_t* rowp = O + (size_t)(row0 + ai * 128 + m * 16) * 2048 + col0;
#pragma unroll
                for (int bj = 0; bj < 2; ++bj) { const f32x4 v0 = acc[ai][bj][m][0], v1 = acc[ai][bj][m][1];
                    u32x4 w; w.x = cvt_pk_bf16(v0[0], v0[1]); w.y = cvt_pk_bf16(v0[2], v0[3]); w.z = cvt_pk_bf16(v1[0], v1[1]); w.w = cvt_pk_bf16(v1[2], v1[3]);
                    if (MODE == 1 || flag == 12345) __builtin_nontemporal_store(w, (u32x4*)(rowp + bj * 128)); } }
    }
};
struct EpiNull { static constexpr bool PERM = true, SEG = false, PREF = false; static constexpr int NST = 0;
    __device__ __forceinline__ void operator()(const f32x4 (&acc)[2][2][4][2], const Unit& u, int wr, int wc, int fr, int fq) const {
        float s = 0.f;
#pragma unroll
        for (int ai = 0; ai < 2; ++ai)
#pragma unroll
            for (int bj = 0; bj < 2; ++bj)
#pragma unroll
                for (int m = 0; m < 4; ++m)
#pragma unroll
                    for (int n = 0; n < 2; ++n) s += acc[ai][bj][m][n][0] + acc[ai][bj][m][n][1] + acc[ai][bj][m][n][2] + acc[ai][bj][m][n][3];
        if (s == 123456.789f) *sink = s;
    }
    float* sink;
};
template <int MODE> struct EpiMerge {
    static constexpr bool PERM = true, SEG = false, PREF = false; static constexpr int NST = 0;
    bf16_t* Mg; const bf16_t* Z; int gcol0; const float* scale;
    __device__ __forceinline__ void operator()(const f32x4 (&acc)[2][2][4][2], const Unit& u, int wr, int wc, int fr, int fq) const {
        const int row0 = u.pm * 256 + wr * 64 + fr, col0 = u.pn * 256 + wc * 32 + 8 * fq;
        f32x4 sv[2][2];
#pragma unroll
        for (int bj = 0; bj < 2; ++bj)
#pragma unroll
            for (int n = 0; n < 2; ++n) sv[bj][n] = scale ? *(const f32x4*)(scale + col0 + bj * 128 + 4 * n) : (f32x4){1.f, 1.f, 1.f, 1.f};
#pragma unroll
        for (int ai = 0; ai < 2; ++ai)
#pragma unroll
            for (int m = 0; m < 4; ++m) { const size_t row = (size_t)(row0 + ai * 128 + m * 16);
#pragma unroll
                for (int bj = 0; bj < 2; ++bj) {
                    const u32x4 g = *(const u32x4*)(Z + row * INCOLS + gcol0 + col0 + bj * 128);
                    f32x4 v0 = acc[ai][bj][m][0] * sv[bj][0], v1 = acc[ai][bj][m][1] * sv[bj][1];
                    v0[0] *= bf_lo(g.x); v0[1] *= bf_hi(g.x); v0[2] *= bf_lo(g.y); v0[3] *= bf_hi(g.y);
                    v1[0] *= bf_lo(g.z); v1[1] *= bf_hi(g.z); v1[2] *= bf_lo(g.w); v1[3] *= bf_hi(g.w);
                    u32x4* mp = (u32x4*)(Mg + row * D + col0 + bj * 128);
                    if (MODE) { const u32x4 o = *mp;
                        v0[0] += bf_lo(o.x); v0[1] += bf_hi(o.x); v0[2] += bf_lo(o.y); v0[3] += bf_hi(o.y);
                        v1[0] += bf_lo(o.z); v1[1] += bf_hi(o.z); v1[2] += bf_lo(o.w); v1[3] += bf_hi(o.w); }
                    u32x4 w; w.x = cvt_pk_bf16(v0[0], v0[1]); w.y = cvt_pk_bf16(v0[2], v0[3]); w.z = cvt_pk_bf16(v1[0], v1[1]); w.w = cvt_pk_bf16(v1[2], v1[3]);
                    *mp = w; } }
    }
};
struct EpiMix3 {
    static constexpr bool PERM = true, SEG = true, PREF = false; static constexpr int T1 = 16, T2 = 20, NST = 0;
    bf16_t* Mg; const bf16_t* Z; const float* pscale; int light;
    __device__ __forceinline__ static f32x4 ub4(unsigned w) { return (f32x4){(float)(w & 0xffu), (float)((w >> 8) & 0xffu), (float)((w >> 16) & 0xffu), (float)(w >> 24)}; }
    __device__ __forceinline__ void mid(f32x4 (&acc)[2][2][4][2], const Unit& u, int seg, int wr, int wc, int fr, int fq) const {
        if (light) {
#pragma unroll
            for (int ai = 0; ai < 2; ++ai)
#pragma unroll
                for (int bj = 0; bj < 2; ++bj)
#pragma unroll
                    for (int m = 0; m < 4; ++m)
#pragma unroll
                        for (int n = 0; n < 2; ++n) acc[ai][bj][m][n] = acc[ai][bj][m][n] * 1.0001f;
            return; }
        const int row0 = u.pm * 256 + wr * 64 + fr, col0 = u.pn * 256 + wc * 32 + 8 * fq;
        const bool s1 = (seg == 1);
        f32x4 sr[2][2];
#pragma unroll
        for (int bj = 0; bj < 2; ++bj)
#pragma unroll
            for (int n = 0; n < 2; ++n) { const f32x4 ps = *(const f32x4*)(pscale + col0 + bj * 128 + 4 * n);
#pragma unroll
                for (int j = 0; j < 4; ++j) sr[bj][n][j] = s1 ? __builtin_amdgcn_rcpf(ps[j]) : ps[j]; }
        const unsigned char* zb = (const unsigned char*)Z + 2 * GATE0 + col0;
        const unsigned char* zn = zb + (s1 ? 0 : D); const unsigned char* zd = zb + (s1 ? D : 2 * D);
#pragma unroll
        for (int ai = 0; ai < 2; ++ai)
#pragma unroll
            for (int m = 0; m < 4; ++m) { const size_t rb = (size_t)(row0 + ai * 128 + m * 16) * (2 * INCOLS);
#pragma unroll
                for (int bj = 0; bj < 2; ++bj) {
                    const u32x2 gn = *(const u32x2*)(zn + rb + bj * 128), gd = *(const u32x2*)(zd + rb + bj * 128);
                    const f32x4 n0 = ub4(gn.x) * sr[bj][0], n1 = ub4(gn.y) * sr[bj][1], d0 = ub4(gd.x), d1 = ub4(gd.y);
#pragma unroll
                    for (int j = 0; j < 4; ++j) { acc[ai][bj][m][0][j] *= n0[j] * __builtin_amdgcn_rcpf(d0[j]); acc[ai][bj][m][1][j] *= n1[j] * __builtin_amdgcn_rcpf(d1[j]); } }
                asm volatile("" ::: "memory"); }
    }
    __device__ __forceinline__ void operator()(const f32x4 (&acc)[2][2][4][2], const Unit& u, int wr, int wc, int fr, int fq) const {
        const int row0 = u.pm * 256 + wr * 64 + fr, col0 = u.pn * 256 + wc * 32 + 8 * fq;
        const unsigned char* zg = (const unsigned char*)Z + 2 * GATE0 + 2 * D + col0;
#pragma unroll
        for (int ai = 0; ai < 2; ++ai)
#pragma unroll
            for (int m = 0; m < 4; ++m) { const size_t row = (size_t)(row0 + ai * 128 + m * 16);
#pragma unroll
                for (int bj = 0; bj < 2; ++bj) {
                    const u32x2 g = *(const u32x2*)(zg + row * (2 * INCOLS) + bj * 128);
                    const f32x4 v0 = acc[ai][bj][m][0] * (ub4(g.x) * (1.0f / 255.0f)), v1 = acc[ai][bj][m][1] * (ub4(g.y) * (1.0f / 255.0f));
                    u32x4 w; w.x = cvt_pk_bf16(v0[0], v0[1]); w.y = cvt_pk_bf16(v0[2], v0[3]); w.z = cvt_pk_bf16(v1[0], v1[1]); w.w = cvt_pk_bf16(v1[2], v1[3]);
                    *(u32x4*)(Mg + row * D + col0 + bj * 128) = w; } }
    }
};
struct EpiResBf16 {
    static constexpr bool PERM = true, SEG = false, PREF = false; static constexpr int NST = 12;
    bf16_t* O; const float* base; float alpha;
    __device__ __forceinline__ void operator()(const f32x4 (&acc)[2][2][4][2], const Unit& u, int wr, int wc, int fr, int fq) const {
        const int row0 = u.pm * 256 + wr * 64 + fr, col0 = u.pn * 256 + wc * 32 + 8 * fq;
#pragma unroll
        for (int ai = 0; ai < 2; ++ai)
#pragma unroll
            for (int m = 0; m < 4; ++m) { const size_t off = (size_t)(row0 + ai * 128 + m * 16) * D + col0;
#pragma unroll
                for (int bj = 0; bj < 2; ++bj) { const f32x4 b0 = *(const f32x4*)(base + off + bj * 128), b1 = *(const f32x4*)(base + off + bj * 128 + 4);
                    const f32x4 v0 = b0 * alpha + acc[ai][bj][m][0], v1 = b1 * alpha + acc[ai][bj][m][1];
                    u32x4 w; w.x = cvt_pk_bf16(v0[0], v0[1]); w.y = cvt_pk_bf16(v0[2], v0[3]); w.z = cvt_pk_bf16(v1[0], v1[1]); w.w = cvt_pk_bf16(v1[2], v1[3]);
                    *(u32x4*)(O + off + bj * 128) = w; } }
    }
};
struct EpiAct {
    static constexpr bool PERM = true, SEG = false, PREF = false; static constexpr int NST = 6;
    unsigned char* O; const float* rs; const float* cs;
    __device__ __forceinline__ void operator()(const f32x4 (&acc)[2][2][4][2], const Unit& u, int wr, int wc, int fr, int fq) const {
        const int row0 = u.pm * 256 + wr * 64 + fr, col0 = u.pn * 128 + wc * 32 + 8 * fq;
        const float* cse = cs + (size_t)u.kind * D + u.pn * 256 + wc * 32 + 8 * fq;
        f32x4 cg[2], cv[2];
#pragma unroll
        for (int n = 0; n < 2; ++n) { cg[n] = *(const f32x4*)(cse + 4 * n); cv[n] = *(const f32x4*)(cse + 128 + 4 * n); }
#pragma unroll
        for (int ai = 0; ai < 2; ++ai)
#pragma unroll
            for (int m = 0; m < 4; ++m) { const int row = row0 + ai * 128 + m * 16; unsigned char* rowp = O + (size_t)row * DEXP + col0; const float r = rs[row];
                f32x4 r0, r1;
#pragma unroll
                for (int j = 0; j < 4; ++j) { const float g0 = acc[ai][0][m][0][j] * (cg[0][j] * r), g1 = acc[ai][0][m][1][j] * (cg[1][j] * r);
                    r0[j] = g0 * sigmoidf_(g0) * (acc[ai][1][m][0][j] * (cv[0][j] * r)); r1[j] = g1 * sigmoidf_(g1) * (acc[ai][1][m][1][j] * (cv[1][j] * r)); }
                u32x2 w; { int q = __builtin_amdgcn_cvt_pk_fp8_f32(r0[0], r0[1], 0, false); q = __builtin_amdgcn_cvt_pk_fp8_f32(r0[2], r0[3], q, true); w.x = (unsigned)q; }
                { int q = __builtin_amdgcn_cvt_pk_fp8_f32(r1[0], r1[1], 0, false); q = __builtin_amdgcn_cvt_pk_fp8_f32(r1[2], r1[3], q, true); w.y = (unsigned)q; }
                *(u32x2*)rowp = w; }
    }
};

struct Frame {
    LAS unsigned char* lds; int tid, lane, wave, G, bid;
    const Params* p;
};

struct TItem { const float* src; bf16_t* dst; int ldw, ldt, f8; };
constexpr int PREP_NIT = 16 * 256 + 3 * 16 * 32 + 16 * 64 + 4 * 4 * 8 + NEXP * 16 * 32 + NEXP * 8 * 32;
constexpr int PREP_LATE = 0;
__device__ __forceinline__ bool prep_item(const Params& P, unsigned char* ws, int it, int it_end, TItem& t) {
    constexpr int I_IN = 16 * 256, I_SQ = 16 * 32, I_KV = 16 * 64, I_P = 4 * 4 * 8, I_UP = NEXP * 16 * 32, I_DN = NEXP * 8 * 32;
    constexpr int NIT = I_IN + 3 * I_SQ + I_KV + I_P + I_UP + I_DN; static_assert(NIT == PREP_NIT, "item count");
    if (it >= it_end) return false;
    int r = it;
    if (r < I_IN) { const int kb = r / 256, nb = r % 256, n0 = 32 * nb;
        int drow = n0; if (n0 >= D && n0 < 3 * D) { const int c = (n0 - D) & (D - 1); drow = D + (c >> 7) * 256 + (n0 >= 2 * D ? 128 : 0) + (c & 127); }
        t.src = P.in[I_WIN] + (size_t)(64 * kb) * INCOLS + n0; t.ldw = INCOLS; t.dst = (bf16_t*)(ws + WS_WIN) + (size_t)drow * D + 64 * kb; t.ldt = D; t.f8 = 0; return true; } r -= I_IN;
    if (r < I_SQ) { const int kb = r / 32, nb = r % 32; t.src = P.in[I_WCONV] + (size_t)(64 * kb) * D + 32 * nb; t.ldw = D; t.dst = (bf16_t*)(ws + WS_WCAT) + (size_t)(32 * nb) * KCAT + 64 * kb; t.ldt = KCAT; t.f8 = 0; return true; } r -= I_SQ;
    if (r < I_SQ) { const int kb = r / 32, nb = r % 32; t.src = P.in[I_WXO] + (size_t)(64 * kb) * D + 32 * nb; t.ldw = D; t.dst = (bf16_t*)(ws + WS_WCAT) + (size_t)(32 * nb) * KCAT + 1280 + 64 * kb; t.ldt = KCAT; t.f8 = 0; return true; } r -= I_SQ;
    if (r < I_SQ) { const int kb = r / 32, nb = r % 32; t.src = P.in[I_WO] + (size_t)(64 * kb) * D + 32 * nb; t.ldw = D; t.dst = (bf16_t*)(ws + WS_WO) + (size_t)(32 * nb) * D + 64 * kb; t.ldt = D; t.f8 = 0; return true; } r -= I_SQ;
    if (r < I_KV) { const int kb = r / 64, nb = r % 64; t.src = P.in[I_WKV] + (size_t)(64 * kb) * (2 * D) + 32 * nb; t.ldw = 2 * D; t.dst = (bf16_t*)(ws + WS_WKV) + (size_t)(32 * nb) * D + 64 * kb; t.ldt = D; t.f8 = 0; return true; } r -= I_KV;
    if (r < I_P) { const int g = r / 32, q = r % 32, kb = q / 8, nb = q % 8;
        t.src = P.in[I_WPOOL] + (size_t)g * 65536 + (size_t)(64 * kb) * 256 + 32 * nb; t.ldw = 256; t.dst = (bf16_t*)(ws + WS_WCAT) + (size_t)(g * 256 + 32 * nb) * KCAT + 1024 + 64 * kb; t.ldt = KCAT; t.f8 = 0; return true; } r -= I_P;
    if (r < I_UP) { const int e = r / 512, q = r % 512, kb = q / 32, nb = q % 32; const int n0 = 32 * nb;
        const int j0 = n0 & 511, drow = (j0 >> 7) * 256 + (n0 >= 512 ? 128 : 0) + (j0 & 127);
        t.src = P.in[I_WUP] + (size_t)e * D * D + (size_t)(64 * kb) * D + n0; t.ldw = D; t.dst = (bf16_t*)(ws + WS_WUP + (size_t)e * D * D + (size_t)drow * D + 64 * kb); t.ldt = D; t.f8 = 1; return true; } r -= I_UP;
    { const int e = r / 256, q = r % 256, kb = q / 32, nb = q % 32;
        t.src = P.in[I_WDN] + (size_t)e * DEXP * D + (size_t)(64 * kb) * D + 32 * nb; t.ldw = D; t.dst = (bf16_t*)(ws + WS_WDN + (size_t)e * D * DEXP + (size_t)(32 * nb) * DEXP + 64 * kb); t.ldt = DEXP; t.f8 = 1; return true; }
}
__device__ __forceinline__ void titem_load(const TItem& t, int lane, f32x4 (&v)[8]) {
    const float* s = t.src + (size_t)(lane >> 3) * t.ldw + (lane & 7) * 4;
#pragma unroll
    for (int j = 0; j < 8; ++j) v[j] = *(const f32x4*)(s + (size_t)(8 * j) * t.ldw);
}
__device__ __forceinline__ void titem_finish(const TItem& t, int lane, const f32x4 (&v)[8], LAS float* scr) {
#pragma unroll
    for (int j = 0; j < 8; ++j) { LAS float* d = scr + (8 * j + (lane >> 3)) * 33 + (lane & 7) * 4; d[0] = v[j][0]; d[1] = v[j][1]; d[2] = v[j][2]; d[3] = v[j][3]; }
    asm volatile("s_waitcnt lgkmcnt(0)" ::: "memory");
    if (t.f8) {
        const int c = lane & 3;
#pragma unroll
        for (int j = 0; j < 2; ++j) { const int n = (lane >> 2) + 16 * j; const LAS float* s = scr + (16 * c) * 33 + n;
            u32x4 o;
            { int r = __builtin_amdgcn_cvt_pk_fp8_f32(s[0 * 33] * 32.f, s[1 * 33] * 32.f, 0, false); r = __builtin_amdgcn_cvt_pk_fp8_f32(s[2 * 33] * 32.f, s[3 * 33] * 32.f, r, true); o.x = (unsigned)r; }
            { int r = __builtin_amdgcn_cvt_pk_fp8_f32(s[4 * 33] * 32.f, s[5 * 33] * 32.f, 0, false); r = __builtin_amdgcn_cvt_pk_fp8_f32(s[6 * 33] * 32.f, s[7 * 33] * 32.f, r, true); o.y = (unsigned)r; }
            { int r = __builtin_amdgcn_cvt_pk_fp8_f32(s[8 * 33] * 32.f, s[9 * 33] * 32.f, 0, false); r = __builtin_amdgcn_cvt_pk_fp8_f32(s[10 * 33] * 32.f, s[11 * 33] * 32.f, r, true); o.z = (unsigned)r; }
            { int r = __builtin_amdgcn_cvt_pk_fp8_f32(s[12 * 33] * 32.f, s[13 * 33] * 32.f, 0, false); r = __builtin_amdgcn_cvt_pk_fp8_f32(s[14 * 33] * 32.f, s[15 * 33] * 32.f, r, true); o.w = (unsigned)r; }
            *(u32x4*)((unsigned char*)t.dst + (size_t)n * t.ldt + 16 * c) = o; }
    } else {
    const int c = lane & 7;
#pragma unroll
    for (int j = 0; j < 4; ++j) { const int n = (lane >> 3) + 8 * j; const LAS float* s = scr + (8 * c) * 33 + n;
        u32x4 o; o.x = cvt_pk_bf16(s[0 * 33], s[1 * 33]); o.y = cvt_pk_bf16(s[2 * 33], s[3 * 33]); o.z = cvt_pk_bf16(s[4 * 33], s[5 * 33]); o.w = cvt_pk_bf16(s[6 * 33], s[7 * 33]);
        *(u32x4*)(t.dst + (size_t)n * t.ldt + 8 * c) = o; }
    }
    asm volatile("s_waitcnt lgkmcnt(0)" ::: "memory");
}

struct WTask { const float* src; int ldw; unsigned char* dst; float* sc; };
__device__ __forceinline__ bool wtask_get(const Params& P, unsigned char* ws, int t, WTask& k) {
    constexpr int T_IN = INCOLS / 32, T_UP = NEXP * (D / 32);
    if (t >= T_IN + T_UP) return false;
    if (t < T_IN) { const int n0 = 32 * t;
        int drow = n0; if (n0 >= D && n0 < 3 * D) { const int c = (n0 - D) & (D - 1); drow = D + (c >> 7) * 256 + (n0 >= 2 * D ? 128 : 0) + (c & 127); }
        k.src = P.in[I_WIN] + n0; k.ldw = INCOLS; k.dst = ws + WS_WIN + (size_t)drow * D; k.sc = (float*)(ws + WS_SW) + drow;
    } else { const int q = t - T_IN, e = q >> 5, n0 = 32 * (q & 31);
        const int j0 = n0 & 511, drow = (j0 >> 7) * 256 + (n0 >= 512 ? 128 : 0) + (j0 & 127);
        k.src = P.in[I_WUP] + (size_t)e * D * D + n0; k.ldw = D; k.dst = ws + WS_WUP + (size_t)e * D * D + (size_t)drow * D; k.sc = (float*)(ws + WS_SWU) + e * D + drow; }
    return true;
}
__device__ __forceinline__ void wtask_load(const Frame& F, const WTask& k, f32x4 (&va)[8], f32x4 (&vb)[8]) {
    TItem ta, tb; ta.src = k.src + (size_t)(64 * (2 * F.wave)) * k.ldw; ta.ldw = k.ldw; tb.src = ta.src + (size_t)64 * k.ldw; tb.ldw = k.ldw;
    titem_load(ta, F.lane, va); titem_load(tb, F.lane, vb);
}
__device__ __forceinline__ void wtask_finish(const Frame& F, const WTask& k, const f32x4 (&va)[8], const f32x4 (&vb)[8]) {
    LAS float* scr = (LAS float*)(F.lds + F.wave * 16384);
    LAS float* cmx = (LAS float*)(F.lds + 131072 + 8192);
    const int lane = F.lane, c4 = (lane & 7) * 4;
    f32x4 mx = (f32x4){0.f, 0.f, 0.f, 0.f};
#pragma unroll
    for (int j = 0; j < 8; ++j) { mx = __builtin_elementwise_max(mx, __builtin_elementwise_max(__builtin_elementwise_abs(va[j]), __builtin_elementwise_abs(vb[j]))); }
#pragma unroll
    for (int o = 8; o < 64; o <<= 1) {
#pragma unroll
        for (int q = 0; q < 4; ++q) mx[q] = fmaxf(mx[q], __shfl_xor(mx[q], o)); }
    __syncthreads();
    if (lane < 8) { LAS float* d = cmx + F.wave * 32 + c4; d[0] = mx[0]; d[1] = mx[1]; d[2] = mx[2]; d[3] = mx[3]; }
    __syncthreads();
    if (F.tid < 32) { float m = 0.f;
#pragma unroll
        for (int w = 0; w < 8; ++w) m = fmaxf(m, cmx[w * 32 + F.tid]);
        cmx[256 + F.tid] = m > 0.f ? 127.0f / m : 0.f; k.sc[F.tid] = m > 0.f ? m * (1.0f / 127.0f) : 1.0f; }
    __syncthreads();
#pragma unroll
    for (int blk = 0; blk < 2; ++blk) {
#pragma unroll
        for (int j = 0; j < 8; ++j) { const f32x4 x = blk ? vb[j] : va[j]; LAS float* d = scr + (8 * j + (lane >> 3)) * 33 + c4; d[0] = x[0]; d[1] = x[1]; d[2] = x[2]; d[3] = x[3]; }
        asm volatile("s_waitcnt lgkmcnt(0)" ::: "memory");
        const int c = lane & 3;
#pragma unroll
        for (int j = 0; j < 2; ++j) { const int n = (lane >> 2) + 16 * j; const LAS float* s = scr + (16 * c) * 33 + n; const float inv = cmx[256 + n];
            u32x4 o;
#pragma unroll
            for (int g = 0; g < 4; ++g) { o[g] = ((unsigned)(int)__builtin_rintf(s[(4 * g) * 33] * inv) & 0xffu) | (((unsigned)(int)__builtin_rintf(s[(4 * g + 1) * 33] * inv) & 0xffu) << 8) | (((unsigned)(int)__builtin_rintf(s[(4 * g + 2) * 33] * inv) & 0xffu) << 16) | ((unsigned)(int)__builtin_rintf(s[(4 * g + 3) * 33] * inv) << 24); }
            *(u32x4*)(k.dst + (size_t)n * D + 64 * (2 * F.wave + blk) + 16 * c) = o; }
        asm volatile("s_waitcnt lgkmcnt(0)" ::: "memory");
    }
}
__device__ __forceinline__ void prep_i8_tasks(const Frame& F) {
    const Params& P = *F.p; unsigned char* ws = P.ws;
    WTask cur, nxt; f32x4 va[8], vb[8], wa[8], wb[8];
    int t = F.bid; bool have = wtask_get(P, ws, t, cur);
    if (have) wtask_load(F, cur, va, vb);
    while (have) {
        const bool hn = wtask_get(P, ws, t + F.G, nxt);
        if (hn) wtask_load(F, nxt, wa, wb);
        wtask_finish(F, cur, va, vb);
        if (!hn) break;
        t += 2 * F.G;
        have = wtask_get(P, ws, t, cur);
        if (have) wtask_load(F, cur, va, vb);
        wtask_finish(F, nxt, wa, wb);
    }
    __syncthreads();
}

__device__ __forceinline__ void convert_items(const Frame& F, int it0, int it1, int w, int nw) {
    const Params& P = *F.p; unsigned char* ws = P.ws;
    LAS float* scr = (LAS float*)(F.lds + F.wave * 16384);
    TItem cur, nxt; f32x4 va[8], vb[8];
    int it = it0 + w; bool have = prep_item(P, ws, it, it1, cur);
    if (have) titem_load(cur, F.lane, va);
    while (have) {
        const bool hn = prep_item(P, ws, it + nw, it1, nxt);
        if (hn) titem_load(nxt, F.lane, vb);
        titem_finish(cur, F.lane, va, scr);
        if (!hn) break;
        it += 2 * nw;
        have = prep_item(P, ws, it, it1, cur);
        if (have) titem_load(cur, F.lane, va);
        titem_finish(nxt, F.lane, vb, scr);
    }
}

__device__ __forceinline__ void phase_prep(const Frame& F) {
    const Params& P = *F.p; unsigned char* ws = P.ws;
    LAS float* scr = (LAS float*)(F.lds + F.wave * 16384);
    const int gw = F.bid * NWAVES + F.wave, NGW = F.G * NWAVES;
    prep_i8_tasks(F);
    const size_t gt = (size_t)F.bid * NTHR + F.tid, NGT = (size_t)F.G * NTHR;
    for (int row0 = gw * 4; row0 < NTOK; row0 += NGW * 4) {
        f32x4 v[4][4]; float am[4];
#pragma unroll
        for (int a = 0; a < 4; ++a) { const f32x4* xr = (const f32x4*)(P.in[I_X] + (size_t)(row0 + a) * D) + F.lane;
#pragma unroll
            for (int j = 0; j < 4; ++j) v[a][j] = xr[64 * j]; }
#pragma unroll
        for (int a = 0; a < 4; ++a) { am[a] = 0.f;
#pragma unroll
            for (int j = 0; j < 4; ++j) am[a] = fmaxf(am[a], fmaxf(fmaxf(fabsf(v[a][j][0]), fabsf(v[a][j][1])), fmaxf(fabsf(v[a][j][2]), fabsf(v[a][j][3])))); }
#pragma unroll
        for (int o = 1; o < 64; o <<= 1) {
#pragma unroll
            for (int a = 0; a < 4; ++a) am[a] = fmaxf(am[a], __shfl_xor(am[a], o)); }
#pragma unroll
        for (int a = 0; a < 4; ++a) { const float inv = am[a] > 0.f ? 127.0f / am[a] : 0.f;
            if (F.lane == 0) ((float*)(ws + WS_XS))[row0 + a] = am[a] > 0.f ? am[a] * (1.0f / 127.0f) : 1.0f;
#pragma unroll
            for (int j = 0; j < 4; ++j) { const f32x4 q = v[a][j] * inv;
                const unsigned w = ((unsigned)(int)__builtin_rintf(q[0]) & 0xffu) | (((unsigned)(int)__builtin_rintf(q[1]) & 0xffu) << 8) | (((unsigned)(int)__builtin_rintf(q[2]) & 0xffu) << 16) | ((unsigned)(int)__builtin_rintf(q[3]) << 24);
                *((unsigned*)(ws + WS_XB + (size_t)(row0 + a) * D) + F.lane + 64 * j) = w; } }
    }
    { const f32x4* src = (const f32x4*)P.in[I_MEM]; u32x4* dst = (u32x4*)(ws + WS_MEMB);
      for (size_t i = gt; i < (size_t)NMEM * D / 8; i += NGT) { const f32x4 a = src[2 * i], b = src[2 * i + 1]; u32x4 o; o.x = cvt_pk_bf16(a[0], a[1]); o.y = cvt_pk_bf16(a[2], a[3]); o.z = cvt_pk_bf16(b[0], b[1]); o.w = cvt_pk_bf16(b[2], b[3]); dst[i] = o; } }
    { bf16_t* wr = (bf16_t*)(ws + WS_WR);
      for (size_t i = gt; i < (size_t)80 * D; i += NGT) { const int o = (int)(i / D), k = (int)(i % D); wr[i] = (bf16_t)f2bf(o < 8 ? P.in[I_WRG][(size_t)k * 8 + o] : (o < 72 ? P.in[I_WRE][(size_t)k * 64 + (o - 8)] : 0.f)); } }
    { constexpr int I0 = 16 * 256, I_UP0 = I0 + 3 * 16 * 32 + 16 * 64 + 4 * 4 * 8, I_DN0 = I_UP0 + NEXP * 16 * 32;
      convert_items(F, I0, I_UP0, gw, NGW); convert_items(F, I_DN0, PREP_NIT, gw, NGW); }
}

struct F8 { f32x4 a, b; };
__device__ __forceinline__ F8 up8(const u32x4 v) { F8 r; r.a = (f32x4){bf_lo(v.x), bf_hi(v.x), bf_lo(v.y), bf_hi(v.y)}; r.b = (f32x4){bf_lo(v.z), bf_hi(v.z), bf_lo(v.w), bf_hi(v.w)}; return r; }
__device__ __forceinline__ u32x4 pk8(const F8 v) { u32x4 o; o.x = pk2(v.a[0], v.a[1]); o.y = pk2(v.a[2], v.a[3]); o.z = pk2(v.b[0], v.b[1]); o.w = pk2(v.b[2], v.b[3]); return o; }
__device__ __forceinline__ void phase_convpool(const Frame& F) {
    const Params& P = *F.p; unsigned char* ws = P.ws;
    const bf16_t* __restrict__ Z = (const bf16_t*)(ws + WS_Z); bf16_t* __restrict__ AC = (bf16_t*)(ws + WS_ACONV); bf16_t* __restrict__ DP = (bf16_t*)(ws + WS_DPOOL);
    const float* cw = P.in[I_CONVW];
    constexpr int TSEG = 16;
    unsigned* ctr = (unsigned*)(ws + WS_CTL) + CW_CPCTR;
    volatile LAS unsigned* slot = (volatile LAS unsigned*)(F.lds + 131072 + 12288);
    for (;;) {
        __syncthreads();
        if (F.tid == 0) slot[0] = atomicAdd(ctr, 1u);
        __syncthreads();
        const unsigned chunk = slot[0];
        if (chunk >= (unsigned)((NTOK / TSEG) * (D / 8) / NTHR)) break;
        const int it = (int)chunk * NTHR + F.tid;
        const int c0 = (it & 127) * 8, t0 = (it >> 7) * TSEG, s0 = t0 & (SEQ - 1);
        const int gi = c0 >> 8, w = 2 << gi;
        F8 w0, w1, w2;
        w0.a = *(const f32x4*)(cw + c0); w0.b = *(const f32x4*)(cw + c0 + 4); w1.a = *(const f32x4*)(cw + D + c0); w1.b = *(const f32x4*)(cw + D + c0 + 4); w2.a = *(const f32x4*)(cw + 2 * D + c0); w2.b = *(const f32x4*)(cw + 2 * D + c0 + 4);
        const bf16_t* zr0 = Z + (size_t)t0 * INCOLS + c0;
        F8 u1, u2, run;
        u1.a = u1.b = u2.a = u2.b = run.a = run.b = (f32x4){0.f, 0.f, 0.f, 0.f};
        if (s0 > 0) {
            u1 = up8(*(const u32x4*)(zr0 - INCOLS + D)); u2 = up8(*(const u32x4*)(zr0 - 2 * INCOLS + D));
            for (int i = 1; i < w; ++i) { const F8 pp = up8(*(const u32x4*)(zr0 - (size_t)i * INCOLS + 3 * D)); run.a += pp.a; run.b += pp.b; }
        }
        for (int tb = 0; tb < TSEG; tb += 4) {
            u32x4 lcb[4], lcc[4], lp[4], lold[4];
#pragma unroll
            for (int j = 0; j < 4; ++j) { const bf16_t* zr = zr0 + (size_t)(tb + j) * INCOLS;
                lcb[j] = *(const u32x4*)(zr); lcc[j] = *(const u32x4*)(zr + D); lp[j] = *(const u32x4*)(zr + 3 * D);
                lold[j] = (s0 + tb + j - (w - 1) >= 0) ? *(const u32x4*)(zr - (size_t)(w - 1) * INCOLS + 3 * D) : (u32x4){0u, 0u, 0u, 0u}; }
#pragma unroll
            for (int j = 0; j < 4; ++j) {
                const F8 cb = up8(lcb[j]), u0 = up8(lcc[j]);
                F8 v; v.a = (w0.a * u2.a + w1.a * u1.a + w2.a * u0.a) * cb.a; v.b = (w0.b * u2.b + w1.b * u1.b + w2.b * u0.b) * cb.b;
                *(u32x4*)(AC + (size_t)(t0 + tb + j) * D + c0) = pk8(v);
                u2 = u1; u1 = u0;
                const F8 pp = up8(lp[j]), po = up8(lold[j]);
                run.a += pp.a; run.b += pp.b;
                const int s = s0 + tb + j; const int cnt = (s + 1) < w ? (s + 1) : w; const float inv = 1.0f / (float)cnt;
                F8 d; d.a = run.a * inv - pp.a; d.b = run.b * inv - pp.b;
                *(u32x4*)(DP + (size_t)(t0 + tb + j) * D + c0) = pk8(d);
                run.a -= po.a; run.b -= po.b;
            }
        }
    }
}

typedef float f32x16 __attribute__((ext_vector_type(16)));
typedef float f32x2_t __attribute__((ext_vector_type(2))); typedef __bf16 bf16x2_t __attribute__((ext_vector_type(2)));
__device__ __forceinline__ unsigned cvtpk(float lo, float hi) { f32x2_t v = {lo, hi}; bf16x2_t b = __builtin_convertvector(v, bf16x2_t); return __builtin_bit_cast(unsigned, b); }
#define MFMA32(a, b, c) __builtin_amdgcn_mfma_f32_32x32x16_bf16((a), (b), (c), 0, 0, 0)
template <int VAR> __device__ __forceinline__ void phase_attn(const Frame& F) {
    const Params& P = *F.p; unsigned char* ws = P.ws;
    const bf16_t* Z = (const bf16_t*)(ws + WS_Z); bf16_t* O = (bf16_t*)(ws + (VAR ? WS_MERGED : WS_O));
    const int tid = F.tid, lane = F.lane, wave = F.wave, r = lane & 31, hh = lane >> 5;
    const int prow = tid >> 5, pc = (tid & 31) ^ prow;
    LAS unsigned char* lds = F.lds;
    int rb[8];
#pragma unroll
    for (int t = 0; t < 8; ++t) rb[t] = r * 512 + (((2 * t + hh) ^ (r & 15)) << 4);
#define AT_WAIT_BAR(N) asm volatile("s_waitcnt vmcnt(" #N ")\n\ts_barrier" ::: "memory")
#define AT_ISSUE(i) do { if (VAR == 2) break; const char* _s = ((i) < 8) ? ksrc + (size_t)(32 * (i)) * 2048 : vsrc + (size_t)(32 * ((i) - 8)) * 512; const size_t _rs = ((i) < 8) ? 2048 : 512; \
        _Pragma("unroll") for (int _it = 0; _it < 2; ++_it) \
        __builtin_amdgcn_global_load_lds((const unsigned*)(_s + (size_t)(16 * _it) * _rs), (LAS unsigned*)(lds + ((i) & 7) * 16384 + _it * 8192 + wave * 1024), 16, 0, 0); } while (0)
#define AT_FRAG(slot, s) (*(const LAS pg8::bf16x8*)(lds + rb[(s) & 7] + (slot) * 16384 + ((s) >> 3) * 256))
#define AT_DSR(dst, s, slot) asm volatile("ds_read_b128 %0, %1 offset:%2" : "=v"(dst) : "v"(((slot) & 4) ? rbh[(s) & 7] : rbv[(s) & 7]), "n"(((slot) & 3) * 16384 + ((s) >> 3) * 256) : "memory")
#define AT_LW(dst, n) asm volatile("s_waitcnt lgkmcnt(%1)" : "+v"(dst) : "n"(n) : "memory")
#define AT_PIPE(slot, STMT) do { asm volatile("s_waitcnt lgkmcnt(0)" ::: "memory"); \
        AT_DSR(fr[0], 0, slot); AT_DSR(fr[1], 1, slot); AT_DSR(fr[2], 2, slot); AT_DSR(fr[3], 3, slot); \
        _Pragma("unroll") for (int s = 0; s < 16; ++s) { AT_LW(fr[s & 7], (15 - s) < 3 ? (15 - s) : 3); if (VAR != 1 && VAR != 4) { STMT; } if (s + 4 < 16 && VAR != 3 && VAR != 4) AT_DSR(fr[(s + 4) & 7], s + 4, slot); } } while (0)
    pg8::bf16x8 fr[8]; unsigned rbv[8], rbh[8];
#pragma unroll
    for (int t = 0; t < 8; ++t) { rbv[t] = (unsigned)(size_t)lds + (unsigned)rb[t]; rbh[t] = rbv[t] + 65536u; }
    for (int ui = F.bid; ui < (NTOK / 256) * 4; ui += F.G) {
        const int h = ui & 3, t0 = (ui >> 2) * 256, b = t0 / SEQ;
        const bf16_t* qrow = Z + (size_t)(t0 + 32 * wave + r) * INCOLS + 4 * D + h * 256 + 8 * hh;
        pg8::bf16x8 qf[16];
#pragma unroll
        for (int s = 0; s < 16; ++s) qf[s] = *(const pg8::bf16x8*)(qrow + 16 * s);
        const char* ksrc = (const char*)(ws + WS_KB) + ((size_t)(b * 256 + prow) * D + h * 256) * 2 + pc * 16;
        const char* vsrc = (const char*)(ws + WS_VT) + ((size_t)(b * D + h * 256 + prow) * 256) * 2 + pc * 16;
        asm volatile("s_barrier" ::: "memory");
        AT_ISSUE(0); AT_ISSUE(1); AT_ISSUE(2); AT_ISSUE(3); AT_ISSUE(4); AT_ISSUE(5);
        f32x16 S[8];
#pragma unroll
        for (int i = 0; i < 8; ++i)
#pragma unroll
            for (int j = 0; j < 16; ++j) S[i][j] = 0.f;
#pragma unroll
        for (int i = 0; i < 8; ++i) {
            AT_WAIT_BAR(10);
            AT_ISSUE(i + 6);
#pragma unroll
            AT_PIPE(i & 7, S[i] = MFMA32(fr[s & 7], qf[s], S[i]));
        }
        float mx = S[0][0];
#pragma unroll
        for (int i = 0; i < 8; ++i)
#pragma unroll
            for (int j = 0; j < 16; ++j) mx = fmaxf(mx, S[i][j]);
        mx = fmaxf(mx, __shfl_xor(mx, 32));
        const float c2 = 0.0625f * 1.4426950408889634f;
        float sum = 0.f;
        pg8::bf16x8 pf[8][2];
#pragma unroll
        for (int i = 0; i < 8; ++i) {
#pragma unroll
            for (int j = 0; j < 16; ++j) { const float e = __builtin_amdgcn_exp2f((S[i][j] - mx) * c2); S[i][j] = e; sum += e; }
#pragma unroll
            for (int s2 = 0; s2 < 2; ++s2) { u32x4 w; w.x = cvtpk(S[i][8 * s2], S[i][8 * s2 + 1]); w.y = cvtpk(S[i][8 * s2 + 2], S[i][8 * s2 + 3]); w.z = cvtpk(S[i][8 * s2 + 4], S[i][8 * s2 + 5]); w.w = cvtpk(S[i][8 * s2 + 6], S[i][8 * s2 + 7]);
                pf[i][s2] = __builtin_bit_cast(pg8::bf16x8, w); }
        }
        sum += __shfl_xor(sum, 32);
        const float inv = 1.0f / sum;
        bf16_t* orow = O + (size_t)(t0 + 32 * wave + r) * D + h * 256 + 4 * hh;
#pragma unroll
        for (int i = 8; i < 16; ++i) {
            if (i == 8) AT_WAIT_BAR(10); else if (i == 9) AT_WAIT_BAR(13); else if (i == 10) AT_WAIT_BAR(16); else if (i == 11) AT_WAIT_BAR(17); else if (i == 12) AT_WAIT_BAR(18); else if (i == 13) AT_WAIT_BAR(19); else if (i == 14) AT_WAIT_BAR(20); else AT_WAIT_BAR(18);
            if (i + 6 < 16) AT_ISSUE(i + 6);
            f32x16 o;
#pragma unroll
            for (int j = 0; j < 16; ++j) o[j] = 0.f;
#pragma unroll
            AT_PIPE(i & 7, o = MFMA32(fr[s & 7], pf[s >> 1][s & 1], o));
#pragma unroll
            for (int g = 0; g < 4; ++g) { u32x2 w; w.x = cvtpk(o[4 * g] * inv, o[4 * g + 1] * inv); w.y = cvtpk(o[4 * g + 2] * inv, o[4 * g + 3] * inv);
                *(u32x2*)(orow + 32 * (i - 8) + 8 * g) = w; }
        }
    }
    asm volatile("s_waitcnt vmcnt(0)\n\ts_barrier" ::: "memory");
#undef AT_WAIT_BAR
#undef AT_ISSUE
#undef AT_FRAG
#undef AT_DSR
#undef AT_LW
#undef AT_PIPE
}

__device__ __forceinline__ void phase_ln1_router(const Frame& F) {
    const Params& P = *F.p; unsigned char* ws = P.ws;
    const bf16_t* H1 = (const bf16_t*)(ws + WS_H1); bf16_t* H1B = (bf16_t*)(ws + WS_H1B); const bf16_t* WRB = (const bf16_t*)(ws + WS_WR);
    unsigned* ctl = (unsigned*)(ws + WS_CTL);
    int* tok_e = (int*)(ws + WS_MISC + MS_TOKE); int* tok_pos = (int*)(ws + WS_MISC + MS_TOKPOS); float* tok_w = (float*)(ws + WS_MISC + MS_TOKW);
    LAS float* lg = (LAS float*)(F.lds + F.wave * 5120);
    LAS unsigned* lcnt = (LAS unsigned*)(F.lds + 8 * 5120);
    const int lane = F.lane;
    const float* g1 = P.in[I_LN1G]; const float* b1 = P.in[I_LN1B];
    f32x4 gg[4], bb[4];
#pragma unroll
    for (int j = 0; j < 4; ++j) { gg[j] = *((const f32x4*)g1 + lane + 64 * j); bb[j] = *((const f32x4*)b1 + lane + 64 * j); }
    for (int grp0 = F.bid * NWAVES; grp0 < NTOK / 16; grp0 += F.G * NWAVES) {
        const int row0 = (grp0 + F.wave) * 16;
        if (F.tid < 128) lcnt[F.tid] = 0u;
        for (int rb = 0; rb < 16; rb += 4) {
            f32x4 v[4][4]; float s[4], q[4];
#pragma unroll
            for (int a = 0; a < 4; ++a) { const u32x2* xr = (const u32x2*)(H1 + (size_t)(row0 + rb + a) * D) + lane;
#pragma unroll
                for (int j = 0; j < 4; ++j) { const u32x2 p = xr[64 * j]; v[a][j] = (f32x4){bf_lo(p.x), bf_hi(p.x), bf_lo(p.y), bf_hi(p.y)}; } }
#pragma unroll
            for (int a = 0; a < 4; ++a) { s[a] = 0.f;
#pragma unroll
                for (int j = 0; j < 4; ++j) s[a] += (v[a][j][0] + v[a][j][1]) + (v[a][j][2] + v[a][j][3]); }
#pragma unroll
            for (int o = 1; o < 64; o <<= 1) {
#pragma unroll
                for (int a = 0; a < 4; ++a) s[a] += __shfl_xor(s[a], o); }
#pragma unroll
            for (int a = 0; a < 4; ++a) { const float mean = s[a] * (1.f / D); q[a] = 0.f;
#pragma unroll
                for (int j = 0; j < 4; ++j) { v[a][j] = v[a][j] - mean; q[a] += (v[a][j][0] * v[a][j][0] + v[a][j][1] * v[a][j][1]) + (v[a][j][2] * v[a][j][2] + v[a][j][3] * v[a][j][3]); } }
#pragma unroll
            for (int o = 1; o < 64; o <<= 1) {
#pragma unroll
                for (int a = 0; a < 4; ++a) q[a] += __shfl_xor(q[a], o); }
            float am[4];
#pragma unroll
            for (int a = 0; a < 4; ++a) { const float rstd = 1.f / sqrtf(q[a] * (1.f / D) + LN_EPS); am[a] = 0.f;
#pragma unroll
                for (int j = 0; j < 4; ++j) { const f32x4 y = v[a][j] * rstd * gg[j] + bb[j]; v[a][j] = y;
                    am[a] = fmaxf(am[a], fmaxf(fmaxf(fabsf(y[0]), fabsf(y[1])), fmaxf(fabsf(y[2]), fabsf(y[3]))));
                    u32x2 o; o.x = cvt_pk_bf16(y[0], y[1]); o.y = cvt_pk_bf16(y[2], y[3]); *((u32x2*)(H1B + (size_t)(row0 + rb + a) * D) + lane + 64 * j) = o; } }
#pragma unroll
            for (int o = 1; o < 64; o <<= 1) {
#pragma unroll
                for (int a = 0; a < 4; ++a) am[a] = fmaxf(am[a], __shfl_xor(am[a], o)); }
#pragma unroll
            for (int a = 0; a < 4; ++a) { const float inv = am[a] > 0.f ? 127.0f / am[a] : 0.f;
                if (lane == 0) ((float*)(ws + WS_H1S))[row0 + rb + a] = am[a] > 0.f ? am[a] * (1.0f / 127.0f) : 1.0f;
#pragma unroll
                for (int j = 0; j < 4; ++j) { const f32x4 z = v[a][j] * inv;
                    const unsigned w = ((unsigned)(int)__builtin_rintf(z[0]) & 0xffu) | (((unsigned)(int)__builtin_rintf(z[1]) & 0xffu) << 8) | (((unsigned)(int)__builtin_rintf(z[2]) & 0xffu) << 16) | ((unsigned)(int)__builtin_rintf(z[3]) << 24);
                    *((unsigned*)(ws + WS_H1F8 + (size_t)(row0 + rb + a) * D) + lane + 64 * j) = w; } }
        }
        asm volatile("s_waitcnt vmcnt(0)" ::: "memory");
        f32x4 acc[5];
#pragma unroll
        for (int n = 0; n < 5; ++n) acc[n] = (f32x4){0.f, 0.f, 0.f, 0.f};
        const bf16_t* ap = H1B + (size_t)(row0 + (lane & 15)) * D + 8 * (lane >> 4);
        const bf16_t* bp = WRB + (size_t)(lane & 15) * D + 8 * (lane >> 4);
#pragma unroll 8
        for (int ks = 0; ks < 32; ++ks) {
            const pg8::bf16x8 a = *(const pg8::bf16x8*)(ap + 32 * ks);
#pragma unroll
            for (int n = 0; n < 5; ++n) { const pg8::bf16x8 bw = *(const pg8::bf16x8*)(bp + (size_t)n * 16 * D + 32 * ks); acc[n] = __builtin_amdgcn_mfma_f32_16x16x32_bf16(a, bw, acc[n], 0, 0, 0); }
        }
#pragma unroll
        for (int n = 0; n < 5; ++n)
#pragma unroll
            for (int i = 0; i < 4; ++i) lg[(4 * (lane >> 4) + i) * 80 + 16 * n + (lane & 15)] = acc[n][i];
        __syncthreads();
        int ea = 0, eb = 0; unsigned la = 0, lb = 0; float w1 = 0.f, w2 = 0.f;
        if (lane < 16) {
            const LAS float* l = lg + lane * 80;
            const float* brg = P.in[I_BRG]; const float* bre = P.in[I_BRE];
            int gs = 0; float gm = l[0] + brg[0];
            for (int i = 1; i < 8; ++i) { const float x = l[i] + brg[i]; if (x > gm) { gm = x; gs = i; } }
            float den = 0.f; for (int i = 0; i < 8; ++i) den += __expf(l[i] + brg[i] - gm);
            const float gwt = 1.0f / den;
            int i1 = 0; float l1 = l[8 + gs * 8] + bre[gs * 8];
            for (int i = 1; i < 8; ++i) { const float x = l[8 + gs * 8 + i] + bre[gs * 8 + i]; if (x > l1) { l1 = x; i1 = i; } }
            int i2 = -1; float l2 = 0.f;
            for (int i = 0; i < 8; ++i) { if (i == i1) continue; const float x = l[8 + gs * 8 + i] + bre[gs * 8 + i]; if (i2 < 0 || x > l2) { l2 = x; i2 = i; } }
            const float e2 = __expf(l2 - l1); w1 = gwt / (1.0f + e2); w2 = gwt * e2 / (1.0f + e2);
            ea = gs * 8 + i1; eb = gs * 8 + i2;
            la = atomicAdd((unsigned*)(lcnt + ea), 1u); lb = atomicAdd((unsigned*)(lcnt + eb), 1u);
        }
        __syncthreads();
        if (F.tid < 64) { const unsigned c = lcnt[F.tid]; lcnt[64 + F.tid] = c ? atomicAdd(ctl + CW_COUNTS + F.tid, c) : 0u; }
        __syncthreads();
        if (lane < 16) { const int row = row0 + lane;
            tok_e[2 * row] = ea; tok_e[2 * row + 1] = eb; tok_pos[2 * row] = (int)(lcnt[64 + ea] + la); tok_pos[2 * row + 1] = (int)(lcnt[64 + eb] + lb); tok_w[2 * row] = w1; tok_w[2 * row + 1] = w2; }
        __syncthreads();
    }
}

__device__ __forceinline__ void phase_gather(const Frame& F) {
    const Params& P = *F.p; unsigned char* ws = P.ws;
    const int* tok_e = (const int*)(ws + WS_MISC + MS_TOKE); const int* tok_pos = (const int*)(ws + WS_MISC + MS_TOKPOS); int* tok_dest = (int*)(ws + WS_MISC + MS_TOKDEST);
    const unsigned char* H1F = ws + WS_H1F8; unsigned char* XB = ws + WS_XBUF;
    LAS int* ps = (LAS int*)F.lds;
    if (F.tid == 0) {
        const unsigned* cnt = (const unsigned*)(ws + WS_CTL) + CW_COUNTS;
        int* tile_e = (int*)(ws + WS_MISC + MS_TILEE); int* ntl = (int*)(ws + WS_MISC + MS_NTILES);
        int run = 0;
        for (int e = 0; e < NEXP; ++e) { const int c = (int)cnt[e]; ps[e] = run * 256; const int nte = (c + 255) / 256; if (F.bid == 0) for (int k = 0; k < nte; ++k) tile_e[run + k] = e; run += nte; }
        if (F.bid == 0) ntl[0] = run;
    }
    __syncthreads();
    const int gw = F.bid * NWAVES + F.wave, NGW = F.G * NWAVES;
    for (int a = gw; a < NASSIGN; a += NGW) {
        const int dest = ps[tok_e[a]] + tok_pos[a];
        const u32x4* src = (const u32x4*)(H1F + (size_t)(a >> 1) * D) + F.lane; u32x4* dst = (u32x4*)(XB + (size_t)dest * D) + F.lane;
        dst[0] = src[0];
        if (F.lane == 0) { tok_dest[a] = dest; ((float*)(ws + WS_XSB))[dest] = ((const float*)(ws + WS_H1S))[a >> 1]; }
    }
    __syncthreads();
}

__device__ __forceinline__ void phase_combine(const Frame& F) {
    const Params& P = *F.p; unsigned char* ws = P.ws;
    const bf16_t* H1B = (const bf16_t*)(ws + WS_H1B); const bf16_t* YB = (const bf16_t*)(ws + WS_YBUF);
    const int* tok_dest = (const int*)(ws + WS_MISC + MS_TOKDEST); const float* tok_w = (const float*)(ws + WS_MISC + MS_TOKW);
    const int gw = F.bid * NWAVES + F.wave, NGW = F.G * NWAVES, lane = F.lane;
    const float* g2 = P.in[I_LN2G]; const float* b2 = P.in[I_LN2B];
    f32x4 gg[4], bb[4];
#pragma unroll
    for (int j = 0; j < 4; ++j) { gg[j] = *((const f32x4*)g2 + lane + 64 * j); bb[j] = *((const f32x4*)b2 + lane + 64 * j); }
    for (int row0 = gw * 4; row0 < NTOK; row0 += NGW * 4) {
        f32x4 v[4][4]; float s[4], q[4];
        u32x2 lx[4][4]; unsigned la[4][4], lb[4][4]; float w0[4], w1[4];
#pragma unroll
        for (int a = 0; a < 4; ++a) { const int row = row0 + a; const int d0 = tok_dest[2 * row], d1 = tok_dest[2 * row + 1]; w0[a] = tok_w[2 * row]; w1[a] = tok_w[2 * row + 1];
            const u32x2* xr = (const u32x2*)(H1B + (size_t)row * D) + lane;
            const unsigned* y0 = (const unsigned*)((const unsigned char*)YB + (size_t)d0 * D) + lane; const unsigned* y1 = (const unsigned*)((const unsigned char*)YB + (size_t)d1 * D) + lane;
            w0[a] *= 0.0625f; w1[a] *= 0.0625f;
#pragma unroll
            for (int j = 0; j < 4; ++j) { lx[a][j] = xr[64 * j]; la[a][j] = y0[64 * j]; lb[a][j] = y1[64 * j]; } }
#pragma unroll
        for (int a = 0; a < 4; ++a) { s[a] = 0.f;
#pragma unroll
            for (int j = 0; j < 4; ++j) { const u32x2 x = lx[a][j];
                const f32x2 a01 = __builtin_amdgcn_cvt_pk_f32_fp8((int)la[a][j], false), a23 = __builtin_amdgcn_cvt_pk_f32_fp8((int)la[a][j], true), b01 = __builtin_amdgcn_cvt_pk_f32_fp8((int)lb[a][j], false), b23 = __builtin_amdgcn_cvt_pk_f32_fp8((int)lb[a][j], true);
                v[a][j][0] = ALPHA * bf_lo(x.x) + (w0[a] * a01[0] + w1[a] * b01[0]); v[a][j][1] = ALPHA * bf_hi(x.x) + (w0[a] * a01[1] + w1[a] * b01[1]);
                v[a][j][2] = ALPHA * bf_lo(x.y) + (w0[a] * a23[0] + w1[a] * b23[0]); v[a][j][3] = ALPHA * bf_hi(x.y) + (w0[a] * a23[1] + w1[a] * b23[1]);
                s[a] += (v[a][j][0] + v[a][j][1]) + (v[a][j][2] + v[a][j][3]); } }
#pragma unroll
        for (int o = 1; o < 64; o <<= 1) {
#pragma unroll
            for (int a = 0; a < 4; ++a) s[a] += __shfl_xor(s[a], o); }
#pragma unroll
        for (int a = 0; a < 4; ++a) { const float mean = s[a] * (1.f / D); q[a] = 0.f;
#pragma unroll
            for (int j = 0; j < 4; ++j) { v[a][j] = v[a][j] - mean; q[a] += (v[a][j][0] * v[a][j][0] + v[a][j][1] * v[a][j][1]) + (v[a][j][2] * v[a][j][2] + v[a][j][3] * v[a][j][3]); } }
#pragma unroll
        for (int o = 1; o < 64; o <<= 1) {
#pragma unroll
            for (int a = 0; a < 4; ++a) q[a] += __shfl_xor(q[a], o); }
#pragma unroll
        for (int a = 0; a < 4; ++a) { const float rstd = 1.f / sqrtf(q[a] * (1.f / D) + LN_EPS);
            f32x4* orow = (f32x4*)(P.out + (size_t)(row0 + a) * D) + lane;
#pragma unroll
            for (int j = 0; j < 4; ++j) __builtin_nontemporal_store(v[a][j] * rstd * gg[j] + bb[j], orow + 64 * j); }
    }
}

constexpr int NPHASE = 15;
__global__ void __launch_bounds__(NTHR, 2) fwd_kernel(Params prm) {
    extern __shared__ __attribute__((aligned(16))) unsigned char lds_raw[];
    Frame F; F.lds = (LAS unsigned char*)lds_raw; F.tid = threadIdx.x; F.lane = F.tid & 63; F.wave = __builtin_amdgcn_readfirstlane(F.tid >> 6); F.G = gridDim.x; F.bid = blockIdx.x; F.p = &prm;
    unsigned char* ws = prm.ws;
    const int lo = prm.ph_lo, hi = prm.ph_hi;
    volatile LAS unsigned* MISC = (volatile LAS unsigned*)(F.lds + MISC_OFF);
    if (F.tid < 32) MISC[F.tid] = 0u;
    __syncthreads();
    if (lo < 0) cg::this_grid().sync();
    XcdBarrier bar; bar.bar = (unsigned*)(ws + WS_CTL) + CW_BAR; bar.x = 0; bar.st = nullptr;
    if (hi - lo > 1) bar = xcd_barrier_post((unsigned*)(ws + WS_CTL) + CW_BAR, MISC + 8);
#define IN(k) (lo <= (k) && (k) < hi)
#define SEAM(k) do { if (IN(k) && IN((k) + 1)) { xcd_barrier(bar); } } while (0)
#define PHASE(k, ...) do { if (IN(k)) { __VA_ARGS__ if (PROBE_PH == (k)) { xcd_barrier(bar); __VA_ARGS__ } } SEAM(k); } while (0);
    const bf16_t* Zc = (const bf16_t*)(ws + WS_Z);

    PHASE(0, { phase_prep(F); })
    PHASE(1, {
        pg8::StaticOrder S{NTOK / 256, INCOLS / 256, F.G, F.bid, (const char*)(ws + WS_XB), (const char*)(ws + WS_WIN), (size_t)256 * D, (size_t)256 * D, 0};
        EpiBf16 E{(bf16_t*)(ws + WS_Z), INCOLS, prm.in[I_BGATE], GATE0 / 256, GATE0, 1.0f, 4, 12, D, (const float*)(ws + WS_XS), (const float*)(ws + WS_SW), 0};
        pg8::gemm_phase<EpiBf16, pg8::StaticOrder, true, true, 2>(F.lds, D / 2, D / 2, D / 2, S, E);
    })
    PHASE(2, {
        pg8::KVOrder S{F.G, F.bid, (const char*)(ws + WS_MEMB), (const char*)(ws + WS_WKV)};
        EpiKV E{(bf16_t*)(ws + WS_KB), (bf16_t*)(ws + WS_VT)};
        pg8::gemm_phase<EpiKV, pg8::KVOrder, true, true>(F.lds, D, D, D, S, E);
        phase_convpool(F);
    })
    PHASE(4, { phase_attn<0>(F); if (PROBE_PH == 401) { xcd_barrier(bar); phase_attn<1>(F); } if (PROBE_PH == 402) { xcd_barrier(bar); phase_attn<2>(F); } if (PROBE_PH == 404) { xcd_barrier(bar); phase_attn<4>(F); } })
    PHASE(7, {
        pg8::SegOrder S{NTOK / 256, D / 256, F.G, F.bid, (const char*)(ws + WS_ACONV), (const char*)(ws + WS_DPOOL), (const char*)(ws + WS_O), (const char*)(ws + WS_WCAT), (size_t)256 * D * 2, (size_t)256 * KCAT * 2, (size_t)256 * 2};
        EpiMix3 E{(bf16_t*)(ws + WS_MERGED), Zc, prm.in[I_PSCALE], 0};
        pg8::gemm_phase<EpiMix3, pg8::SegOrder, true, true>(F.lds, KCAT, D, KCAT, S, E);
        if (PROBE_PH == 207) { xcd_barrier(bar); EpiMix3 E2{(bf16_t*)(ws + WS_XBUF), Zc, prm.in[I_PSCALE], 1}; pg8::gemm_phase<EpiMix3, pg8::SegOrder, true, true>(F.lds, KCAT, D, KCAT, S, E2); }
    })
    PHASE(8, {
        pg8::StaticOrder S{NTOK / 256, D / 256, F.G, F.bid, (const char*)(ws + WS_MERGED), (const char*)(ws + WS_WO), (size_t)256 * D * 2, (size_t)256 * D * 2, 0};
        EpiResBf16 E{(bf16_t*)(ws + WS_H1), prm.in[I_X], ALPHA};
        pg8::gemm_phase<EpiResBf16, pg8::StaticOrder, true, true>(F.lds, D, D, D, S, E);
    })
    PHASE(9, { phase_ln1_router(F); if (PROBE_PH == 300) { xcd_barrier(bar); xcd_barrier(bar); xcd_barrier(bar); xcd_barrier(bar); } })
    PHASE(11, { phase_gather(F); })
    PHASE(12, {
        const int ntl = *(const int*)(ws + WS_MISC + MS_NTILES);
        pg8::MoeOrder S{ntl, 4, F.G, F.bid, (const char*)(ws + WS_XBUF), (const char*)(ws + WS_WUP), (size_t)256 * D, (size_t)256 * D, (size_t)D * D, (const int*)(ws + WS_MISC + MS_TILEE)};
        EpiAct E{ws + WS_ACT, (const float*)(ws + WS_XSB), (const float*)(ws + WS_SWU)};
        pg8::gemm_phase<EpiAct, pg8::MoeOrder, true, true, 2>(F.lds, D / 2, D / 2, D / 2, S, E);
    })
    PHASE(13, {
        const int ntl = *(const int*)(ws + WS_MISC + MS_NTILES);
        pg8::MoeOrder S{ntl, 4, F.G, F.bid, (const char*)(ws + WS_ACT), (const char*)(ws + WS_WDN), (size_t)256 * DEXP, (size_t)256 * DEXP, (size_t)D * DEXP, (const int*)(ws + WS_MISC + MS_TILEE)};
        EpiBf16 E{(bf16_t*)(ws + WS_YBUF), D, nullptr, 1 << 30, 0, 0.03125f * 16.0f, 0, 0, 0, nullptr, nullptr, 1};
        pg8::gemm_phase<EpiBf16, pg8::MoeOrder, true, true, 1>(F.lds, DEXP / 2, DEXP / 2, DEXP / 2, S, E);
    })
    PHASE(14, { phase_combine(F); })
#undef IN
#undef SEAM
}

extern "C" void kernel_launch(void* const* d_in, const int* in_sizes, int n_in, void* d_out, int out_size, void* d_ws, size_t ws_size, hipStream_t stream) {
    static int grid = 0;
    if (grid == 0) {
        if (n_in != 21 || out_size != NTOK * D || ws_size < WS_END) { fprintf(stderr, "kernel_launch: unexpected shapes (n_in %d out %d ws %zu, need ws >= %zu)\n", n_in, out_size, ws_size, (size_t)WS_END); grid = -1; return; }
        int dev = 0, cus = 0, per_cu = 0;
        if (hipGetDevice(&dev) != hipSuccess || hipDeviceGetAttribute(&cus, hipDeviceAttributeMultiprocessorCount, dev) != hipSuccess) { grid = -1; return; }
        if (hipFuncSetAttribute((const void*)fwd_kernel, hipFuncAttributeMaxDynamicSharedMemorySize, LDS_BYTES) != hipSuccess) { fprintf(stderr, "kernel_launch: hipFuncSetAttribute failed\n"); grid = -1; return; }
        if (hipOccupancyMaxActiveBlocksPerMultiprocessor(&per_cu, (const void*)fwd_kernel, NTHR, LDS_BYTES) != hipSuccess || per_cu < 1) { fprintf(stderr, "kernel_launch: occupancy query says %d\n", per_cu); (void)hipGetLastError(); per_cu = 1; }
        grid = cus * 1;
        fprintf(stderr, "kernel_launch: cus %d per_cu %d grid %d\n", cus, per_cu, grid);
    }
    if (grid < 0) return;
    (void)hipMemsetAsync((char*)d_ws + WS_CTL, 0, CTL_ZERO_BYTES, stream);
    Params a{};
    for (int i = 0; i < 21; ++i) a.in[i] = (const float*)d_in[i];
    a.out = (float*)d_out; a.ws = (unsigned char*)d_ws;
#if MK_ONE_LAUNCH
    a.ph_lo = 0; a.ph_hi = NPHASE;
    void* args[] = {&a};
    hipError_t e = hipLaunchCooperativeKernel((const void*)fwd_kernel, dim3(grid), dim3(NTHR), args, LDS_BYTES, stream);
    if (e != hipSuccess) fprintf(stderr, "cooperative launch failed: %s (grid %d)\n", hipGetErrorString(e), grid);
#else
    for (int ph = 0; ph < NPHASE; ++ph) {
        a.ph_lo = ph; a.ph_hi = ph + 1;
        hipLaunchKernelGGL(fwd_kernel, dim3(grid), dim3(NTHR), LDS_BYTES, stream, a);
    }
#endif
}
```

```cpp
#include <hip/hip_runtime.h>
#include <hip/hip_cooperative_groups.h>
#include <cstdio>
#include <cstdint>
namespace cg = cooperative_groups;

#ifndef PROBE_PH
#define PROBE_PH -1
#endif
#ifndef STAG_G1
#define STAG_G1 0
#endif
#ifndef MK_ONE_LAUNCH
#define MK_ONE_LAUNCH 1
#endif

namespace pg8 {
#define PG8_LAS __attribute__((address_space(3)))
#define PG8_GAS __attribute__((address_space(1)))
typedef unsigned short bf16_t;
typedef short bf16x8 __attribute__((ext_vector_type(8)));
typedef float f32x4 __attribute__((ext_vector_type(4)));
typedef float f32x2 __attribute__((ext_vector_type(2)));
typedef unsigned u32x4 __attribute__((ext_vector_type(4)));
typedef unsigned u32x2 __attribute__((ext_vector_type(2)));
constexpr int BM = 256, BK = 64, HALF = 128, HTB = HALF * BK * 2  , STAGE_BYTES = 8 * HTB, NXCD = 8, WGM = 4;

__host__ __device__ __forceinline__ int lds_byte(int r, int c) { const int st = (r >> 4) * 2 + (c >> 5), rr = r & 15, cc = c & 31, ob = rr * 64 + cc * 2; return st * 1024 + (ob ^ (((ob >> 9) & 1) << 5)); }
__host__ __device__ __forceinline__ void stage_rc(int b, int& R, int& C) { const int st = b / 1024, sb = b % 1024, swz = sb ^ (((sb >> 9) & 1) << 5); R = (st >> 1) * 16 + swz / 64; C = (st & 1) * 32 + (swz % 64) / 2; }
__host__ __device__ __forceinline__ int perm32(int rho) { const int n = rho >> 4, i = rho & 15; return 8 * (i >> 2) + 4 * n + (i & 3); }

struct Unit { int pm, pn, kind; const char* a; const char* b; int nt, seg, fin; };

__device__ __forceinline__ void tile_of(int L, int nM, int nN, int& pm, int& pn) {
    const int nwg = nM * nN; int wgid = L;
    { const int q = nwg / NXCD, r = nwg % NXCD, xcd = wgid % NXCD, off = wgid / NXCD; wgid = (xcd < r ? xcd * (q + 1) : r * (q + 1) + (xcd - r) * q) + off; }
    const int nig = WGM * nN, gid = wgid / nig, fm = gid * WGM, gsz = (nM - fm) < WGM ? (nM - fm) : WGM;
    pm = fm + ((wgid % nig) % gsz); pn = (wgid % nig) / gsz;
}
struct StaticOrder {
    int nM, nN, G, c; const char* A; const char* B; size_t tA, tB, aN;
    __device__ __forceinline__ bool next(int i, Unit& u) const {
        const long L = (long)i * G + c; if (L >= (long)nM * nN) return false;
        tile_of((int)L, nM, nN, u.pm, u.pn); u.kind = 0;
        u.a = A + (size_t)u.pm * tA + (size_t)u.pn * aN; u.b = B + (size_t)u.pn * tB; return true;
    }
};
struct MoeOrder {
    int nM, nN, G, c; const char* A; const char* B; size_t tA, tB, eB; const int* tile_expert;
    __device__ __forceinline__ bool next(int i, Unit& u) const {
        const long L = (long)i * G + c; if (L >= (long)nM * nN) return false;
        tile_of((int)L, nM, nN, u.pm, u.pn); u.kind = 0;
        const int e = __builtin_amdgcn_readfirstlane(tile_expert[u.pm]); u.kind = e;
        u.a = A + (size_t)u.pm * tA; u.b = B + (size_t)e * eB + (size_t)u.pn * tB; return true;
    }
};

struct SegOrder {
    int nM, nN, G, c; const char* A; const char* A2; const char* A3; const char* B; size_t tA, tB, aN2;
    __device__ __forceinline__ bool next(int i, Unit& u) const {
        const int iu = i / 3, seg = i - 3 * iu;
        const long L = (long)iu * G + c; if (L >= (long)nM * nN) return false;
        tile_of((int)L, nM, nN, u.pm, u.pn); u.kind = 0; u.seg = seg; u.fin = (seg == 2); u.nt = (seg == 1) ? 4 : 16;
        u.a = (seg == 0 ? A : (seg == 1 ? A2 + (size_t)u.pn * aN2 : A3)) + (size_t)u.pm * tA;
        u.b = B + (size_t)u.pn * tB + (size_t)(seg == 0 ? 0 : (seg == 1 ? 1024 : 1280)) * 2; return true;
    }
};
struct KVOrder {
    int G, c; const char* memb; const char* wkv;
    __device__ __forceinline__ bool next(int i, Unit& u) const {
        const int L = i * G + c; if (L >= 64) return false;
        if (L < 32) { u.pm = L >> 2; u.pn = L & 3; u.kind = 0; u.a = memb + (size_t)u.pm * 256 * 2048; u.b = wkv + (size_t)u.pn * 256 * 2048; }
        else { const int j = L - 32; u.pm = j; u.pn = 0; u.kind = 1; u.a = wkv + (size_t)(1024 + (j & 3) * 256) * 2048; u.b = memb + (size_t)(j >> 2) * 256 * 2048; }
        return true;
    }
};

__device__ __forceinline__ unsigned cvt_pk_bf16(float lo, float hi) { unsigned r; asm volatile("v_cvt_pk_bf16_f32 %0, %1, %2" : "=v"(r) : "v"(lo), "v"(hi)); return r; }
__device__ __forceinline__ float bf_lo(unsigned w) { return __uint_as_float(w << 16); }
__device__ __forceinline__ float bf_hi(unsigned w) { return __uint_as_float(w & 0xffff0000u); }

typedef int i32x4 __attribute__((ext_vector_type(4)));
typedef int i32x8 __attribute__((ext_vector_type(8)));
typedef float f32x32 __attribute__((ext_vector_type(32)));
__device__ __forceinline__ i32x8 pg8_cat(const bf16x8 lo, const bf16x8 hi) { const i32x4 a = __builtin_bit_cast(i32x4, lo), b = __builtin_bit_cast(i32x4, hi); return __builtin_shufflevector(a, b, 0, 1, 2, 3, 4, 5, 6, 7); }
template <class Epi, class Sched, bool ALIGN_EPI = false, bool SP2 = false, int MODE = 0>
__device__ __forceinline__ void gemm_phase(PG8_LAS unsigned char* lds, const int K, const int lda, const int ldb, const Sched& S, const Epi& E) {
    const int tid = threadIdx.x, wid = __builtin_amdgcn_readfirstlane(tid >> 6), lane = tid & 63, wr = wid >> 2, wc = wid & 3, fr = lane & 15, fq = lane >> 4;
    constexpr bool FP8 = (MODE == 1), INT8 = (MODE == 2);
    const int nt = K / BK; constexpr int NST = Epi::NST;
    unsigned voffA[2], voffB[2];
#pragma unroll
    for (int i = 0; i < 2; ++i) { int R, C; stage_rc(tid * 16 + i * 8192, R, C); const int Rb = Epi::PERM ? ((R & ~31) + perm32(R & 31)) : R;
        voffA[i] = (unsigned)(R * lda + C) * 2u; voffB[i] = (unsigned)(Rb * ldb + C) * 2u; }
    const size_t kstep = (size_t)(BK * 2);
    const size_t hstepA = (size_t)HALF * lda * 2, hstepB = (size_t)HALF * ldb * 2;
    const unsigned ldsw = (unsigned)wid * 1024u;
    const int aoff = lds_byte(wr * 64 + fr, fq * 8), boff = lds_byte(wc * 32 + fr, fq * 8);
#define PG8_SA(b, h) (((b) * 2 + (h)) * HTB)
#define PG8_SB(b, h) ((4 + (b) * 2 + (h)) * HTB)
#define PG8_STAGE(bufoff, gbase, voff) do { _Pragma("unroll") for (int _i = 0; _i < 2; ++_i) \
        __builtin_amdgcn_global_load_lds((const PG8_GAS unsigned*)((const PG8_GAS char*)(gbase) + (voff)[_i]), (PG8_LAS unsigned*)(lds + (bufoff) + ldsw + _i * 8192), 16, 0, 0); } while (0)
#define PG8_LDA(dst, b, h) do { if constexpr (FP8) { _Pragma("unroll") for (int m = 0; m < 4; ++m) dst##8[m] = pg8_cat(*(const PG8_LAS bf16x8*)(lds + PG8_SA(b, h) + aoff + m * 2048), *(const PG8_LAS bf16x8*)(lds + PG8_SA(b, h) + aoff + m * 2048 + 1024)); } \
        else { _Pragma("unroll") for (int m = 0; m < 4; ++m) _Pragma("unroll") for (int k = 0; k < 2; ++k) dst[m][k] = *(const PG8_LAS bf16x8*)(lds + PG8_SA(b, h) + aoff + m * 2048 + k * 1024); } } while (0)
#define PG8_LDB(dst, b, h) do { if constexpr (FP8) { _Pragma("unroll") for (int n = 0; n < 2; ++n) dst##8[n] = pg8_cat(*(const PG8_LAS bf16x8*)(lds + PG8_SB(b, h) + boff + n * 2048), *(const PG8_LAS bf16x8*)(lds + PG8_SB(b, h) + boff + n * 2048 + 1024)); } \
        else { _Pragma("unroll") for (int n = 0; n < 2; ++n) _Pragma("unroll") for (int k = 0; k < 2; ++k) dst[n][k] = *(const PG8_LAS bf16x8*)(lds + PG8_SB(b, h) + boff + n * 2048 + k * 1024); } } while (0)
#define PG8_MMA(ai, bj, At, Bt) do { __builtin_amdgcn_s_setprio(1); \
        if constexpr (FP8) { _Pragma("unroll") for (int m = 0; m < 4; ++m) _Pragma("unroll") for (int n = 0; n < 2; ++n) { \
            const f32x4 _c = (f32x4){accv[ai][bj][(m * 2 + n) * 4], accv[ai][bj][(m * 2 + n) * 4 + 1], accv[ai][bj][(m * 2 + n) * 4 + 2], accv[ai][bj][(m * 2 + n) * 4 + 3]}; \
            const f32x4 _d = __builtin_amdgcn_mfma_scale_f32_16x16x128_f8f6f4(Bt##8[n], At##8[m], _c, 0, 0, 0, 0x7f7f7f7f, 0, 0x7f7f7f7f); \
            _Pragma("unroll") for (int _j = 0; _j < 4; ++_j) accv[ai][bj][(m * 2 + n) * 4 + _j] = _d[_j]; } } \
        else if constexpr (INT8) { _Pragma("unroll") for (int m = 0; m < 4; ++m) _Pragma("unroll") for (int n = 0; n < 2; ++n) _Pragma("unroll") for (int k = 0; k < 2; ++k) \
            acc[ai][bj][m][n] = __builtin_bit_cast(f32x4, __builtin_amdgcn_mfma_i32_16x16x64_i8(__builtin_bit_cast(i32x4, Bt[n][k]), __builtin_bit_cast(i32x4, At[m][k]), __builtin_bit_cast(i32x4, acc[ai][bj][m][n]), 0, 0, 0)); } \
        else { _Pragma("unroll") for (int m = 0; m < 4; ++m) _Pragma("unroll") for (int n = 0; n < 2; ++n) _Pragma("unroll") for (int k = 0; k < 2; ++k) \
            acc[ai][bj][m][n] = __builtin_amdgcn_mfma_f32_16x16x32_bf16(Bt[n][k], At[m][k], acc[ai][bj][m][n], 0, 0, 0); } \
        __builtin_amdgcn_s_setprio(0); } while (0)
#define PG8_WAIT_V(n) asm volatile("s_waitcnt vmcnt(" #n ")" ::: "memory")
#define PG8_WAIT_VN(n) asm volatile("s_waitcnt vmcnt(%0)" :: "n"(n) : "memory")
#define PG8_WAIT_L(n) asm volatile("s_waitcnt lgkmcnt(" #n ")" ::: "memory")
#define PG8_BAR __builtin_amdgcn_s_barrier()
#define PG8_SCHED __builtin_amdgcn_sched_barrier(0)
    Unit cur, nxt; int ui = 0;
    if (!S.next(0, cur)) return;
    f32x4 acc[2][2][4][2];
#pragma unroll
    for (int a = 0; a < 2; ++a)
#pragma unroll
        for (int b = 0; b < 2; ++b)
#pragma unroll
            for (int m = 0; m < 4; ++m)
#pragma unroll
                for (int n = 0; n < 2; ++n) acc[a][b][m][n] = (f32x4){0.f, 0.f, 0.f, 0.f};
    bf16x8 At[4][2], B0[2][2], B1[2][2]; i32x8 At8[4], B08[2], B18[2]; f32x32 accv[2][2];
    if constexpr (FP8) {
#pragma unroll
        for (int a = 0; a < 2; ++a)
#pragma unroll
            for (int b = 0; b < 2; ++b)
#pragma unroll
                for (int j = 0; j < 32; ++j) accv[a][b][j] = 0.f; }
    const char* cA = cur.a; const char* cB = cur.b;
    if constexpr (SP2) {
        PG8_STAGE(PG8_SB(0, 0), cB, voffB); PG8_STAGE(PG8_SB(0, 1), cB + hstepB, voffB); PG8_STAGE(PG8_SA(0, 0), cA, voffA); PG8_STAGE(PG8_SA(0, 1), cA + hstepA, voffA);
        if (wr == 1) PG8_BAR;
        PG8_WAIT_V(2); PG8_BAR;
        PG8_STAGE(PG8_SB(1, 0), cB + kstep, voffB); PG8_STAGE(PG8_SA(1, 0), cA + kstep, voffA); PG8_STAGE(PG8_SB(1, 1), cB + hstepB + kstep, voffB);
        PG8_WAIT_V(6); PG8_BAR;
    } else {
        PG8_STAGE(PG8_SB(0, 0), cB, voffB); PG8_STAGE(PG8_SA(0, 0), cA, voffA); PG8_STAGE(PG8_SB(0, 1), cB + hstepB, voffB); PG8_STAGE(PG8_SA(0, 1), cA + hstepA, voffA);
        if (wr == 1) PG8_BAR;
        PG8_WAIT_V(4); PG8_BAR;
        PG8_STAGE(PG8_SB(1, 0), cB + kstep, voffB); PG8_STAGE(PG8_SA(1, 0), cA + kstep, voffA); PG8_STAGE(PG8_SB(1, 1), cB + hstepB + kstep, voffB);
        PG8_WAIT_V(6); PG8_BAR;
    }
    for (;;) {
        const bool has_next = S.next(ui + 1, nxt);
        const char* nA = has_next ? nxt.a : cA; const char* nB = has_next ? nxt.b : cB;
        int ntc = nt; if constexpr (Epi::SEG) ntc = cur.nt;
        if constexpr (Epi::PREF) E.prefetch(cur, lds + 131072 + 1024 + wid * 256, tid);
#pragma nounroll
        for (int t = 0; t < ntc; t += 2) {
            const bool last = (t == ntc - 2);
            const char* a1 = cA + (size_t)(t + 1) * kstep;
            const char* a2 = last ? nA : cA + (size_t)(t + 2) * kstep; const char* b2 = last ? nB : cB + (size_t)(t + 2) * kstep;
            const char* a3 = a2 + kstep; const char* b3 = b2 + kstep;
            if constexpr (SP2) {
            const bool fresh = !FP8 && (NST > 0) && (t == 0) && (ui > 0);
            PG8_LDB(B0, 0, 0); PG8_LDB(B1, 0, 1); PG8_SCHED; PG8_LDA(At, 0, 0); PG8_STAGE(PG8_SA(1, 1), a1 + hstepA, voffA);
            if (fresh) PG8_WAIT_VN(8 + NST); else PG8_WAIT_V(8);
            PG8_WAIT_L(0); PG8_BAR; PG8_MMA(0, 0, At, B0); PG8_MMA(0, 1, At, B1); PG8_BAR; PG8_SCHED;
            PG8_LDA(At, 0, 1); PG8_STAGE(PG8_SB(0, 0), b2, voffB); PG8_STAGE(PG8_SB(0, 1), b2 + hstepB, voffB); PG8_STAGE(PG8_SA(0, 0), a2, voffA);
            if (fresh) PG8_WAIT_VN(8 + NST); else PG8_WAIT_V(8);
            PG8_WAIT_L(0); PG8_BAR; PG8_MMA(1, 0, At, B0); PG8_MMA(1, 1, At, B1); PG8_BAR; PG8_SCHED;
            PG8_LDB(B0, 1, 0); PG8_LDB(B1, 1, 1); PG8_SCHED; PG8_LDA(At, 1, 0); PG8_STAGE(PG8_SA(0, 1), a2 + hstepA, voffA);
            PG8_WAIT_V(8); PG8_WAIT_L(0); PG8_BAR; PG8_MMA(0, 0, At, B0); PG8_MMA(0, 1, At, B1); PG8_BAR; PG8_SCHED;
            PG8_LDA(At, 1, 1); PG8_STAGE(PG8_SB(1, 0), b3, voffB); PG8_STAGE(PG8_SB(1, 1), b3 + hstepB, voffB); PG8_STAGE(PG8_SA(1, 0), a3, voffA);
            PG8_WAIT_V(8); PG8_WAIT_L(0); PG8_BAR; PG8_MMA(1, 0, At, B0); PG8_MMA(1, 1, At, B1); PG8_BAR; PG8_SCHED;
            } else {
            PG8_LDB(B0, 0, 0); PG8_SCHED; PG8_LDA(At, 0, 0); PG8_STAGE(PG8_SA(1, 1), a1 + hstepA, voffA);
            PG8_WAIT_L(8); PG8_BAR; PG8_WAIT_L(0); PG8_MMA(0, 0, At, B0); PG8_BAR; PG8_SCHED;
            PG8_LDB(B1, 0, 1); PG8_STAGE(PG8_SB(0, 0), b2, voffB);
            PG8_BAR; PG8_WAIT_L(0); PG8_MMA(0, 1, At, B1); PG8_BAR;
            PG8_LDA(At, 0, 1); PG8_STAGE(PG8_SA(0, 0), a2, voffA);
            PG8_BAR; PG8_WAIT_L(0); PG8_MMA(1, 0, At, B0); PG8_BAR; PG8_SCHED;
            PG8_STAGE(PG8_SB(0, 1), b2 + hstepB, voffB);
            PG8_WAIT_V(6); PG8_BAR; PG8_MMA(1, 1, At, B1); PG8_BAR;
            PG8_LDB(B0, 1, 0); PG8_SCHED; PG8_LDA(At, 1, 0); PG8_STAGE(PG8_SA(0, 1), a2 + hstepA, voffA);
            PG8_WAIT_L(8); PG8_BAR; PG8_WAIT_L(0); PG8_MMA(0, 0, At, B0); PG8_BAR; PG8_SCHED;
            PG8_LDB(B1, 1, 1); PG8_STAGE(PG8_SB(1, 0), b3, voffB);
            PG8_BAR; PG8_WAIT_L(0); PG8_MMA(0, 1, At, B1); PG8_BAR;
            PG8_LDA(At, 1, 1); PG8_STAGE(PG8_SA(1, 0), a3, voffA);
            PG8_BAR; PG8_WAIT_L(0); PG8_MMA(1, 0, At, B0); PG8_BAR; PG8_SCHED;
            PG8_STAGE(PG8_SB(1, 1), b3 + hstepB, voffB);
            PG8_WAIT_V(6); PG8_BAR; PG8_MMA(1, 1, At, B1); PG8_BAR;
            }
        }
        if constexpr (ALIGN_EPI) { if (wr == 0) PG8_BAR; }
        if constexpr (FP8) {
#pragma unroll
            for (int a = 0; a < 2; ++a)
#pragma unroll
                for (int b = 0; b < 2; ++b)
#pragma unroll
                    for (int m = 0; m < 4; ++m)
#pragma unroll
                        for (int n = 0; n < 2; ++n) { acc[a][b][m][n] = (f32x4){accv[a][b][(m * 2 + n) * 4], accv[a][b][(m * 2 + n) * 4 + 1], accv[a][b][(m * 2 + n) * 4 + 2], accv[a][b][(m * 2 + n) * 4 + 3]}; }
#pragma unroll
            for (int a = 0; a < 2; ++a)
#pragma unroll
                for (int b = 0; b < 2; ++b)
#pragma unroll
                    for (int j = 0; j < 32; ++j) accv[a][b][j] = 0.f; }
        if constexpr (INT8) {
#pragma unroll
            for (int a = 0; a < 2; ++a)
#pragma unroll
                for (int b = 0; b < 2; ++b)
#pragma unroll
                    for (int m = 0; m < 4; ++m)
#pragma unroll
                        for (int n = 0; n < 2; ++n) { const i32x4 iv = __builtin_bit_cast(i32x4, acc[a][b][m][n]); acc[a][b][m][n] = (f32x4){(float)iv[0], (float)iv[1], (float)iv[2], (float)iv[3]}; } }
        bool fin = true;
        if constexpr (Epi::SEG) { fin = cur.fin != 0; if (fin) E(acc, cur, wr, wc, fr, fq); else E.mid(acc, cur, cur.seg + 1, wr, wc, fr, fq); } else E(acc, cur, wr, wc, fr, fq);
        if (!has_next) break;
        if (fin) {
#pragma unroll
        for (int a = 0; a < 2; ++a)
#pragma unroll
            for (int b = 0; b < 2; ++b)
#pragma unroll
                for (int m = 0; m < 4; ++m)
#pragma unroll
                    for (int n = 0; n < 2; ++n) acc[a][b][m][n] = (f32x4){0.f, 0.f, 0.f, 0.f};
        }
        cur = nxt; cA = nA; cB = nB; ++ui;
        if constexpr (ALIGN_EPI) { if (wr == 1) PG8_BAR; }
    }
    PG8_WAIT_V(0);
    if constexpr (!ALIGN_EPI) { if (wr == 0) PG8_BAR; }
    PG8_BAR;
#undef PG8_SA
#undef PG8_SB
#undef PG8_STAGE
#undef PG8_LDA
#undef PG8_LDB
#undef PG8_MMA
#undef PG8_WAIT_V
#undef PG8_WAIT_VN
#undef PG8_WAIT_L
#undef PG8_BAR
#undef PG8_SCHED
}
}
using pg8::bf16_t; using pg8::f32x4; using pg8::f32x2; using pg8::u32x4; using pg8::u32x2; using pg8::Unit; using pg8::cvt_pk_bf16; using pg8::bf_lo; using pg8::bf_hi;
#define LAS __attribute__((address_space(3)))

constexpr int D = 1024, BATCH = 8, SEQ = 4096, NTOK = BATCH * SEQ, MEMLEN = 256, NMEM = BATCH * MEMLEN;
constexpr int INCOLS = 8192, GATE0 = 5120;
constexpr int NEXP = 64, DEXP = 512, NGRP = 8, EPG = 8;
constexpr int NASSIGN = NTOK * 2, PMAX_TILES = 320, PMAX = PMAX_TILES * 256;
constexpr float ALPHA = 1.189207115002721f;
constexpr float LN_EPS = 1e-5f;
constexpr int NWAVES = 8, NTHR = 512;

constexpr size_t MiB = 1u << 20;
constexpr size_t WS_CTL = 0, CTL_ZERO_BYTES = 1 * MiB;
constexpr size_t WS_WIN = 1 * MiB, WS_WKV = 17 * MiB, WS_WCAT = 21 * MiB, WS_WO = 26 * MiB, WS_WR = 28 * MiB;
constexpr int KCAT = 2304;
constexpr size_t WS_WUP = 29 * MiB, WS_WDN = 157 * MiB, WS_MISC = 221 * MiB;
constexpr size_t WS_Z = 224 * MiB;
constexpr size_t WS_XB = 736 * MiB, WS_MEMB = 800 * MiB, WS_KV = 804 * MiB, WS_ACONV = 812 * MiB, WS_DPOOL = 876 * MiB, WS_MERGED = 940 * MiB;
constexpr size_t WS_KB = WS_KV, WS_VT = WS_KV + 4 * MiB;
constexpr size_t WS_XS = WS_MISC + 3 * (MiB / 2), WS_SW = WS_MISC + 7 * (MiB / 4);
constexpr size_t WS_SWU = WS_MISC + 2 * MiB;
constexpr size_t WS_XSB = WS_MISC + 9 * (MiB / 4), WS_H1S = WS_MISC + 21 * (MiB / 8);
constexpr size_t WS_O = WS_XB;
constexpr size_t WS_H1 = 224 * MiB;
constexpr size_t WS_H1B = 480 * MiB;
constexpr size_t WS_XBUF = 544 * MiB;
constexpr size_t WS_H1F8 = 640 * MiB;
constexpr size_t WS_ACT = 736 * MiB;
constexpr size_t WS_YBUF = 816 * MiB;
constexpr size_t WS_END = 1004 * MiB;
constexpr size_t MS_TOKE = 0, MS_TOKPOS = MS_TOKE + NASSIGN * 4, MS_TOKW = MS_TOKPOS + NASSIGN * 4, MS_TOKDEST = MS_TOKW + NASSIGN * 4, MS_TILEE = MS_TOKDEST + NASSIGN * 4, MS_PSTART = MS_TILEE + 4096, MS_NTILES = MS_PSTART + 1024;
constexpr int CW_COUNTS = 1024;
constexpr int CW_CPCTR = 1152, CW_CPCTR2 = 1216, CW_WDCTR = 1280;
constexpr int CP_CHUNKS = (NTOK / 16) * (D / 8) / NTHR, CP_EARLY = 180;
constexpr int NATT = 192;
constexpr int CW_BAR = 4096;

constexpr int LDS_BYTES = 147456, MISC_OFF = 131072 + 320;

struct Params { const float* in[21]; float* out; unsigned char* ws; int ph_lo, ph_hi; };
enum { I_X = 0, I_MEM, I_WIN, I_BGATE, I_CONVW, I_WCONV, I_WPOOL, I_PSCALE, I_WKV, I_WXO, I_WO, I_LN1G, I_LN1B, I_WRG, I_BRG, I_WRE, I_BRE, I_WUP, I_WDN, I_LN2G, I_LN2B };

__device__ __forceinline__ unsigned f2bf(float f) { unsigned u = __float_as_uint(f); return (u + 0x7fffu + ((u >> 16) & 1u)) >> 16; }
__device__ __forceinline__ unsigned pk2(float lo, float hi) { return f2bf(lo) | (f2bf(hi) << 16); }
__device__ __forceinline__ float wave_sum(float v) {
#pragma unroll
    for (int o = 1; o < 64; o <<= 1) v += __shfl_xor(v, o);
    return v;
}
__device__ __forceinline__ float sigmoidf_(float x) { return __builtin_amdgcn_rcpf(1.0f + __expf(-x)); }


#define XB_TMO      128
#define XB_XCNT(j)  (256  + 64 * (j))
#define XB_XSUB(j)  (1280 + 64 * (j))
#define XB_XGEN(j)  (2304 + 64 * (j))
#define XB_TOP      3328
#define XB_TOPGEN   3392
#define XCD_BAR_WORDS 3456
#define XB_SPIN_CAP (1u << 18)
__device__ __forceinline__ unsigned xb_ld(unsigned* p)              { return __hip_atomic_load(p, __ATOMIC_RELAXED, __HIP_MEMORY_SCOPE_AGENT); }
__device__ __forceinline__ unsigned xb_add(unsigned* p, unsigned v) { return __hip_atomic_fetch_add(p, v, __ATOMIC_RELAXED, __HIP_MEMORY_SCOPE_AGENT); }
__device__ __forceinline__ unsigned xb_xcc_id() { return (unsigned)__builtin_amdgcn_s_getreg((3 << 11) | 20) & 0xFu; }
#define XB_SPIN(cond, bar) do { unsigned _sp = 0; while (cond) { __builtin_amdgcn_s_sleep(1); \
    if ((++_sp & 255u) == 0u) { if (xb_ld(&(bar)[XB_TMO])) break; if (_sp > XB_SPIN_CAP) { atomicAdd(&(bar)[XB_TMO], 1u); break; } } } } while (0)
struct XcdBarrier { unsigned* bar; unsigned x; volatile LAS unsigned* st; };
__device__ __forceinline__ XcdBarrier xcd_barrier_post(unsigned* bar, volatile LAS unsigned* st) {
    XcdBarrier b; b.bar = bar; b.x = xb_xcc_id(); b.st = st;
    if (threadIdx.x == 0) (void)xb_add(&bar[XB_XCNT(b.x)], 1u);
    return b;
}
__device__ __forceinline__ void xcd_barrier_complete(unsigned* bar, unsigned x, unsigned& nloc, unsigned& nx) {
    const unsigned G = gridDim.x * gridDim.y * gridDim.z;
    unsigned sum, cnt, mine, sp = 0u;
    for (;;) {
        sum = 0u; cnt = 0u; mine = 0u;
#pragma unroll
        for (unsigned j = 0; j < 16; ++j) { const unsigned c = xb_ld(&bar[XB_XCNT(j)]); sum += c; cnt += (c > 0u) ? 1u : 0u; mine = (j == x) ? c : mine; }
        if (sum == G) break;
        __builtin_amdgcn_s_sleep(1);
        if ((++sp & 255u) == 0u) { if (xb_ld(&bar[XB_TMO])) break; if (sp > XB_SPIN_CAP) { atomicAdd(&bar[XB_TMO], 1u); break; } }
    }
    nloc = mine > 0u ? mine : 1u; nx = cnt > 0u ? cnt : 1u;
}
__device__ __forceinline__ void xcd_barrier(const XcdBarrier& b) {
    asm volatile("s_waitcnt vmcnt(0)" ::: "memory");
    __syncthreads();
    if (threadIdx.x == 0) {
        unsigned* bar = b.bar;
        __builtin_amdgcn_s_waitcnt(0);
        unsigned nloc = b.st[0], nx = b.st[1];
        if (nloc == 0u) { xcd_barrier_complete(bar, b.x, nloc, nx); b.st[0] = nloc; b.st[1] = nx; }
        const unsigned old = xb_add(&bar[XB_XSUB(b.x)], 1u);
        const unsigned gen = old / nloc;
        if (old + 1u == (gen + 1u) * nloc) {
            __builtin_amdgcn_fence(__ATOMIC_RELEASE, "agent");
            asm volatile("s_waitcnt vmcnt(0)" ::: "memory");
            const unsigned og = xb_add(&bar[XB_TOP], 1u);
            const unsigned tg = og / nx;
            if (og + 1u == (tg + 1u) * nx) xb_add(&bar[XB_TOPGEN], 1u);
            else XB_SPIN(xb_ld(&bar[XB_TOPGEN]) == tg, bar);
            __builtin_amdgcn_fence(__ATOMIC_ACQUIRE, "agent");
            xb_add(&bar[XB_XGEN(b.x)], 1u);
            asm volatile("s_waitcnt vmcnt(0)" ::: "memory");
        } else {
            XB_SPIN(xb_ld(&bar[XB_XGEN(b.x)]) == gen, bar);
            __builtin_amdgcn_fence(__ATOMIC_ACQUIRE, "agent");
            asm volatile("s_waitcnt vmcnt(0)" ::: "memory");
        }
    }
    __syncthreads();
}

__device__ __forceinline__ void stagger_delay(unsigned ticks) {
    const unsigned long long t0 = __builtin_amdgcn_s_memrealtime();
    while (__builtin_amdgcn_s_memrealtime() - t0 < (unsigned long long)ticks) __builtin_amdgcn_s_sleep(4);
}

template <int LPR> __device__ __forceinline__ void touch_tile(const char* base, size_t pitch, LAS unsigned char* junk, int tid) {
#pragma unroll
    for (int i = 0; i < (256 * LPR) / 512; ++i) { const int ln = i * 512 + tid, r = ln / LPR, c = ln % LPR;
        __builtin_amdgcn_global_load_lds((const PG8_GAS unsigned*)(base + (size_t)r * pitch + c * 128), (LAS unsigned*)junk, 4, 0, 0); }
}

struct EpiBf16 {
    static constexpr bool PERM = true, SEG = false, PREF = false; static constexpr int NST = 8;
    bf16_t* O; int ldc; const float* bias; int gate_pn; int gate_col0; float oscale; int mul_pn0, mul_pn1, mul_col0; const float* rs; const float* cs; int f8out;
    __device__ __forceinline__ void operator()(const f32x4 (&acc)[2][2][4][2], const Unit& u, int wr, int wc, int fr, int fq) const {
        const int row0 = u.pm * 256 + wr * 64 + fr, col0 = u.pn * 256 + wc * 32 + 8 * fq;
        f32x4 cv[2][2]; float rv[2][4];
#pragma unroll
        for (int bj = 0; bj < 2; ++bj)
#pragma unroll
            for (int n = 0; n < 2; ++n) cv[bj][n] = cs ? *(const f32x4*)(cs + col0 + bj * 128 + 4 * n) : (f32x4){1.f, 1.f, 1.f, 1.f};
#pragma unroll
        for (int ai = 0; ai < 2; ++ai)
#pragma unroll
            for (int m = 0; m < 4; ++m) rv[ai][m] = (rs ? rs[row0 + ai * 128 + m * 16] : 1.0f) * oscale;
        if (u.pn >= mul_pn0 && u.pn < mul_pn1) {
            const int mc = mul_col0 + (u.pn - mul_pn0) * 128 + wc * 32 + 8 * fq;
#pragma unroll
            for (int ai = 0; ai < 2; ++ai)
#pragma unroll
                for (int m = 0; m < 4; ++m) { const float r2 = rv[ai][m] * rv[ai][m];
                    const f32x4 v0 = (acc[ai][0][m][0] * cv[0][0]) * (acc[ai][1][m][0] * cv[1][0]) * r2, v1 = (acc[ai][0][m][1] * cv[0][1]) * (acc[ai][1][m][1] * cv[1][1]) * r2;
                    u32x4 w; w.x = cvt_pk_bf16(v0[0], v0[1]); w.y = cvt_pk_bf16(v0[2], v0[3]); w.z = cvt_pk_bf16(v1[0], v1[1]); w.w = cvt_pk_bf16(v1[2], v1[3]);
                    __builtin_nontemporal_store(w, (u32x4*)(O + (size_t)(row0 + ai * 128 + m * 16) * ldc + mc)); }
            return;
        }
        const bool gate = u.pn >= gate_pn;
        f32x4 bv[2][2];
#pragma unroll
        for (int bj = 0; bj < 2; ++bj)
#pragma unroll
            for (int n = 0; n < 2; ++n) bv[bj][n] = gate ? *(const f32x4*)(bias + (col0 - gate_col0) + bj * 128 + 4 * n) : (f32x4){0.f, 0.f, 0.f, 0.f};
#pragma unroll
        for (int ai = 0; ai < 2; ++ai)
#pragma unroll
            for (int m = 0; m < 4; ++m) { bf16_t* rowp = O + (size_t)(row0 + ai * 128 + m * 16) * ldc + col0;
#pragma unroll
                for (int bj = 0; bj < 2; ++bj) { f32x4 v0 = acc[ai][bj][m][0] * (cv[bj][0] * rv[ai][m]) + bv[bj][0], v1 = acc[ai][bj][m][1] * (cv[bj][1] * rv[ai][m]) + bv[bj][1];
                    if (gate) {
                        unsigned q0 = 0u, q1 = 0u;
#pragma unroll
                        for (int j = 0; j < 4; ++j) { q0 = __builtin_amdgcn_cvt_pk_u8_f32(fmaxf(__builtin_floorf(sigmoidf_(v0[j]) * 255.0f + 0.5f), 1.0f), j, q0); q1 = __builtin_amdgcn_cvt_pk_u8_f32(fmaxf(__builtin_floorf(sigmoidf_(v1[j]) * 255.0f + 0.5f), 1.0f), j, q1); }
                        u32x2 w8; w8.x = q0; w8.y = q1;
                        *(u32x2*)((unsigned char*)(O + (size_t)(row0 + ai * 128 + m * 16) * ldc) + 2 * gate_col0 + (col0 - gate_col0) + bj * 128) = w8;
                        continue; }
                    if (f8out) { u32x2 w8; { int q = __builtin_amdgcn_cvt_pk_fp8_f32(v0[0], v0[1], 0, false); q = __builtin_amdgcn_cvt_pk_fp8_f32(v0[2], v0[3], q, true); w8.x = (unsigned)q; }
                        { int q = __builtin_amdgcn_cvt_pk_fp8_f32(v1[0], v1[1], 0, false); q = __builtin_amdgcn_cvt_pk_fp8_f32(v1[2], v1[3], q, true); w8.y = (unsigned)q; }
                        *(u32x2*)((unsigned char*)O + (size_t)(row0 + ai * 128 + m * 16) * ldc + col0 + bj * 128) = w8; continue; }
                    u32x4 w; w.x = cvt_pk_bf16(v0[0], v0[1]); w.y = cvt_pk_bf16(v0[2], v0[3]); w.z = cvt_pk_bf16(v1[0], v1[1]); w.w = cvt_pk_bf16(v1[2], v1[3]);
                    __builtin_nontemporal_store(w, (u32x4*)(rowp + bj * 128)); } }
    }
};
struct EpiKV {
    static constexpr bool PERM = true, SEG = false, PREF = false; static constexpr int NST = 0;
    bf16_t* KB; bf16_t* VT;
    __device__ __forceinline__ void operator()(const f32x4 (&acc)[2][2][4][2], const Unit& u, int wr, int wc, int fr, int fq) const {
        const int row0 = u.pm * 256 + wr * 64 + fr, col0 = u.pn * 256 + wc * 32 + 8 * fq;
#pragma unroll
        for (int ai = 0; ai < 2; ++ai)
#pragma unroll
            for (int m = 0; m < 4; ++m) { const size_t row = (size_t)(row0 + ai * 128 + m * 16);
#pragma unroll
                for (int bj = 0; bj < 2; ++bj) { const f32x4 v0 = acc[ai][bj][m][0], v1 = acc[ai][bj][m][1];
                    u32x4 w; w.x = cvt_pk_bf16(v0[0], v0[1]); w.y = cvt_pk_bf16(v0[2], v0[3]); w.z = cvt_pk_bf16(v1[0], v1[1]); w.w = cvt_pk_bf16(v1[2], v1[3]);
                    if (u.kind == 0) { *(u32x4*)(KB + row * D + col0 + bj * 128) = w; }
                    else { const int k0 = col0 + bj * 128, base = k0 & ~15, hi8 = (k0 & 8) ? 1 : 0;
                        u32x2 lo2; lo2.x = w.x; lo2.y = w.y; u32x2 hi2; hi2.x = w.z; hi2.y = w.w;
                        *(u32x2*)(VT + row * 256 + base + (hi8 ? 4 : 0)) = lo2; *(u32x2*)(VT + row * 256 + base + (hi8 ? 12 : 8)) = hi2; } } }
    }
};
template <int MODE> struct EpiProbe { static constexpr bool PERM = true, SEG = false, PREF = false; static constexpr int NST = 0;
    bf16_t* O; int flag;
    __device__ __forceinline__ void operator()(const f32x4 (&acc)[2][2][4][2], const Unit& u, int wr, int wc, int fr, int fq) const {
        const int row0 = (MODE == 1 ? 0 : u.pm * 256) + wr * 64 + fr, col0 = (MODE == 1 ? 0 : u.pn * 256) + wc * 32 + 8 * fq;
#pragma unroll
        for (int ai = 0; ai < 2; ++ai)
#pragma unroll
            for (int m = 0; m < 4; ++m) { bf16_t* rowp = O + (size_t)(row0 + ai * 128 + m * 16) * 2048 + col0;
#pragma unroll
                for (int bj = 0; bj < 2; ++bj) { const f32x4 v0 = acc[ai][bj][m][0], v1 = acc[ai][bj][m][1];
                    u32x4 w; w.x = cvt_pk_bf16(v0[0], v0[1]); w.y = cvt_pk_bf16(v0[2], v0[3]); w.z = cvt_pk_bf16(v1[0], v1[1]); w.w = cvt_pk_bf16(v1[2], v1[3]);
                    if (MODE == 1 || flag == 12345) __builtin_nontemporal_store(w, (u32x4*)(rowp + bj * 128)); } }
    }
};
struct EpiNull { static constexpr bool PERM = true, SEG = false, PREF = false; static constexpr int NST = 0;
    __device__ __forceinline__ void operator()(const f32x4 (&acc)[2][2][4][2], const Unit& u, int wr, int wc, int fr, int fq) const {
        float s = 0.f;
#pragma unroll
        for (int ai = 0; ai < 2; ++ai)
#pragma unroll
            for (int bj = 0; bj < 2; ++bj)
#pragma unroll
                for (int m = 0; m < 4; ++m)
#pragma unroll
                    for (int n = 0; n < 2; ++n) s += acc[ai][bj][m][n][0] + acc[ai][bj][m][n][1] + acc[ai][bj][m][n][2] + acc[ai][bj][m][n][3];
        if (s == 123456.789f) *sink = s;
    }
    float* sink;
};
template <int MODE> struct EpiMerge {
    static constexpr bool PERM = true, SEG = false, PREF = false; static constexpr int NST = 0;
    bf16_t* Mg; const bf16_t* Z; int gcol0; const float* scale;
    __device__ __forceinline__ void operator()(const f32x4 (&acc)[2][2][4][2], const Unit& u, int wr, int wc, int fr, int fq) const {
        const int row0 = u.pm * 256 + wr * 64 + fr, col0 = u.pn * 256 + wc * 32 + 8 * fq;
        f32x4 sv[2][2];
#pragma unroll
        for (int bj = 0; bj < 2; ++bj)
#pragma unroll
            for (int n = 0; n < 2; ++n) sv[bj][n] = scale ? *(const f32x4*)(scale + col0 + bj * 128 + 4 * n) : (f32x4){1.f, 1.f, 1.f, 1.f};
#pragma unroll
        for (int ai = 0; ai < 2; ++ai)
#pragma unroll
            for (int m = 0; m < 4; ++m) { const size_t row = (size_t)(row0 + ai * 128 + m * 16);
#pragma unroll
                for (int bj = 0; bj < 2; ++bj) {
                    const u32x4 g = *(const u32x4*)(Z + row * INCOLS + gcol0 + col0 + bj * 128);
                    f32x4 v0 = acc[ai][bj][m][0] * sv[bj][0], v1 = acc[ai][bj][m][1] * sv[bj][1];
                    v0[0] *= bf_lo(g.x); v0[1] *= bf_hi(g.x); v0[2] *= bf_lo(g.y); v0[3] *= bf_hi(g.y);
                    v1[0] *= bf_lo(g.z); v1[1] *= bf_hi(g.z); v1[2] *= bf_lo(g.w); v1[3] *= bf_hi(g.w);
                    u32x4* mp = (u32x4*)(Mg + row * D + col0 + bj * 128);
                    if (MODE) { const u32x4 o = *mp;
                        v0[0] += bf_lo(o.x); v0[1] += bf_hi(o.x); v0[2] += bf_lo(o.y); v0[3] += bf_hi(o.y);
                        v1[0] += bf_lo(o.z); v1[1] += bf_hi(o.z); v1[2] += bf_lo(o.w); v1[3] += bf_hi(o.w); }
                    u32x4 w; w.x = cvt_pk_bf16(v0[0], v0[1]); w.y = cvt_pk_bf16(v0[2], v0[3]); w.z = cvt_pk_bf16(v1[0], v1[1]); w.w = cvt_pk_bf16(v1[2], v1[3]);
                    *mp = w; } }
    }
};
struct EpiMix3 {
    static constexpr bool PERM = true, SEG = true, PREF = false; static constexpr int T1 = 16, T2 = 20, NST = 0;
    bf16_t* Mg; const bf16_t* Z; const float* pscale; int light;
    __device__ __forceinline__ static f32x4 ub4(unsigned w) { return (f32x4){(float)(w & 0xffu), (float)((w >> 8) & 0xffu), (float)((w >> 16) & 0xffu), (float)(w >> 24)}; }
    __device__ __forceinline__ void mid(f32x4 (&acc)[2][2][4][2], const Unit& u, int seg, int wr, int wc, int fr, int fq) const {
        if (light) {
#pragma unroll
            for (int ai = 0; ai < 2; ++ai)
#pragma unroll
                for (int bj = 0; bj < 2; ++bj)
#pragma unroll
                    for (int m = 0; m < 4; ++m)
#pragma unroll
                        for (int n = 0; n < 2; ++n) acc[ai][bj][m][n] = acc[ai][bj][m][n] * 1.0001f;
            return; }
        const int row0 = u.pm * 256 + wr * 64 + fr, col0 = u.pn * 256 + wc * 32 + 8 * fq;
        const bool s1 = (seg == 1);
        f32x4 sr[2][2];
#pragma unroll
        for (int bj = 0; bj < 2; ++bj)
#pragma unroll
            for (int n = 0; n < 2; ++n) { const f32x4 ps = *(const f32x4*)(pscale + col0 + bj * 128 + 4 * n);
#pragma unroll
                for (int j = 0; j < 4; ++j) sr[bj][n][j] = s1 ? __builtin_amdgcn_rcpf(ps[j]) : ps[j]; }
        const unsigned char* zb = (const unsigned char*)Z + 2 * GATE0 + col0;
        const unsigned char* zn = zb + (s1 ? 0 : D); const unsigned char* zd = zb + (s1 ? D : 2 * D);
#pragma unroll
        for (int ai = 0; ai < 2; ++ai)
#pragma unroll
            for (int m = 0; m < 4; ++m) { const size_t rb = (size_t)(row0 + ai * 128 + m * 16) * (2 * INCOLS);
#pragma unroll
                for (int bj = 0; bj < 2; ++bj) {
                    const u32x2 gn = *(const u32x2*)(zn + rb + bj * 128), gd = *(const u32x2*)(zd + rb + bj * 128);
                    const f32x4 n0 = ub4(gn.x) * sr[bj][0], n1 = ub4(gn.y) * sr[bj][1], d0 = ub4(gd.x), d1 = ub4(gd.y);
#pragma unroll
                    for (int j = 0; j < 4; ++j) { acc[ai][bj][m][0][j] *= n0[j] * __builtin_amdgcn_rcpf(d0[j]); acc[ai][bj][m][1][j] *= n1[j] * __builtin_amdgcn_rcpf(d1[j]); } }
                asm volatile("" ::: "memory"); }
    }
    __device__ __forceinline__ void operator()(const f32x4 (&acc)[2][2][4][2], const Unit& u, int wr, int wc, int fr, int fq) const {
        const int row0 = u.pm * 256 + wr * 64 + fr, col0 = u.pn * 256 + wc * 32 + 8 * fq;
        const unsigned char* zg = (const unsigned char*)Z + 2 * GATE0 + 2 * D + col0;
#pragma unroll
        for (int ai = 0; ai < 2; ++ai)
#pragma unroll
            for (int m = 0; m < 4; ++m) { const size_t row = (size_t)(row0 + ai * 128 + m * 16);
#pragma unroll
                for (int bj = 0; bj < 2; ++bj) {
                    const u32x2 g = *(const u32x2*)(zg + row * (2 * INCOLS) + bj * 128);
                    const f32x4 v0 = acc[ai][bj][m][0] * (ub4(g.x) * (1.0f / 255.0f)), v1 = acc[ai][bj][m][1] * (ub4(g.y) * (1.0f / 255.0f));
                    u32x4 w; w.x = cvt_pk_bf16(v0[0], v0[1]); w.y = cvt_pk_bf16(v0[2], v0[3]); w.z = cvt_pk_bf16(v1[0], v1[1]); w.w = cvt_pk_bf16(v1[2], v1[3]);
                    *(u32x4*)(Mg + row * D + col0 + bj * 128) = w; } }
    }
};
struct EpiResBf16 {
    static constexpr bool PERM = true, SEG = false, PREF = false; static constexpr int NST = 12;
    bf16_t* O; const float* base; float alpha;
    __device__ __forceinline__ void operator()(const f32x4 (&acc)[2][2][4][2], const Unit& u, int wr, int wc, int fr, int fq) const {
        const int row0 = u.pm * 256 + wr * 64 + fr, col0 = u.pn * 256 + wc * 32 + 8 * fq;
#pragma unroll
        for (int ai = 0; ai < 2; ++ai)
#pragma unroll
            for (int m = 0; m < 4; ++m) { const size_t off = (size_t)(row0 + ai * 128 + m * 16) * D + col0;
#pragma unroll
                for (int bj = 0; bj < 2; ++bj) { const f32x4 b0 = *(const f32x4*)(base + off + bj * 128), b1 = *(const f32x4*)(base + off + bj * 128 + 4);
                    const f32x4 v0 = b0 * alpha + acc[ai][bj][m][0], v1 = b1 * alpha + acc[ai][bj][m][1];
                    u32x4 w; w.x = cvt_pk_bf16(v0[0], v0[1]); w.y = cvt_pk_bf16(v0[2], v0[3]); w.z = cvt_pk_bf16(v1[0], v1[1]); w.w = cvt_pk_bf16(v1[2], v1[3]);
                    *(u32x4*)(O + off + bj * 128) = w; } }
    }
};
struct EpiAct {
    static constexpr bool PERM = true, SEG = false, PREF = false; static constexpr int NST = 6;
    unsigned char* O; const float* rs; const float* cs;
    __device__ __forceinline__ void operator()(const f32x4 (&acc)[2][2][4][2], const Unit& u, int wr, int wc, int fr, int fq) const {
        const int row0 = u.pm * 256 + wr * 64 + fr, col0 = u.pn * 128 + wc * 32 + 8 * fq;
        const float* cse = cs + (size_t)u.kind * D + u.pn * 256 + wc * 32 + 8 * fq;
        f32x4 cg[2], cv[2];
#pragma unroll
        for (int n = 0; n < 2; ++n) { cg[n] = *(const f32x4*)(cse + 4 * n); cv[n] = *(const f32x4*)(cse + 128 + 4 * n); }
#pragma unroll
        for (int ai = 0; ai < 2; ++ai)
#pragma unroll
            for (int m = 0; m < 4; ++m) { const int row = row0 + ai * 128 + m * 16; unsigned char* rowp = O + (size_t)row * DEXP + col0; const float r = rs[row];
                f32x4 r0, r1;
#pragma unroll
                for (int j = 0; j < 4; ++j) { const float g0 = acc[ai][0][m][0][j] * (cg[0][j] * r), g1 = acc[ai][0][m][1][j] * (cg[1][j] * r);
                    r0[j] = g0 * sigmoidf_(g0) * (acc[ai][1][m][0][j] * (cv[0][j] * r)); r1[j] = g1 * sigmoidf_(g1) * (acc[ai][1][m][1][j] * (cv[1][j] * r)); }
                u32x2 w; { int q = __builtin_amdgcn_cvt_pk_fp8_f32(r0[0], r0[1], 0, false); q = __builtin_amdgcn_cvt_pk_fp8_f32(r0[2], r0[3], q, true); w.x = (unsigned)q; }
                { int q = __builtin_amdgcn_cvt_pk_fp8_f32(r1[0], r1[1], 0, false); q = __builtin_amdgcn_cvt_pk_fp8_f32(r1[2], r1[3], q, true); w.y = (unsigned)q; }
                *(u32x2*)rowp = w; }
    }
};

struct Frame {
    LAS unsigned char* lds; int tid, lane, wave, G, bid;
    const Params* p;
};

struct TItem { const float* src; bf16_t* dst; int ldw, ldt, f8; };
constexpr int PREP_NIT = 16 * 256 + 3 * 16 * 32 + 16 * 64 + 4 * 4 * 8 + NEXP * 16 * 32 + NEXP * 8 * 32;
constexpr int PREP_LATE = 0;
__device__ __forceinline__ bool prep_item(const Params& P, unsigned char* ws, int it, int it_end, TItem& t) {
    constexpr int I_IN = 16 * 256, I_SQ = 16 * 32, I_KV = 16 * 64, I_P = 4 * 4 * 8, I_UP = NEXP * 16 * 32, I_DN = NEXP * 8 * 32;
    constexpr int NIT = I_IN + 3 * I_SQ + I_KV + I_P + I_UP + I_DN; static_assert(NIT == PREP_NIT, "item count");
    if (it >= it_end) return false;
    int r = it;
    if (r < I_IN) { const int kb = r / 256, nb = r % 256, n0 = 32 * nb;
        int drow = n0; if (n0 >= D && n0 < 3 * D) { const int c = (n0 - D) & (D - 1); drow = D + (c >> 7) * 256 + (n0 >= 2 * D ? 128 : 0) + (c & 127); }
        t.src = P.in[I_WIN] + (size_t)(64 * kb) * INCOLS + n0; t.ldw = INCOLS; t.dst = (bf16_t*)(ws + WS_WIN) + (size_t)drow * D + 64 * kb; t.ldt = D; t.f8 = 0; return true; } r -= I_IN;
    if (r < I_SQ) { const int kb = r / 32, nb = r % 32; t.src = P.in[I_WCONV] + (size_t)(64 * kb) * D + 32 * nb; t.ldw = D; t.dst = (bf16_t*)(ws + WS_WCAT) + (size_t)(32 * nb) * KCAT + 64 * kb; t.ldt = KCAT; t.f8 = 0; return true; } r -= I_SQ;
    if (r < I_SQ) { const int kb = r / 32, nb = r % 32; t.src = P.in[I_WXO] + (size_t)(64 * kb) * D + 32 * nb; t.ldw = D; t.dst = (bf16_t*)(ws + WS_WCAT) + (size_t)(32 * nb) * KCAT + 1280 + 64 * kb; t.ldt = KCAT; t.f8 = 0; return true; } r -= I_SQ;
    if (r < I_SQ) { const int kb = r / 32, nb = r % 32; t.src = P.in[I_WO] + (size_t)(64 * kb) * D + 32 * nb; t.ldw = D; t.dst = (bf16_t*)(ws + WS_WO) + (size_t)(32 * nb) * D + 64 * kb; t.ldt = D; t.f8 = 0; return true; } r -= I_SQ;
    if (r < I_KV) { const int kb = r / 64, nb = r % 64; t.src = P.in[I_WKV] + (size_t)(64 * kb) * (2 * D) + 32 * nb; t.ldw = 2 * D; t.dst = (bf16_t*)(ws + WS_WKV) + (size_t)(32 * nb) * D + 64 * kb; t.ldt = D; t.f8 = 0; return true; } r -= I_KV;
    if (r < I_P) { const int g = r / 32, q = r % 32, kb = q / 8, nb = q % 8;
        t.src = P.in[I_WPOOL] + (size_t)g * 65536 + (size_t)(64 * kb) * 256 + 32 * nb; t.ldw = 256; t.dst = (bf16_t*)(ws + WS_WCAT) + (size_t)(g * 256 + 32 * nb) * KCAT + 1024 + 64 * kb; t.ldt = KCAT; t.f8 = 0; return true; } r -= I_P;
    if (r < I_UP) { const int e = r / 512, q = r % 512, kb = q / 32, nb = q % 32; const int n0 = 32 * nb;
        const int j0 = n0 & 511, drow = (j0 >> 7) * 256 + (n0 >= 512 ? 128 : 0) + (j0 & 127);
        t.src = P.in[I_WUP] + (size_t)e * D * D + (size_t)(64 * kb) * D + n0; t.ldw = D; t.dst = (bf16_t*)(ws + WS_WUP + (size_t)e * D * D + (size_t)drow * D + 64 * kb); t.ldt = D; t.f8 = 1; return true; } r -= I_UP;
    { const int e = r / 256, q = r % 256, kb = q / 32, nb = q % 32;
        t.src = P.in[I_WDN] + (size_t)e * DEXP * D + (size_t)(64 * kb) * D + 32 * nb; t.ldw = D; t.dst = (bf16_t*)(ws + WS_WDN + (size_t)e * D * DEXP + (size_t)(32 * nb) * DEXP + 64 * kb); t.ldt = DEXP; t.f8 = 1; return true; }
}
__device__ __forceinline__ void titem_load(const TItem& t, int lane, f32x4 (&v)[8]) {
    const float* s = t.src + (size_t)(lane >> 3) * t.ldw + (lane & 7) * 4;
#pragma unroll
    for (int j = 0; j < 8; ++j) v[j] = *(const f32x4*)(s + (size_t)(8 * j) * t.ldw);
}
__device__ __forceinline__ void titem_finish(const TItem& t, int lane, const f32x4 (&v)[8], LAS float* scr) {
#pragma unroll
    for (int j = 0; j < 8; ++j) { LAS float* d = scr + (8 * j + (lane >> 3)) * 33 + (lane & 7) * 4; d[0] = v[j][0]; d[1] = v[j][1]; d[2] = v[j][2]; d[3] = v[j][3]; }
    asm volatile("s_waitcnt lgkmcnt(0)" ::: "memory");
    if (t.f8) {
        const int c = lane & 3;
#pragma unroll
        for (int j = 0; j < 2; ++j) { const int n = (lane >> 2) + 16 * j; const LAS float* s = scr + (16 * c) * 33 + n;
            u32x4 o;
            { int r = __builtin_amdgcn_cvt_pk_fp8_f32(s[0 * 33] * 32.f, s[1 * 33] * 32.f, 0, false); r = __builtin_amdgcn_cvt_pk_fp8_f32(s[2 * 33] * 32.f, s[3 * 33] * 32.f, r, true); o.x = (unsigned)r; }
            { int r = __builtin_amdgcn_cvt_pk_fp8_f32(s[4 * 33] * 32.f, s[5 * 33] * 32.f, 0, false); r = __builtin_amdgcn_cvt_pk_fp8_f32(s[6 * 33] * 32.f, s[7 * 33] * 32.f, r, true); o.y = (unsigned)r; }
            { int r = __builtin_amdgcn_cvt_pk_fp8_f32(s[8 * 33] * 32.f, s[9 * 33] * 32.f, 0, false); r = __builtin_amdgcn_cvt_pk_fp8_f32(s[10 * 33] * 32.f, s[11 * 33] * 32.f, r, true); o.z = (unsigned)r; }
            { int r = __builtin_amdgcn_cvt_pk_fp8_f32(s[12 * 33] * 32.f, s[13 * 33] * 32.f, 0, false); r = __builtin_amdgcn_cvt_pk_fp8_f32(s[14 * 33] * 32.f, s[15 * 33] * 32.f, r, true); o.w = (unsigned)r; }
            *(u32x4*)((unsigned char*)t.dst + (size_t)n * t.ldt + 16 * c) = o; }
    } else {
    const int c = lane & 7;
#pragma unroll
    for (int j = 0; j < 4; ++j) { const int n = (lane >> 3) + 8 * j; const LAS float* s = scr + (8 * c) * 33 + n;
        u32x4 o; o.x = cvt_pk_bf16(s[0 * 33], s[1 * 33]); o.y = cvt_pk_bf16(s[2 * 33], s[3 * 33]); o.z = cvt_pk_bf16(s[4 * 33], s[5 * 33]); o.w = cvt_pk_bf16(s[6 * 33], s[7 * 33]);
        *(u32x4*)(t.dst + (size_t)n * t.ldt + 8 * c) = o; }
    }
    asm volatile("s_waitcnt lgkmcnt(0)" ::: "memory");
}

struct WTask { const float* src; int ldw; unsigned char* dst; float* sc; };
__device__ __forceinline__ bool wtask_get(const Params& P, unsigned char* ws, int t, WTask& k) {
    constexpr int T_IN = INCOLS / 32, T_UP = NEXP * (D / 32);
    if (t >= T_IN + T_UP) return false;
    if (t < T_IN) { const int n0 = 32 * t;
        int drow = n0; if (n0 >= D && n0 < 3 * D) { const int c = (n0 - D) & (D - 1); drow = D + (c >> 7) * 256 + (n0 >= 2 * D ? 128 : 0) + (c & 127); }
        k.src = P.in[I_WIN] + n0; k.ldw = INCOLS; k.dst = ws + WS_WIN + (size_t)drow * D; k.sc = (float*)(ws + WS_SW) + drow;
    } else { const int q = t - T_IN, e = q >> 5, n0 = 32 * (q & 31);
        const int j0 = n0 & 511, drow = (j0 >> 7) * 256 + (n0 >= 512 ? 128 : 0) + (j0 & 127);
        k.src = P.in[I_WUP] + (size_t)e * D * D + n0; k.ldw = D; k.dst = ws + WS_WUP + (size_t)e * D * D + (size_t)drow * D; k.sc = (float*)(ws + WS_SWU) + e * D + drow; }
    return true;
}
__device__ __forceinline__ void wtask_load(const Frame& F, const WTask& k, f32x4 (&va)[8], f32x4 (&vb)[8]) {
    TItem ta, tb; ta.src = k.src + (size_t)(64 * (2 * F.wave)) * k.ldw; ta.ldw = k.ldw; tb.src = ta.src + (size_t)64 * k.ldw; tb.ldw = k.ldw;
    titem_load(ta, F.lane, va); titem_load(tb, F.lane, vb);
}
__device__ __forceinline__ void wtask_finish(const Frame& F, const WTask& k, const f32x4 (&va)[8], const f32x4 (&vb)[8]) {
    LAS float* scr = (LAS float*)(F.lds + F.wave * 16384);
    LAS float* cmx = (LAS float*)(F.lds + 131072 + 8192);
    const int lane = F.lane, c4 = (lane & 7) * 4;
    f32x4 mx = (f32x4){0.f, 0.f, 0.f, 0.f};
#pragma unroll
    for (int j = 0; j < 8; ++j) { mx = __builtin_elementwise_max(mx, __builtin_elementwise_max(__builtin_elementwise_abs(va[j]), __builtin_elementwise_abs(vb[j]))); }
#pragma unroll
    for (int o = 8; o < 64; o <<= 1) {
#pragma unroll
        for (int q = 0; q < 4; ++q) mx[q] = fmaxf(mx[q], __shfl_xor(mx[q], o)); }
    __syncthreads();
    if (lane < 8) { LAS float* d = cmx + F.wave * 32 + c4; d[0] = mx[0]; d[1] = mx[1]; d[2] = mx[2]; d[3] = mx[3]; }
    __syncthreads();
    if (F.tid < 32) { float m = 0.f;
#pragma unroll
        for (int w = 0; w < 8; ++w) m = fmaxf(m, cmx[w * 32 + F.tid]);
        cmx[256 + F.tid] = m > 0.f ? 127.0f / m : 0.f; k.sc[F.tid] = m > 0.f ? m * (1.0f / 127.0f) : 1.0f; }
    __syncthreads();
#pragma unroll
    for (int blk = 0; blk < 2; ++blk) {
#pragma unroll
        for (int j = 0; j < 8; ++j) { const f32x4 x = blk ? vb[j] : va[j]; LAS float* d = scr + (8 * j + (lane >> 3)) * 33 + c4; d[0] = x[0]; d[1] = x[1]; d[2] = x[2]; d[3] = x[3]; }
        asm volatile("s_waitcnt lgkmcnt(0)" ::: "memory");
        const int c = lane & 3;
#pragma unroll
        for (int j = 0; j < 2; ++j) { const int n = (lane >> 2) + 16 * j; const LAS float* s = scr + (16 * c) * 33 + n; const float inv = cmx[256 + n];
            u32x4 o;
#pragma unroll
            for (int g = 0; g < 4; ++g) { o[g] = ((unsigned)(int)__builtin_rintf(s[(4 * g) * 33] * inv) & 0xffu) | (((unsigned)(int)__builtin_rintf(s[(4 * g + 1) * 33] * inv) & 0xffu) << 8) | (((unsigned)(int)__builtin_rintf(s[(4 * g + 2) * 33] * inv) & 0xffu) << 16) | ((unsigned)(int)__builtin_rintf(s[(4 * g + 3) * 33] * inv) << 24); }
            *(u32x4*)(k.dst + (size_t)n * D + 64 * (2 * F.wave + blk) + 16 * c) = o; }
        asm volatile("s_waitcnt lgkmcnt(0)" ::: "memory");
    }
}
__device__ __forceinline__ void prep_i8_tasks(const Frame& F) {
    const Params& P = *F.p; unsigned char* ws = P.ws;
    WTask cur, nxt; f32x4 va[8], vb[8], wa[8], wb[8];
    int t = F.bid; bool have = wtask_get(P, ws, t, cur);
    if (have) wtask_load(F, cur, va, vb);
    while (have) {
        const bool hn = wtask_get(P, ws, t + F.G, nxt);
        if (hn) wtask_load(F, nxt, wa, wb);
        wtask_finish(F, cur, va, vb);
        if (!hn) break;
        t += 2 * F.G;
        have = wtask_get(P, ws, t, cur);
        if (have) wtask_load(F, cur, va, vb);
        wtask_finish(F, nxt, wa, wb);
    }
    __syncthreads();
}

__device__ __forceinline__ void convert_items(const Frame& F, int it0, int it1, int w, int nw) {
    const Params& P = *F.p; unsigned char* ws = P.ws;
    LAS float* scr = (LAS float*)(F.lds + F.wave * 16384);
    TItem cur, nxt; f32x4 va[8], vb[8];
    int it = it0 + w; bool have = prep_item(P, ws, it, it1, cur);
    if (have) titem_load(cur, F.lane, va);
    while (have) {
        const bool hn = prep_item(P, ws, it + nw, it1, nxt);
        if (hn) titem_load(nxt, F.lane, vb);
        titem_finish(cur, F.lane, va, scr);
        if (!hn) break;
        it += 2 * nw;
        have = prep_item(P, ws, it, it1, cur);
        if (have) titem_load(cur, F.lane, va);
        titem_finish(nxt, F.lane, vb, scr);
    }
}

__device__ __forceinline__ void convert_items_dyn(const Frame& F, int it0, int it1, int cw_ctr) {
    const Params& P = *F.p; unsigned char* ws = P.ws;
    LAS float* scr = (LAS float*)(F.lds + F.wave * 16384);
    unsigned* ctr = (unsigned*)(ws + WS_CTL) + cw_ctr;
    volatile LAS unsigned* slot = (volatile LAS unsigned*)(F.lds + 131072 + 12288);
    for (;;) {
        __syncthreads();
        if (F.tid == 0) slot[0] = atomicAdd(ctr, 1u);
        __syncthreads();
        const int it = it0 + (int)slot[0] * NWAVES + F.wave;
        if (it0 + (int)slot[0] * NWAVES >= it1) break;
        TItem t; f32x4 v[8];
        if (prep_item(P, ws, it, it1, t)) { titem_load(t, F.lane, v); titem_finish(t, F.lane, v, scr); }
    }
}

__device__ __forceinline__ void phase_prep(const Frame& F) {
    const Params& P = *F.p; unsigned char* ws = P.ws;
    LAS float* scr = (LAS float*)(F.lds + F.wave * 16384);
    const int gw = F.bid * NWAVES + F.wave, NGW = F.G * NWAVES;
    prep_i8_tasks(F);
    const size_t gt = (size_t)F.bid * NTHR + F.tid, NGT = (size_t)F.G * NTHR;
    for (int row0 = gw * 4; row0 < NTOK; row0 += NGW * 4) {
        f32x4 v[4][4]; float am[4];
#pragma unroll
        for (int a = 0; a < 4; ++a) { const f32x4* xr = (const f32x4*)(P.in[I_X] + (size_t)(row0 + a) * D) + F.lane;
#pragma unroll
            for (int j = 0; j < 4; ++j) v[a][j] = xr[64 * j]; }
#pragma unroll
        for (int a = 0; a < 4; ++a) { am[a] = 0.f;
#pragma unroll
            for (int j = 0; j < 4; ++j) am[a] = fmaxf(am[a], fmaxf(fmaxf(fabsf(v[a][j][0]), fabsf(v[a][j][1])), fmaxf(fabsf(v[a][j][2]), fabsf(v[a][j][3])))); }
#pragma unroll
        for (int o = 1; o < 64; o <<= 1) {
#pragma unroll
            for (int a = 0; a < 4; ++a) am[a] = fmaxf(am[a], __shfl_xor(am[a], o)); }
#pragma unroll
        for (int a = 0; a < 4; ++a) { const float inv = am[a] > 0.f ? 127.0f / am[a] : 0.f;
            if (F.lane == 0) ((float*)(ws + WS_XS))[row0 + a] = am[a] > 0.f ? am[a] * (1.0f / 127.0f) : 1.0f;
#pragma unroll
            for (int j = 0; j < 4; ++j) { const f32x4 q = v[a][j] * inv;
                const unsigned w = ((unsigned)(int)__builtin_rintf(q[0]) & 0xffu) | (((unsigned)(int)__builtin_rintf(q[1]) & 0xffu) << 8) | (((unsigned)(int)__builtin_rintf(q[2]) & 0xffu) << 16) | ((unsigned)(int)__builtin_rintf(q[3]) << 24);
                *((unsigned*)(ws + WS_XB + (size_t)(row0 + a) * D) + F.lane + 64 * j) = w; } }
    }
    { const f32x4* src = (const f32x4*)P.in[I_MEM]; u32x4* dst = (u32x4*)(ws + WS_MEMB);
      for (size_t i = gt; i < (size_t)NMEM * D / 8; i += NGT) { const f32x4 a = src[2 * i], b = src[2 * i + 1]; u32x4 o; o.x = cvt_pk_bf16(a[0], a[1]); o.y = cvt_pk_bf16(a[2], a[3]); o.z = cvt_pk_bf16(b[0], b[1]); o.w = cvt_pk_bf16(b[2], b[3]); dst[i] = o; } }
    { bf16_t* wr = (bf16_t*)(ws + WS_WR);
      for (size_t i = gt; i < (size_t)80 * D; i += NGT) { const int o = (int)(i / D), k = (int)(i % D); wr[i] = (bf16_t)f2bf(o < 8 ? P.in[I_WRG][(size_t)k * 8 + o] : (o < 72 ? P.in[I_WRE][(size_t)k * 64 + (o - 8)] : 0.f)); } }
    { constexpr int I0 = 16 * 256, I_UP0 = I0 + 3 * 16 * 32 + 16 * 64 + 4 * 4 * 8, I_DN0 = I_UP0 + NEXP * 16 * 32;
      convert_items(F, I0, I_UP0, gw, NGW); }
}

struct F8 { f32x4 a, b; };
__device__ __forceinline__ F8 up8(const u32x4 v) { F8 r; r.a = (f32x4){bf_lo(v.x), bf_hi(v.x), bf_lo(v.y), bf_hi(v.y)}; r.b = (f32x4){bf_lo(v.z), bf_hi(v.z), bf_lo(v.w), bf_hi(v.w)}; return r; }
__device__ __forceinline__ u32x4 pk8(const F8 v) { u32x4 o; o.x = pk2(v.a[0], v.a[1]); o.y = pk2(v.a[2], v.a[3]); o.z = pk2(v.b[0], v.b[1]); o.w = pk2(v.b[2], v.b[3]); return o; }
__device__ __forceinline__ void phase_convpool(const Frame& F, int cw_ctr, unsigned c_lo, unsigned c_hi) {
    const Params& P = *F.p; unsigned char* ws = P.ws;
    const bf16_t* __restrict__ Z = (const bf16_t*)(ws + WS_Z); bf16_t* __restrict__ AC = (bf16_t*)(ws + WS_ACONV); bf16_t* __restrict__ DP = (bf16_t*)(ws + WS_DPOOL);
    const float* cw = P.in[I_CONVW];
    constexpr int TSEG = 16;
    unsigned* ctr = (unsigned*)(ws + WS_CTL) + cw_ctr;
    volatile LAS unsigned* slot = (volatile LAS unsigned*)(F.lds + 131072 + 12288);
    for (;;) {
        __syncthreads();
        if (F.tid == 0) slot[0] = c_lo + atomicAdd(ctr, 1u);
        __syncthreads();
        const unsigned chunk = slot[0];
        if (chunk >= c_hi) break;
        const int it = (int)chunk * NTHR + F.tid;
        const int c0 = (it & 127) * 8, t0 = (it >> 7) * TSEG, s0 = t0 & (SEQ - 1);
        const int gi = c0 >> 8, w = 2 << gi;
        F8 w0, w1, w2;
        w0.a = *(const f32x4*)(cw + c0); w0.b = *(const f32x4*)(cw + c0 + 4); w1.a = *(const f32x4*)(cw + D + c0); w1.b = *(const f32x4*)(cw + D + c0 + 4); w2.a = *(const f32x4*)(cw + 2 * D + c0); w2.b = *(const f32x4*)(cw + 2 * D + c0 + 4);
        const bf16_t* zr0 = Z + (size_t)t0 * INCOLS + c0;
        F8 u1, u2, run;
        u1.a = u1.b = u2.a = u2.b = run.a = run.b = (f32x4){0.f, 0.f, 0.f, 0.f};
        if (s0 > 0) {
            u1 = up8(*(const u32x4*)(zr0 - INCOLS + D)); u2 = up8(*(const u32x4*)(zr0 - 2 * INCOLS + D));
            for (int i = 1; i < w; ++i) { const F8 pp = up8(*(const u32x4*)(zr0 - (size_t)i * INCOLS + 3 * D)); run.a += pp.a; run.b += pp.b; }
        }
        for (int tb = 0; tb < TSEG; tb += 4) {
            u32x4 lcb[4], lcc[4], lp[4], lold[4];
#pragma unroll
            for (int j = 0; j < 4; ++j) { const bf16_t* zr = zr0 + (size_t)(tb + j) * INCOLS;
                lcb[j] = *(const u32x4*)(zr); lcc[j] = *(const u32x4*)(zr + D); lp[j] = *(const u32x4*)(zr + 3 * D);
                lold[j] = (s0 + tb + j - (w - 1) >= 0) ? *(const u32x4*)(zr - (size_t)(w - 1) * INCOLS + 3 * D) : (u32x4){0u, 0u, 0u, 0u}; }
#pragma unroll
            for (int j = 0; j < 4; ++j) {
                const F8 cb = up8(lcb[j]), u0 = up8(lcc[j]);
                F8 v; v.a = (w0.a * u2.a + w1.a * u1.a + w2.a * u0.a) * cb.a; v.b = (w0.b * u2.b + w1.b * u1.b + w2.b * u0.b) * cb.b;
                *(u32x4*)(AC + (size_t)(t0 + tb + j) * D + c0) = pk8(v);
                u2 = u1; u1 = u0;
                const F8 pp = up8(lp[j]), po = up8(lold[j]);
                run.a += pp.a; run.b += pp.b;
                const int s = s0 + tb + j; const int cnt = (s + 1) < w ? (s + 1) : w; const float inv = 1.0f / (float)cnt;
                F8 d; d.a = run.a * inv - pp.a; d.b = run.b * inv - pp.b;
                *(u32x4*)(DP + (size_t)(t0 + tb + j) * D + c0) = pk8(d);
                run.a -= po.a; run.b -= po.b;
            }
        }
    }
}

typedef float f32x16 __attribute__((ext_vector_type(16)));
typedef float f32x2_t __attribute__((ext_vector_type(2))); typedef __bf16 bf16x2_t __attribute__((ext_vector_type(2)));
__device__ __forceinline__ unsigned cvtpk(float lo, float hi) { f32x2_t v = {lo, hi}; bf16x2_t b = __builtin_convertvector(v, bf16x2_t); return __builtin_bit_cast(unsigned, b); }
#define MFMA32(a, b, c) __builtin_amdgcn_mfma_f32_32x32x16_bf16((a), (b), (c), 0, 0, 0)
template <int VAR> __device__ __forceinline__ void phase_attn(const Frame& F, int u0, int ustride) {
    const Params& P = *F.p; unsigned char* ws = P.ws;
    const bf16_t* Z = (const bf16_t*)(ws + WS_Z); bf16_t* O = (bf16_t*)(ws + (VAR ? WS_MERGED : WS_O));
    const int tid = F.tid, lane = F.lane, wave = F.wave, r = lane & 31, hh = lane >> 5;
    const int prow = tid >> 5, pc = (tid & 31) ^ prow;
    LAS unsigned char* lds = F.lds;
    int rb[8];
#pragma unroll
    for (int t = 0; t < 8; ++t) rb[t] = r * 512 + (((2 * t + hh) ^ (r & 15)) << 4);
#define AT_WAIT_BAR(N) asm volatile("s_waitcnt vmcnt(" #N ")\n\ts_barrier" ::: "memory")
#define AT_ISSUE(i) do { if (VAR == 2) break; const char* _s = ((i) < 8) ? ksrc + (size_t)(32 * (i)) * 2048 : vsrc + (size_t)(32 * ((i) - 8)) * 512; const size_t _rs = ((i) < 8) ? 2048 : 512; \
        _Pragma("unroll") for (int _it = 0; _it < 2; ++_it) \
        __builtin_amdgcn_global_load_lds((const unsigned*)(_s + (size_t)(16 * _it) * _rs), (LAS unsigned*)(lds + ((i) & 7) * 16384 + _it * 8192 + wave * 1024), 16, 0, 0); } while (0)
#define AT_FRAG(slot, s) (*(const LAS pg8::bf16x8*)(lds + rb[(s) & 7] + (slot) * 16384 + ((s) >> 3) * 256))
#define AT_DSR(dst, s, slot) asm volatile("ds_read_b128 %0, %1 offset:%2" : "=v"(dst) : "v"(((slot) & 4) ? rbh[(s) & 7] : rbv[(s) & 7]), "n"(((slot) & 3) * 16384 + ((s) >> 3) * 256) : "memory")
#define AT_LW(dst, n) asm volatile("s_waitcnt lgkmcnt(%1)" : "+v"(dst) : "n"(n) : "memory")
#define AT_PIPE(slot, STMT) do { asm volatile("s_waitcnt lgkmcnt(0)" ::: "memory"); \
        AT_DSR(fr[0], 0, slot); AT_DSR(fr[1], 1, slot); AT_DSR(fr[2], 2, slot); AT_DSR(fr[3], 3, slot); \
        _Pragma("unroll") for (int s = 0; s < 16; ++s) { AT_LW(fr[s & 7], (15 - s) < 3 ? (15 - s) : 3); if (VAR != 1 && VAR != 4) { STMT; } if (s + 4 < 16 && VAR != 3 && VAR != 4) AT_DSR(fr[(s + 4) & 7], s + 4, slot); } } while (0)
    pg8::bf16x8 fr[8]; unsigned rbv[8], rbh[8];
#pragma unroll
    for (int t = 0; t < 8; ++t) { rbv[t] = (unsigned)(size_t)lds + (unsigned)rb[t]; rbh[t] = rbv[t] + 65536u; }
    for (int ui = u0; ui < (NTOK / 256) * 4; ui += ustride) {
        const int h = ui & 3, t0 = (ui >> 2) * 256, b = t0 / SEQ;
        const bf16_t* qrow = Z + (size_t)(t0 + 32 * wave + r) * INCOLS + 4 * D + h * 256 + 8 * hh;
        pg8::bf16x8 qf[16];
#pragma unroll
        for (int s = 0; s < 16; ++s) qf[s] = *(const pg8::bf16x8*)(qrow + 16 * s);
        const char* ksrc = (const char*)(ws + WS_KB) + ((size_t)(b * 256 + prow) * D + h * 256) * 2 + pc * 16;
        const char* vsrc = (const char*)(ws + WS_VT) + ((size_t)(b * D + h * 256 + prow) * 256) * 2 + pc * 16;
        asm volatile("s_barrier" ::: "memory");
        AT_ISSUE(0); AT_ISSUE(1); AT_ISSUE(2); AT_ISSUE(3); AT_ISSUE(4); AT_ISSUE(5);
        f32x16 S[8];
#pragma unroll
        for (int i = 0; i < 8; ++i)
#pragma unroll
            for (int j = 0; j < 16; ++j) S[i][j] = 0.f;
#pragma unroll
        for (int i = 0; i < 8; ++i) {
            AT_WAIT_BAR(10);
            AT_ISSUE(i + 6);
#pragma unroll
            AT_PIPE(i & 7, S[i] = MFMA32(fr[s & 7], qf[s], S[i]));
        }
        float mx = S[0][0];
#pragma unroll
        for (int i = 0; i < 8; ++i)
#pragma unroll
            for (int j = 0; j < 16; ++j) mx = fmaxf(mx, S[i][j]);
        mx = fmaxf(mx, __shfl_xor(mx, 32));
        const float c2 = 0.0625f * 1.4426950408889634f;
        float sum = 0.f;
        pg8::bf16x8 pf[8][2];
#pragma unroll
        for (int i = 0; i < 8; ++i) {
#pragma unroll
            for (int j = 0; j < 16; ++j) { const float e = __builtin_amdgcn_exp2f((S[i][j] - mx) * c2); S[i][j] = e; sum += e; }
#pragma unroll
            for (int s2 = 0; s2 < 2; ++s2) { u32x4 w; w.x = cvtpk(S[i][8 * s2], S[i][8 * s2 + 1]); w.y = cvtpk(S[i][8 * s2 + 2], S[i][8 * s2 + 3]); w.z = cvtpk(S[i][8 * s2 + 4], S[i][8 * s2 + 5]); w.w = cvtpk(S[i][8 * s2 + 6], S[i][8 * s2 + 7]);
                pf[i][s2] = __builtin_bit_cast(pg8::bf16x8, w); }
        }
        sum += __shfl_xor(sum, 32);
        const float inv = 1.0f / sum;
        bf16_t* orow = O + (size_t)(t0 + 32 * wave + r) * D + h * 256 + 4 * hh;
#pragma unroll
        for (int i = 8; i < 16; ++i) {
            if (i == 8) AT_WAIT_BAR(10); else if (i == 9) AT_WAIT_BAR(13); else if (i == 10) AT_WAIT_BAR(16); else if (i == 11) AT_WAIT_BAR(17); else if (i == 12) AT_WAIT_BAR(18); else if (i == 13) AT_WAIT_BAR(19); else if (i == 14) AT_WAIT_BAR(20); else AT_WAIT_BAR(18);
            if (i + 6 < 16) AT_ISSUE(i + 6);
            f32x16 o;
#pragma unroll
            for (int j = 0; j < 16; ++j) o[j] = 0.f;
#pragma unroll
            AT_PIPE(i & 7, o = MFMA32(fr[s & 7], pf[s >> 1][s & 1], o));
#pragma unroll
            for (int g = 0; g < 4; ++g) { u32x2 w; w.x = cvtpk(o[4 * g] * inv, o[4 * g + 1] * inv); w.y = cvtpk(o[4 * g + 2] * inv, o[4 * g + 3] * inv);
                *(u32x2*)(orow + 32 * (i - 8) + 8 * g) = w; }
        }
    }
    asm volatile("s_waitcnt vmcnt(0)\n\ts_barrier" ::: "memory");
#undef AT_WAIT_BAR
#undef AT_ISSUE
#undef AT_FRAG
#undef AT_DSR
#undef AT_LW
#undef AT_PIPE
}

__device__ __forceinline__ void phase_ln1_router(const Frame& F) {
    const Params& P = *F.p; unsigned char* ws = P.ws;
    const bf16_t* H1 = (const bf16_t*)(ws + WS_H1); bf16_t* H1B = (bf16_t*)(ws + WS_H1B); const bf16_t* WRB = (const bf16_t*)(ws + WS_WR);
    unsigned* ctl = (unsigned*)(ws + WS_CTL);
    int* tok_e = (int*)(ws + WS_MISC + MS_TOKE); int* tok_pos = (int*)(ws + WS_MISC + MS_TOKPOS); float* tok_w = (float*)(ws + WS_MISC + MS_TOKW);
    LAS float* lg = (LAS float*)(F.lds + F.wave * 5120);
    LAS unsigned* lcnt = (LAS unsigned*)(F.lds + 8 * 5120);
    const int lane = F.lane;
    const float* g1 = P.in[I_LN1G]; const float* b1 = P.in[I_LN1B];
    f32x4 gg[4], bb[4];
#pragma unroll
    for (int j = 0; j < 4; ++j) { gg[j] = *((const f32x4*)g1 + lane + 64 * j); bb[j] = *((const f32x4*)b1 + lane + 64 * j); }
    for (int grp0 = F.bid * NWAVES; grp0 < NTOK / 16; grp0 += F.G * NWAVES) {
        const int row0 = (grp0 + F.wave) * 16;
        if (F.tid < 128) lcnt[F.tid] = 0u;
        for (int rb = 0; rb < 16; rb += 4) {
            f32x4 v[4][4]; float s[4], q[4];
#pragma unroll
            for (int a = 0; a < 4; ++a) { const u32x2* xr = (const u32x2*)(H1 + (size_t)(row0 + rb + a) * D) + lane;
#pragma unroll
                for (int j = 0; j < 4; ++j) { const u32x2 p = xr[64 * j]; v[a][j] = (f32x4){bf_lo(p.x), bf_hi(p.x), bf_lo(p.y), bf_hi(p.y)}; } }
#pragma unroll
            for (int a = 0; a < 4; ++a) { s[a] = 0.f;
#pragma unroll
                for (int j = 0; j < 4; ++j) s[a] += (v[a][j][0] + v[a][j][1]) + (v[a][j][2] + v[a][j][3]); }
#pragma unroll
            for (int o = 1; o < 64; o <<= 1) {
#pragma unroll
                for (int a = 0; a < 4; ++a) s[a] += __shfl_xor(s[a], o); }
#pragma unroll
            for (int a = 0; a < 4; ++a) { const float mean = s[a] * (1.f / D); q[a] = 0.f;
#pragma unroll
                for (int j = 0; j < 4; ++j) { v[a][j] = v[a][j] - mean; q[a] += (v[a][j][0] * v[a][j][0] + v[a][j][1] * v[a][j][1]) + (v[a][j][2] * v[a][j][2] + v[a][j][3] * v[a][j][3]); } }
#pragma unroll
            for (int o = 1; o < 64; o <<= 1) {
#pragma unroll
                for (int a = 0; a < 4; ++a) q[a] += __shfl_xor(q[a], o); }
            float am[4];
#pragma unroll
            for (int a = 0; a < 4; ++a) { const float rstd = 1.f / sqrtf(q[a] * (1.f / D) + LN_EPS); am[a] = 0.f;
#pragma unroll
                for (int j = 0; j < 4; ++j) { const f32x4 y = v[a][j] * rstd * gg[j] + bb[j]; v[a][j] = y;
                    am[a] = fmaxf(am[a], fmaxf(fmaxf(fabsf(y[0]), fabsf(y[1])), fmaxf(fabsf(y[2]), fabsf(y[3]))));
                    u32x2 o; o.x = cvt_pk_bf16(y[0], y[1]); o.y = cvt_pk_bf16(y[2], y[3]); *((u32x2*)(H1B + (size_t)(row0 + rb + a) * D) + lane + 64 * j) = o; } }
#pragma unroll
            for (int o = 1; o < 64; o <<= 1) {
#pragma unroll
                for (int a = 0; a < 4; ++a) am[a] = fmaxf(am[a], __shfl_xor(am[a], o)); }
#pragma unroll
            for (int a = 0; a < 4; ++a) { const float inv = am[a] > 0.f ? 127.0f / am[a] : 0.f;
                if (lane == 0) ((float*)(ws + WS_H1S))[row0 + rb + a] = am[a] > 0.f ? am[a] * (1.0f / 127.0f) : 1.0f;
#pragma unroll
                for (int j = 0; j < 4; ++j) { const f32x4 z = v[a][j] * inv;
                    const unsigned w = ((unsigned)(int)__builtin_rintf(z[0]) & 0xffu) | (((unsigned)(int)__builtin_rintf(z[1]) & 0xffu) << 8) | (((unsigned)(int)__builtin_rintf(z[2]) & 0xffu) << 16) | ((unsigned)(int)__builtin_rintf(z[3]) << 24);
                    *((unsigned*)(ws + WS_H1F8 + (size_t)(row0 + rb + a) * D) + lane + 64 * j) = w; } }
        }
        asm volatile("s_waitcnt vmcnt(0)" ::: "memory");
        f32x4 acc[5];
#pragma unroll
        for (int n = 0; n < 5; ++n) acc[n] = (f32x4){0.f, 0.f, 0.f, 0.f};
        const bf16_t* ap = H1B + (size_t)(row0 + (lane & 15)) * D + 8 * (lane >> 4);
        const bf16_t* bp = WRB + (size_t)(lane & 15) * D + 8 * (lane >> 4);
#pragma unroll 8
        for (int ks = 0; ks < 32; ++ks) {
            const pg8::bf16x8 a = *(const pg8::bf16x8*)(ap + 32 * ks);
#pragma unroll
            for (int n = 0; n < 5; ++n) { const pg8::bf16x8 bw = *(const pg8::bf16x8*)(bp + (size_t)n * 16 * D + 32 * ks); acc[n] = __builtin_amdgcn_mfma_f32_16x16x32_bf16(a, bw, acc[n], 0, 0, 0); }
        }
#pragma unroll
        for (int n = 0; n < 5; ++n)
#pragma unroll
            for (int i = 0; i < 4; ++i) lg[(4 * (lane >> 4) + i) * 80 + 16 * n + (lane & 15)] = acc[n][i];
        __syncthreads();
        int ea = 0, eb = 0; unsigned la = 0, lb = 0; float w1 = 0.f, w2 = 0.f;
        if (lane < 16) {
            const LAS float* l = lg + lane * 80;
            const float* brg = P.in[I_BRG]; const float* bre = P.in[I_BRE];
            int gs = 0; float gm = l[0] + brg[0];
            for (int i = 1; i < 8; ++i) { const float x = l[i] + brg[i]; if (x > gm) { gm = x; gs = i; } }
            float den = 0.f; for (int i = 0; i < 8; ++i) den += __expf(l[i] + brg[i] - gm);
            const float gwt = 1.0f / den;
            int i1 = 0; float l1 = l[8 + gs * 8] + bre[gs * 8];
            for (int i = 1; i < 8; ++i) { const float x = l[8 + gs * 8 + i] + bre[gs * 8 + i]; if (x > l1) { l1 = x; i1 = i; } }
            int i2 = -1; float l2 = 0.f;
            for (int i = 0; i < 8; ++i) { if (i == i1) continue; const float x = l[8 + gs * 8 + i] + bre[gs * 8 + i]; if (i2 < 0 || x > l2) { l2 = x; i2 = i; } }
            const float e2 = __expf(l2 - l1); w1 = gwt / (1.0f + e2); w2 = gwt * e2 / (1.0f + e2);
            ea = gs * 8 + i1; eb = gs * 8 + i2;
            la = atomicAdd((unsigned*)(lcnt + ea), 1u); lb = atomicAdd((unsigned*)(lcnt + eb), 1u);
        }
        __syncthreads();
        if (F.tid < 64) { const unsigned c = lcnt[F.tid]; lcnt[64 + F.tid] = c ? atomicAdd(ctl + CW_COUNTS + F.tid, c) : 0u; }
        __syncthreads();
        if (lane < 16) { const int row = row0 + lane;
            tok_e[2 * row] = ea; tok_e[2 * row + 1] = eb; tok_pos[2 * row] = (int)(lcnt[64 + ea] + la); tok_pos[2 * row + 1] = (int)(lcnt[64 + eb] + lb); tok_w[2 * row] = w1; tok_w[2 * row + 1] = w2; }
        __syncthreads();
    }
}

__device__ __forceinline__ void phase_gather(const Frame& F) {
    const Params& P = *F.p; unsigned char* ws = P.ws;
    const int* tok_e = (const int*)(ws + WS_MISC + MS_TOKE); const int* tok_pos = (const int*)(ws + WS_MISC + MS_TOKPOS); int* tok_dest = (int*)(ws + WS_MISC + MS_TOKDEST);
    const unsigned char* H1F = ws + WS_H1F8; unsigned char* XB = ws + WS_XBUF;
    LAS int* ps = (LAS int*)F.lds;
    if (F.tid == 0) {
        const unsigned* cnt = (const unsigned*)(ws + WS_CTL) + CW_COUNTS;
        int* tile_e = (int*)(ws + WS_MISC + MS_TILEE); int* ntl = (int*)(ws + WS_MISC + MS_NTILES);
        int run = 0;
        for (int e = 0; e < NEXP; ++e) { const int c = (int)cnt[e]; ps[e] = run * 256; const int nte = (c + 255) / 256; if (F.bid == 0) for (int k = 0; k < nte; ++k) tile_e[run + k] = e; run += nte; }
        if (F.bid == 0) ntl[0] = run;
    }
    __syncthreads();
    const int gw = F.bid * NWAVES + F.wave, NGW = F.G * NWAVES;
    for (int a = gw; a < NASSIGN; a += NGW) {
        const int dest = ps[tok_e[a]] + tok_pos[a];
        const u32x4* src = (const u32x4*)(H1F + (size_t)(a >> 1) * D) + F.lane; u32x4* dst = (u32x4*)(XB + (size_t)dest * D) + F.lane;
        dst[0] = src[0];
        if (F.lane == 0) { tok_dest[a] = dest; ((float*)(ws + WS_XSB))[dest] = ((const float*)(ws + WS_H1S))[a >> 1]; }
    }
    __syncthreads();
}

__device__ __forceinline__ void phase_combine(const Frame& F) {
    const Params& P = *F.p; unsigned char* ws = P.ws;
    const bf16_t* H1B = (const bf16_t*)(ws + WS_H1B); const bf16_t* YB = (const bf16_t*)(ws + WS_YBUF);
    const int* tok_dest = (const int*)(ws + WS_MISC + MS_TOKDEST); const float* tok_w = (const float*)(ws + WS_MISC + MS_TOKW);
    const int gw = F.bid * NWAVES + F.wave, NGW = F.G * NWAVES, lane = F.lane;
    const float* g2 = P.in[I_LN2G]; const float* b2 = P.in[I_LN2B];
    f32x4 gg[4], bb[4];
#pragma unroll
    for (int j = 0; j < 4; ++j) { gg[j] = *((const f32x4*)g2 + lane + 64 * j); bb[j] = *((const f32x4*)b2 + lane + 64 * j); }
    for (int row0 = gw * 4; row0 < NTOK; row0 += NGW * 4) {
        f32x4 v[4][4]; float s[4], q[4];
        u32x2 lx[4][4]; unsigned la[4][4], lb[4][4]; float w0[4], w1[4];
#pragma unroll
        for (int a = 0; a < 4; ++a) { const int row = row0 + a; const int d0 = tok_dest[2 * row], d1 = tok_dest[2 * row + 1]; w0[a] = tok_w[2 * row]; w1[a] = tok_w[2 * row + 1];
            const u32x2* xr = (const u32x2*)(H1B + (size_t)row * D) + lane;
            const unsigned* y0 = (const unsigned*)((const unsigned char*)YB + (size_t)d0 * D) + lane; const unsigned* y1 = (const unsigned*)((const unsigned char*)YB + (size_t)d1 * D) + lane;
            w0[a] *= 0.0625f; w1[a] *= 0.0625f;
#pragma unroll
            for (int j = 0; j < 4; ++j) { lx[a][j] = xr[64 * j]; la[a][j] = y0[64 * j]; lb[a][j] = y1[64 * j]; } }
#pragma unroll
        for (int a = 0; a < 4; ++a) { s[a] = 0.f;
#pragma unroll
            for (int j = 0; j < 4; ++j) { const u32x2 x = lx[a][j];
                const f32x2 a01 = __builtin_amdgcn_cvt_pk_f32_fp8((int)la[a][j], false), a23 = __builtin_amdgcn_cvt_pk_f32_fp8((int)la[a][j], true), b01 = __builtin_amdgcn_cvt_pk_f32_fp8((int)lb[a][j], false), b23 = __builtin_amdgcn_cvt_pk_f32_fp8((int)lb[a][j], true);
                v[a][j][0] = ALPHA * bf_lo(x.x) + (w0[a] * a01[0] + w1[a] * b01[0]); v[a][j][1] = ALPHA * bf_hi(x.x) + (w0[a] * a01[1] + w1[a] * b01[1]);
                v[a][j][2] = ALPHA * bf_lo(x.y) + (w0[a] * a23[0] + w1[a] * b23[0]); v[a][j][3] = ALPHA * bf_hi(x.y) + (w0[a] * a23[1] + w1[a] * b23[1]);
                s[a] += (v[a][j][0] + v[a][j][1]) + (v[a][j][2] + v[a][j][3]); } }
#pragma unroll
        for (int o = 1; o < 64; o <<= 1) {
#pragma unroll
            for (int a = 0; a < 4; ++a) s[a] += __shfl_xor(s[a], o); }
#pragma unroll
        for (int a = 0; a < 4; ++a) { const float mean = s[a] * (1.f / D); q[a] = 0.f;
#pragma unroll
            for (int j = 0; j < 4; ++j) { v[a][j] = v[a][j] - mean; q[a] += (v[a][j][0] * v[a][j][0] + v[a][j][1] * v[a][j][1]) + (v[a][j][2] * v[a][j][2] + v[a][j][3] * v[a][j][3]); } }
#pragma unroll
        for (int o = 1; o < 64; o <<= 1) {
#pragma unroll
            for (int a = 0; a < 4; ++a) q[a] += __shfl_xor(q[a], o); }
#pragma unroll
        for (int a = 0; a < 4; ++a) { const float rstd = 1.f / sqrtf(q[a] * (1.f / D) + LN_EPS);
            f32x4* orow = (f32x4*)(P.out + (size_t)(row0 + a) * D) + lane;
#pragma unroll
            for (int j = 0; j < 4; ++j) __builtin_nontemporal_store(v[a][j] * rstd * gg[j] + bb[j], orow + 64 * j); }
    }
}

constexpr int NPHASE = 15;
__global__ void __launch_bounds__(NTHR, 2) fwd_kernel(Params prm) {
    extern __shared__ __attribute__((aligned(16))) unsigned char lds_raw[];
    Frame F; F.lds = (LAS unsigned char*)lds_raw; F.tid = threadIdx.x; F.lane = F.tid & 63; F.wave = __builtin_amdgcn_readfirstlane(F.tid >> 6); F.G = gridDim.x; F.bid = blockIdx.x; F.p = &prm;
    unsigned char* ws = prm.ws;
    const int lo = prm.ph_lo, hi = prm.ph_hi;
    volatile LAS unsigned* MISC = (volatile LAS unsigned*)(F.lds + MISC_OFF);
    if (F.tid < 32) MISC[F.tid] = 0u;
    __syncthreads();
    if (lo < 0) cg::this_grid().sync();
    XcdBarrier bar; bar.bar = (unsigned*)(ws + WS_CTL) + CW_BAR; bar.x = 0; bar.st = nullptr;
    if (hi - lo > 1) bar = xcd_barrier_post((unsigned*)(ws + WS_CTL) + CW_BAR, MISC + 8);
#define IN(k) (lo <= (k) && (k) < hi)
#define SEAM(k) do { if (IN(k) && IN((k) + 1)) { xcd_barrier(bar); } } while (0)
#define PHASE(k, ...) do { if (IN(k)) { __VA_ARGS__ if (PROBE_PH == (k)) { xcd_barrier(bar); __VA_ARGS__ } } SEAM(k); } while (0);
    const bf16_t* Zc = (const bf16_t*)(ws + WS_Z);

    PHASE(0, { phase_prep(F); })
    PHASE(1, {
        pg8::StaticOrder S{NTOK / 256, INCOLS / 256, F.G, F.bid, (const char*)(ws + WS_XB), (const char*)(ws + WS_WIN), (size_t)256 * D, (size_t)256 * D, 0};
        EpiBf16 E{(bf16_t*)(ws + WS_Z), INCOLS, prm.in[I_BGATE], GATE0 / 256, GATE0, 1.0f, 4, 12, D, (const float*)(ws + WS_XS), (const float*)(ws + WS_SW), 0};
        pg8::gemm_phase<EpiBf16, pg8::StaticOrder, true, true, 2>(F.lds, D / 2, D / 2, D / 2, S, E);
    })
    PHASE(2, {
        pg8::KVOrder S{F.G, F.bid, (const char*)(ws + WS_MEMB), (const char*)(ws + WS_WKV)};
        EpiKV E{(bf16_t*)(ws + WS_KB), (bf16_t*)(ws + WS_VT)};
        pg8::gemm_phase<EpiKV, pg8::KVOrder, true, true>(F.lds, D, D, D, S, E);
        if (F.bid >= 64) phase_convpool(F, CW_CPCTR, 0u, (unsigned)CP_EARLY);
    })
    PHASE(4, {
        if (F.bid < NATT) phase_attn<0>(F, F.bid, NATT);
        phase_convpool(F, CW_CPCTR2, (unsigned)CP_EARLY, (unsigned)CP_CHUNKS);
        { constexpr int I_DN0 = 16 * 256 + 3 * 16 * 32 + 16 * 64 + 4 * 4 * 8 + NEXP * 16 * 32; convert_items_dyn(F, I_DN0, PREP_NIT, CW_WDCTR); }
    })
    PHASE(7, {
        pg8::SegOrder S{NTOK / 256, D / 256, F.G, F.bid, (const char*)(ws + WS_ACONV), (const char*)(ws + WS_DPOOL), (const char*)(ws + WS_O), (const char*)(ws + WS_WCAT), (size_t)256 * D * 2, (size_t)256 * KCAT * 2, (size_t)256 * 2};
        EpiMix3 E{(bf16_t*)(ws + WS_MERGED), Zc, prm.in[I_PSCALE], 0};
        pg8::gemm_phase<EpiMix3, pg8::SegOrder, true, true>(F.lds, KCAT, D, KCAT, S, E);
        if (PROBE_PH == 207) { xcd_barrier(bar); EpiMix3 E2{(bf16_t*)(ws + WS_XBUF), Zc, prm.in[I_PSCALE], 1}; pg8::gemm_phase<EpiMix3, pg8::SegOrder, true, true>(F.lds, KCAT, D, KCAT, S, E2); }
    })
    PHASE(8, {
        pg8::StaticOrder S{NTOK / 256, D / 256, F.G, F.bid, (const char*)(ws + WS_MERGED), (const char*)(ws + WS_WO), (size_t)256 * D * 2, (size_t)256 * D * 2, 0};
        EpiResBf16 E{(bf16_t*)(ws + WS_H1), prm.in[I_X], ALPHA};
        pg8::gemm_phase<EpiResBf16, pg8::StaticOrder, true, true>(F.lds, D, D, D, S, E);
    })
    PHASE(9, { phase_ln1_router(F); if (PROBE_PH == 300) { xcd_barrier(bar); xcd_barrier(bar); xcd_barrier(bar); xcd_barrier(bar); } })
    PHASE(11, { phase_gather(F); })
    PHASE(12, {
        const int ntl = *(const int*)(ws + WS_MISC + MS_NTILES);
        pg8::MoeOrder S{ntl, 4, F.G, F.bid, (const char*)(ws + WS_XBUF), (const char*)(ws + WS_WUP), (size_t)256 * D, (size_t)256 * D, (size_t)D * D, (const int*)(ws + WS_MISC + MS_TILEE)};
        EpiAct E{ws + WS_ACT, (const float*)(ws + WS_XSB), (const float*)(ws + WS_SWU)};
        pg8::gemm_phase<EpiAct, pg8::MoeOrder, true, true, 2>(F.lds, D / 2, D / 2, D / 2, S, E);
    })
    PHASE(13, {
        const int ntl = *(const int*)(ws + WS_MISC + MS_NTILES);
        pg8::MoeOrder S{ntl, 4, F.G, F.bid, (const char*)(ws + WS_ACT), (const char*)(ws + WS_WDN), (size_t)256 * DEXP, (size_t)256 * DEXP, (size_t)D * DEXP, (const int*)(ws + WS_MISC + MS_TILEE)};
        EpiBf16 E{(bf16_t*)(ws + WS_YBUF), D, nullptr, 1 << 30, 0, 0.03125f * 16.0f, 0, 0, 0, nullptr, nullptr, 1};
        pg8::gemm_phase<EpiBf16, pg8::MoeOrder, true, true, 1>(F.lds, DEXP / 2, DEXP / 2, DEXP / 2, S, E);
    })
    PHASE(14, { phase_combine(F); })
#undef IN
#undef SEAM
}

extern "C" void kernel_launch(void* const* d_in, const int* in_sizes, int n_in, void* d_out, int out_size, void* d_ws, size_t ws_size, hipStream_t stream) {
    static int grid = 0;
    if (grid == 0) {
        if (n_in != 21 || out_size != NTOK * D || ws_size < WS_END) { fprintf(stderr, "kernel_launch: unexpected shapes (n_in %d out %d ws %zu, need ws >= %zu)\n", n_in, out_size, ws_size, (size_t)WS_END); grid = -1; return; }
        int dev = 0, cus = 0, per_cu = 0;
        if (hipGetDevice(&dev) != hipSuccess || hipDeviceGetAttribute(&cus, hipDeviceAttributeMultiprocessorCount, dev) != hipSuccess) { grid = -1; return; }
        if (hipFuncSetAttribute((const void*)fwd_kernel, hipFuncAttributeMaxDynamicSharedMemorySize, LDS_BYTES) != hipSuccess) { fprintf(stderr, "kernel_launch: hipFuncSetAttribute failed\n"); grid = -1; return; }
        if (hipOccupancyMaxActiveBlocksPerMultiprocessor(&per_cu, (const void*)fwd_kernel, NTHR, LDS_BYTES) != hipSuccess || per_cu < 1) { fprintf(stderr, "kernel_launch: occupancy query says %d\n", per_cu); (void)hipGetLastError(); per_cu = 1; }
        grid = cus * 1;
        fprintf(stderr, "kernel_launch: cus %d per_cu %d grid %d\n", cus, per_cu, grid);
    }
    if (grid < 0) return;
    (void)hipMemsetAsync((char*)d_ws + WS_CTL, 0, CTL_ZERO_BYTES, stream);
    Params a{};
    for (int i = 0; i < 21; ++i) a.in[i] = (const float*)d_in[i];
    a.out = (float*)d_out; a.ws = (unsigned char*)d_ws;
#if MK_ONE_LAUNCH
    a.ph_lo = 0; a.ph_hi = NPHASE;
    void* args[] = {&a};
    hipError_t e = hipLaunchCooperativeKernel((const void*)fwd_kernel, dim3(grid), dim3(NTHR), args, LDS_BYTES, stream);
    if (e != hipSuccess) fprintf(stderr, "cooperative launch failed: %s (grid %d)\n", hipGetErrorString(e), grid);
#else
    for (int ph = 0; ph < NPHASE; ++ph) {
        a.ph_lo = ph; a.ph_hi = ph + 1;
        hipLaunchKernelGGL(fwd_kernel, dim3(grid), dim3(NTHR), LDS_BYTES, stream, a);
    }
#endif
}
```

```cpp
#include <hip/hip_runtime.h>
#include <hip/hip_cooperative_groups.h>
#include <cstdio>
#include <cstdint>
namespace cg = cooperative_groups;

#ifndef PROBE_PH
#define PROBE_PH -1
#endif
#ifndef STAG_G1
#define STAG_G1 0
#endif
#ifndef MK_ONE_LAUNCH
#define MK_ONE_LAUNCH 1
#endif

namespace pg8 {
#define PG8_LAS __attribute__((address_space(3)))
#define PG8_GAS __attribute__((address_space(1)))
typedef unsigned short bf16_t;
typedef short bf16x8 __attribute__((ext_vector_type(8)));
typedef float f32x4 __attribute__((ext_vector_type(4)));
typedef float f32x2 __attribute__((ext_vector_type(2)));
typedef unsigned u32x4 __attribute__((ext_vector_type(4)));
typedef unsigned u32x2 __attribute__((ext_vector_type(2)));
constexpr int BM = 256, BK = 64, HALF = 128, HTB = HALF * BK * 2  , STAGE_BYTES = 8 * HTB, NXCD = 8, WGM = 4;

__host__ __device__ __forceinline__ int lds_byte(int r, int c) { const int st = (r >> 4) * 2 + (c >> 5), rr = r & 15, cc = c & 31, ob = rr * 64 + cc * 2; return st * 1024 + (ob ^ (((ob >> 9) & 1) << 5)); }
__host__ __device__ __forceinline__ void stage_rc(int b, int& R, int& C) { const int st = b / 1024, sb = b % 1024, swz = sb ^ (((sb >> 9) & 1) << 5); R = (st >> 1) * 16 + swz / 64; C = (st & 1) * 32 + (swz % 64) / 2; }
__host__ __device__ __forceinline__ int perm32(int rho) { const int n = rho >> 4, i = rho & 15; return 8 * (i >> 2) + 4 * n + (i & 3); }

struct Unit { int pm, pn, kind; const char* a; const char* b; int nt, seg, fin; };

__device__ __forceinline__ void tile_of(int L, int nM, int nN, int& pm, int& pn) {
    const int nwg = nM * nN; int wgid = L;
    { const int q = nwg / NXCD, r = nwg % NXCD, xcd = wgid % NXCD, off = wgid / NXCD; wgid = (xcd < r ? xcd * (q + 1) : r * (q + 1) + (xcd - r) * q) + off; }
    const int nig = WGM * nN, gid = wgid / nig, fm = gid * WGM, gsz = (nM - fm) < WGM ? (nM - fm) : WGM;
    pm = fm + ((wgid % nig) % gsz); pn = (wgid % nig) / gsz;
}
struct StaticOrder {
    int nM, nN, G, c; const char* A; const char* B; size_t tA, tB, aN;
    __device__ __forceinline__ bool next(int i, Unit& u) const {
        const long L = (long)i * G + c; if (L >= (long)nM * nN) return false;
        tile_of((int)L, nM, nN, u.pm, u.pn); u.kind = 0;
        u.a = A + (size_t)u.pm * tA + (size_t)u.pn * aN; u.b = B + (size_t)u.pn * tB; return true;
    }
};
struct MoeOrder {
    int nM, nN, G, c; const char* A; const char* B; size_t tA, tB, eB; const int* tile_expert;
    __device__ __forceinline__ bool next(int i, Unit& u) const {
        const long L = (long)i * G + c; if (L >= (long)nM * nN) return false;
        tile_of((int)L, nM, nN, u.pm, u.pn); u.kind = 0;
        const int e = __builtin_amdgcn_readfirstlane(tile_expert[u.pm]); u.kind = e;
        u.a = A + (size_t)u.pm * tA; u.b = B + (size_t)e * eB + (size_t)u.pn * tB; return true;
    }
};

struct SegOrder {
    int nM, nN, G, c; const char* A; const char* A2; const char* A3; const char* B; size_t tA, tB, aN2;
    __device__ __forceinline__ bool next(int i, Unit& u) const {
        const int iu = i / 3, seg = i - 3 * iu;
        const long L = (long)iu * G + c; if (L >= (long)nM * nN) return false;
        tile_of((int)L, nM, nN, u.pm, u.pn); u.kind = 0; u.seg = seg; u.fin = (seg == 2); u.nt = (seg == 1) ? 4 : 16;
        u.a = (seg == 0 ? A : (seg == 1 ? A2 + (size_t)u.pn * aN2 : A3)) + (size_t)u.pm * tA;
        u.b = B + (size_t)u.pn * tB + (size_t)(seg == 0 ? 0 : (seg == 1 ? 1024 : 1280)) * 2; return true;
    }
};
struct KVOrder {
    int G, c; const char* memb; const char* wkv;
    __device__ __forceinline__ bool next(int i, Unit& u) const {
        const int L = i * G + c; if (L >= 64) return false;
        if (L < 32) { u.pm = L >> 2; u.pn = L & 3; u.kind = 0; u.a = memb + (size_t)u.pm * 256 * 2048; u.b = wkv + (size_t)u.pn * 256 * 2048; }
        else { const int j = L - 32; u.pm = j; u.pn = 0; u.kind = 1; u.a = wkv + (size_t)(1024 + (j & 3) * 256) * 2048; u.b = memb + (size_t)(j >> 2) * 256 * 2048; }
        return true;
    }
};

__device__ __forceinline__ unsigned cvt_pk_bf16(float lo, float hi) { unsigned r; asm volatile("v_cvt_pk_bf16_f32 %0, %1, %2" : "=v"(r) : "v"(lo), "v"(hi)); return r; }
__device__ __forceinline__ float bf_lo(unsigned w) { return __uint_as_float(w << 16); }
__device__ __forceinline__ float bf_hi(unsigned w) { return __uint_as_float(w & 0xffff0000u); }

typedef int i32x4 __attribute__((ext_vector_type(4)));
typedef int i32x8 __attribute__((ext_vector_type(8)));
typedef float f32x32 __attribute__((ext_vector_type(32)));
__device__ __forceinline__ i32x8 pg8_cat(const bf16x8 lo, const bf16x8 hi) { const i32x4 a = __builtin_bit_cast(i32x4, lo), b = __builtin_bit_cast(i32x4, hi); return __builtin_shufflevector(a, b, 0, 1, 2, 3, 4, 5, 6, 7); }
template <class Epi, class Sched, bool ALIGN_EPI = false, bool SP2 = false, int MODE = 0>
__device__ __forceinline__ void gemm_phase(PG8_LAS unsigned char* lds, const int K, const int lda, const int ldb, const Sched& S, const Epi& E) {
    const int tid = threadIdx.x, wid = __builtin_amdgcn_readfirstlane(tid >> 6), lane = tid & 63, wr = wid >> 2, wc = wid & 3, fr = lane & 15, fq = lane >> 4;
    constexpr bool FP8 = (MODE == 1), INT8 = (MODE == 2);
    const int nt = K / BK; constexpr int NST = Epi::NST;
    unsigned voffA[2], voffB[2];
#pragma unroll
    for (int i = 0; i < 2; ++i) { int R, C; stage_rc(tid * 16 + i * 8192, R, C); const int Rb = Epi::PERM ? ((R & ~31) + perm32(R & 31)) : R;
        voffA[i] = (unsigned)(R * lda + C) * 2u; voffB[i] = (unsigned)(Rb * ldb + C) * 2u; }
    const size_t kstep = (size_t)(BK * 2);
    const size_t hstepA = (size_t)HALF * lda * 2, hstepB = (size_t)HALF * ldb * 2;
    const unsigned ldsw = (unsigned)wid * 1024u;
    const int aoff = lds_byte(wr * 64 + fr, fq * 8), boff = lds_byte(wc * 32 + fr, fq * 8);
#define PG8_SA(b, h) (((b) * 2 + (h)) * HTB)
#define PG8_SB(b, h) ((4 + (b) * 2 + (h)) * HTB)
#define PG8_STAGE(bufoff, gbase, voff) do { _Pragma("unroll") for (int _i = 0; _i < 2; ++_i) \
        __builtin_amdgcn_global_load_lds((const PG8_GAS unsigned*)((const PG8_GAS char*)(gbase) + (voff)[_i]), (PG8_LAS unsigned*)(lds + (bufoff) + ldsw + _i * 8192), 16, 0, 0); } while (0)
#define PG8_LDA(dst, b, h) do { if constexpr (FP8) { _Pragma("unroll") for (int m = 0; m < 4; ++m) dst##8[m] = pg8_cat(*(const PG8_LAS bf16x8*)(lds + PG8_SA(b, h) + aoff + m * 2048), *(const PG8_LAS bf16x8*)(lds + PG8_SA(b, h) + aoff + m * 2048 + 1024)); } \
        else { _Pragma("unroll") for (int m = 0; m < 4; ++m) _Pragma("unroll") for (int k = 0; k < 2; ++k) dst[m][k] = *(const PG8_LAS bf16x8*)(lds + PG8_SA(b, h) + aoff + m * 2048 + k * 1024); } } while (0)
#define PG8_LDB(dst, b, h) do { if constexpr (FP8) { _Pragma("unroll") for (int n = 0; n < 2; ++n) dst##8[n] = pg8_cat(*(const PG8_LAS bf16x8*)(lds + PG8_SB(b, h) + boff + n * 2048), *(const PG8_LAS bf16x8*)(lds + PG8_SB(b, h) + boff + n * 2048 + 1024)); } \
        else { _Pragma("unroll") for (int n = 0; n < 2; ++n) _Pragma("unroll") for (int k = 0; k < 2; ++k) dst[n][k] = *(const PG8_LAS bf16x8*)(lds + PG8_SB(b, h) + boff + n * 2048 + k * 1024); } } while (0)
#define PG8_MMA(ai, bj, At, Bt) do { __builtin_amdgcn_s_setprio(1); \
        if constexpr (FP8) { _Pragma("unroll") for (int m = 0; m < 4; ++m) _Pragma("unroll") for (int n = 0; n < 2; ++n) { \
            const f32x4 _c = (f32x4){accv[ai][bj][(m * 2 + n) * 4], accv[ai][bj][(m * 2 + n) * 4 + 1], accv[ai][bj][(m * 2 + n) * 4 + 2], accv[ai][bj][(m * 2 + n) * 4 + 3]}; \
            const f32x4 _d = __builtin_amdgcn_mfma_scale_f32_16x16x128_f8f6f4(Bt##8[n], At##8[m], _c, 0, 0, 0, 0x7f7f7f7f, 0, 0x7f7f7f7f); \
            _Pragma("unroll") for (int _j = 0; _j < 4; ++_j) accv[ai][bj][(m * 2 + n) * 4 + _j] = _d[_j]; } } \
        else if constexpr (INT8) { _Pragma("unroll") for (int m = 0; m < 4; ++m) _Pragma("unroll") for (int n = 0; n < 2; ++n) _Pragma("unroll") for (int k = 0; k < 2; ++k) \
            acc[ai][bj][m][n] = __builtin_bit_cast(f32x4, __builtin_amdgcn_mfma_i32_16x16x64_i8(__builtin_bit_cast(i32x4, Bt[n][k]), __builtin_bit_cast(i32x4, At[m][k]), __builtin_bit_cast(i32x4, acc[ai][bj][m][n]), 0, 0, 0)); } \
        else { _Pragma("unroll") for (int m = 0; m < 4; ++m) _Pragma("unroll") for (int n = 0; n < 2; ++n) _Pragma("unroll") for (int k = 0; k < 2; ++k) \
            acc[ai][bj][m][n] = __builtin_amdgcn_mfma_f32_16x16x32_bf16(Bt[n][k], At[m][k], acc[ai][bj][m][n], 0, 0, 0); } \
        __builtin_amdgcn_s_setprio(0); } while (0)
#define PG8_WAIT_V(n) asm volatile("s_waitcnt vmcnt(" #n ")" ::: "memory")
#define PG8_WAIT_VN(n) asm volatile("s_waitcnt vmcnt(%0)" :: "n"(n) : "memory")
#define PG8_WAIT_L(n) asm volatile("s_waitcnt lgkmcnt(" #n ")" ::: "memory")
#define PG8_BAR __builtin_amdgcn_s_barrier()
#define PG8_SCHED __builtin_amdgcn_sched_barrier(0)
    Unit cur, nxt; int ui = 0;
    if (!S.next(0, cur)) return;
    f32x4 acc[2][2][4][2];
#pragma unroll
    for (int a = 0; a < 2; ++a)
#pragma unroll
        for (int b = 0; b < 2; ++b)
#pragma unroll
            for (int m = 0; m < 4; ++m)
#pragma unroll
                for (int n = 0; n < 2; ++n) acc[a][b][m][n] = (f32x4){0.f, 0.f, 0.f, 0.f};
    bf16x8 At[4][2], B0[2][2], B1[2][2]; i32x8 At8[4], B08[2], B18[2]; f32x32 accv[2][2];
    if constexpr (FP8) {
#pragma unroll
        for (int a = 0; a < 2; ++a)
#pragma unroll
            for (int b = 0; b < 2; ++b)
#pragma unroll
                for (int j = 0; j < 32; ++j) accv[a][b][j] = 0.f; }
    const char* cA = cur.a; const char* cB = cur.b;
    if constexpr (SP2) {
        PG8_STAGE(PG8_SB(0, 0), cB, voffB); PG8_STAGE(PG8_SB(0, 1), cB + hstepB, voffB); PG8_STAGE(PG8_SA(0, 0), cA, voffA); PG8_STAGE(PG8_SA(0, 1), cA + hstepA, voffA);
        if (wr == 1) PG8_BAR;
        PG8_WAIT_V(2); PG8_BAR;
        PG8_STAGE(PG8_SB(1, 0), cB + kstep, voffB); PG8_STAGE(PG8_SA(1, 0), cA + kstep, voffA); PG8_STAGE(PG8_SB(1, 1), cB + hstepB + kstep, voffB);
        PG8_WAIT_V(6); PG8_BAR;
    } else {
        PG8_STAGE(PG8_SB(0, 0), cB, voffB); PG8_STAGE(PG8_SA(0, 0), cA, voffA); PG8_STAGE(PG8_SB(0, 1), cB + hstepB, voffB); PG8_STAGE(PG8_SA(0, 1), cA + hstepA, voffA);
        if (wr == 1) PG8_BAR;
        PG8_WAIT_V(4); PG8_BAR;
        PG8_STAGE(PG8_SB(1, 0), cB + kstep, voffB); PG8_STAGE(PG8_SA(1, 0), cA + kstep, voffA); PG8_STAGE(PG8_SB(1, 1), cB + hstepB + kstep, voffB);
        PG8_WAIT_V(6); PG8_BAR;
    }
    for (;;) {
        const bool has_next = S.next(ui + 1, nxt);
        const char* nA = has_next ? nxt.a : cA; const char* nB = has_next ? nxt.b : cB;
        int ntc = nt; if constexpr (Epi::SEG) ntc = cur.nt;
        if constexpr (Epi::PREF) E.prefetch(cur, lds + 131072 + 1024 + wid * 256, tid);
#pragma nounroll
        for (int t = 0; t < ntc; t += 2) {
            const bool last = (t == ntc - 2);
            const char* a1 = cA + (size_t)(t + 1) * kstep;
            const char* a2 = last ? nA : cA + (size_t)(t + 2) * kstep; const char* b2 = last ? nB : cB + (size_t)(t + 2) * kstep;
            const char* a3 = a2 + kstep; const char* b3 = b2 + kstep;
            if constexpr (SP2) {
            const bool fresh = !FP8 && (NST > 0) && (t == 0) && (ui > 0);
            PG8_LDB(B0, 0, 0); PG8_LDB(B1, 0, 1); PG8_SCHED; PG8_LDA(At, 0, 0); PG8_STAGE(PG8_SA(1, 1), a1 + hstepA, voffA);
            if (fresh) PG8_WAIT_VN(8 + NST); else PG8_WAIT_V(8);
            PG8_WAIT_L(0); PG8_BAR; PG8_MMA(0, 0, At, B0); PG8_MMA(0, 1, At, B1); PG8_BAR; PG8_SCHED;
            PG8_LDA(At, 0, 1); PG8_STAGE(PG8_SB(0, 0), b2, voffB); PG8_STAGE(PG8_SB(0, 1), b2 + hstepB, voffB); PG8_STAGE(PG8_SA(0, 0), a2, voffA);
            if (fresh) PG8_WAIT_VN(8 + NST); else PG8_WAIT_V(8);
            PG8_WAIT_L(0); PG8_BAR; PG8_MMA(1, 0, At, B0); PG8_MMA(1, 1, At, B1); PG8_BAR; PG8_SCHED;
            PG8_LDB(B0, 1, 0); PG8_LDB(B1, 1, 1); PG8_SCHED; PG8_LDA(At, 1, 0); PG8_STAGE(PG8_SA(0, 1), a2 + hstepA, voffA);
            PG8_WAIT_V(8); PG8_WAIT_L(0); PG8_BAR; PG8_MMA(0, 0, At, B0); PG8_MMA(0, 1, At, B1); PG8_BAR; PG8_SCHED;
            PG8_LDA(At, 1, 1); PG8_STAGE(PG8_SB(1, 0), b3, voffB); PG8_STAGE(PG8_SB(1, 1), b3 + hstepB, voffB); PG8_STAGE(PG8_SA(1, 0), a3, voffA);
            PG8_WAIT_V(8); PG8_WAIT_L(0); PG8_BAR; PG8_MMA(1, 0, At, B0); PG8_MMA(1, 1, At, B1); PG8_BAR; PG8_SCHED;
            } else {
            PG8_LDB(B0, 0, 0); PG8_SCHED; PG8_LDA(At, 0, 0); PG8_STAGE(PG8_SA(1, 1), a1 + hstepA, voffA);
            PG8_WAIT_L(8); PG8_BAR; PG8_WAIT_L(0); PG8_MMA(0, 0, At, B0); PG8_BAR; PG8_SCHED;
            PG8_LDB(B1, 0, 1); PG8_STAGE(PG8_SB(0, 0), b2, voffB);
            PG8_BAR; PG8_WAIT_L(0); PG8_MMA(0, 1, At, B1); PG8_BAR;
            PG8_LDA(At, 0, 1); PG8_STAGE(PG8_SA(0, 0), a2, voffA);
            PG8_BAR; PG8_WAIT_L(0); PG8_MMA(1, 0, At, B0); PG8_BAR; PG8_SCHED;
            PG8_STAGE(PG8_SB(0, 1), b2 + hstepB, voffB);
            PG8_WAIT_V(6); PG8_BAR; PG8_MMA(1, 1, At, B1); PG8_BAR;
            PG8_LDB(B0, 1, 0); PG8_SCHED; PG8_LDA(At, 1, 0); PG8_STAGE(PG8_SA(0, 1), a2 + hstepA, voffA);
            PG8_WAIT_L(8); PG8_BAR; PG8_WAIT_L(0); PG8_MMA(0, 0, At, B0); PG8_BAR; PG8_SCHED;
            PG8_LDB(B1, 1, 1); PG8_STAGE(PG8_SB(1, 0), b3, voffB);
            PG8_BAR; PG8_WAIT_L(0); PG8_MMA(0, 1, At, B1); PG8_BAR;
            PG8_LDA(At, 1, 1); PG8_STAGE(PG8_SA(1, 0), a3, voffA);
            PG8_BAR; PG8_WAIT_L(0); PG8_MMA(1, 0, At, B0); PG8_BAR; PG8_SCHED;
            PG8_STAGE(PG8_SB(1, 1), b3 + hstepB, voffB);
            PG8_WAIT_V(6); PG8_BAR; PG8_MMA(1, 1, At, B1); PG8_BAR;
            }
        }
        if constexpr (ALIGN_EPI) { if (wr == 0) PG8_BAR; }
        if constexpr (FP8) {
#pragma unroll
            for (int a = 0; a < 2; ++a)
#pragma unroll
                for (int b = 0; b < 2; ++b)
#pragma unroll
                    for (int m = 0; m < 4; ++m)
#pragma unroll
                        for (int n = 0; n < 2; ++n) { acc[a][b][m][n] = (f32x4){accv[a][b][(m * 2 + n) * 4], accv[a][b][(m * 2 + n) * 4 + 1], accv[a][b][(m * 2 + n) * 4 + 2], accv[a][b][(m * 2 + n) * 4 + 3]}; }
#pragma unroll
            for (int a = 0; a < 2; ++a)
#pragma unroll
                for (int b = 0; b < 2; ++b)
#pragma unroll
                    for (int j = 0; j < 32; ++j) accv[a][b][j] = 0.f; }
        if constexpr (INT8) {
#pragma unroll
            for (int a = 0; a < 2; ++a)
#pragma unroll
                for (int b = 0; b < 2; ++b)
#pragma unroll
                    for (int m = 0; m < 4; ++m)
#pragma unroll
                        for (int n = 0; n < 2; ++n) { const i32x4 iv = __builtin_bit_cast(i32x4, acc[a][b][m][n]); acc[a][b][m][n] = (f32x4){(float)iv[0], (float)iv[1], (float)iv[2], (float)iv[3]}; } }
        bool fin = true;
        if constexpr (Epi::SEG) { fin = cur.fin != 0; if (fin) E(acc, cur, wr, wc, fr, fq); else E.mid(acc, cur, cur.seg + 1, wr, wc, fr, fq); } else E(acc, cur, wr, wc, fr, fq);
        if (!has_next) break;
        if (fin) {
#pragma unroll
        for (int a = 0; a < 2; ++a)
#pragma unroll
            for (int b = 0; b < 2; ++b)
#pragma unroll
                for (int m = 0; m < 4; ++m)
#pragma unroll
                    for (int n = 0; n < 2; ++n) acc[a][b][m][n] = (f32x4){0.f, 0.f, 0.f, 0.f};
        }
        cur = nxt; cA = nA; cB = nB; ++ui;
        if constexpr (ALIGN_EPI) { if (wr == 1) PG8_BAR; }
    }
    PG8_WAIT_V(0);
    if constexpr (!ALIGN_EPI) { if (wr == 0) PG8_BAR; }
    PG8_BAR;
#undef PG8_SA
#undef PG8_SB
#undef PG8_STAGE
#undef PG8_LDA
#undef PG8_LDB
#undef PG8_MMA
#undef PG8_WAIT_V
#undef PG8_WAIT_VN
#undef PG8_WAIT_L
#undef PG8_BAR
#undef PG8_SCHED
}
}
using pg8::bf16_t; using pg8::f32x4; using pg8::f32x2; using pg8::u32x4; using pg8::u32x2; using pg8::Unit; using pg8::cvt_pk_bf16; using pg8::bf_lo; using pg8::bf_hi;
#define LAS __attribute__((address_space(3)))

constexpr int D = 1024, BATCH = 8, SEQ = 4096, NTOK = BATCH * SEQ, MEMLEN = 256, NMEM = BATCH * MEMLEN;
constexpr int INCOLS = 8192, GATE0 = 5120;
constexpr int NEXP = 64, DEXP = 512, NGRP = 8, EPG = 8;
constexpr int NASSIGN = NTOK * 2, PMAX_TILES = 320, PMAX = PMAX_TILES * 256;
constexpr float ALPHA = 1.189207115002721f;
constexpr float LN_EPS = 1e-5f;
constexpr int NWAVES = 8, NTHR = 512;

constexpr size_t MiB = 1u << 20;
constexpr size_t WS_CTL = 0, CTL_ZERO_BYTES = 1 * MiB;
constexpr size_t WS_WIN = 1 * MiB, WS_WKV = 17 * MiB, WS_WCAT = 21 * MiB, WS_WO = 26 * MiB, WS_WR = 28 * MiB;
constexpr int KCAT = 2304;
constexpr size_t WS_WUP = 29 * MiB, WS_WDN = 157 * MiB, WS_MISC = 221 * MiB;
constexpr size_t WS_Z = 224 * MiB;
constexpr size_t WS_XB = 736 * MiB, WS_MEMB = 800 * MiB, WS_KV = 804 * MiB, WS_ACONV = 812 * MiB, WS_DPOOL = 876 * MiB, WS_MERGED = 940 * MiB;
constexpr size_t WS_KB = WS_KV, WS_VT = WS_KV + 4 * MiB;
constexpr size_t WS_XS = WS_MISC + 3 * (MiB / 2), WS_SW = WS_MISC + 7 * (MiB / 4);
constexpr size_t WS_SWU = WS_MISC + 2 * MiB;
constexpr size_t WS_XSB = WS_MISC + 9 * (MiB / 4), WS_H1S = WS_MISC + 21 * (MiB / 8);
constexpr size_t WS_O = WS_XB;
constexpr size_t WS_H1 = 224 * MiB;
constexpr size_t WS_H1B = 480 * MiB;
constexpr size_t WS_XBUF = 544 * MiB;
constexpr size_t WS_H1F8 = 640 * MiB;
constexpr size_t WS_ACT = 736 * MiB;
constexpr size_t WS_YBUF = 816 * MiB;
constexpr size_t WS_END = 1004 * MiB;
constexpr size_t MS_TOKE = 0, MS_TOKPOS = MS_TOKE + NASSIGN * 4, MS_TOKW = MS_TOKPOS + NASSIGN * 4, MS_TOKDEST = MS_TOKW + NASSIGN * 4, MS_TILEE = MS_TOKDEST + NASSIGN * 4, MS_PSTART = MS_TILEE + 4096, MS_NTILES = MS_PSTART + 1024;
constexpr int CW_COUNTS = 1024;
constexpr int CW_CPCTR = 1152, CW_CPCTR2 = 1216, CW_WDCTR = 1280;
constexpr int CP_CHUNKS = (NTOK / 16) * (D / 8) / NTHR, CP_EARLY = 180;
constexpr int NATT = 192;
constexpr int CW_BAR = 4096;

constexpr int LDS_BYTES = 147456, MISC_OFF = 131072 + 320;

struct Params { const float* in[21]; float* out; unsigned char* ws; int ph_lo, ph_hi; };
enum { I_X = 0, I_MEM, I_WIN, I_BGATE, I_CONVW, I_WCONV, I_WPOOL, I_PSCALE, I_WKV, I_WXO, I_WO, I_LN1G, I_LN1B, I_WRG, I_BRG, I_WRE, I_BRE, I_WUP, I_WDN, I_LN2G, I_LN2B };

__device__ __forceinline__ unsigned f2bf(float f) { unsigned u = __float_as_uint(f); return (u + 0x7fffu + ((u >> 16) & 1u)) >> 16; }
__device__ __forceinline__ unsigned pk2(float lo, float hi) { return f2bf(lo) | (f2bf(hi) << 16); }
__device__ __forceinline__ float wave_sum(float v) {
#pragma unroll
    for (int o = 1; o < 64; o <<= 1) v += __shfl_xor(v, o);
    return v;
}
__device__ __forceinline__ float sigmoidf_(float x) { return __builtin_amdgcn_rcpf(1.0f + __expf(-x)); }


#define XB_TMO      128
#define XB_XCNT(j)  (256  + 64 * (j))
#define XB_XSUB(j)  (1280 + 64 * (j))
#define XB_XGEN(j)  (2304 + 64 * (j))
#define XB_TOP      3328
#define XB_TOPGEN   3392
#define XCD_BAR_WORDS 3456
#define XB_SPIN_CAP (1u << 18)
__device__ __forceinline__ unsigned xb_ld(unsigned* p)              { return __hip_atomic_load(p, __ATOMIC_RELAXED, __HIP_MEMORY_SCOPE_AGENT); }
__device__ __forceinline__ unsigned xb_add(unsigned* p, unsigned v) { return __hip_atomic_fetch_add(p, v, __ATOMIC_RELAXED, __HIP_MEMORY_SCOPE_AGENT); }
__device__ __forceinline__ unsigned xb_xcc_id() { return (unsigned)__builtin_amdgcn_s_getreg((3 << 11) | 20) & 0xFu; }
#define XB_SPIN(cond, bar) do { unsigned _sp = 0; while (cond) { __builtin_amdgcn_s_sleep(1); \
    if ((++_sp & 255u) == 0u) { if (xb_ld(&(bar)[XB_TMO])) break; if (_sp > XB_SPIN_CAP) { atomicAdd(&(bar)[XB_TMO], 1u); break; } } } } while (0)
struct XcdBarrier { unsigned* bar; unsigned x; volatile LAS unsigned* st; };
__device__ __forceinline__ XcdBarrier xcd_barrier_post(unsigned* bar, volatile LAS unsigned* st) {
    XcdBarrier b; b.bar = bar; b.x = xb_xcc_id(); b.st = st;
    if (threadIdx.x == 0) (void)xb_add(&bar[XB_XCNT(b.x)], 1u);
    return b;
}
__device__ __forceinline__ void xcd_barrier_complete(unsigned* bar, unsigned x, unsigned& nloc, unsigned& nx) {
    const unsigned G = gridDim.x * gridDim.y * gridDim.z;
    unsigned sum, cnt, mine, sp = 0u;
    for (;;) {
        sum = 0u; cnt = 0u; mine = 0u;
#pragma unroll
        for (unsigned j = 0; j < 16; ++j) { const unsigned c = xb_ld(&bar[XB_XCNT(j)]); sum += c; cnt += (c > 0u) ? 1u : 0u; mine = (j == x) ? c : mine; }
        if (sum == G) break;
        __builtin_amdgcn_s_sleep(1);
        if ((++sp & 255u) == 0u) { if (xb_ld(&bar[XB_TMO])) break; if (sp > XB_SPIN_CAP) { atomicAdd(&bar[XB_TMO], 1u); break; } }
    }
    nloc = mine > 0u ? mine : 1u; nx = cnt > 0u ? cnt : 1u;
}
__device__ __forceinline__ void xcd_barrier(const XcdBarrier& b) {
    asm volatile("s_waitcnt vmcnt(0)" ::: "memory");
    __syncthreads();
    if (threadIdx.x == 0) {
        unsigned* bar = b.bar;
        __builtin_amdgcn_s_waitcnt(0);
        unsigned nloc = b.st[0], nx = b.st[1];
        if (nloc == 0u) { xcd_barrier_complete(bar, b.x, nloc, nx); b.st[0] = nloc; b.st[1] = nx; }
        const unsigned old = xb_add(&bar[XB_XSUB(b.x)], 1u);
        const unsigned gen = old / nloc;
        if (old + 1u == (gen + 1u) * nloc) {
            __builtin_amdgcn_fence(__ATOMIC_RELEASE, "agent");
            asm volatile("s_waitcnt vmcnt(0)" ::: "memory");
            const unsigned og = xb_add(&bar[XB_TOP], 1u);
            const unsigned tg = og / nx;
            if (og + 1u == (tg + 1u) * nx) xb_add(&bar[XB_TOPGEN], 1u);
            else XB_SPIN(xb_ld(&bar[XB_TOPGEN]) == tg, bar);
            __builtin_amdgcn_fence(__ATOMIC_ACQUIRE, "agent");
            xb_add(&bar[XB_XGEN(b.x)], 1u);
            asm volatile("s_waitcnt vmcnt(0)" ::: "memory");
        } else {
            XB_SPIN(xb_ld(&bar[XB_XGEN(b.x)]) == gen, bar);
            __builtin_amdgcn_fence(__ATOMIC_ACQUIRE, "agent");
            asm volatile("s_waitcnt vmcnt(0)" ::: "memory");
        }
    }
    __syncthreads();
}

__device__ __forceinline__ void stagger_delay(unsigned ticks) {
    const unsigned long long t0 = __builtin_amdgcn_s_memrealtime();
    while (__builtin_amdgcn_s_memrealtime() - t0 < (unsigned long long)ticks) __builtin_amdgcn_s_sleep(4);
}

template <int LPR> __device__ __forceinline__ void touch_tile(const char* base, size_t pitch, LAS unsigned char* junk, int tid) {
#pragma unroll
    for (int i = 0; i < (256 * LPR) / 512; ++i) { const int ln = i * 512 + tid, r = ln / LPR, c = ln % LPR;
        __builtin_amdgcn_global_load_lds((const PG8_GAS unsigned*)(base + (size_t)r * pitch + c * 128), (LAS unsigned*)junk, 4, 0, 0); }
}

struct EpiBf16 {
    static constexpr bool PERM = true, SEG = false, PREF = false; static constexpr int NST = 8;
    bf16_t* O; int ldc; const float* bias; int gate_pn; int gate_col0; float oscale; int mul_pn0, mul_pn1, mul_col0; const float* rs; const float* cs; int f8out;
    __device__ __forceinline__ void operator()(const f32x4 (&acc)[2][2][4][2], const Unit& u, int wr, int wc, int fr, int fq) const {
        const int row0 = u.pm * 256 + wr * 64 + fr, col0 = u.pn * 256 + wc * 32 + 8 * fq;
        f32x4 cv[2][2]; float rv[2][4];
#pragma unroll
        for (int bj = 0; bj < 2; ++bj)
#pragma unroll
            for (int n = 0; n < 2; ++n) cv[bj][n] = cs ? *(const f32x4*)(cs + col0 + bj * 128 + 4 * n) : (f32x4){1.f, 1.f, 1.f, 1.f};
#pragma unroll
        for (int ai = 0; ai < 2; ++ai)
#pragma unroll
            for (int m = 0; m < 4; ++m) rv[ai][m] = (rs ? rs[row0 + ai * 128 + m * 16] : 1.0f) * oscale;
        if (u.pn >= mul_pn0 && u.pn < mul_pn1) {
            const int mc = mul_col0 + (u.pn - mul_pn0) * 128 + wc * 32 + 8 * fq;
#pragma unroll
            for (int ai = 0; ai < 2; ++ai)
#pragma unroll
                for (int m = 0; m < 4; ++m) { const float r2 = rv[ai][m] * rv[ai][m];
                    const f32x4 v0 = (acc[ai][0][m][0] * cv[0][0]) * (acc[ai][1][m][0] * cv[1][0]) * r2, v1 = (acc[ai][0][m][1] * cv[0][1]) * (acc[ai][1][m][1] * cv[1][1]) * r2;
                    u32x4 w; w.x = cvt_pk_bf16(v0[0], v0[1]); w.y = cvt_pk_bf16(v0[2], v0[3]); w.z = cvt_pk_bf16(v1[0], v1[1]); w.w = cvt_pk_bf16(v1[2], v1[3]);
                    __builtin_nontemporal_store(w, (u32x4*)(O + (size_t)(row0 + ai * 128 + m * 16) * ldc + mc)); }
            return;
        }
        const bool gate = u.pn >= gate_pn;
        f32x4 bv[2][2];
#pragma unroll
        for (int bj = 0; bj < 2; ++bj)
#pragma unroll
            for (int n = 0; n < 2; ++n) bv[bj][n] = gate ? *(const f32x4*)(bias + (col0 - gate_col0) + bj * 128 + 4 * n) : (f32x4){0.f, 0.f, 0.f, 0.f};
        if (gate || f8out) {
            const int odd = fq & 1; const int colb = col0 - 8 * odd + 128 * odd;
            unsigned char* ob = gate ? (unsigned char*)O + 2 * gate_col0 + (colb - gate_col0) : (unsigned char*)O + colb;
            const size_t pitch = gate ? (size_t)ldc * 2 : (size_t)ldc;
#pragma unroll
            for (int ai = 0; ai < 2; ++ai)
#pragma unroll
                for (int m = 0; m < 4; ++m) { u32x2 w8[2];
#pragma unroll
                    for (int bj = 0; bj < 2; ++bj) { const f32x4 v0 = acc[ai][bj][m][0] * (cv[bj][0] * rv[ai][m]) + bv[bj][0], v1 = acc[ai][bj][m][1] * (cv[bj][1] * rv[ai][m]) + bv[bj][1];
                        if (gate) { unsigned q0 = 0u, q1 = 0u;
#pragma unroll
                            for (int j = 0; j < 4; ++j) { q0 = __builtin_amdgcn_cvt_pk_u8_f32(fmaxf(__builtin_floorf(sigmoidf_(v0[j]) * 255.0f + 0.5f), 1.0f), j, q0); q1 = __builtin_amdgcn_cvt_pk_u8_f32(fmaxf(__builtin_floorf(sigmoidf_(v1[j]) * 255.0f + 0.5f), 1.0f), j, q1); }
                            w8[bj].x = q0; w8[bj].y = q1;
                        } else { int q = __builtin_amdgcn_cvt_pk_fp8_f32(v0[0], v0[1], 0, false); q = __builtin_amdgcn_cvt_pk_fp8_f32(v0[2], v0[3], q, true); w8[bj].x = (unsigned)q;
                            q = __builtin_amdgcn_cvt_pk_fp8_f32(v1[0], v1[1], 0, false); q = __builtin_amdgcn_cvt_pk_fp8_f32(v1[2], v1[3], q, true); w8[bj].y = (unsigned)q; } }
                    const u32x2 sx = __builtin_amdgcn_permlane16_swap(w8[0].x, w8[1].x, false, false), sy = __builtin_amdgcn_permlane16_swap(w8[0].y, w8[1].y, false, false);
                    u32x4 w; w.x = sx[0]; w.y = sy[0]; w.z = sx[1]; w.w = sy[1];
                    *(u32x4*)(ob + (size_t)(row0 + ai * 128 + m * 16) * pitch) = w; }
            return;
        }
#pragma unroll
        for (int ai = 0; ai < 2; ++ai)
#pragma unroll
            for (int m = 0; m < 4; ++m) { bf16_t* rowp = O + (size_t)(row0 + ai * 128 + m * 16) * ldc + col0;
#pragma unroll
                for (int bj = 0; bj < 2; ++bj) { f32x4 v0 = acc[ai][bj][m][0] * (cv[bj][0] * rv[ai][m]) + bv[bj][0], v1 = acc[ai][bj][m][1] * (cv[bj][1] * rv[ai][m]) + bv[bj][1];
                    if (gate) {
                        unsigned q0 = 0u, q1 = 0u;
#pragma unroll
                        for (int j = 0; j < 4; ++j) { q0 = __builtin_amdgcn_cvt_pk_u8_f32(fmaxf(__builtin_floorf(sigmoidf_(v0[j]) * 255.0f + 0.5f), 1.0f), j, q0); q1 = __builtin_amdgcn_cvt_pk_u8_f32(fmaxf(__builtin_floorf(sigmoidf_(v1[j]) * 255.0f + 0.5f), 1.0f), j, q1); }
                        u32x2 w8; w8.x = q0; w8.y = q1;
                        *(u32x2*)((unsigned char*)(O + (size_t)(row0 + ai * 128 + m * 16) * ldc) + 2 * gate_col0 + (col0 - gate_col0) + bj * 128) = w8;
                        continue; }
                    if (f8out) { u32x2 w8; { int q = __builtin_amdgcn_cvt_pk_fp8_f32(v0[0], v0[1], 0, false); q = __builtin_amdgcn_cvt_pk_fp8_f32(v0[2], v0[3], q, true); w8.x = (unsigned)q; }
                        { int q = __builtin_amdgcn_cvt_pk_fp8_f32(v1[0], v1[1], 0, false); q = __builtin_amdgcn_cvt_pk_fp8_f32(v1[2], v1[3], q, true); w8.y = (unsigned)q; }
                        *(u32x2*)((unsigned char*)O + (size_t)(row0 + ai * 128 + m * 16) * ldc + col0 + bj * 128) = w8; continue; }
                    u32x4 w; w.x = cvt_pk_bf16(v0[0], v0[1]); w.y = cvt_pk_bf16(v0[2], v0[3]); w.z = cvt_pk_bf16(v1[0], v1[1]); w.w = cvt_pk_bf16(v1[2], v1[3]);
                    __builtin_nontemporal_store(w, (u32x4*)(rowp + bj * 128)); } }
    }
};
struct EpiKV {
    static constexpr bool PERM = true, SEG = false, PREF = false; static constexpr int NST = 0;
    bf16_t* KB; bf16_t* VT;
    __device__ __forceinline__ void operator()(const f32x4 (&acc)[2][2][4][2], const Unit& u, int wr, int wc, int fr, int fq) const {
        const int row0 = u.pm * 256 + wr * 64 + fr, col0 = u.pn * 256 + wc * 32 + 8 * fq;
#pragma unroll
        for (int ai = 0; ai < 2; ++ai)
#pragma unroll
            for (int m = 0; m < 4; ++m) { const size_t row = (size_t)(row0 + ai * 128 + m * 16);
#pragma unroll
                for (int bj = 0; bj < 2; ++bj) { const f32x4 v0 = acc[ai][bj][m][0], v1 = acc[ai][bj][m][1];
                    u32x4 w; w.x = cvt_pk_bf16(v0[0], v0[1]); w.y = cvt_pk_bf16(v0[2], v0[3]); w.z = cvt_pk_bf16(v1[0], v1[1]); w.w = cvt_pk_bf16(v1[2], v1[3]);
                    if (u.kind == 0) { *(u32x4*)(KB + row * D + col0 + bj * 128) = w; }
                    else { const int k0 = col0 + bj * 128, base = k0 & ~15, hi8 = (k0 & 8) ? 1 : 0;
                        u32x2 lo2; lo2.x = w.x; lo2.y = w.y; u32x2 hi2; hi2.x = w.z; hi2.y = w.w;
                        *(u32x2*)(VT + row * 256 + base + (hi8 ? 4 : 0)) = lo2; *(u32x2*)(VT + row * 256 + base + (hi8 ? 12 : 8)) = hi2; } } }
    }
};
template <int MODE> struct EpiProbe { static constexpr bool PERM = true, SEG = false, PREF = false; static constexpr int NST = 0;
    bf16_t* O; int flag;
    __device__ __forceinline__ void operator()(const f32x4 (&acc)[2][2][4][2], const Unit& u, int wr, int wc, int fr, int fq) const {
        const int row0 = (MODE == 1 ? 0 : u.pm * 256) + wr * 64 + fr, col0 = (MODE == 1 ? 0 : u.pn * 256) + wc * 32 + 8 * fq;
#pragma unroll
        for (int ai = 0; ai < 2; ++ai)
#pragma unroll
            for (int m = 0; m < 4; ++m) { bf16_t* rowp = O + (size_t)(row0 + ai * 128 + m * 16) * 2048 + col0;
#pragma unroll
                for (int bj = 0; bj < 2; ++bj) { const f32x4 v0 = acc[ai][bj][m][0], v1 = acc[ai][bj][m][1];
                    u32x4 w; w.x = cvt_pk_bf16(v0[0], v0[1]); w.y = cvt_pk_bf16(v0[2], v0[3]); w.z = cvt_pk_bf16(v1[0], v1[1]); w.w = cvt_pk_bf16(v1[2], v1[3]);
                    if (MODE == 1 || flag == 12345) __builtin_nontemporal_store(w, (u32x4*)(rowp + bj * 128)); } }
    }
};
struct EpiNull { static constexpr bool PERM = true, SEG = false, PREF = false; static constexpr int NST = 0;
    __device__ __forceinline__ void operator()(const f32x4 (&acc)[2][2][4][2], const Unit& u, int wr, int wc, int fr, int fq) const {
        float s = 0.f;
#pragma unroll
        for (int ai = 0; ai < 2; ++ai)
#pragma unroll
            for (int bj = 0; bj < 2; ++bj)
#pragma unroll
                for (int m = 0; m < 4; ++m)
#pragma unroll
                    for (int n = 0; n < 2; ++n) s += acc[ai][bj][m][n][0] + acc[ai][bj][m][n][1] + acc[ai][bj][m][n][2] + acc[ai][bj][m][n][3];
        if (s == 123456.789f) *sink = s;
    }
    float* sink;
};
template <int MODE> struct EpiMerge {
    static constexpr bool PERM = true, SEG = false, PREF = false; static constexpr int NST = 0;
    bf16_t* Mg; const bf16_t* Z; int gcol0; const float* scale;
    __device__ __forceinline__ void operator()(const f32x4 (&acc)[2][2][4][2], const Unit& u, int wr, int wc, int fr, int fq) const {
        const int row0 = u.pm * 256 + wr * 64 + fr, col0 = u.pn * 256 + wc * 32 + 8 * fq;
        f32x4 sv[2][2];
#pragma unroll
        for (int bj = 0; bj < 2; ++bj)
#pragma unroll
            for (int n = 0; n < 2; ++n) sv[bj][n] = scale ? *(const f32x4*)(scale + col0 + bj * 128 + 4 * n) : (f32x4){1.f, 1.f, 1.f, 1.f};
#pragma unroll
        for (int ai = 0; ai < 2; ++ai)
#pragma unroll
            for (int m = 0; m < 4; ++m) { const size_t row = (size_t)(row0 + ai * 128 + m * 16);
#pragma unroll
                for (int bj = 0; bj < 2; ++bj) {
                    const u32x4 g = *(const u32x4*)(Z + row * INCOLS + gcol0 + col0 + bj * 128);
                    f32x4 v0 = acc[ai][bj][m][0] * sv[bj][0], v1 = acc[ai][bj][m][1] * sv[bj][1];
                    v0[0] *= bf_lo(g.x); v0[1] *= bf_hi(g.x); v0[2] *= bf_lo(g.y); v0[3] *= bf_hi(g.y);
                    v1[0] *= bf_lo(g.z); v1[1] *= bf_hi(g.z); v1[2] *= bf_lo(g.w); v1[3] *= bf_hi(g.w);
                    u32x4* mp = (u32x4*)(Mg + row * D + col0 + bj * 128);
                    if (MODE) { const u32x4 o = *mp;
                        v0[0] += bf_lo(o.x); v0[1] += bf_hi(o.x); v0[2] += bf_lo(o.y); v0[3] += bf_hi(o.y);
                        v1[0] += bf_lo(o.z); v1[1] += bf_hi(o.z); v1[2] += bf_lo(o.w); v1[3] += bf_hi(o.w); }
                    u32x4 w; w.x = cvt_pk_bf16(v0[0], v0[1]); w.y = cvt_pk_bf16(v0[2], v0[3]); w.z = cvt_pk_bf16(v1[0], v1[1]); w.w = cvt_pk_bf16(v1[2], v1[3]);
                    *mp = w; } }
    }
};
struct EpiMix3 {
    static constexpr bool PERM = true, SEG = true, PREF = false; static constexpr int T1 = 16, T2 = 20, NST = 0;
    bf16_t* Mg; const bf16_t* Z; const float* pscale; int light;
    __device__ __forceinline__ static f32x4 ub4(unsigned w) { return (f32x4){(float)(w & 0xffu), (float)((w >> 8) & 0xffu), (float)((w >> 16) & 0xffu), (float)(w >> 24)}; }
    __device__ __forceinline__ void mid(f32x4 (&acc)[2][2][4][2], const Unit& u, int seg, int wr, int wc, int fr, int fq) const {
        if (light) {
#pragma unroll
            for (int ai = 0; ai < 2; ++ai)
#pragma unroll
                for (int bj = 0; bj < 2; ++bj)
#pragma unroll
                    for (int m = 0; m < 4; ++m)
#pragma unroll
                        for (int n = 0; n < 2; ++n) acc[ai][bj][m][n] = acc[ai][bj][m][n] * 1.0001f;
            return; }
        const int row0 = u.pm * 256 + wr * 64 + fr, col0 = u.pn * 256 + wc * 32 + 8 * fq;
        const bool s1 = (seg == 1);
        f32x4 sr[2][2];
#pragma unroll
        for (int bj = 0; bj < 2; ++bj)
#pragma unroll
            for (int n = 0; n < 2; ++n) { const f32x4 ps = *(const f32x4*)(pscale + col0 + bj * 128 + 4 * n);
#pragma unroll
                for (int j = 0; j < 4; ++j) sr[bj][n][j] = s1 ? __builtin_amdgcn_rcpf(ps[j]) : ps[j]; }
        const unsigned char* zb = (const unsigned char*)Z + 2 * GATE0 + col0;
        const unsigned char* zn = zb + (s1 ? 0 : D); const unsigned char* zd = zb + (s1 ? D : 2 * D);
#pragma unroll
        for (int ai = 0; ai < 2; ++ai)
#pragma unroll
            for (int m = 0; m < 4; ++m) { const size_t rb = (size_t)(row0 + ai * 128 + m * 16) * (2 * INCOLS);
#pragma unroll
                for (int bj = 0; bj < 2; ++bj) {
                    const u32x2 gn = *(const u32x2*)(zn + rb + bj * 128), gd = *(const u32x2*)(zd + rb + bj * 128);
                    const f32x4 n0 = ub4(gn.x) * sr[bj][0], n1 = ub4(gn.y) * sr[bj][1], d0 = ub4(gd.x), d1 = ub4(gd.y);
#pragma unroll
                    for (int j = 0; j < 4; ++j) { acc[ai][bj][m][0][j] *= n0[j] * __builtin_amdgcn_rcpf(d0[j]); acc[ai][bj][m][1][j] *= n1[j] * __builtin_amdgcn_rcpf(d1[j]); } }
                asm volatile("" ::: "memory"); }
    }
    __device__ __forceinline__ void operator()(const f32x4 (&acc)[2][2][4][2], const Unit& u, int wr, int wc, int fr, int fq) const {
        const int row0 = u.pm * 256 + wr * 64 + fr, col0 = u.pn * 256 + wc * 32 + 8 * fq;
        const unsigned char* zg = (const unsigned char*)Z + 2 * GATE0 + 2 * D + col0;
#pragma unroll
        for (int ai = 0; ai < 2; ++ai)
#pragma unroll
            for (int m = 0; m < 4; ++m) { const size_t row = (size_t)(row0 + ai * 128 + m * 16);
#pragma unroll
                for (int bj = 0; bj < 2; ++bj) {
                    const u32x2 g = *(const u32x2*)(zg + row * (2 * INCOLS) + bj * 128);
                    const f32x4 v0 = acc[ai][bj][m][0] * (ub4(g.x) * (1.0f / 255.0f)), v1 = acc[ai][bj][m][1] * (ub4(g.y) * (1.0f / 255.0f));
                    u32x4 w; w.x = cvt_pk_bf16(v0[0], v0[1]); w.y = cvt_pk_bf16(v0[2], v0[3]); w.z = cvt_pk_bf16(v1[0], v1[1]); w.w = cvt_pk_bf16(v1[2], v1[3]);
                    *(u32x4*)(Mg + row * D + col0 + bj * 128) = w; } }
    }
};
struct EpiResBf16 {
    static constexpr bool PERM = true, SEG = false, PREF = false; static constexpr int NST = 12;
    bf16_t* O; const float* base; float alpha;
    __device__ __forceinline__ void operator()(const f32x4 (&acc)[2][2][4][2], const Unit& u, int wr, int wc, int fr, int fq) const {
        const int row0 = u.pm * 256 + wr * 64 + fr, col0 = u.pn * 256 + wc * 32 + 8 * fq;
#pragma unroll
        for (int ai = 0; ai < 2; ++ai)
#pragma unroll
            for (int m = 0; m < 4; ++m) { const size_t off = (size_t)(row0 + ai * 128 + m * 16) * D + col0;
#pragma unroll
                for (int bj = 0; bj < 2; ++bj) { const f32x4 b0 = *(const f32x4*)(base + off + bj * 128), b1 = *(const f32x4*)(base + off + bj * 128 + 4);
                    const f32x4 v0 = b0 * alpha + acc[ai][bj][m][0], v1 = b1 * alpha + acc[ai][bj][m][1];
                    u32x4 w; w.x = cvt_pk_bf16(v0[0], v0[1]); w.y = cvt_pk_bf16(v0[2], v0[3]); w.z = cvt_pk_bf16(v1[0], v1[1]); w.w = cvt_pk_bf16(v1[2], v1[3]);
                    *(u32x4*)(O + off + bj * 128) = w; } }
    }
};
struct EpiAct {
    static constexpr bool PERM = true, SEG = false, PREF = false; static constexpr int NST = 3;
    unsigned char* O; const float* rs; const float* cs;
    __device__ __forceinline__ void operator()(const f32x4 (&acc)[2][2][4][2], const Unit& u, int wr, int wc, int fr, int fq) const {
        const int row0 = u.pm * 256 + wr * 64 + fr, col0 = u.pn * 128 + wc * 32 + 8 * fq;
        const float* cse = cs + (size_t)u.kind * D + u.pn * 256 + wc * 32 + 8 * fq;
        f32x4 cg[2], cv[2];
#pragma unroll
        for (int n = 0; n < 2; ++n) { cg[n] = *(const f32x4*)(cse + 4 * n); cv[n] = *(const f32x4*)(cse + 128 + 4 * n); }
        const int odd = fq & 1;
#pragma unroll
        for (int ai = 0; ai < 2; ++ai)
#pragma unroll
            for (int mp = 0; mp < 4; mp += 2) { u32x2 w8[2];
#pragma unroll
                for (int k = 0; k < 2; ++k) { const int m = mp + k; const int row = row0 + ai * 128 + m * 16; const float r = rs[row];
                    f32x4 r0, r1;
#pragma unroll
                    for (int j = 0; j < 4; ++j) { const float g0 = acc[ai][0][m][0][j] * (cg[0][j] * r), g1 = acc[ai][0][m][1][j] * (cg[1][j] * r);
                        r0[j] = g0 * sigmoidf_(g0) * (acc[ai][1][m][0][j] * (cv[0][j] * r)); r1[j] = g1 * sigmoidf_(g1) * (acc[ai][1][m][1][j] * (cv[1][j] * r)); }
                    int q = __builtin_amdgcn_cvt_pk_fp8_f32(r0[0], r0[1], 0, false); q = __builtin_amdgcn_cvt_pk_fp8_f32(r0[2], r0[3], q, true); w8[k].x = (unsigned)q;
                    q = __builtin_amdgcn_cvt_pk_fp8_f32(r1[0], r1[1], 0, false); q = __builtin_amdgcn_cvt_pk_fp8_f32(r1[2], r1[3], q, true); w8[k].y = (unsigned)q; }
                const u32x2 sx = __builtin_amdgcn_permlane16_swap(w8[0].x, w8[1].x, false, false), sy = __builtin_amdgcn_permlane16_swap(w8[0].y, w8[1].y, false, false);
                u32x4 w; w.x = sx[0]; w.y = sy[0]; w.z = sx[1]; w.w = sy[1];
                *(u32x4*)(O + (size_t)(row0 + ai * 128 + (mp + odd) * 16) * DEXP + (col0 - 8 * odd)) = w; }
    }
};

struct Frame {
    LAS unsigned char* lds; int tid, lane, wave, G, bid;
    const Params* p;
};

struct TItem { const float* src; bf16_t* dst; int ldw, ldt, f8; };
constexpr int PREP_NIT = 16 * 256 + 3 * 16 * 32 + 16 * 64 + 4 * 4 * 8 + NEXP * 16 * 32 + NEXP * 8 * 32;
constexpr int PREP_LATE = 0;
__device__ __forceinline__ bool prep_item(const Params& P, unsigned char* ws, int it, int it_end, TItem& t) {
    constexpr int I_IN = 16 * 256, I_SQ = 16 * 32, I_KV = 16 * 64, I_P = 4 * 4 * 8, I_UP = NEXP * 16 * 32, I_DN = NEXP * 8 * 32;
    constexpr int NIT = I_IN + 3 * I_SQ + I_KV + I_P + I_UP + I_DN; static_assert(NIT == PREP_NIT, "item count");
    if (it >= it_end) return false;
    int r = it;
    if (r < I_IN) { const int kb = r / 256, nb = r % 256, n0 = 32 * nb;
        int drow = n0; if (n0 >= D && n0 < 3 * D) { const int c = (n0 - D) & (D - 1); drow = D + (c >> 7) * 256 + (n0 >= 2 * D ? 128 : 0) + (c & 127); }
        t.src = P.in[I_WIN] + (size_t)(64 * kb) * INCOLS + n0; t.ldw = INCOLS; t.dst = (bf16_t*)(ws + WS_WIN) + (size_t)drow * D + 64 * kb; t.ldt = D; t.f8 = 0; return true; } r -= I_IN;
    if (r < I_SQ) { const int kb = r / 32, nb = r % 32; t.src = P.in[I_WCONV] + (size_t)(64 * kb) * D + 32 * nb; t.ldw = D; t.dst = (bf16_t*)(ws + WS_WCAT) + (size_t)(32 * nb) * KCAT + 64 * kb; t.ldt = KCAT; t.f8 = 0; return true; } r -= I_SQ;
    if (r < I_SQ) { const int kb = r / 32, nb = r % 32; t.src = P.in[I_WXO] + (size_t)(64 * kb) * D + 32 * nb; t.ldw = D; t.dst = (bf16_t*)(ws + WS_WCAT) + (size_t)(32 * nb) * KCAT + 1280 + 64 * kb; t.ldt = KCAT; t.f8 = 0; return true; } r -= I_SQ;
    if (r < I_SQ) { const int kb = r / 32, nb = r % 32; t.src = P.in[I_WO] + (size_t)(64 * kb) * D + 32 * nb; t.ldw = D; t.dst = (bf16_t*)(ws + WS_WO) + (size_t)(32 * nb) * D + 64 * kb; t.ldt = D; t.f8 = 0; return true; } r -= I_SQ;
    if (r < I_KV) { const int kb = r / 64, nb = r % 64; t.src = P.in[I_WKV] + (size_t)(64 * kb) * (2 * D) + 32 * nb; t.ldw = 2 * D; t.dst = (bf16_t*)(ws + WS_WKV) + (size_t)(32 * nb) * D + 64 * kb; t.ldt = D; t.f8 = 0; return true; } r -= I_KV;
    if (r < I_P) { const int g = r / 32, q = r % 32, kb = q / 8, nb = q % 8;
        t.src = P.in[I_WPOOL] + (size_t)g * 65536 + (size_t)(64 * kb) * 256 + 32 * nb; t.ldw = 256; t.dst = (bf16_t*)(ws + WS_WCAT) + (size_t)(g * 256 + 32 * nb) * KCAT + 1024 + 64 * kb; t.ldt = KCAT; t.f8 = 0; return true; } r -= I_P;
    if (r < I_UP) { const int e = r / 512, q = r % 512, kb = q / 32, nb = q % 32; const int n0 = 32 * nb;
        const int j0 = n0 & 511, drow = (j0 >> 7) * 256 + (n0 >= 512 ? 128 : 0) + (j0 & 127);
        t.src = P.in[I_WUP] + (size_t)e * D * D + (size_t)(64 * kb) * D + n0; t.ldw = D; t.dst = (bf16_t*)(ws + WS_WUP + (size_t)e * D * D + (size_t)drow * D + 64 * kb); t.ldt = D; t.f8 = 1; return true; } r -= I_UP;
    { const int e = r / 256, q = r % 256, kb = q / 32, nb = q % 32;
        t.src = P.in[I_WDN] + (size_t)e * DEXP * D + (size_t)(64 * kb) * D + 32 * nb; t.ldw = D; t.dst = (bf16_t*)(ws + WS_WDN + (size_t)e * D * DEXP + (size_t)(32 * nb) * DEXP + 64 * kb); t.ldt = DEXP; t.f8 = 1; return true; }
}
__device__ __forceinline__ void titem_load(const TItem& t, int lane, f32x4 (&v)[8]) {
    const float* s = t.src + (size_t)(lane >> 3) * t.ldw + (lane & 7) * 4;
#pragma unroll
    for (int j = 0; j < 8; ++j) v[j] = *(const f32x4*)(s + (size_t)(8 * j) * t.ldw);
}
__device__ __forceinline__ void titem_finish(const TItem& t, int lane, const f32x4 (&v)[8], LAS float* scr) {
#pragma unroll
    for (int j = 0; j < 8; ++j) { LAS float* d = scr + (8 * j + (lane >> 3)) * 33 + (lane & 7) * 4; d[0] = v[j][0]; d[1] = v[j][1]; d[2] = v[j][2]; d[3] = v[j][3]; }
    asm volatile("s_waitcnt lgkmcnt(0)" ::: "memory");
    if (t.f8) {
        const int c = lane & 3;
#pragma unroll
        for (int j = 0; j < 2; ++j) { const int n = (lane >> 2) + 16 * j; const LAS float* s = scr + (16 * c) * 33 + n;
            u32x4 o;
            { int r = __builtin_amdgcn_cvt_pk_fp8_f32(s[0 * 33] * 32.f, s[1 * 33] * 32.f, 0, false); r = __builtin_amdgcn_cvt_pk_fp8_f32(s[2 * 33] * 32.f, s[3 * 33] * 32.f, r, true); o.x = (unsigned)r; }
            { int r = __builtin_amdgcn_cvt_pk_fp8_f32(s[4 * 33] * 32.f, s[5 * 33] * 32.f, 0, false); r = __builtin_amdgcn_cvt_pk_fp8_f32(s[6 * 33] * 32.f, s[7 * 33] * 32.f, r, true); o.y = (unsigned)r; }
            { int r = __builtin_amdgcn_cvt_pk_fp8_f32(s[8 * 33] * 32.f, s[9 * 33] * 32.f, 0, false); r = __builtin_amdgcn_cvt_pk_fp8_f32(s[10 * 33] * 32.f, s[11 * 33] * 32.f, r, true); o.z = (unsigned)r; }
            { int r = __builtin_amdgcn_cvt_pk_fp8_f32(s[12 * 33] * 32.f, s[13 * 33] * 32.f, 0, false); r = __builtin_amdgcn_cvt_pk_fp8_f32(s[14 * 33] * 32.f, s[15 * 33] * 32.f, r, true); o.w = (unsigned)r; }
            *(u32x4*)((unsigned char*)t.dst + (size_t)n * t.ldt + 16 * c) = o; }
    } else {
    const int c = lane & 7;
#pragma unroll
    for (int j = 0; j < 4; ++j) { const int n = (lane >> 3) + 8 * j; const LAS float* s = scr + (8 * c) * 33 + n;
        u32x4 o; o.x = cvt_pk_bf16(s[0 * 33], s[1 * 33]); o.y = cvt_pk_bf16(s[2 * 33], s[3 * 33]); o.z = cvt_pk_bf16(s[4 * 33], s[5 * 33]); o.w = cvt_pk_bf16(s[6 * 33], s[7 * 33]);
        *(u32x4*)(t.dst + (size_t)n * t.ldt + 8 * c) = o; }
    }
    asm volatile("s_waitcnt lgkmcnt(0)" ::: "memory");
}

struct WTask { const float* src; int ldw; unsigned char* dst; float* sc; };
__device__ __forceinline__ bool wtask_get(const Params& P, unsigned char* ws, int t, WTask& k) {
    constexpr int T_IN = INCOLS / 32, T_UP = NEXP * (D / 32);
    if (t >= T_IN + T_UP) return false;
    if (t < T_IN) { const int n0 = 32 * t;
        int drow = n0; if (n0 >= D && n0 < 3 * D) { const int c = (n0 - D) & (D - 1); drow = D + (c >> 7) * 256 + (n0 >= 2 * D ? 128 : 0) + (c & 127); }
        k.src = P.in[I_WIN] + n0; k.ldw = INCOLS; k.dst = ws + WS_WIN + (size_t)drow * D; k.sc = (float*)(ws + WS_SW) + drow;
    } else { const int q = t - T_IN, e = q >> 5, n0 = 32 * (q & 31);
        const int j0 = n0 & 511, drow = (j0 >> 7) * 256 + (n0 >= 512 ? 128 : 0) + (j0 & 127);
        k.src = P.in[I_WUP] + (size_t)e * D * D + n0; k.ldw = D; k.dst = ws + WS_WUP + (size_t)e * D * D + (size_t)drow * D; k.sc = (float*)(ws + WS_SWU) + e * D + drow; }
    return true;
}
__device__ __forceinline__ void wtask_load(const Frame& F, const WTask& k, f32x4 (&va)[8], f32x4 (&vb)[8]) {
    TItem ta, tb; ta.src = k.src + (size_t)(64 * (2 * F.wave)) * k.ldw; ta.ldw = k.ldw; tb.src = ta.src + (size_t)64 * k.ldw; tb.ldw = k.ldw;
    titem_load(ta, F.lane, va); titem_load(tb, F.lane, vb);
}
__device__ __forceinline__ void wtask_finish(const Frame& F, const WTask& k, const f32x4 (&va)[8], const f32x4 (&vb)[8]) {
    LAS float* scr = (LAS float*)(F.lds + F.wave * 16384);
    LAS float* cmx = (LAS float*)(F.lds + 131072 + 8192);
    const int lane = F.lane, c4 = (lane & 7) * 4;
    f32x4 mx = (f32x4){0.f, 0.f, 0.f, 0.f};
#pragma unroll
    for (int j = 0; j < 8; ++j) { mx = __builtin_elementwise_max(mx, __builtin_elementwise_max(__builtin_elementwise_abs(va[j]), __builtin_elementwise_abs(vb[j]))); }
#pragma unroll
    for (int o = 8; o < 64; o <<= 1) {
#pragma unroll
        for (int q = 0; q < 4; ++q) mx[q] = fmaxf(mx[q], __shfl_xor(mx[q], o)); }
    __syncthreads();
    if (lane < 8) { LAS float* d = cmx + F.wave * 32 + c4; d[0] = mx[0]; d[1] = mx[1]; d[2] = mx[2]; d[3] = mx[3]; }
    __syncthreads();
    if (F.tid < 32) { float m = 0.f;
#pragma unroll
        for (int w = 0; w < 8; ++w) m = fmaxf(m, cmx[w * 32 + F.tid]);
        cmx[256 + F.tid] = m > 0.f ? 127.0f / m : 0.f; k.sc[F.tid] = m > 0.f ? m * (1.0f / 127.0f) : 1.0f; }
    __syncthreads();
#pragma unroll
    for (int blk = 0; blk < 2; ++blk) {
#pragma unroll
        for (int j = 0; j < 8; ++j) { const f32x4 x = blk ? vb[j] : va[j]; LAS float* d = scr + (8 * j + (lane >> 3)) * 33 + c4; d[0] = x[0]; d[1] = x[1]; d[2] = x[2]; d[3] = x[3]; }
        asm volatile("s_waitcnt lgkmcnt(0)" ::: "memory");
        const int c = lane & 3;
#pragma unroll
        for (int j = 0; j < 2; ++j) { const int n = (lane >> 2) + 16 * j; const LAS float* s = scr + (16 * c) * 33 + n; const float inv = cmx[256 + n];
            u32x4 o;
#pragma unroll
            for (int g = 0; g < 4; ++g) { o[g] = ((unsigned)(int)__builtin_rintf(s[(4 * g) * 33] * inv) & 0xffu) | (((unsigned)(int)__builtin_rintf(s[(4 * g + 1) * 33] * inv) & 0xffu) << 8) | (((unsigned)(int)__builtin_rintf(s[(4 * g + 2) * 33] * inv) & 0xffu) << 16) | ((unsigned)(int)__builtin_rintf(s[(4 * g + 3) * 33] * inv) << 24); }
            *(u32x4*)(k.dst + (size_t)n * D + 64 * (2 * F.wave + blk) + 16 * c) = o; }
        asm volatile("s_waitcnt lgkmcnt(0)" ::: "memory");
    }
}
__device__ __forceinline__ void prep_i8_tasks(const Frame& F) {
    const Params& P = *F.p; unsigned char* ws = P.ws;
    WTask cur, nxt; f32x4 va[8], vb[8], wa[8], wb[8];
    int t = F.bid; bool have = wtask_get(P, ws, t, cur);
    if (have) wtask_load(F, cur, va, vb);
    while (have) {
        const bool hn = wtask_get(P, ws, t + F.G, nxt);
        if (hn) wtask_load(F, nxt, wa, wb);
        wtask_finish(F, cur, va, vb);
        if (!hn) break;
        t += 2 * F.G;
        have = wtask_get(P, ws, t, cur);
        if (have) wtask_load(F, cur, va, vb);
        wtask_finish(F, nxt, wa, wb);
    }
    __syncthreads();
}

__device__ __forceinline__ void convert_items(const Frame& F, int it0, int it1, int w, int nw) {
    const Params& P = *F.p; unsigned char* ws = P.ws;
    LAS float* scr = (LAS float*)(F.lds + F.wave * 16384);
    TItem cur, nxt; f32x4 va[8], vb[8];
    int it = it0 + w; bool have = prep_item(P, ws, it, it1, cur);
    if (have) titem_load(cur, F.lane, va);
    while (have) {
        const bool hn = prep_item(P, ws, it + nw, it1, nxt);
        if (hn) titem_load(nxt, F.lane, vb);
        titem_finish(cur, F.lane, va, scr);
        if (!hn) break;
        it += 2 * nw;
        have = prep_item(P, ws, it, it1, cur);
        if (have) titem_load(cur, F.lane, va);
        titem_finish(nxt, F.lane, vb, scr);
    }
}

__device__ __forceinline__ void convert_items_dyn(const Frame& F, int it0, int it1, int cw_ctr) {
    const Params& P = *F.p; unsigned char* ws = P.ws;
    LAS float* scr = (LAS float*)(F.lds + F.wave * 16384);
    unsigned* ctr = (unsigned*)(ws + WS_CTL) + cw_ctr;
    volatile LAS unsigned* slot = (volatile LAS unsigned*)(F.lds + 131072 + 12288);
    for (;;) {
        __syncthreads();
        if (F.tid == 0) slot[0] = atomicAdd(ctr, 1u);
        __syncthreads();
        const int it = it0 + (int)slot[0] * NWAVES + F.wave;
        if (it0 + (int)slot[0] * NWAVES >= it1) break;
        TItem t; f32x4 v[8];
        if (prep_item(P, ws, it, it1, t)) { titem_load(t, F.lane, v); titem_finish(t, F.lane, v, scr); }
    }
}

__device__ __forceinline__ void phase_prep(const Frame& F) {
    const Params& P = *F.p; unsigned char* ws = P.ws;
    LAS float* scr = (LAS float*)(F.lds + F.wave * 16384);
    const int gw = F.bid * NWAVES + F.wave, NGW = F.G * NWAVES;
    prep_i8_tasks(F);
    const size_t gt = (size_t)F.bid * NTHR + F.tid, NGT = (size_t)F.G * NTHR;
    for (int row0 = gw * 4; row0 < NTOK; row0 += NGW * 4) {
        f32x4 v[4][4]; float am[4];
#pragma unroll
        for (int a = 0; a < 4; ++a) { const f32x4* xr = (const f32x4*)(P.in[I_X] + (size_t)(row0 + a) * D) + F.lane;
#pragma unroll
            for (int j = 0; j < 4; ++j) v[a][j] = xr[64 * j]; }
#pragma unroll
        for (int a = 0; a < 4; ++a) { am[a] = 0.f;
#pragma unroll
            for (int j = 0; j < 4; ++j) am[a] = fmaxf(am[a], fmaxf(fmaxf(fabsf(v[a][j][0]), fabsf(v[a][j][1])), fmaxf(fabsf(v[a][j][2]), fabsf(v[a][j][3])))); }
#pragma unroll
        for (int o = 1; o < 64; o <<= 1) {
#pragma unroll
            for (int a = 0; a < 4; ++a) am[a] = fmaxf(am[a], __shfl_xor(am[a], o)); }
#pragma unroll
        for (int a = 0; a < 4; ++a) { const float inv = am[a] > 0.f ? 127.0f / am[a] : 0.f;
            if (F.lane == 0) ((float*)(ws + WS_XS))[row0 + a] = am[a] > 0.f ? am[a] * (1.0f / 127.0f) : 1.0f;
#pragma unroll
            for (int j = 0; j < 4; ++j) { const f32x4 q = v[a][j] * inv;
                const unsigned w = ((unsigned)(int)__builtin_rintf(q[0]) & 0xffu) | (((unsigned)(int)__builtin_rintf(q[1]) & 0xffu) << 8) | (((unsigned)(int)__builtin_rintf(q[2]) & 0xffu) << 16) | ((unsigned)(int)__builtin_rintf(q[3]) << 24);
                *((unsigned*)(ws + WS_XB + (size_t)(row0 + a) * D) + F.lane + 64 * j) = w; } }
    }
    { const f32x4* src = (const f32x4*)P.in[I_MEM]; u32x4* dst = (u32x4*)(ws + WS_MEMB);
      for (size_t i = gt; i < (size_t)NMEM * D / 8; i += NGT) { const f32x4 a = src[2 * i], b = src[2 * i + 1]; u32x4 o; o.x = cvt_pk_bf16(a[0], a[1]); o.y = cvt_pk_bf16(a[2], a[3]); o.z = cvt_pk_bf16(b[0], b[1]); o.w = cvt_pk_bf16(b[2], b[3]); dst[i] = o; } }
    { bf16_t* wr = (bf16_t*)(ws + WS_WR);
      for (size_t i = gt; i < (size_t)80 * D; i += NGT) { const int o = (int)(i / D), k = (int)(i % D); wr[i] = (bf16_t)f2bf(o < 8 ? P.in[I_WRG][(size_t)k * 8 + o] : (o < 72 ? P.in[I_WRE][(size_t)k * 64 + (o - 8)] : 0.f)); } }
    { constexpr int I0 = 16 * 256, I_UP0 = I0 + 3 * 16 * 32 + 16 * 64 + 4 * 4 * 8, I_DN0 = I_UP0 + NEXP * 16 * 32;
      convert_items(F, I0, I_UP0, gw, NGW); }
}

struct F8 { f32x4 a, b; };
__device__ __forceinline__ F8 up8(const u32x4 v) { F8 r; r.a = (f32x4){bf_lo(v.x), bf_hi(v.x), bf_lo(v.y), bf_hi(v.y)}; r.b = (f32x4){bf_lo(v.z), bf_hi(v.z), bf_lo(v.w), bf_hi(v.w)}; return r; }
__device__ __forceinline__ u32x4 pk8(const F8 v) { u32x4 o; o.x = pk2(v.a[0], v.a[1]); o.y = pk2(v.a[2], v.a[3]); o.z = pk2(v.b[0], v.b[1]); o.w = pk2(v.b[2], v.b[3]); return o; }
__device__ __forceinline__ void phase_convpool(const Frame& F, int cw_ctr, unsigned c_lo, unsigned c_hi) {
    const Params& P = *F.p; unsigned char* ws = P.ws;
    const bf16_t* __restrict__ Z = (const bf16_t*)(ws + WS_Z); bf16_t* __restrict__ AC = (bf16_t*)(ws + WS_ACONV); bf16_t* __restrict__ DP = (bf16_t*)(ws + WS_DPOOL);
    const float* cw = P.in[I_CONVW];
    constexpr int TSEG = 16;
    unsigned* ctr = (unsigned*)(ws + WS_CTL) + cw_ctr;
    volatile LAS unsigned* slot = (volatile LAS unsigned*)(F.lds + 131072 + 12288);
    for (;;) {
        __syncthreads();
        if (F.tid == 0) slot[0] = c_lo + atomicAdd(ctr, 1u);
        __syncthreads();
        const unsigned chunk = slot[0];
        if (chunk >= c_hi) break;
        const int it = (int)chunk * NTHR + F.tid;
        const int c0 = (it & 127) * 8, t0 = (it >> 7) * TSEG, s0 = t0 & (SEQ - 1);
        const int gi = c0 >> 8, w = 2 << gi;
        F8 w0, w1, w2;
        w0.a = *(const f32x4*)(cw + c0); w0.b = *(const f32x4*)(cw + c0 + 4); w1.a = *(const f32x4*)(cw + D + c0); w1.b = *(const f32x4*)(cw + D + c0 + 4); w2.a = *(const f32x4*)(cw + 2 * D + c0); w2.b = *(const f32x4*)(cw + 2 * D + c0 + 4);
        const bf16_t* zr0 = Z + (size_t)t0 * INCOLS + c0;
        F8 u1, u2, run;
        u1.a = u1.b = u2.a = u2.b = run.a = run.b = (f32x4){0.f, 0.f, 0.f, 0.f};
        if (s0 > 0) {
            u1 = up8(*(const u32x4*)(zr0 - INCOLS + D)); u2 = up8(*(const u32x4*)(zr0 - 2 * INCOLS + D));
            for (int i = 1; i < w; ++i) { const F8 pp = up8(*(const u32x4*)(zr0 - (size_t)i * INCOLS + 3 * D)); run.a += pp.a; run.b += pp.b; }
        }
        for (int tb = 0; tb < TSEG; tb += 4) {
            u32x4 lcb[4], lcc[4], lp[4], lold[4];
#pragma unroll
            for (int j = 0; j < 4; ++j) { const bf16_t* zr = zr0 + (size_t)(tb + j) * INCOLS;
                lcb[j] = *(const u32x4*)(zr); lcc[j] = *(const u32x4*)(zr + D); lp[j] = *(const u32x4*)(zr + 3 * D);
                lold[j] = (s0 + tb + j - (w - 1) >= 0) ? *(const u32x4*)(zr - (size_t)(w - 1) * INCOLS + 3 * D) : (u32x4){0u, 0u, 0u, 0u}; }
#pragma unroll
            for (int j = 0; j < 4; ++j) {
                const F8 cb = up8(lcb[j]), u0 = up8(lcc[j]);
                F8 v; v.a = (w0.a * u2.a + w1.a * u1.a + w2.a * u0.a) * cb.a; v.b = (w0.b * u2.b + w1.b * u1.b + w2.b * u0.b) * cb.b;
                *(u32x4*)(AC + (size_t)(t0 + tb + j) * D + c0) = pk8(v);
                u2 = u1; u1 = u0;
                const F8 pp = up8(lp[j]), po = up8(lold[j]);
                run.a += pp.a; run.b += pp.b;
                const int s = s0 + tb + j; const int cnt = (s + 1) < w ? (s + 1) : w; const float inv = 1.0f / (float)cnt;
                F8 d; d.a = run.a * inv - pp.a; d.b = run.b * inv - pp.b;
                *(u32x4*)(DP + (size_t)(t0 + tb + j) * D + c0) = pk8(d);
                run.a -= po.a; run.b -= po.b;
            }
        }
    }
}

typedef float f32x16 __attribute__((ext_vector_type(16)));
typedef float f32x2_t __attribute__((ext_vector_type(2))); typedef __bf16 bf16x2_t __attribute__((ext_vector_type(2)));
__device__ __forceinline__ unsigned cvtpk(float lo, float hi) { f32x2_t v = {lo, hi}; bf16x2_t b = __builtin_convertvector(v, bf16x2_t); return __builtin_bit_cast(unsigned, b); }
#define MFMA32(a, b, c) __builtin_amdgcn_mfma_f32_32x32x16_bf16((a), (b), (c), 0, 0, 0)
template <int VAR> __device__ __forceinline__ void phase_attn(const Frame& F, int u0, int ustride) {
    const Params& P = *F.p; unsigned char* ws = P.ws;
    const bf16_t* Z = (const bf16_t*)(ws + WS_Z); bf16_t* O = (bf16_t*)(ws + (VAR ? WS_MERGED : WS_O));
    const int tid = F.tid, lane = F.lane, wave = F.wave, r = lane & 31, hh = lane >> 5;
    const int prow = tid >> 5, pc = (tid & 31) ^ prow;
    LAS unsigned char* lds = F.lds;
    int rb[8];
#pragma unroll
    for (int t = 0; t < 8; ++t) rb[t] = r * 512 + (((2 * t + hh) ^ (r & 15)) << 4);
#define AT_WAIT_BAR(N) asm volatile("s_waitcnt vmcnt(" #N ")\n\ts_barrier" ::: "memory")
#define AT_ISSUE(i) do { if (VAR == 2) break; const char* _s = ((i) < 8) ? ksrc + (size_t)(32 * (i)) * 2048 : vsrc + (size_t)(32 * ((i) - 8)) * 512; const size_t _rs = ((i) < 8) ? 2048 : 512; \
        _Pragma("unroll") for (int _it = 0; _it < 2; ++_it) \
        __builtin_amdgcn_global_load_lds((const unsigned*)(_s + (size_t)(16 * _it) * _rs), (LAS unsigned*)(lds + ((i) & 7) * 16384 + _it * 8192 + wave * 1024), 16, 0, 0); } while (0)
#define AT_FRAG(slot, s) (*(const LAS pg8::bf16x8*)(lds + rb[(s) & 7] + (slot) * 16384 + ((s) >> 3) * 256))
#define AT_DSR(dst, s, slot) asm volatile("ds_read_b128 %0, %1 offset:%2" : "=v"(dst) : "v"(((slot) & 4) ? rbh[(s) & 7] : rbv[(s) & 7]), "n"(((slot) & 3) * 16384 + ((s) >> 3) * 256) : "memory")
#define AT_LW(dst, n) asm volatile("s_waitcnt lgkmcnt(%1)" : "+v"(dst) : "n"(n) : "memory")
#define AT_PIPE(slot, STMT) do { asm volatile("s_waitcnt lgkmcnt(0)" ::: "memory"); \
        AT_DSR(fr[0], 0, slot); AT_DSR(fr[1], 1, slot); AT_DSR(fr[2], 2, slot); AT_DSR(fr[3], 3, slot); \
        _Pragma("unroll") for (int s = 0; s < 16; ++s) { AT_LW(fr[s & 7], (15 - s) < 3 ? (15 - s) : 3); if (VAR != 1 && VAR != 4) { STMT; } if (s + 4 < 16 && VAR != 3 && VAR != 4) AT_DSR(fr[(s + 4) & 7], s + 4, slot); } } while (0)
    pg8::bf16x8 fr[8]; unsigned rbv[8], rbh[8];
#pragma unroll
    for (int t = 0; t < 8; ++t) { rbv[t] = (unsigned)(size_t)lds + (unsigned)rb[t]; rbh[t] = rbv[t] + 65536u; }
    for (int ui = u0; ui < (NTOK / 256) * 4; ui += ustride) {
        const int h = ui & 3, t0 = (ui >> 2) * 256, b = t0 / SEQ;
        const bf16_t* qrow = Z + (size_t)(t0 + 32 * wave + r) * INCOLS + 4 * D + h * 256 + 8 * hh;
        pg8::bf16x8 qf[16];
#pragma unroll
        for (int s = 0; s < 16; ++s) qf[s] = *(const pg8::bf16x8*)(qrow + 16 * s);
        const char* ksrc = (const char*)(ws + WS_KB) + ((size_t)(b * 256 + prow) * D + h * 256) * 2 + pc * 16;
        const char* vsrc = (const char*)(ws + WS_VT) + ((size_t)(b * D + h * 256 + prow) * 256) * 2 + pc * 16;
        asm volatile("s_barrier" ::: "memory");
        AT_ISSUE(0); AT_ISSUE(1); AT_ISSUE(2); AT_ISSUE(3); AT_ISSUE(4); AT_ISSUE(5);
        f32x16 S[8];
#pragma unroll
        for (int i = 0; i < 8; ++i)
#pragma unroll
            for (int j = 0; j < 16; ++j) S[i][j] = 0.f;
#pragma unroll
        for (int sp = 0; sp < 4; ++sp) {
            AT_WAIT_BAR(8);
            AT_ISSUE(2 * sp + 6); AT_ISSUE(2 * sp + 7);
            AT_PIPE((2 * sp) & 7, S[2 * sp] = MFMA32(fr[s & 7], qf[s], S[2 * sp]));
            AT_PIPE((2 * sp + 1) & 7, S[2 * sp + 1] = MFMA32(fr[s & 7], qf[s], S[2 * sp + 1]));
        }
        float mx = S[0][0];
#pragma unroll
        for (int i = 0; i < 8; ++i)
#pragma unroll
            for (int j = 0; j < 16; ++j) mx = fmaxf(mx, S[i][j]);
        mx = fmaxf(mx, __shfl_xor(mx, 32));
        const float c2 = 0.0625f * 1.4426950408889634f;
        float sum = 0.f;
        pg8::bf16x8 pf[8][2];
#pragma unroll
        for (int i = 0; i < 8; ++i) {
#pragma unroll
            for (int j = 0; j < 16; ++j) { const float e = __builtin_amdgcn_exp2f((S[i][j] - mx) * c2); S[i][j] = e; sum += e; }
#pragma unroll
            for (int s2 = 0; s2 < 2; ++s2) { u32x4 w; w.x = cvtpk(S[i][8 * s2], S[i][8 * s2 + 1]); w.y = cvtpk(S[i][8 * s2 + 2], S[i][8 * s2 + 3]); w.z = cvtpk(S[i][8 * s2 + 4], S[i][8 * s2 + 5]); w.w = cvtpk(S[i][8 * s2 + 6], S[i][8 * s2 + 7]);
                pf[i][s2] = __builtin_bit_cast(pg8::bf16x8, w); }
        }
        sum += __shfl_xor(sum, 32);
        const float inv = 1.0f / sum;
        bf16_t* orow = O + (size_t)(t0 + 32 * wave + r) * D + h * 256 + 4 * hh;
#pragma unroll
        for (int sp = 4; sp < 8; ++sp) {
            if (sp == 4) AT_WAIT_BAR(8); else if (sp == 5) AT_WAIT_BAR(14); else if (sp == 6) AT_WAIT_BAR(16); else AT_WAIT_BAR(18);
            if (sp == 4) { AT_ISSUE(14); AT_ISSUE(15); }
#pragma unroll
            for (int hf = 0; hf < 2; ++hf) { const int i = 2 * sp + hf;
                f32x16 o;
#pragma unroll
                for (int j = 0; j < 16; ++j) o[j] = 0.f;
                AT_PIPE(i & 7, o = MFMA32(fr[s & 7], pf[s >> 1][s & 1], o));
#pragma unroll
                for (int g = 0; g < 4; ++g) { u32x2 w; w.x = cvtpk(o[4 * g] * inv, o[4 * g + 1] * inv); w.y = cvtpk(o[4 * g + 2] * inv, o[4 * g + 3] * inv);
                    *(u32x2*)(orow + 32 * (i - 8) + 8 * g) = w; }
            }
        }
    }
    asm volatile("s_waitcnt vmcnt(0)\n\ts_barrier" ::: "memory");
#undef AT_WAIT_BAR
#undef AT_ISSUE
#undef AT_FRAG
#undef AT_DSR
#undef AT_LW
#undef AT_PIPE
}

__device__ __forceinline__ void phase_ln1_router(const Frame& F) {
    const Params& P = *F.p; unsigned char* ws = P.ws;
    const bf16_t* H1 = (const bf16_t*)(ws + WS_H1); bf16_t* H1B = (bf16_t*)(ws + WS_H1B); const bf16_t* WRB = (const bf16_t*)(ws + WS_WR);
    unsigned* ctl = (unsigned*)(ws + WS_CTL);
    int* tok_e = (int*)(ws + WS_MISC + MS_TOKE); int* tok_pos = (int*)(ws + WS_MISC + MS_TOKPOS); float* tok_w = (float*)(ws + WS_MISC + MS_TOKW);
    LAS float* lg = (LAS float*)(F.lds + F.wave * 5120);
    LAS unsigned* lcnt = (LAS unsigned*)(F.lds + 8 * 5120);
    const int lane = F.lane;
    const float* g1 = P.in[I_LN1G]; const float* b1 = P.in[I_LN1B];
    f32x4 gg[4], bb[4];
#pragma unroll
    for (int j = 0; j < 4; ++j) { gg[j] = *((const f32x4*)g1 + lane + 64 * j); bb[j] = *((const f32x4*)b1 + lane + 64 * j); }
    for (int grp0 = F.bid * NWAVES; grp0 < NTOK / 16; grp0 += F.G * NWAVES) {
        const int row0 = (grp0 + F.wave) * 16;
        if (F.tid < 128) lcnt[F.tid] = 0u;
        for (int rb = 0; rb < 16; rb += 4) {
            f32x4 v[4][4]; float s[4], q[4];
#pragma unroll
            for (int a = 0; a < 4; ++a) { const u32x2* xr = (const u32x2*)(H1 + (size_t)(row0 + rb + a) * D) + lane;
#pragma unroll
                for (int j = 0; j < 4; ++j) { const u32x2 p = xr[64 * j]; v[a][j] = (f32x4){bf_lo(p.x), bf_hi(p.x), bf_lo(p.y), bf_hi(p.y)}; } }
#pragma unroll
            for (int a = 0; a < 4; ++a) { s[a] = 0.f;
#pragma unroll
                for (int j = 0; j < 4; ++j) s[a] += (v[a][j][0] + v[a][j][1]) + (v[a][j][2] + v[a][j][3]); }
#pragma unroll
            for (int o = 1; o < 64; o <<= 1) {
#pragma unroll
                for (int a = 0; a < 4; ++a) s[a] += __shfl_xor(s[a], o); }
#pragma unroll
            for (int a = 0; a < 4; ++a) { const float mean = s[a] * (1.f / D); q[a] = 0.f;
#pragma unroll
                for (int j = 0; j < 4; ++j) { v[a][j] = v[a][j] - mean; q[a] += (v[a][j][0] * v[a][j][0] + v[a][j][1] * v[a][j][1]) + (v[a][j][2] * v[a][j][2] + v[a][j][3] * v[a][j][3]); } }
#pragma unroll
            for (int o = 1; o < 64; o <<= 1) {
#pragma unroll
                for (int a = 0; a < 4; ++a) q[a] += __shfl_xor(q[a], o); }
            float am[4];
#pragma unroll
            for (int a = 0; a < 4; ++a) { const float rstd = 1.f / sqrtf(q[a] * (1.f / D) + LN_EPS); am[a] = 0.f;
#pragma unroll
                for (int j = 0; j < 4; ++j) { const f32x4 y = v[a][j] * rstd * gg[j] + bb[j]; v[a][j] = y;
                    am[a] = fmaxf(am[a], fmaxf(fmaxf(fabsf(y[0]), fabsf(y[1])), fmaxf(fabsf(y[2]), fabsf(y[3]))));
                    u32x2 o; o.x = cvt_pk_bf16(y[0], y[1]); o.y = cvt_pk_bf16(y[2], y[3]); *((u32x2*)(H1B + (size_t)(row0 + rb + a) * D) + lane + 64 * j) = o; } }
#pragma unroll
            for (int o = 1; o < 64; o <<= 1) {
#pragma unroll
                for (int a = 0; a < 4; ++a) am[a] = fmaxf(am[a], __shfl_xor(am[a], o)); }
#pragma unroll
            for (int a = 0; a < 4; ++a) { const float inv = am[a] > 0.f ? 127.0f / am[a] : 0.f;
                if (lane == 0) ((float*)(ws + WS_H1S))[row0 + rb + a] = am[a] > 0.f ? am[a] * (1.0f / 127.0f) : 1.0f;
#pragma unroll
                for (int j = 0; j < 4; ++j) { const f32x4 z = v[a][j] * inv;
                    const unsigned w = ((unsigned)(int)__builtin_rintf(z[0]) & 0xffu) | (((unsigned)(int)__builtin_rintf(z[1]) & 0xffu) << 8) | (((unsigned)(int)__builtin_rintf(z[2]) & 0xffu) << 16) | ((unsigned)(int)__builtin_rintf(z[3]) << 24);
                    *((unsigned*)(ws + WS_H1F8 + (size_t)(row0 + rb + a) * D) + lane + 64 * j) = w; } }
        }
        asm volatile("s_waitcnt vmcnt(0)" ::: "memory");
        f32x4 acc[5];
#pragma unroll
        for (int n = 0; n < 5; ++n) acc[n] = (f32x4){0.f, 0.f, 0.f, 0.f};
        const bf16_t* ap = H1B + (size_t)(row0 + (lane & 15)) * D + 8 * (lane >> 4);
        const bf16_t* bp = WRB + (size_t)(lane & 15) * D + 8 * (lane >> 4);
#pragma unroll 8
        for (int ks = 0; ks < 32; ++ks) {
            const pg8::bf16x8 a = *(const pg8::bf16x8*)(ap + 32 * ks);
#pragma unroll
            for (int n = 0; n < 5; ++n) { const pg8::bf16x8 bw = *(const pg8::bf16x8*)(bp + (size_t)n * 16 * D + 32 * ks); acc[n] = __builtin_amdgcn_mfma_f32_16x16x32_bf16(a, bw, acc[n], 0, 0, 0); }
        }
#pragma unroll
        for (int n = 0; n < 5; ++n)
#pragma unroll
            for (int i = 0; i < 4; ++i) lg[(4 * (lane >> 4) + i) * 80 + 16 * n + (lane & 15)] = acc[n][i];
        __syncthreads();
        int ea = 0, eb = 0; unsigned la = 0, lb = 0; float w1 = 0.f, w2 = 0.f;
        if (lane < 16) {
            const LAS float* l = lg + lane * 80;
            const float* brg = P.in[I_BRG]; const float* bre = P.in[I_BRE];
            int gs = 0; float gm = l[0] + brg[0];
            for (int i = 1; i < 8; ++i) { const float x = l[i] + brg[i]; if (x > gm) { gm = x; gs = i; } }
            float den = 0.f; for (int i = 0; i < 8; ++i) den += __expf(l[i] + brg[i] - gm);
            const float gwt = 1.0f / den;
            int i1 = 0; float l1 = l[8 + gs * 8] + bre[gs * 8];
            for (int i = 1; i < 8; ++i) { const float x = l[8 + gs * 8 + i] + bre[gs * 8 + i]; if (x > l1) { l1 = x; i1 = i; } }
            int i2 = -1; float l2 = 0.f;
            for (int i = 0; i < 8; ++i) { if (i == i1) continue; const float x = l[8 + gs * 8 + i] + bre[gs * 8 + i]; if (i2 < 0 || x > l2) { l2 = x; i2 = i; } }
            const float e2 = __expf(l2 - l1); w1 = gwt / (1.0f + e2); w2 = gwt * e2 / (1.0f + e2);
            ea = gs * 8 + i1; eb = gs * 8 + i2;
            la = atomicAdd((unsigned*)(lcnt + ea), 1u); lb = atomicAdd((unsigned*)(lcnt + eb), 1u);
        }
        __syncthreads();
        if (F.tid < 64) { const unsigned c = lcnt[F.tid]; lcnt[64 + F.tid] = c ? atomicAdd(ctl + CW_COUNTS + F.tid, c) : 0u; }
        __syncthreads();
        if (lane < 16) { const int row = row0 + lane;
            tok_e[2 * row] = ea; tok_e[2 * row + 1] = eb; tok_pos[2 * row] = (int)(lcnt[64 + ea] + la); tok_pos[2 * row + 1] = (int)(lcnt[64 + eb] + lb); tok_w[2 * row] = w1; tok_w[2 * row + 1] = w2; }
        __syncthreads();
    }
}

__device__ __forceinline__ void phase_gather(const Frame& F) {
    const Params& P = *F.p; unsigned char* ws = P.ws;
    const int* tok_e = (const int*)(ws + WS_MISC + MS_TOKE); const int* tok_pos = (const int*)(ws + WS_MISC + MS_TOKPOS); int* tok_dest = (int*)(ws + WS_MISC + MS_TOKDEST);
    const unsigned char* H1F = ws + WS_H1F8; unsigned char* XB = ws + WS_XBUF;
    LAS int* ps = (LAS int*)F.lds;
    if (F.tid == 0) {
        const unsigned* cnt = (const unsigned*)(ws + WS_CTL) + CW_COUNTS;
        int* tile_e = (int*)(ws + WS_MISC + MS_TILEE); int* ntl = (int*)(ws + WS_MISC + MS_NTILES);
        int run = 0;
        for (int e = 0; e < NEXP; ++e) { const int c = (int)cnt[e]; ps[e] = run * 256; const int nte = (c + 255) / 256; if (F.bid == 0) for (int k = 0; k < nte; ++k) tile_e[run + k] = e; run += nte; }
        if (F.bid == 0) ntl[0] = run;
    }
    __syncthreads();
    const int gw = F.bid * NWAVES + F.wave, NGW = F.G * NWAVES;
    for (int a = gw; a < NASSIGN; a += NGW) {
        const int dest = ps[tok_e[a]] + tok_pos[a];
        const u32x4* src = (const u32x4*)(H1F + (size_t)(a >> 1) * D) + F.lane; u32x4* dst = (u32x4*)(XB + (size_t)dest * D) + F.lane;
        dst[0] = src[0];
        if (F.lane == 0) { tok_dest[a] = dest; ((float*)(ws + WS_XSB))[dest] = ((const float*)(ws + WS_H1S))[a >> 1]; }
    }
    __syncthreads();
}

__device__ __forceinline__ void phase_combine(const Frame& F) {
    const Params& P = *F.p; unsigned char* ws = P.ws;
    const bf16_t* H1B = (const bf16_t*)(ws + WS_H1B); const bf16_t* YB = (const bf16_t*)(ws + WS_YBUF);
    const int* tok_dest = (const int*)(ws + WS_MISC + MS_TOKDEST); const float* tok_w = (const float*)(ws + WS_MISC + MS_TOKW);
    const int gw = F.bid * NWAVES + F.wave, NGW = F.G * NWAVES, lane = F.lane;
    const float* g2 = P.in[I_LN2G]; const float* b2 = P.in[I_LN2B];
    f32x4 gg[4], bb[4];
#pragma unroll
    for (int j = 0; j < 4; ++j) { gg[j] = *((const f32x4*)g2 + lane + 64 * j); bb[j] = *((const f32x4*)b2 + lane + 64 * j); }
    for (int row0 = gw * 4; row0 < NTOK; row0 += NGW * 4) {
        f32x4 v[4][4]; float s[4], q[4];
        u32x2 lx[4][4]; unsigned la[4][4], lb[4][4]; float w0[4], w1[4];
#pragma unroll
        for (int a = 0; a < 4; ++a) { const int row = row0 + a; const int d0 = tok_dest[2 * row], d1 = tok_dest[2 * row + 1]; w0[a] = tok_w[2 * row]; w1[a] = tok_w[2 * row + 1];
            const u32x2* xr = (const u32x2*)(H1B + (size_t)row * D) + lane;
            const unsigned* y0 = (const unsigned*)((const unsigned char*)YB + (size_t)d0 * D) + lane; const unsigned* y1 = (const unsigned*)((const unsigned char*)YB + (size_t)d1 * D) + lane;
            w0[a] *= 0.0625f; w1[a] *= 0.0625f;
#pragma unroll
            for (int j = 0; j < 4; ++j) { lx[a][j] = xr[64 * j]; la[a][j] = y0[64 * j]; lb[a][j] = y1[64 * j]; } }
#pragma unroll
        for (int a = 0; a < 4; ++a) { s[a] = 0.f;
#pragma unroll
            for (int j = 0; j < 4; ++j) { const u32x2 x = lx[a][j];
                const f32x2 a01 = __builtin_amdgcn_cvt_pk_f32_fp8((int)la[a][j], false), a23 = __builtin_amdgcn_cvt_pk_f32_fp8((int)la[a][j], true), b01 = __builtin_amdgcn_cvt_pk_f32_fp8((int)lb[a][j], false), b23 = __builtin_amdgcn_cvt_pk_f32_fp8((int)lb[a][j], true);
                v[a][j][0] = ALPHA * bf_lo(x.x) + (w0[a] * a01[0] + w1[a] * b01[0]); v[a][j][1] = ALPHA * bf_hi(x.x) + (w0[a] * a01[1] + w1[a] * b01[1]);
                v[a][j][2] = ALPHA * bf_lo(x.y) + (w0[a] * a23[0] + w1[a] * b23[0]); v[a][j][3] = ALPHA * bf_hi(x.y) + (w0[a] * a23[1] + w1[a] * b23[1]);
                s[a] += (v[a][j][0] + v[a][j][1]) + (v[a][j][2] + v[a][j][3]); } }
#pragma unroll
        for (int o = 1; o < 64; o <<= 1) {
#pragma unroll
            for (int a = 0; a < 4; ++a) s[a] += __shfl_xor(s[a], o); }
#pragma unroll
        for (int a = 0; a < 4; ++a) { const float mean = s[a] * (1.f / D); q[a] = 0.f;
#pragma unroll
            for (int j = 0; j < 4; ++j) { v[a][j] = v[a][j] - mean; q[a] += (v[a][j][0] * v[a][j][0] + v[a][j][1] * v[a][j][1]) + (v[a][j][2] * v[a][j][2] + v[a][j][3] * v[a][j][3]); } }
#pragma unroll
        for (int o = 1; o < 64; o <<= 1) {
#pragma unroll
            for (int a = 0; a < 4; ++a) q[a] += __shfl_xor(q[a], o); }
#pragma unroll
        for (int a = 0; a < 4; ++a) { const float rstd = 1.f / sqrtf(q[a] * (1.f / D) + LN_EPS);
            f32x4* orow = (f32x4*)(P.out + (size_t)(row0 + a) * D) + lane;
#pragma unroll
            for (int j = 0; j < 4; ++j) __builtin_nontemporal_store(v[a][j] * rstd * gg[j] + bb[j], orow + 64 * j); }
    }
}

constexpr int NPHASE = 15;
__global__ void __launch_bounds__(NTHR, 2) fwd_kernel(Params prm) {
    extern __shared__ __attribute__((aligned(16))) unsigned char lds_raw[];
    Frame F; F.lds = (LAS unsigned char*)lds_raw; F.tid = threadIdx.x; F.lane = F.tid & 63; F.wave = __builtin_amdgcn_readfirstlane(F.tid >> 6); F.G = gridDim.x; F.bid = blockIdx.x; F.p = &prm;
    unsigned char* ws = prm.ws;
    const int lo = prm.ph_lo, hi = prm.ph_hi;
    volatile LAS unsigned* MISC = (volatile LAS unsigned*)(F.lds + MISC_OFF);
    if (F.tid < 32) MISC[F.tid] = 0u;
    __syncthreads();
    if (lo < 0) cg::this_grid().sync();
    XcdBarrier bar; bar.bar = (unsigned*)(ws + WS_CTL) + CW_BAR; bar.x = 0; bar.st = nullptr;
    if (hi - lo > 1) bar = xcd_barrier_post((unsigned*)(ws + WS_CTL) + CW_BAR, MISC + 8);
#define IN(k) (lo <= (k) && (k) < hi)
#define SEAM(k) do { if (IN(k) && IN((k) + 1)) { xcd_barrier(bar); } } while (0)
#define PHASE(k, ...) do { if (IN(k)) { __VA_ARGS__ if (PROBE_PH == (k)) { xcd_barrier(bar); __VA_ARGS__ } } SEAM(k); } while (0);
    const bf16_t* Zc = (const bf16_t*)(ws + WS_Z);

    PHASE(0, { phase_prep(F); })
    PHASE(1, {
        pg8::StaticOrder S{NTOK / 256, INCOLS / 256, F.G, F.bid, (const char*)(ws + WS_XB), (const char*)(ws + WS_WIN), (size_t)256 * D, (size_t)256 * D, 0};
        EpiBf16 E{(bf16_t*)(ws + WS_Z), INCOLS, prm.in[I_BGATE], GATE0 / 256, GATE0, 1.0f, 4, 12, D, (const float*)(ws + WS_XS), (const float*)(ws + WS_SW), 0};
        pg8::gemm_phase<EpiBf16, pg8::StaticOrder, true, true, 2>(F.lds, D / 2, D / 2, D / 2, S, E);
    })
    PHASE(2, {
        pg8::KVOrder S{F.G, F.bid, (const char*)(ws + WS_MEMB), (const char*)(ws + WS_WKV)};
        EpiKV E{(bf16_t*)(ws + WS_KB), (bf16_t*)(ws + WS_VT)};
        pg8::gemm_phase<EpiKV, pg8::KVOrder, true, true>(F.lds, D, D, D, S, E);
        if (F.bid >= 64) phase_convpool(F, CW_CPCTR, 0u, (unsigned)CP_EARLY);
    })
    PHASE(4, {
        if (F.bid < NATT) phase_attn<0>(F, F.bid, NATT);
        phase_convpool(F, CW_CPCTR2, (unsigned)CP_EARLY, (unsigned)CP_CHUNKS);
        { constexpr int I_DN0 = 16 * 256 + 3 * 16 * 32 + 16 * 64 + 4 * 4 * 8 + NEXP * 16 * 32; convert_items_dyn(F, I_DN0, PREP_NIT, CW_WDCTR); }
    })
    PHASE(7, {
        pg8::SegOrder S{NTOK / 256, D / 256, F.G, F.bid, (const char*)(ws + WS_ACONV), (const char*)(ws + WS_DPOOL), (const char*)(ws + WS_O), (const char*)(ws + WS_WCAT), (size_t)256 * D * 2, (size_t)256 * KCAT * 2, (size_t)256 * 2};
        EpiMix3 E{(bf16_t*)(ws + WS_MERGED), Zc, prm.in[I_PSCALE], 0};
        pg8::gemm_phase<EpiMix3, pg8::SegOrder, true, true>(F.lds, KCAT, D, KCAT, S, E);
        if (PROBE_PH == 207) { xcd_barrier(bar); EpiMix3 E2{(bf16_t*)(ws + WS_XBUF), Zc, prm.in[I_PSCALE], 1}; pg8::gemm_phase<EpiMix3, pg8::SegOrder, true, true>(F.lds, KCAT, D, KCAT, S, E2); }
    })
    PHASE(8, {
        pg8::StaticOrder S{NTOK / 256, D / 256, F.G, F.bid, (const char*)(ws + WS_MERGED), (const char*)(ws + WS_WO), (size_t)256 * D * 2, (size_t)256 * D * 2, 0};
        EpiResBf16 E{(bf16_t*)(ws + WS_H1), prm.in[I_X], ALPHA};
        pg8::gemm_phase<EpiResBf16, pg8::StaticOrder, true, true>(F.lds, D, D, D, S, E);
    })
    PHASE(9, { phase_ln1_router(F); if (PROBE_PH == 300) { xcd_barrier(bar); xcd_barrier(bar); xcd_barrier(bar); xcd_barrier(bar); } })
    PHASE(11, { phase_gather(F); })
    PHASE(12, {
        const int ntl = *(const int*)(ws + WS_MISC + MS_NTILES);
        pg8::MoeOrder S{ntl, 4, F.G, F.bid, (const char*)(ws + WS_XBUF), (const char*)(ws + WS_WUP), (size_t)256 * D, (size_t)256 * D, (size_t)D * D, (const int*)(ws + WS_MISC + MS_TILEE)};
        EpiAct E{ws + WS_ACT, (const float*)(ws + WS_XSB), (const float*)(ws + WS_SWU)};
        pg8::gemm_phase<EpiAct, pg8::MoeOrder, true, true, 2>(F.lds, D / 2, D / 2, D / 2, S, E);
    })
    PHASE(13, {
        const int ntl = *(const int*)(ws + WS_MISC + MS_NTILES);
        pg8::MoeOrder S{ntl, 4, F.G, F.bid, (const char*)(ws + WS_ACT), (const char*)(ws + WS_WDN), (size_t)256 * DEXP, (size_t)256 * DEXP, (size_t)D * DEXP, (const int*)(ws + WS_MISC + MS_TILEE)};
        EpiBf16 E{(bf16_t*)(ws + WS_YBUF), D, nullptr, 1 << 30, 0, 0.03125f * 16.0f, 0, 0, 0, nullptr, nullptr, 1};
        pg8::gemm_phase<EpiBf16, pg8::MoeOrder, true, true, 1>(F.lds, DEXP / 2, DEXP / 2, DEXP / 2, S, E);
    })
    PHASE(14, { phase_combine(F); })
#undef IN
#undef SEAM
}

extern "C" void kernel_launch(void* const* d_in, const int* in_sizes, int n_in, void* d_out, int out_size, void* d_ws, size_t ws_size, hipStream_t stream) {
    static int grid = 0;
    if (grid == 0) {
        if (n_in != 21 || out_size != NTOK * D || ws_size < WS_END) { fprintf(stderr, "kernel_launch: unexpected shapes (n_in %d out %d ws %zu, need ws >= %zu)\n", n_in, out_size, ws_size, (size_t)WS_END); grid = -1; return; }
        int dev = 0, cus = 0, per_cu = 0;
        if (hipGetDevice(&dev) != hipSuccess || hipDeviceGetAttribute(&cus, hipDeviceAttributeMultiprocessorCount, dev) != hipSuccess) { grid = -1; return; }
        if (hipFuncSetAttribute((const void*)fwd_kernel, hipFuncAttributeMaxDynamicSharedMemorySize, LDS_BYTES) != hipSuccess) { fprintf(stderr, "kernel_launch: hipFuncSetAttribute failed\n"); grid = -1; return; }
        if (hipOccupancyMaxActiveBlocksPerMultiprocessor(&per_cu, (const void*)fwd_kernel, NTHR, LDS_BYTES) != hipSuccess || per_cu < 1) { fprintf(stderr, "kernel_launch: occupancy query says %d\n", per_cu); (void)hipGetLastError(); per_cu = 1; }
        grid = cus * 1;
        fprintf(stderr, "kernel_launch: cus %d per_cu %d grid %d\n", cus, per_cu, grid);
    }
    if (grid < 0) return;
    (void)hipMemsetAsync((char*)d_ws + WS_CTL, 0, CTL_ZERO_BYTES, stream);
    Params a{};
    for (int i = 0; i < 21; ++i) a.in[i] = (const float*)d_in[i];
    a.out = (float*)d_out; a.ws = (unsigned char*)d_ws;
#if MK_ONE_LAUNCH
    a.ph_lo = 0; a.ph_hi = NPHASE;
    void* args[] = {&a};
    hipError_t e = hipLaunchCooperativeKernel((const void*)fwd_kernel, dim3(grid), dim3(NTHR), args, LDS_BYTES, stream);
    if (e != hipSuccess) fprintf(stderr, "cooperative launch failed: %s (grid %d)\n", hipGetErrorString(e), grid);
#else
    for (int ph = 0; ph < NPHASE; ++ph) {
        a.ph_lo = ph; a.ph_hi = ph + 1;
        hipLaunchKernelGGL(fwd_kernel, dim3(grid), dim3(NTHR), LDS_BYTES, stream, a);
    }
#endif
}
```

```cpp
#include <hip/hip_runtime.h>
#include <hip/hip_cooperative_groups.h>
#include <cstdio>
#include <cstdint>
namespace cg = cooperative_groups;

#ifndef PROBE_PH
#define PROBE_PH -1
#endif
#ifndef STAG_G1
#define STAG_G1 0
#endif
#ifndef MK_ONE_LAUNCH
#define MK_ONE_LAUNCH 1
#endif

namespace pg8 {
#define PG8_LAS __attribute__((address_space(3)))
#define PG8_GAS __attribute__((address_space(1)))
typedef unsigned short bf16_t;
typedef short bf16x8 __attribute__((ext_vector_type(8)));
typedef float f32x4 __attribute__((ext_vector_type(4)));
typedef float f32x2 __attribute__((ext_vector_type(2)));
typedef unsigned u32x4 __attribute__((ext_vector_type(4)));
typedef unsigned u32x2 __attribute__((ext_vector_type(2)));
constexpr int BM = 256, BK = 64, HALF = 128, HTB = HALF * BK * 2  , STAGE_BYTES = 8 * HTB, NXCD = 8, WGM = 4;

__host__ __device__ __forceinline__ int lds_byte(int r, int c) { const int st = (r >> 4) * 2 + (c >> 5), rr = r & 15, cc = c & 31, ob = rr * 64 + cc * 2; return st * 1024 + (ob ^ (((ob >> 9) & 1) << 5)); }
__host__ __device__ __forceinline__ void stage_rc(int b, int& R, int& C) { const int st = b / 1024, sb = b % 1024, swz = sb ^ (((sb >> 9) & 1) << 5); R = (st >> 1) * 16 + swz / 64; C = (st & 1) * 32 + (swz % 64) / 2; }
__host__ __device__ __forceinline__ int perm32(int rho) { const int n = rho >> 4, i = rho & 15; return 8 * (i >> 2) + 4 * n + (i & 3); }

struct Unit { int pm, pn, kind; const char* a; const char* b; int nt, seg, fin; };

__device__ __forceinline__ void tile_of(int L, int nM, int nN, int& pm, int& pn) {
    const int nwg = nM * nN; int wgid = L;
    { const int q = nwg / NXCD, r = nwg % NXCD, xcd = wgid % NXCD, off = wgid / NXCD; wgid = (xcd < r ? xcd * (q + 1) : r * (q + 1) + (xcd - r) * q) + off; }
    const int nig = WGM * nN, gid = wgid / nig, fm = gid * WGM, gsz = (nM - fm) < WGM ? (nM - fm) : WGM;
    pm = fm + ((wgid % nig) % gsz); pn = (wgid % nig) / gsz;
}
struct StaticOrder {
    int nM, nN, G, c; const char* A; const char* B; size_t tA, tB, aN;
    __device__ __forceinline__ bool next(int i, Unit& u) const {
        const long L = (long)i * G + c; if (L >= (long)nM * nN) return false;
        tile_of((int)L, nM, nN, u.pm, u.pn); u.kind = 0;
        u.a = A + (size_t)u.pm * tA + (size_t)u.pn * aN; u.b = B + (size_t)u.pn * tB; return true;
    }
};
struct MoeOrder {
    int nM, nN, G, c; const char* A; const char* B; size_t tA, tB, eB; const int* tile_expert;
    __device__ __forceinline__ bool next(int i, Unit& u) const {
        const long L = (long)i * G + c; if (L >= (long)nM * nN) return false;
        tile_of((int)L, nM, nN, u.pm, u.pn); u.kind = 0;
        const int e = __builtin_amdgcn_readfirstlane(tile_expert[u.pm]); u.kind = e;
        u.a = A + (size_t)u.pm * tA; u.b = B + (size_t)e * eB + (size_t)u.pn * tB; return true;
    }
};

struct SegOrder {
    int nM, nN, G, c; const char* A; const char* A2; const char* A3; const char* B; size_t tA, tB, aN2;
    __device__ __forceinline__ bool next(int i, Unit& u) const {
        const int iu = i / 3, seg = i - 3 * iu;
        const long L = (long)iu * G + c; if (L >= (long)nM * nN) return false;
        tile_of((int)L, nM, nN, u.pm, u.pn); u.kind = 0; u.seg = seg; u.fin = (seg == 2); u.nt = (seg == 1) ? 4 : 16;
        u.a = (seg == 0 ? A : (seg == 1 ? A2 + (size_t)u.pn * aN2 : A3)) + (size_t)u.pm * tA;
        u.b = B + (size_t)u.pn * tB + (size_t)(seg == 0 ? 0 : (seg == 1 ? 1024 : 1280)) * 2; return true;
    }
};
struct KVOrder {
    int G, c; const char* memb; const char* wkv;
    __device__ __forceinline__ bool next(int i, Unit& u) const {
        const int L = i * G + c; if (L >= 64) return false;
        if (L < 32) { u.pm = L >> 2; u.pn = L & 3; u.kind = 0; u.a = memb + (size_t)u.pm * 256 * 2048; u.b = wkv + (size_t)u.pn * 256 * 2048; }
        else { const int j = L - 32; u.pm = j; u.pn = 0; u.kind = 1; u.a = wkv + (size_t)(1024 + (j & 3) * 256) * 2048; u.b = memb + (size_t)(j >> 2) * 256 * 2048; }
        return true;
    }
};

__device__ __forceinline__ unsigned cvt_pk_bf16(float lo, float hi) { unsigned r; asm volatile("v_cvt_pk_bf16_f32 %0, %1, %2" : "=v"(r) : "v"(lo), "v"(hi)); return r; }
__device__ __forceinline__ float bf_lo(unsigned w) { return __uint_as_float(w << 16); }
__device__ __forceinline__ float bf_hi(unsigned w) { return __uint_as_float(w & 0xffff0000u); }

typedef int i32x4 __attribute__((ext_vector_type(4)));
typedef int i32x8 __attribute__((ext_vector_type(8)));
typedef float f32x32 __attribute__((ext_vector_type(32)));
__device__ __forceinline__ i32x8 pg8_cat(const bf16x8 lo, const bf16x8 hi) { const i32x4 a = __builtin_bit_cast(i32x4, lo), b = __builtin_bit_cast(i32x4, hi); return __builtin_shufflevector(a, b, 0, 1, 2, 3, 4, 5, 6, 7); }
template <class Epi, class Sched, bool ALIGN_EPI = false, bool SP2 = false, int MODE = 0>
__device__ __forceinline__ void gemm_phase(PG8_LAS unsigned char* lds, const int K, const int lda, const int ldb, const Sched& S, const Epi& E) {
    const int tid = threadIdx.x, wid = __builtin_amdgcn_readfirstlane(tid >> 6), lane = tid & 63, wr = wid >> 2, wc = wid & 3, fr = lane & 15, fq = lane >> 4;
    constexpr bool FP8 = (MODE == 1), INT8 = (MODE == 2);
    const int nt = K / BK; constexpr int NST = Epi::NST;
    unsigned voffA[2], voffB[2];
#pragma unroll
    for (int i = 0; i < 2; ++i) { int R, C; stage_rc(tid * 16 + i * 8192, R, C); const int Rb = Epi::PERM ? ((R & ~31) + perm32(R & 31)) : R;
        voffA[i] = (unsigned)(R * lda + C) * 2u; voffB[i] = (unsigned)(Rb * ldb + C) * 2u; }
    const size_t kstep = (size_t)(BK * 2);
    const size_t hstepA = (size_t)HALF * lda * 2, hstepB = (size_t)HALF * ldb * 2;
    const unsigned ldsw = (unsigned)wid * 1024u;
    const int aoff = lds_byte(wr * 64 + fr, fq * 8), boff = lds_byte(wc * 32 + fr, fq * 8);
#define PG8_SA(b, h) (((b) * 2 + (h)) * HTB)
#define PG8_SB(b, h) ((4 + (b) * 2 + (h)) * HTB)
#define PG8_STAGE(bufoff, gbase, voff) do { _Pragma("unroll") for (int _i = 0; _i < 2; ++_i) \
        __builtin_amdgcn_global_load_lds((const PG8_GAS unsigned*)((const PG8_GAS char*)(gbase) + (voff)[_i]), (PG8_LAS unsigned*)(lds + (bufoff) + ldsw + _i * 8192), 16, 0, 0); } while (0)
#define PG8_LDA(dst, b, h) do { if constexpr (FP8) { _Pragma("unroll") for (int m = 0; m < 4; ++m) dst##8[m] = pg8_cat(*(const PG8_LAS bf16x8*)(lds + PG8_SA(b, h) + aoff + m * 2048), *(const PG8_LAS bf16x8*)(lds + PG8_SA(b, h) + aoff + m * 2048 + 1024)); } \
        else { _Pragma("unroll") for (int m = 0; m < 4; ++m) _Pragma("unroll") for (int k = 0; k < 2; ++k) dst[m][k] = *(const PG8_LAS bf16x8*)(lds + PG8_SA(b, h) + aoff + m * 2048 + k * 1024); } } while (0)
#define PG8_LDB(dst, b, h) do { if constexpr (FP8) { _Pragma("unroll") for (int n = 0; n < 2; ++n) dst##8[n] = pg8_cat(*(const PG8_LAS bf16x8*)(lds + PG8_SB(b, h) + boff + n * 2048), *(const PG8_LAS bf16x8*)(lds + PG8_SB(b, h) + boff + n * 2048 + 1024)); } \
        else { _Pragma("unroll") for (int n = 0; n < 2; ++n) _Pragma("unroll") for (int k = 0; k < 2; ++k) dst[n][k] = *(const PG8_LAS bf16x8*)(lds + PG8_SB(b, h) + boff + n * 2048 + k * 1024); } } while (0)
#define PG8_MMA(ai, bj, At, Bt) do { __builtin_amdgcn_s_setprio(1); \
        if constexpr (FP8) { _Pragma("unroll") for (int m = 0; m < 4; ++m) _Pragma("unroll") for (int n = 0; n < 2; ++n) { \
            const f32x4 _c = (f32x4){accv[ai][bj][(m * 2 + n) * 4], accv[ai][bj][(m * 2 + n) * 4 + 1], accv[ai][bj][(m * 2 + n) * 4 + 2], accv[ai][bj][(m * 2 + n) * 4 + 3]}; \
            const f32x4 _d = __builtin_amdgcn_mfma_scale_f32_16x16x128_f8f6f4(Bt##8[n], At##8[m], _c, 0, 0, 0, 0x7f7f7f7f, 0, 0x7f7f7f7f); \
            _Pragma("unroll") for (int _j = 0; _j < 4; ++_j) accv[ai][bj][(m * 2 + n) * 4 + _j] = _d[_j]; } } \
        else if constexpr (INT8) { _Pragma("unroll") for (int m = 0; m < 4; ++m) _Pragma("unroll") for (int n = 0; n < 2; ++n) _Pragma("unroll") for (int k = 0; k < 2; ++k) \
            acc[ai][bj][m][n] = __builtin_bit_cast(f32x4, __builtin_amdgcn_mfma_i32_16x16x64_i8(__builtin_bit_cast(i32x4, Bt[n][k]), __builtin_bit_cast(i32x4, At[m][k]), __builtin_bit_cast(i32x4, acc[ai][bj][m][n]), 0, 0, 0)); } \
        else { _Pragma("unroll") for (int m = 0; m < 4; ++m) _Pragma("unroll") for (int n = 0; n < 2; ++n) _Pragma("unroll") for (int k = 0; k < 2; ++k) \
            acc[ai][bj][m][n] = __builtin_amdgcn_mfma_f32_16x16x32_bf16(Bt[n][k], At[m][k], acc[ai][bj][m][n], 0, 0, 0); } \
        __builtin_amdgcn_s_setprio(0); } while (0)
#define PG8_WAIT_V(n) asm volatile("s_waitcnt vmcnt(" #n ")" ::: "memory")
#define PG8_WAIT_VN(n) asm volatile("s_waitcnt vmcnt(%0)" :: "n"(n) : "memory")
#define PG8_WAIT_L(n) asm volatile("s_waitcnt lgkmcnt(" #n ")" ::: "memory")
#define PG8_BAR __builtin_amdgcn_s_barrier()
#define PG8_SCHED __builtin_amdgcn_sched_barrier(0)
    Unit cur, nxt; int ui = 0;
    if (!S.next(0, cur)) return;
    f32x4 acc[2][2][4][2];
#pragma unroll
    for (int a = 0; a < 2; ++a)
#pragma unroll
        for (int b = 0; b < 2; ++b)
#pragma unroll
            for (int m = 0; m < 4; ++m)
#pragma unroll
                for (int n = 0; n < 2; ++n) acc[a][b][m][n] = (f32x4){0.f, 0.f, 0.f, 0.f};
    bf16x8 At[4][2], B0[2][2], B1[2][2]; i32x8 At8[4], B08[2], B18[2]; f32x32 accv[2][2];
    if constexpr (FP8) {
#pragma unroll
        for (int a = 0; a < 2; ++a)
#pragma unroll
            for (int b = 0; b < 2; ++b)
#pragma unroll
                for (int j = 0; j < 32; ++j) accv[a][b][j] = 0.f; }
    const char* cA = cur.a; const char* cB = cur.b;
    if constexpr (SP2) {
        PG8_STAGE(PG8_SB(0, 0), cB, voffB); PG8_STAGE(PG8_SB(0, 1), cB + hstepB, voffB); PG8_STAGE(PG8_SA(0, 0), cA, voffA); PG8_STAGE(PG8_SA(0, 1), cA + hstepA, voffA);
        if (wr == 1) PG8_BAR;
        PG8_WAIT_V(2); PG8_BAR;
        PG8_STAGE(PG8_SB(1, 0), cB + kstep, voffB); PG8_STAGE(PG8_SA(1, 0), cA + kstep, voffA); PG8_STAGE(PG8_SB(1, 1), cB + hstepB + kstep, voffB);
        PG8_WAIT_V(6); PG8_BAR;
    } else {
        PG8_STAGE(PG8_SB(0, 0), cB, voffB); PG8_STAGE(PG8_SA(0, 0), cA, voffA); PG8_STAGE(PG8_SB(0, 1), cB + hstepB, voffB); PG8_STAGE(PG8_SA(0, 1), cA + hstepA, voffA);
        if (wr == 1) PG8_BAR;
        PG8_WAIT_V(4); PG8_BAR;
        PG8_STAGE(PG8_SB(1, 0), cB + kstep, voffB); PG8_STAGE(PG8_SA(1, 0), cA + kstep, voffA); PG8_STAGE(PG8_SB(1, 1), cB + hstepB + kstep, voffB);
        PG8_WAIT_V(6); PG8_BAR;
    }
    for (;;) {
        const bool has_next = S.next(ui + 1, nxt);
        const char* nA = has_next ? nxt.a : cA; const char* nB = has_next ? nxt.b : cB;
        int ntc = nt; if constexpr (Epi::SEG) ntc = cur.nt;
        if constexpr (Epi::PREF) E.prefetch(cur, lds + 131072 + 1024 + wid * 256, tid);
#pragma nounroll
        for (int t = 0; t < ntc; t += 2) {
            const bool last = (t == ntc - 2);
            const char* a1 = cA + (size_t)(t + 1) * kstep;
            const char* a2 = last ? nA : cA + (size_t)(t + 2) * kstep; const char* b2 = last ? nB : cB + (size_t)(t + 2) * kstep;
            const char* a3 = a2 + kstep; const char* b3 = b2 + kstep;
            if constexpr (SP2) {
            const bool fresh = !FP8 && (NST > 0) && (t == 0) && (ui > 0);
            PG8_LDB(B0, 0, 0); PG8_LDB(B1, 0, 1); PG8_SCHED; PG8_LDA(At, 0, 0); PG8_STAGE(PG8_SA(1, 1), a1 + hstepA, voffA);
            if (fresh) PG8_WAIT_VN(8 + NST); else PG8_WAIT_V(8);
            PG8_WAIT_L(0); PG8_BAR; PG8_MMA(0, 0, At, B0); PG8_MMA(0, 1, At, B1); PG8_BAR; PG8_SCHED;
            PG8_LDA(At, 0, 1); PG8_STAGE(PG8_SB(0, 0), b2, voffB); PG8_STAGE(PG8_SB(0, 1), b2 + hstepB, voffB); PG8_STAGE(PG8_SA(0, 0), a2, voffA);
            if (fresh) PG8_WAIT_VN(8 + NST); else PG8_WAIT_V(8);
            PG8_WAIT_L(0); PG8_BAR; PG8_MMA(1, 0, At, B0); PG8_MMA(1, 1, At, B1); PG8_BAR; PG8_SCHED;
            PG8_LDB(B0, 1, 0); PG8_LDB(B1, 1, 1); PG8_SCHED; PG8_LDA(At, 1, 0); PG8_STAGE(PG8_SA(0, 1), a2 + hstepA, voffA);
            PG8_WAIT_V(8); PG8_WAIT_L(0); PG8_BAR; PG8_MMA(0, 0, At, B0); PG8_MMA(0, 1, At, B1); PG8_BAR; PG8_SCHED;
            PG8_LDA(At, 1, 1); PG8_STAGE(PG8_SB(1, 0), b3, voffB); PG8_STAGE(PG8_SB(1, 1), b3 + hstepB, voffB); PG8_STAGE(PG8_SA(1, 0), a3, voffA);
            PG8_WAIT_V(8); PG8_WAIT_L(0); PG8_BAR; PG8_MMA(1, 0, At, B0); PG8_MMA(1, 1, At, B1); PG8_BAR; PG8_SCHED;
            } else {
            PG8_LDB(B0, 0, 0); PG8_SCHED; PG8_LDA(At, 0, 0); PG8_STAGE(PG8_SA(1, 1), a1 + hstepA, voffA);
            PG8_WAIT_L(8); PG8_BAR; PG8_WAIT_L(0); PG8_MMA(0, 0, At, B0); PG8_BAR; PG8_SCHED;
            PG8_LDB(B1, 0, 1); PG8_STAGE(PG8_SB(0, 0), b2, voffB);
            PG8_BAR; PG8_WAIT_L(0); PG8_MMA(0, 1, At, B1); PG8_BAR;
            PG8_LDA(At, 0, 1); PG8_STAGE(PG8_SA(0, 0), a2, voffA);
            PG8_BAR; PG8_WAIT_L(0); PG8_MMA(1, 0, At, B0); PG8_BAR; PG8_SCHED;
            PG8_STAGE(PG8_SB(0, 1), b2 + hstepB, voffB);
            PG8_WAIT_V(6); PG8_BAR; PG8_MMA(1, 1, At, B1); PG8_BAR;
            PG8_LDB(B0, 1, 0); PG8_SCHED; PG8_LDA(At, 1, 0); PG8_STAGE(PG8_SA(0, 1), a2 + hstepA, voffA);
            PG8_WAIT_L(8); PG8_BAR; PG8_WAIT_L(0); PG8_MMA(0, 0, At, B0); PG8_BAR; PG8_SCHED;
            PG8_LDB(B1, 1, 1); PG8_STAGE(PG8_SB(1, 0), b3, voffB);
            PG8_BAR; PG8_WAIT_L(0); PG8_MMA(0, 1, At, B1); PG8_BAR;
            PG8_LDA(At, 1, 1); PG8_STAGE(PG8_SA(1, 0), a3, voffA);
            PG8_BAR; PG8_WAIT_L(0); PG8_MMA(1, 0, At, B0); PG8_BAR; PG8_SCHED;
            PG8_STAGE(PG8_SB(1, 1), b3 + hstepB, voffB);
            PG8_WAIT_V(6); PG8_BAR; PG8_MMA(1, 1, At, B1); PG8_BAR;
            }
        }
        if constexpr (ALIGN_EPI) { if (wr == 0) PG8_BAR; }
        if constexpr (FP8) {
#pragma unroll
            for (int a = 0; a < 2; ++a)
#pragma unroll
                for (int b = 0; b < 2; ++b)
#pragma unroll
                    for (int m = 0; m < 4; ++m)
#pragma unroll
                        for (int n = 0; n < 2; ++n) { acc[a][b][m][n] = (f32x4){accv[a][b][(m * 2 + n) * 4], accv[a][b][(m * 2 + n) * 4 + 1], accv[a][b][(m * 2 + n) * 4 + 2], accv[a][b][(m * 2 + n) * 4 + 3]}; }
#pragma unroll
            for (int a = 0; a < 2; ++a)
#pragma unroll
                for (int b = 0; b < 2; ++b)
#pragma unroll
                    for (int j = 0; j < 32; ++j) accv[a][b][j] = 0.f; }
        if constexpr (INT8) {
#pragma unroll
            for (int a = 0; a < 2; ++a)
#pragma unroll
                for (int b = 0; b < 2; ++b)
#pragma unroll
                    for (int m = 0; m < 4; ++m)
#pragma unroll
                        for (int n = 0; n < 2; ++n) { const i32x4 iv = __builtin_bit_cast(i32x4, acc[a][b][m][n]); acc[a][b][m][n] = (f32x4){(float)iv[0], (float)iv[1], (float)iv[2], (float)iv[3]}; } }
        bool fin = true;
        if constexpr (Epi::SEG) { fin = cur.fin != 0; if (fin) E(acc, cur, wr, wc, fr, fq); else E.mid(acc, cur, cur.seg + 1, wr, wc, fr, fq); } else E(acc, cur, wr, wc, fr, fq);
        if (!has_next) break;
        if (fin) {
#pragma unroll
        for (int a = 0; a < 2; ++a)
#pragma unroll
            for (int b = 0; b < 2; ++b)
#pragma unroll
                for (int m = 0; m < 4; ++m)
#pragma unroll
                    for (int n = 0; n < 2; ++n) acc[a][b][m][n] = (f32x4){0.f, 0.f, 0.f, 0.f};
        }
        cur = nxt; cA = nA; cB = nB; ++ui;
        if constexpr (ALIGN_EPI) { if (wr == 1) PG8_BAR; }
    }
    PG8_WAIT_V(0);
    if constexpr (!ALIGN_EPI) { if (wr == 0) PG8_BAR; }
    PG8_BAR;
#undef PG8_SA
#undef PG8_SB
#undef PG8_STAGE
#undef PG8_LDA
#undef PG8_LDB
#undef PG8_MMA
#undef PG8_WAIT_V
#undef PG8_WAIT_VN
#undef PG8_WAIT_L
#undef PG8_BAR
#undef PG8_SCHED
}
}
using pg8::bf16_t; using pg8::f32x4; using pg8::f32x2; using pg8::u32x4; using pg8::u32x2; using pg8::Unit; using pg8::cvt_pk_bf16; using pg8::bf_lo; using pg8::bf_hi;
#define LAS __attribute__((address_space(3)))

constexpr int D = 1024, BATCH = 8, SEQ = 4096, NTOK = BATCH * SEQ, MEMLEN = 256, NMEM = BATCH * MEMLEN;
constexpr int INCOLS = 8192, GATE0 = 5120;
constexpr int NEXP = 64, DEXP = 512, NGRP = 8, EPG = 8;
constexpr int NASSIGN = NTOK * 2, PMAX_TILES = 320, PMAX = PMAX_TILES * 256;
constexpr float ALPHA = 1.189207115002721f;
constexpr float LN_EPS = 1e-5f;
constexpr int NWAVES = 8, NTHR = 512;

constexpr size_t MiB = 1u << 20;
constexpr size_t WS_CTL = 0, CTL_ZERO_BYTES = 1 * MiB;
constexpr size_t WS_WIN = 1 * MiB, WS_WKV = 17 * MiB, WS_WCAT = 21 * MiB, WS_WO = 26 * MiB, WS_WR = 28 * MiB;
constexpr int KCAT = 2304;
constexpr size_t WS_WUP = 29 * MiB, WS_WDN = 157 * MiB, WS_MISC = 221 * MiB;
constexpr size_t WS_Z = 224 * MiB;
constexpr size_t WS_XB = 736 * MiB, WS_MEMB = 800 * MiB, WS_KV = 804 * MiB, WS_ACONV = 812 * MiB, WS_DPOOL = 876 * MiB, WS_MERGED = 940 * MiB;
constexpr size_t WS_KB = WS_KV, WS_VT = WS_KV + 4 * MiB;
constexpr size_t WS_XS = WS_MISC + 3 * (MiB / 2), WS_SW = WS_MISC + 7 * (MiB / 4);
constexpr size_t WS_SWU = WS_MISC + 2 * MiB;
constexpr size_t WS_XSB = WS_MISC + 9 * (MiB / 4), WS_H1S = WS_MISC + 21 * (MiB / 8);
constexpr size_t WS_O = WS_XB;
constexpr size_t WS_H1 = 224 * MiB;
constexpr size_t WS_H1B = 480 * MiB;
constexpr size_t WS_XBUF = 544 * MiB;
constexpr size_t WS_H1F8 = 640 * MiB;
constexpr size_t WS_ACT = 736 * MiB;
constexpr size_t WS_YBUF = 816 * MiB;
constexpr size_t WS_END = 1004 * MiB;
constexpr size_t MS_TOKE = 0, MS_TOKPOS = MS_TOKE + NASSIGN * 4, MS_TOKW = MS_TOKPOS + NASSIGN * 4, MS_TOKDEST = MS_TOKW + NASSIGN * 4, MS_TILEE = MS_TOKDEST + NASSIGN * 4, MS_PSTART = MS_TILEE + 4096, MS_NTILES = MS_PSTART + 1024;
constexpr int CW_COUNTS = 1024;
constexpr int CW_CPCTR = 1152, CW_CPCTR2 = 1216, CW_WDCTR = 1280;
constexpr int CP_CHUNKS = (NTOK / 16) * (D / 8) / NTHR, CP_EARLY = 180;
constexpr int NATT = 192;
constexpr int CW_BAR = 4096;

constexpr int LDS_BYTES = 147456, MISC_OFF = 131072 + 320;

struct Params { const float* in[21]; float* out; unsigned char* ws; int ph_lo, ph_hi; };
enum { I_X = 0, I_MEM, I_WIN, I_BGATE, I_CONVW, I_WCONV, I_WPOOL, I_PSCALE, I_WKV, I_WXO, I_WO, I_LN1G, I_LN1B, I_WRG, I_BRG, I_WRE, I_BRE, I_WUP, I_WDN, I_LN2G, I_LN2B };

__device__ __forceinline__ unsigned f2bf(float f) { unsigned u = __float_as_uint(f); return (u + 0x7fffu + ((u >> 16) & 1u)) >> 16; }
__device__ __forceinline__ unsigned pk2(float lo, float hi) { return f2bf(lo) | (f2bf(hi) << 16); }
__device__ __forceinline__ float wave_sum(float v) {
#pragma unroll
    for (int o = 1; o < 64; o <<= 1) v += __shfl_xor(v, o);
    return v;
}
__device__ __forceinline__ float sigmoidf_(float x) { return __builtin_amdgcn_rcpf(1.0f + __expf(-x)); }


#define XB_TMO      128
#define XB_XCNT(j)  (256  + 64 * (j))
#define XB_XSUB(j)  (1280 + 64 * (j))
#define XB_XGEN(j)  (2304 + 64 * (j))
#define XB_TOP      3328
#define XB_TOPGEN   3392
#define XCD_BAR_WORDS 3456
#define XB_SPIN_CAP (1u << 18)
__device__ __forceinline__ unsigned xb_ld(unsigned* p)              { return __hip_atomic_load(p, __ATOMIC_RELAXED, __HIP_MEMORY_SCOPE_AGENT); }
__device__ __forceinline__ unsigned xb_add(unsigned* p, unsigned v) { return __hip_atomic_fetch_add(p, v, __ATOMIC_RELAXED, __HIP_MEMORY_SCOPE_AGENT); }
__device__ __forceinline__ unsigned xb_xcc_id() { return (unsigned)__builtin_amdgcn_s_getreg((3 << 11) | 20) & 0xFu; }
#define XB_SPIN(cond, bar) do { unsigned _sp = 0; while (cond) { __builtin_amdgcn_s_sleep(1); \
    if ((++_sp & 255u) == 0u) { if (xb_ld(&(bar)[XB_TMO])) break; if (_sp > XB_SPIN_CAP) { atomicAdd(&(bar)[XB_TMO], 1u); break; } } } } while (0)
struct XcdBarrier { unsigned* bar; unsigned x; volatile LAS unsigned* st; };
__device__ __forceinline__ XcdBarrier xcd_barrier_post(unsigned* bar, volatile LAS unsigned* st) {
    XcdBarrier b; b.bar = bar; b.x = xb_xcc_id(); b.st = st;
    if (threadIdx.x == 0) (void)xb_add(&bar[XB_XCNT(b.x)], 1u);
    return b;
}
__device__ __forceinline__ void xcd_barrier_complete(unsigned* bar, unsigned x, unsigned& nloc, unsigned& nx) {
    const unsigned G = gridDim.x * gridDim.y * gridDim.z;
    unsigned sum, cnt, mine, sp = 0u;
    for (;;) {
        sum = 0u; cnt = 0u; mine = 0u;
#pragma unroll
        for (unsigned j = 0; j < 16; ++j) { const unsigned c = xb_ld(&bar[XB_XCNT(j)]); sum += c; cnt += (c > 0u) ? 1u : 0u; mine = (j == x) ? c : mine; }
        if (sum == G) break;
        __builtin_amdgcn_s_sleep(1);
        if ((++sp & 255u) == 0u) { if (xb_ld(&bar[XB_TMO])) break; if (sp > XB_SPIN_CAP) { atomicAdd(&bar[XB_TMO], 1u); break; } }
    }
    nloc = mine > 0u ? mine : 1u; nx = cnt > 0u ? cnt : 1u;
}
__device__ __forceinline__ void xcd_barrier(const XcdBarrier& b) {
    asm volatile("s_waitcnt vmcnt(0)" ::: "memory");
    __syncthreads();
    if (threadIdx.x == 0) {
        unsigned* bar = b.bar;
        __builtin_amdgcn_s_waitcnt(0);
        unsigned nloc = b.st[0], nx = b.st[1];
        if (nloc == 0u) { xcd_barrier_complete(bar, b.x, nloc, nx); b.st[0] = nloc; b.st[1] = nx; }
        const unsigned old = xb_add(&bar[XB_XSUB(b.x)], 1u);
        const unsigned gen = old / nloc;
        if (old + 1u == (gen + 1u) * nloc) {
            __builtin_amdgcn_fence(__ATOMIC_RELEASE, "agent");
            asm volatile("s_waitcnt vmcnt(0)" ::: "memory");
            const unsigned og = xb_add(&bar[XB_TOP], 1u);
            const unsigned tg = og / nx;
            if (og + 1u == (tg + 1u) * nx) xb_add(&bar[XB_TOPGEN], 1u);
            else XB_SPIN(xb_ld(&bar[XB_TOPGEN]) == tg, bar);
            __builtin_amdgcn_fence(__ATOMIC_ACQUIRE, "agent");
            xb_add(&bar[XB_XGEN(b.x)], 1u);
            asm volatile("s_waitcnt vmcnt(0)" ::: "memory");
        } else {
            XB_SPIN(xb_ld(&bar[XB_XGEN(b.x)]) == gen, bar);
            __builtin_amdgcn_fence(__ATOMIC_ACQUIRE, "agent");
            asm volatile("s_waitcnt vmcnt(0)" ::: "memory");
        }
    }
    __syncthreads();
}

__device__ __forceinline__ void stagger_delay(unsigned ticks) {
    const unsigned long long t0 = __builtin_amdgcn_s_memrealtime();
    while (__builtin_amdgcn_s_memrealtime() - t0 < (unsigned long long)ticks) __builtin_amdgcn_s_sleep(4);
}

template <int LPR> __device__ __forceinline__ void touch_tile(const char* base, size_t pitch, LAS unsigned char* junk, int tid) {
#pragma unroll
    for (int i = 0; i < (256 * LPR) / 512; ++i) { const int ln = i * 512 + tid, r = ln / LPR, c = ln % LPR;
        __builtin_amdgcn_global_load_lds((const PG8_GAS unsigned*)(base + (size_t)r * pitch + c * 128), (LAS unsigned*)junk, 4, 0, 0); }
}

struct EpiBf16 {
    static constexpr bool PERM = true, SEG = false, PREF = false; static constexpr int NST = 8;
    bf16_t* O; int ldc; const float* bias; int gate_pn; int gate_col0; float oscale; int mul_pn0, mul_pn1, mul_col0; const float* rs; const float* cs; int f8out;
    __device__ __forceinline__ void operator()(const f32x4 (&acc)[2][2][4][2], const Unit& u, int wr, int wc, int fr, int fq) const {
        const int row0 = u.pm * 256 + wr * 64 + fr, col0 = u.pn * 256 + wc * 32 + 8 * fq;
        f32x4 cv[2][2]; float rv[2][4];
#pragma unroll
        for (int bj = 0; bj < 2; ++bj)
#pragma unroll
            for (int n = 0; n < 2; ++n) cv[bj][n] = cs ? *(const f32x4*)(cs + col0 + bj * 128 + 4 * n) : (f32x4){1.f, 1.f, 1.f, 1.f};
#pragma unroll
        for (int ai = 0; ai < 2; ++ai)
#pragma unroll
            for (int m = 0; m < 4; ++m) rv[ai][m] = (rs ? rs[row0 + ai * 128 + m * 16] : 1.0f) * oscale;
        if (u.pn >= mul_pn0 && u.pn < mul_pn1) {
            const int mc = mul_col0 + (u.pn - mul_pn0) * 128 + wc * 32 + 8 * fq;
#pragma unroll
            for (int ai = 0; ai < 2; ++ai)
#pragma unroll
                for (int m = 0; m < 4; ++m) { const float r2 = rv[ai][m] * rv[ai][m];
                    const f32x4 v0 = (acc[ai][0][m][0] * cv[0][0]) * (acc[ai][1][m][0] * cv[1][0]) * r2, v1 = (acc[ai][0][m][1] * cv[0][1]) * (acc[ai][1][m][1] * cv[1][1]) * r2;
                    u32x4 w; w.x = cvt_pk_bf16(v0[0], v0[1]); w.y = cvt_pk_bf16(v0[2], v0[3]); w.z = cvt_pk_bf16(v1[0], v1[1]); w.w = cvt_pk_bf16(v1[2], v1[3]);
                    __builtin_nontemporal_store(w, (u32x4*)(O + (size_t)(row0 + ai * 128 + m * 16) * ldc + mc)); }
            return;
        }
        const bool gate = u.pn >= gate_pn;
        f32x4 bv[2][2];
#pragma unroll
        for (int bj = 0; bj < 2; ++bj)
#pragma unroll
            for (int n = 0; n < 2; ++n) bv[bj][n] = gate ? *(const f32x4*)(bias + (col0 - gate_col0) + bj * 128 + 4 * n) : (f32x4){0.f, 0.f, 0.f, 0.f};
        if (gate || f8out) {
            const int odd = fq & 1; const int colb = col0 - 8 * odd + 128 * odd;
            unsigned char* ob = gate ? (unsigned char*)O + 2 * gate_col0 + (colb - gate_col0) : (unsigned char*)O + colb;
            const size_t pitch = gate ? (size_t)ldc * 2 : (size_t)ldc;
#pragma unroll
            for (int ai = 0; ai < 2; ++ai)
#pragma unroll
                for (int m = 0; m < 4; ++m) { u32x2 w8[2];
#pragma unroll
                    for (int bj = 0; bj < 2; ++bj) { const f32x4 v0 = acc[ai][bj][m][0] * (cv[bj][0] * rv[ai][m]) + bv[bj][0], v1 = acc[ai][bj][m][1] * (cv[bj][1] * rv[ai][m]) + bv[bj][1];
                        if (gate) { unsigned q0 = 0u, q1 = 0u;
#pragma unroll
                            for (int j = 0; j < 4; ++j) { q0 = __builtin_amdgcn_cvt_pk_u8_f32(fmaxf(__builtin_floorf(sigmoidf_(v0[j]) * 255.0f + 0.5f), 1.0f), j, q0); q1 = __builtin_amdgcn_cvt_pk_u8_f32(fmaxf(__builtin_floorf(sigmoidf_(v1[j]) * 255.0f + 0.5f), 1.0f), j, q1); }
                            w8[bj].x = q0; w8[bj].y = q1;
                        } else { int q = __builtin_amdgcn_cvt_pk_fp8_f32(v0[0], v0[1], 0, false); q = __builtin_amdgcn_cvt_pk_fp8_f32(v0[2], v0[3], q, true); w8[bj].x = (unsigned)q;
                            q = __builtin_amdgcn_cvt_pk_fp8_f32(v1[0], v1[1], 0, false); q = __builtin_amdgcn_cvt_pk_fp8_f32(v1[2], v1[3], q, true); w8[bj].y = (unsigned)q; } }
                    const u32x2 sx = __builtin_amdgcn_permlane16_swap(w8[0].x, w8[1].x, false, false), sy = __builtin_amdgcn_permlane16_swap(w8[0].y, w8[1].y, false, false);
                    u32x4 w; w.x = sx[0]; w.y = sy[0]; w.z = sx[1]; w.w = sy[1];
                    *(u32x4*)(ob + (size_t)(row0 + ai * 128 + m * 16) * pitch) = w; }
            return;
        }
#pragma unroll
        for (int ai = 0; ai < 2; ++ai)
#pragma unroll
            for (int m = 0; m < 4; ++m) { bf16_t* rowp = O + (size_t)(row0 + ai * 128 + m * 16) * ldc + col0;
#pragma unroll
                for (int bj = 0; bj < 2; ++bj) { f32x4 v0 = acc[ai][bj][m][0] * (cv[bj][0] * rv[ai][m]) + bv[bj][0], v1 = acc[ai][bj][m][1] * (cv[bj][1] * rv[ai][m]) + bv[bj][1];
                    if (gate) {
                        unsigned q0 = 0u, q1 = 0u;
#pragma unroll
                        for (int j = 0; j < 4; ++j) { q0 = __builtin_amdgcn_cvt_pk_u8_f32(fmaxf(__builtin_floorf(sigmoidf_(v0[j]) * 255.0f + 0.5f), 1.0f), j, q0); q1 = __builtin_amdgcn_cvt_pk_u8_f32(fmaxf(__builtin_floorf(sigmoidf_(v1[j]) * 255.0f + 0.5f), 1.0f), j, q1); }
                        u32x2 w8; w8.x = q0; w8.y = q1;
                        *(u32x2*)((unsigned char*)(O + (size_t)(row0 + ai * 128 + m * 16) * ldc) + 2 * gate_col0 + (col0 - gate_col0) + bj * 128) = w8;
                        continue; }
                    if (f8out) { u32x2 w8; { int q = __builtin_amdgcn_cvt_pk_fp8_f32(v0[0], v0[1], 0, false); q = __builtin_amdgcn_cvt_pk_fp8_f32(v0[2], v0[3], q, true); w8.x = (unsigned)q; }
                        { int q = __builtin_amdgcn_cvt_pk_fp8_f32(v1[0], v1[1], 0, false); q = __builtin_amdgcn_cvt_pk_fp8_f32(v1[2], v1[3], q, true); w8.y = (unsigned)q; }
                        *(u32x2*)((unsigned char*)O + (size_t)(row0 + ai * 128 + m * 16) * ldc + col0 + bj * 128) = w8; continue; }
                    u32x4 w; w.x = cvt_pk_bf16(v0[0], v0[1]); w.y = cvt_pk_bf16(v0[2], v0[3]); w.z = cvt_pk_bf16(v1[0], v1[1]); w.w = cvt_pk_bf16(v1[2], v1[3]);
                    __builtin_nontemporal_store(w, (u32x4*)(rowp + bj * 128)); } }
    }
};
struct EpiKV {
    static constexpr bool PERM = true, SEG = false, PREF = false; static constexpr int NST = 0;
    bf16_t* KB; bf16_t* VT;
    __device__ __forceinline__ void operator()(const f32x4 (&acc)[2][2][4][2], const Unit& u, int wr, int wc, int fr, int fq) const {
        const int row0 = u.pm * 256 + wr * 64 + fr, col0 = u.pn * 256 + wc * 32 + 8 * fq;
#pragma unroll
        for (int ai = 0; ai < 2; ++ai)
#pragma unroll
            for (int m = 0; m < 4; ++m) { const size_t row = (size_t)(row0 + ai * 128 + m * 16);
#pragma unroll
                for (int bj = 0; bj < 2; ++bj) { const f32x4 v0 = acc[ai][bj][m][0], v1 = acc[ai][bj][m][1];
                    u32x4 w; w.x = cvt_pk_bf16(v0[0], v0[1]); w.y = cvt_pk_bf16(v0[2], v0[3]); w.z = cvt_pk_bf16(v1[0], v1[1]); w.w = cvt_pk_bf16(v1[2], v1[3]);
                    if (u.kind == 0) { *(u32x4*)(KB + row * D + col0 + bj * 128) = w; }
                    else { const int k0 = col0 + bj * 128, base = k0 & ~15, hi8 = (k0 & 8) ? 1 : 0;
                        u32x2 lo2; lo2.x = w.x; lo2.y = w.y; u32x2 hi2; hi2.x = w.z; hi2.y = w.w;
                        *(u32x2*)(VT + row * 256 + base + (hi8 ? 4 : 0)) = lo2; *(u32x2*)(VT + row * 256 + base + (hi8 ? 12 : 8)) = hi2; } } }
    }
};
template <int MODE> struct EpiProbe { static constexpr bool PERM = true, SEG = false, PREF = false; static constexpr int NST = 0;
    bf16_t* O; int flag;
    __device__ __forceinline__ void operator()(const f32x4 (&acc)[2][2][4][2], const Unit& u, int wr, int wc, int fr, int fq) const {
        const int row0 = (MODE == 1 ? 0 : u.pm * 256) + wr * 64 + fr, col0 = (MODE == 1 ? 0 : u.pn * 256) + wc * 32 + 8 * fq;
#pragma unroll
        for (int ai = 0; ai < 2; ++ai)
#pragma unroll
            for (int m = 0; m < 4; ++m) { bf16_t* rowp = O + (size_t)(row0 + ai * 128 + m * 16) * 2048 + col0;
#pragma unroll
                for (int bj = 0; bj < 2; ++bj) { const f32x4 v0 = acc[ai][bj][m][0], v1 = acc[ai][bj][m][1];
                    u32x4 w; w.x = cvt_pk_bf16(v0[0], v0[1]); w.y = cvt_pk_bf16(v0[2], v0[3]); w.z = cvt_pk_bf16(v1[0], v1[1]); w.w = cvt_pk_bf16(v1[2], v1[3]);
                    if (MODE == 1 || flag == 12345) __builtin_nontemporal_store(w, (u32x4*)(rowp + bj * 128)); } }
    }
};
struct EpiNull { static constexpr bool PERM = true, SEG = false, PREF = false; static constexpr int NST = 0;
    __device__ __forceinline__ void operator()(const f32x4 (&acc)[2][2][4][2], const Unit& u, int wr, int wc, int fr, int fq) const {
        float s = 0.f;
#pragma unroll
        for (int ai = 0; ai < 2; ++ai)
#pragma unroll
            for (int bj = 0; bj < 2; ++bj)
#pragma unroll
                for (int m = 0; m < 4; ++m)
#pragma unroll
                    for (int n = 0; n < 2; ++n) s += acc[ai][bj][m][n][0] + acc[ai][bj][m][n][1] + acc[ai][bj][m][n][2] + acc[ai][bj][m][n][3];
        if (s == 123456.789f) *sink = s;
    }
    float* sink;
};
template <int MODE> struct EpiMerge {
    static constexpr bool PERM = true, SEG = false, PREF = false; static constexpr int NST = 0;
    bf16_t* Mg; const bf16_t* Z; int gcol0; const float* scale;
    __device__ __forceinline__ void operator()(const f32x4 (&acc)[2][2][4][2], const Unit& u, int wr, int wc, int fr, int fq) const {
        const int row0 = u.pm * 256 + wr * 64 + fr, col0 = u.pn * 256 + wc * 32 + 8 * fq;
        f32x4 sv[2][2];
#pragma unroll
        for (int bj = 0; bj < 2; ++bj)
#pragma unroll
            for (int n = 0; n < 2; ++n) sv[bj][n] = scale ? *(const f32x4*)(scale + col0 + bj * 128 + 4 * n) : (f32x4){1.f, 1.f, 1.f, 1.f};
#pragma unroll
        for (int ai = 0; ai < 2; ++ai)
#pragma unroll
            for (int m = 0; m < 4; ++m) { const size_t row = (size_t)(row0 + ai * 128 + m * 16);
#pragma unroll
                for (int bj = 0; bj < 2; ++bj) {
                    const u32x4 g = *(const u32x4*)(Z + row * INCOLS + gcol0 + col0 + bj * 128);
                    f32x4 v0 = acc[ai][bj][m][0] * sv[bj][0], v1 = acc[ai][bj][m][1] * sv[bj][1];
                    v0[0] *= bf_lo(g.x); v0[1] *= bf_hi(g.x); v0[2] *= bf_lo(g.y); v0[3] *= bf_hi(g.y);
                    v1[0] *= bf_lo(g.z); v1[1] *= bf_hi(g.z); v1[2] *= bf_lo(g.w); v1[3] *= bf_hi(g.w);
                    u32x4* mp = (u32x4*)(Mg + row * D + col0 + bj * 128);
                    if (MODE) { const u32x4 o = *mp;
                        v0[0] += bf_lo(o.x); v0[1] += bf_hi(o.x); v0[2] += bf_lo(o.y); v0[3] += bf_hi(o.y);
                        v1[0] += bf_lo(o.z); v1[1] += bf_hi(o.z); v1[2] += bf_lo(o.w); v1[3] += bf_hi(o.w); }
                    u32x4 w; w.x = cvt_pk_bf16(v0[0], v0[1]); w.y = cvt_pk_bf16(v0[2], v0[3]); w.z = cvt_pk_bf16(v1[0], v1[1]); w.w = cvt_pk_bf16(v1[2], v1[3]);
                    *mp = w; } }
    }
};
struct EpiMix3 {
    static constexpr bool PERM = true, SEG = true, PREF = false; static constexpr int T1 = 16, T2 = 20, NST = 0;
    bf16_t* Mg; const bf16_t* Z; const float* pscale; int light;
    __device__ __forceinline__ static f32x4 ub4(unsigned w) { return (f32x4){(float)(w & 0xffu), (float)((w >> 8) & 0xffu), (float)((w >> 16) & 0xffu), (float)(w >> 24)}; }
    __device__ __forceinline__ void mid(f32x4 (&acc)[2][2][4][2], const Unit& u, int seg, int wr, int wc, int fr, int fq) const {
        if (light) {
#pragma unroll
            for (int ai = 0; ai < 2; ++ai)
#pragma unroll
                for (int bj = 0; bj < 2; ++bj)
#pragma unroll
                    for (int m = 0; m < 4; ++m)
#pragma unroll
                        for (int n = 0; n < 2; ++n) acc[ai][bj][m][n] = acc[ai][bj][m][n] * 1.0001f;
            return; }
        const int row0 = u.pm * 256 + wr * 64 + fr, col0 = u.pn * 256 + wc * 32 + 8 * fq;
        const bool s1 = (seg == 1);
        f32x4 sr[2][2];
#pragma unroll
        for (int bj = 0; bj < 2; ++bj)
#pragma unroll
            for (int n = 0; n < 2; ++n) { const f32x4 ps = *(const f32x4*)(pscale + col0 + bj * 128 + 4 * n);
#pragma unroll
                for (int j = 0; j < 4; ++j) sr[bj][n][j] = s1 ? __builtin_amdgcn_rcpf(ps[j]) : ps[j]; }
        const unsigned char* zb = (const unsigned char*)Z + 2 * GATE0 + col0;
        const int odd = fq & 1; const int lofs = 120 * odd;
        const unsigned char* zn = zb + (s1 ? 0 : D) + lofs; const unsigned char* zd = zb + (s1 ? D : 2 * D) + lofs;
#pragma unroll
        for (int ai = 0; ai < 2; ++ai)
#pragma unroll
            for (int m = 0; m < 4; ++m) { const size_t rb = (size_t)(row0 + ai * 128 + m * 16) * (2 * INCOLS);
                const u32x4 Ln = *(const u32x4*)(zn + rb), Ld = *(const u32x4*)(zd + rb);
                const u32x2 nx = __builtin_amdgcn_permlane16_swap(Ln.x, Ln.z, false, false), ny = __builtin_amdgcn_permlane16_swap(Ln.y, Ln.w, false, false);
                const u32x2 dx = __builtin_amdgcn_permlane16_swap(Ld.x, Ld.z, false, false), dy = __builtin_amdgcn_permlane16_swap(Ld.y, Ld.w, false, false);
#pragma unroll
                for (int bj = 0; bj < 2; ++bj) {
                    u32x2 gn, gd; gn.x = nx[bj]; gn.y = ny[bj]; gd.x = dx[bj]; gd.y = dy[bj];
                    const f32x4 n0 = ub4(gn.x) * sr[bj][0], n1 = ub4(gn.y) * sr[bj][1], d0 = ub4(gd.x), d1 = ub4(gd.y);
#pragma unroll
                    for (int j = 0; j < 4; ++j) { acc[ai][bj][m][0][j] *= n0[j] * __builtin_amdgcn_rcpf(d0[j]); acc[ai][bj][m][1][j] *= n1[j] * __builtin_amdgcn_rcpf(d1[j]); } }
                asm volatile("" ::: "memory"); }
    }
    __device__ __forceinline__ void operator()(const f32x4 (&acc)[2][2][4][2], const Unit& u, int wr, int wc, int fr, int fq) const {
        const int row0 = u.pm * 256 + wr * 64 + fr, col0 = u.pn * 256 + wc * 32 + 8 * fq;
        const int odd = fq & 1;
        const unsigned char* zg = (const unsigned char*)Z + 2 * GATE0 + 2 * D + col0 + 120 * odd;
#pragma unroll
        for (int ai = 0; ai < 2; ++ai)
#pragma unroll
            for (int m = 0; m < 4; ++m) { const size_t row = (size_t)(row0 + ai * 128 + m * 16);
                const u32x4 Lg = *(const u32x4*)(zg + row * (2 * INCOLS));
                const u32x2 gx = __builtin_amdgcn_permlane16_swap(Lg.x, Lg.z, false, false), gy = __builtin_amdgcn_permlane16_swap(Lg.y, Lg.w, false, false);
#pragma unroll
                for (int bj = 0; bj < 2; ++bj) {
                    u32x2 g; g.x = gx[bj]; g.y = gy[bj];
                    const f32x4 v0 = acc[ai][bj][m][0] * (ub4(g.x) * (1.0f / 255.0f)), v1 = acc[ai][bj][m][1] * (ub4(g.y) * (1.0f / 255.0f));
                    u32x4 w; w.x = cvt_pk_bf16(v0[0], v0[1]); w.y = cvt_pk_bf16(v0[2], v0[3]); w.z = cvt_pk_bf16(v1[0], v1[1]); w.w = cvt_pk_bf16(v1[2], v1[3]);
                    *(u32x4*)(Mg + row * D + col0 + bj * 128) = w; } }
    }
};
struct EpiResBf16 {
    static constexpr bool PERM = true, SEG = false, PREF = false; static constexpr int NST = 12;
    bf16_t* O; const float* base; float alpha;
    __device__ __forceinline__ void operator()(const f32x4 (&acc)[2][2][4][2], const Unit& u, int wr, int wc, int fr, int fq) const {
        const int row0 = u.pm * 256 + wr * 64 + fr, col0 = u.pn * 256 + wc * 32 + 8 * fq;
#pragma unroll
        for (int ai = 0; ai < 2; ++ai)
#pragma unroll
            for (int m = 0; m < 4; ++m) { const size_t off = (size_t)(row0 + ai * 128 + m * 16) * D + col0;
#pragma unroll
                for (int bj = 0; bj < 2; ++bj) { const f32x4 b0 = *(const f32x4*)(base + off + bj * 128), b1 = *(const f32x4*)(base + off + bj * 128 + 4);
                    const f32x4 v0 = b0 * alpha + acc[ai][bj][m][0], v1 = b1 * alpha + acc[ai][bj][m][1];
                    u32x4 w; w.x = cvt_pk_bf16(v0[0], v0[1]); w.y = cvt_pk_bf16(v0[2], v0[3]); w.z = cvt_pk_bf16(v1[0], v1[1]); w.w = cvt_pk_bf16(v1[2], v1[3]);
                    *(u32x4*)(O + off + bj * 128) = w; } }
    }
};
struct EpiAct {
    static constexpr bool PERM = true, SEG = false, PREF = false; static constexpr int NST = 3;
    unsigned char* O; const float* rs; const float* cs;
    __device__ __forceinline__ void operator()(const f32x4 (&acc)[2][2][4][2], const Unit& u, int wr, int wc, int fr, int fq) const {
        const int row0 = u.pm * 256 + wr * 64 + fr, col0 = u.pn * 128 + wc * 32 + 8 * fq;
        const float* cse = cs + (size_t)u.kind * D + u.pn * 256 + wc * 32 + 8 * fq;
        f32x4 cg[2], cv[2];
#pragma unroll
        for (int n = 0; n < 2; ++n) { cg[n] = *(const f32x4*)(cse + 4 * n); cv[n] = *(const f32x4*)(cse + 128 + 4 * n); }
        const int odd = fq & 1;
#pragma unroll
        for (int ai = 0; ai < 2; ++ai)
#pragma unroll
            for (int mp = 0; mp < 4; mp += 2) { u32x2 w8[2];
#pragma unroll
                for (int k = 0; k < 2; ++k) { const int m = mp + k; const int row = row0 + ai * 128 + m * 16; const float r = rs[row];
                    f32x4 r0, r1;
#pragma unroll
                    for (int j = 0; j < 4; ++j) { const float g0 = acc[ai][0][m][0][j] * (cg[0][j] * r), g1 = acc[ai][0][m][1][j] * (cg[1][j] * r);
                        r0[j] = g0 * sigmoidf_(g0) * (acc[ai][1][m][0][j] * (cv[0][j] * r)); r1[j] = g1 * sigmoidf_(g1) * (acc[ai][1][m][1][j] * (cv[1][j] * r)); }
                    int q = __builtin_amdgcn_cvt_pk_fp8_f32(r0[0], r0[1], 0, false); q = __builtin_amdgcn_cvt_pk_fp8_f32(r0[2], r0[3], q, true); w8[k].x = (unsigned)q;
                    q = __builtin_amdgcn_cvt_pk_fp8_f32(r1[0], r1[1], 0, false); q = __builtin_amdgcn_cvt_pk_fp8_f32(r1[2], r1[3], q, true); w8[k].y = (unsigned)q; }
                const u32x2 sx = __builtin_amdgcn_permlane16_swap(w8[0].x, w8[1].x, false, false), sy = __builtin_amdgcn_permlane16_swap(w8[0].y, w8[1].y, false, false);
                u32x4 w; w.x = sx[0]; w.y = sy[0]; w.z = sx[1]; w.w = sy[1];
                *(u32x4*)(O + (size_t)(row0 + ai * 128 + (mp + odd) * 16) * DEXP + (col0 - 8 * odd)) = w; }
    }
};

struct Frame {
    LAS unsigned char* lds; int tid, lane, wave, G, bid;
    const Params* p;
};

struct TItem { const float* src; bf16_t* dst; int ldw, ldt, f8; };
constexpr int PREP_NIT = 16 * 256 + 3 * 16 * 32 + 16 * 64 + 4 * 4 * 8 + NEXP * 16 * 32 + NEXP * 8 * 32;
constexpr int PREP_LATE = 0;
__device__ __forceinline__ bool prep_item(const Params& P, unsigned char* ws, int it, int it_end, TItem& t) {
    constexpr int I_IN = 16 * 256, I_SQ = 16 * 32, I_KV = 16 * 64, I_P = 4 * 4 * 8, I_UP = NEXP * 16 * 32, I_DN = NEXP * 8 * 32;
    constexpr int NIT = I_IN + 3 * I_SQ + I_KV + I_P + I_UP + I_DN; static_assert(NIT == PREP_NIT, "item count");
    if (it >= it_end) return false;
    int r = it;
    if (r < I_IN) { const int kb = r / 256, nb = r % 256, n0 = 32 * nb;
        int drow = n0; if (n0 >= D && n0 < 3 * D) { const int c = (n0 - D) & (D - 1); drow = D + (c >> 7) * 256 + (n0 >= 2 * D ? 128 : 0) + (c & 127); }
        t.src = P.in[I_WIN] + (size_t)(64 * kb) * INCOLS + n0; t.ldw = INCOLS; t.dst = (bf16_t*)(ws + WS_WIN) + (size_t)drow * D + 64 * kb; t.ldt = D; t.f8 = 0; return true; } r -= I_IN;
    if (r < I_SQ) { const int kb = r / 32, nb = r % 32; t.src = P.in[I_WCONV] + (size_t)(64 * kb) * D + 32 * nb; t.ldw = D; t.dst = (bf16_t*)(ws + WS_WCAT) + (size_t)(32 * nb) * KCAT + 64 * kb; t.ldt = KCAT; t.f8 = 0; return true; } r -= I_SQ;
    if (r < I_SQ) { const int kb = r / 32, nb = r % 32; t.src = P.in[I_WXO] + (size_t)(64 * kb) * D + 32 * nb; t.ldw = D; t.dst = (bf16_t*)(ws + WS_WCAT) + (size_t)(32 * nb) * KCAT + 1280 + 64 * kb; t.ldt = KCAT; t.f8 = 0; return true; } r -= I_SQ;
    if (r < I_SQ) { const int kb = r / 32, nb = r % 32; t.src = P.in[I_WO] + (size_t)(64 * kb) * D + 32 * nb; t.ldw = D; t.dst = (bf16_t*)(ws + WS_WO) + (size_t)(32 * nb) * D + 64 * kb; t.ldt = D; t.f8 = 0; return true; } r -= I_SQ;
    if (r < I_KV) { const int kb = r / 64, nb = r % 64; t.src = P.in[I_WKV] + (size_t)(64 * kb) * (2 * D) + 32 * nb; t.ldw = 2 * D; t.dst = (bf16_t*)(ws + WS_WKV) + (size_t)(32 * nb) * D + 64 * kb; t.ldt = D; t.f8 = 0; return true; } r -= I_KV;
    if (r < I_P) { const int g = r / 32, q = r % 32, kb = q / 8, nb = q % 8;
        t.src = P.in[I_WPOOL] + (size_t)g * 65536 + (size_t)(64 * kb) * 256 + 32 * nb; t.ldw = 256; t.dst = (bf16_t*)(ws + WS_WCAT) + (size_t)(g * 256 + 32 * nb) * KCAT + 1024 + 64 * kb; t.ldt = KCAT; t.f8 = 0; return true; } r -= I_P;
    if (r < I_UP) { const int e = r / 512, q = r % 512, kb = q / 32, nb = q % 32; const int n0 = 32 * nb;
        const int j0 = n0 & 511, drow = (j0 >> 7) * 256 + (n0 >= 512 ? 128 : 0) + (j0 & 127);
        t.src = P.in[I_WUP] + (size_t)e * D * D + (size_t)(64 * kb) * D + n0; t.ldw = D; t.dst = (bf16_t*)(ws + WS_WUP + (size_t)e * D * D + (size_t)drow * D + 64 * kb); t.ldt = D; t.f8 = 1; return true; } r -= I_UP;
    { const int e = r / 256, q = r % 256, kb = q / 32, nb = q % 32;
        t.src = P.in[I_WDN] + (size_t)e * DEXP * D + (size_t)(64 * kb) * D + 32 * nb; t.ldw = D; t.dst = (bf16_t*)(ws + WS_WDN + (size_t)e * D * DEXP + (size_t)(32 * nb) * DEXP + 64 * kb); t.ldt = DEXP; t.f8 = 1; return true; }
}
__device__ __forceinline__ void titem_load(const TItem& t, int lane, f32x4 (&v)[8]) {
    const float* s = t.src + (size_t)(lane >> 3) * t.ldw + (lane & 7) * 4;
#pragma unroll
    for (int j = 0; j < 8; ++j) v[j] = *(const f32x4*)(s + (size_t)(8 * j) * t.ldw);
}
__device__ __forceinline__ void titem_finish(const TItem& t, int lane, const f32x4 (&v)[8], LAS float* scr) {
#pragma unroll
    for (int j = 0; j < 8; ++j) { LAS float* d = scr + (8 * j + (lane >> 3)) * 33 + (lane & 7) * 4; d[0] = v[j][0]; d[1] = v[j][1]; d[2] = v[j][2]; d[3] = v[j][3]; }
    asm volatile("s_waitcnt lgkmcnt(0)" ::: "memory");
    if (t.f8) {
        const int c = lane & 3;
#pragma unroll
        for (int j = 0; j < 2; ++j) { const int n = (lane >> 2) + 16 * j; const LAS float* s = scr + (16 * c) * 33 + n;
            u32x4 o;
            { int r = __builtin_amdgcn_cvt_pk_fp8_f32(s[0 * 33] * 32.f, s[1 * 33] * 32.f, 0, false); r = __builtin_amdgcn_cvt_pk_fp8_f32(s[2 * 33] * 32.f, s[3 * 33] * 32.f, r, true); o.x = (unsigned)r; }
            { int r = __builtin_amdgcn_cvt_pk_fp8_f32(s[4 * 33] * 32.f, s[5 * 33] * 32.f, 0, false); r = __builtin_amdgcn_cvt_pk_fp8_f32(s[6 * 33] * 32.f, s[7 * 33] * 32.f, r, true); o.y = (unsigned)r; }
            { int r = __builtin_amdgcn_cvt_pk_fp8_f32(s[8 * 33] * 32.f, s[9 * 33] * 32.f, 0, false); r = __builtin_amdgcn_cvt_pk_fp8_f32(s[10 * 33] * 32.f, s[11 * 33] * 32.f, r, true); o.z = (unsigned)r; }
            { int r = __builtin_amdgcn_cvt_pk_fp8_f32(s[12 * 33] * 32.f, s[13 * 33] * 32.f, 0, false); r = __builtin_amdgcn_cvt_pk_fp8_f32(s[14 * 33] * 32.f, s[15 * 33] * 32.f, r, true); o.w = (unsigned)r; }
            *(u32x4*)((unsigned char*)t.dst + (size_t)n * t.ldt + 16 * c) = o; }
    } else {
    const int c = lane & 7;
#pragma unroll
    for (int j = 0; j < 4; ++j) { const int n = (lane >> 3) + 8 * j; const LAS float* s = scr + (8 * c) * 33 + n;
        u32x4 o; o.x = cvt_pk_bf16(s[0 * 33], s[1 * 33]); o.y = cvt_pk_bf16(s[2 * 33], s[3 * 33]); o.z = cvt_pk_bf16(s[4 * 33], s[5 * 33]); o.w = cvt_pk_bf16(s[6 * 33], s[7 * 33]);
        *(u32x4*)(t.dst + (size_t)n * t.ldt + 8 * c) = o; }
    }
    asm volatile("s_waitcnt lgkmcnt(0)" ::: "memory");
}

struct WTask { const float* src; int ldw; unsigned char* dst; float* sc; };
__device__ __forceinline__ bool wtask_get(const Params& P, unsigned char* ws, int t, WTask& k) {
    constexpr int T_IN = INCOLS / 32, T_UP = NEXP * (D / 32);
    if (t >= T_IN + T_UP) return false;
    if (t < T_IN) { const int n0 = 32 * t;
        int drow = n0; if (n0 >= D && n0 < 3 * D) { const int c = (n0 - D) & (D - 1); drow = D + (c >> 7) * 256 + (n0 >= 2 * D ? 128 : 0) + (c & 127); }
        k.src = P.in[I_WIN] + n0; k.ldw = INCOLS; k.dst = ws + WS_WIN + (size_t)drow * D; k.sc = (float*)(ws + WS_SW) + drow;
    } else { const int q = t - T_IN, e = q >> 5, n0 = 32 * (q & 31);
        const int j0 = n0 & 511, drow = (j0 >> 7) * 256 + (n0 >= 512 ? 128 : 0) + (j0 & 127);
        k.src = P.in[I_WUP] + (size_t)e * D * D + n0; k.ldw = D; k.dst = ws + WS_WUP + (size_t)e * D * D + (size_t)drow * D; k.sc = (float*)(ws + WS_SWU) + e * D + drow; }
    return true;
}
__device__ __forceinline__ void wtask_load(const Frame& F, const WTask& k, f32x4 (&va)[8], f32x4 (&vb)[8]) {
    TItem ta, tb; ta.src = k.src + (size_t)(64 * (2 * F.wave)) * k.ldw; ta.ldw = k.ldw; tb.src = ta.src + (size_t)64 * k.ldw; tb.ldw = k.ldw;
    titem_load(ta, F.lane, va); titem_load(tb, F.lane, vb);
}
__device__ __forceinline__ void wtask_finish(const Frame& F, const WTask& k, const f32x4 (&va)[8], const f32x4 (&vb)[8]) {
    LAS float* scr = (LAS float*)(F.lds + F.wave * 16384);
    LAS float* cmx = (LAS float*)(F.lds + 131072 + 8192);
    const int lane = F.lane, c4 = (lane & 7) * 4;
    f32x4 mx = (f32x4){0.f, 0.f, 0.f, 0.f};
#pragma unroll
    for (int j = 0; j < 8; ++j) { mx = __builtin_elementwise_max(mx, __builtin_elementwise_max(__builtin_elementwise_abs(va[j]), __builtin_elementwise_abs(vb[j]))); }
#pragma unroll
    for (int o = 8; o < 64; o <<= 1) {
#pragma unroll
        for (int q = 0; q < 4; ++q) mx[q] = fmaxf(mx[q], __shfl_xor(mx[q], o)); }
    __syncthreads();
    if (lane < 8) { LAS float* d = cmx + F.wave * 32 + c4; d[0] = mx[0]; d[1] = mx[1]; d[2] = mx[2]; d[3] = mx[3]; }
    __syncthreads();
    if (F.tid < 32) { float m = 0.f;
#pragma unroll
        for (int w = 0; w < 8; ++w) m = fmaxf(m, cmx[w * 32 + F.tid]);
        cmx[256 + F.tid] = m > 0.f ? 127.0f / m : 0.f; k.sc[F.tid] = m > 0.f ? m * (1.0f / 127.0f) : 1.0f; }
    __syncthreads();
#pragma unroll
    for (int blk = 0; blk < 2; ++blk) {
#pragma unroll
        for (int j = 0; j < 8; ++j) { const f32x4 x = blk ? vb[j] : va[j]; LAS float* d = scr + (8 * j + (lane >> 3)) * 33 + c4; d[0] = x[0]; d[1] = x[1]; d[2] = x[2]; d[3] = x[3]; }
        asm volatile("s_waitcnt lgkmcnt(0)" ::: "memory");
        const int c = lane & 3;
#pragma unroll
        for (int j = 0; j < 2; ++j) { const int n = (lane >> 2) + 16 * j; const LAS float* s = scr + (16 * c) * 33 + n; const float inv = cmx[256 + n];
            u32x4 o;
#pragma unroll
            for (int g = 0; g < 4; ++g) { o[g] = ((unsigned)(int)__builtin_rintf(s[(4 * g) * 33] * inv) & 0xffu) | (((unsigned)(int)__builtin_rintf(s[(4 * g + 1) * 33] * inv) & 0xffu) << 8) | (((unsigned)(int)__builtin_rintf(s[(4 * g + 2) * 33] * inv) & 0xffu) << 16) | ((unsigned)(int)__builtin_rintf(s[(4 * g + 3) * 33] * inv) << 24); }
            *(u32x4*)(k.dst + (size_t)n * D + 64 * (2 * F.wave + blk) + 16 * c) = o; }
        asm volatile("s_waitcnt lgkmcnt(0)" ::: "memory");
    }
}
__device__ __forceinline__ void prep_i8_tasks(const Frame& F) {
    const Params& P = *F.p; unsigned char* ws = P.ws;
    WTask cur, nxt; f32x4 va[8], vb[8], wa[8], wb[8];
    int t = F.bid; bool have = wtask_get(P, ws, t, cur);
    if (have) wtask_load(F, cur, va, vb);
    while (have) {
        const bool hn = wtask_get(P, ws, t + F.G, nxt);
        if (hn) wtask_load(F, nxt, wa, wb);
        wtask_finish(F, cur, va, vb);
        if (!hn) break;
        t += 2 * F.G;
        have = wtask_get(P, ws, t, cur);
        if (have) wtask_load(F, cur, va, vb);
        wtask_finish(F, nxt, wa, wb);
    }
    __syncthreads();
}

__device__ __forceinline__ void convert_items(const Frame& F, int it0, int it1, int w, int nw) {
    const Params& P = *F.p; unsigned char* ws = P.ws;
    LAS float* scr = (LAS float*)(F.lds + F.wave * 16384);
    TItem cur, nxt; f32x4 va[8], vb[8];
    int it = it0 + w; bool have = prep_item(P, ws, it, it1, cur);
    if (have) titem_load(cur, F.lane, va);
    while (have) {
        const bool hn = prep_item(P, ws, it + nw, it1, nxt);
        if (hn) titem_load(nxt, F.lane, vb);
        titem_finish(cur, F.lane, va, scr);
        if (!hn) break;
        it += 2 * nw;
        have = prep_item(P, ws, it, it1, cur);
        if (have) titem_load(cur, F.lane, va);
        titem_finish(nxt, F.lane, vb, scr);
    }
}

__device__ __forceinline__ void convert_items_dyn(const Frame& F, int it0, int it1, int cw_ctr) {
    const Params& P = *F.p; unsigned char* ws = P.ws;
    LAS float* scr = (LAS float*)(F.lds + F.wave * 16384);
    unsigned* ctr = (unsigned*)(ws + WS_CTL) + cw_ctr;
    volatile LAS unsigned* slot = (volatile LAS unsigned*)(F.lds + 131072 + 12288);
    for (;;) {
        __syncthreads();
        if (F.tid == 0) slot[0] = atomicAdd(ctr, 1u);
        __syncthreads();
        const int it = it0 + (int)slot[0] * NWAVES + F.wave;
        if (it0 + (int)slot[0] * NWAVES >= it1) break;
        TItem t; f32x4 v[8];
        if (prep_item(P, ws, it, it1, t)) { titem_load(t, F.lane, v); titem_finish(t, F.lane, v, scr); }
    }
}

__device__ __forceinline__ void phase_prep(const Frame& F) {
    const Params& P = *F.p; unsigned char* ws = P.ws;
    LAS float* scr = (LAS float*)(F.lds + F.wave * 16384);
    const int gw = F.bid * NWAVES + F.wave, NGW = F.G * NWAVES;
    prep_i8_tasks(F);
    const size_t gt = (size_t)F.bid * NTHR + F.tid, NGT = (size_t)F.G * NTHR;
    for (int row0 = gw * 4; row0 < NTOK; row0 += NGW * 4) {
        f32x4 v[4][4]; float am[4];
#pragma unroll
        for (int a = 0; a < 4; ++a) { const f32x4* xr = (const f32x4*)(P.in[I_X] + (size_t)(row0 + a) * D) + F.lane;
#pragma unroll
            for (int j = 0; j < 4; ++j) v[a][j] = xr[64 * j]; }
#pragma unroll
        for (int a = 0; a < 4; ++a) { am[a] = 0.f;
#pragma unroll
            for (int j = 0; j < 4; ++j) am[a] = fmaxf(am[a], fmaxf(fmaxf(fabsf(v[a][j][0]), fabsf(v[a][j][1])), fmaxf(fabsf(v[a][j][2]), fabsf(v[a][j][3])))); }
#pragma unroll
        for (int o = 1; o < 64; o <<= 1) {
#pragma unroll
            for (int a = 0; a < 4; ++a) am[a] = fmaxf(am[a], __shfl_xor(am[a], o)); }
#pragma unroll
        for (int a = 0; a < 4; ++a) { const float inv = am[a] > 0.f ? 127.0f / am[a] : 0.f;
            if (F.lane == 0) ((float*)(ws + WS_XS))[row0 + a] = am[a] > 0.f ? am[a] * (1.0f / 127.0f) : 1.0f;
#pragma unroll
            for (int j = 0; j < 4; ++j) { const f32x4 q = v[a][j] * inv;
                const unsigned w = ((unsigned)(int)__builtin_rintf(q[0]) & 0xffu) | (((unsigned)(int)__builtin_rintf(q[1]) & 0xffu) << 8) | (((unsigned)(int)__builtin_rintf(q[2]) & 0xffu) << 16) | ((unsigned)(int)__builtin_rintf(q[3]) << 24);
                *((unsigned*)(ws + WS_XB + (size_t)(row0 + a) * D) + F.lane + 64 * j) = w; } }
    }
    { const f32x4* src = (const f32x4*)P.in[I_MEM]; u32x4* dst = (u32x4*)(ws + WS_MEMB);
      for (size_t i = gt; i < (size_t)NMEM * D / 8; i += NGT) { const f32x4 a = src[2 * i], b = src[2 * i + 1]; u32x4 o; o.x = cvt_pk_bf16(a[0], a[1]); o.y = cvt_pk_bf16(a[2], a[3]); o.z = cvt_pk_bf16(b[0], b[1]); o.w = cvt_pk_bf16(b[2], b[3]); dst[i] = o; } }
    { bf16_t* wr = (bf16_t*)(ws + WS_WR);
      for (size_t i = gt; i < (size_t)80 * D; i += NGT) { const int o = (int)(i / D), k = (int)(i % D); wr[i] = (bf16_t)f2bf(o < 8 ? P.in[I_WRG][(size_t)k * 8 + o] : (o < 72 ? P.in[I_WRE][(size_t)k * 64 + (o - 8)] : 0.f)); } }
    { constexpr int I0 = 16 * 256, I_UP0 = I0 + 3 * 16 * 32 + 16 * 64 + 4 * 4 * 8, I_DN0 = I_UP0 + NEXP * 16 * 32;
      convert_items(F, I0, I_UP0, gw, NGW); }
}

struct F8 { f32x4 a, b; };
__device__ __forceinline__ F8 up8(const u32x4 v) { F8 r; r.a = (f32x4){bf_lo(v.x), bf_hi(v.x), bf_lo(v.y), bf_hi(v.y)}; r.b = (f32x4){bf_lo(v.z), bf_hi(v.z), bf_lo(v.w), bf_hi(v.w)}; return r; }
__device__ __forceinline__ u32x4 pk8(const F8 v) { u32x4 o; o.x = pk2(v.a[0], v.a[1]); o.y = pk2(v.a[2], v.a[3]); o.z = pk2(v.b[0], v.b[1]); o.w = pk2(v.b[2], v.b[3]); return o; }
__device__ __forceinline__ void phase_convpool(const Frame& F, int cw_ctr, unsigned c_lo, unsigned c_hi) {
    const Params& P = *F.p; unsigned char* ws = P.ws;
    const bf16_t* __restrict__ Z = (const bf16_t*)(ws + WS_Z); bf16_t* __restrict__ AC = (bf16_t*)(ws + WS_ACONV); bf16_t* __restrict__ DP = (bf16_t*)(ws + WS_DPOOL);
    const float* cw = P.in[I_CONVW];
    constexpr int TSEG = 16;
    unsigned* ctr = (unsigned*)(ws + WS_CTL) + cw_ctr;
    volatile LAS unsigned* slot = (volatile LAS unsigned*)(F.lds + 131072 + 12288);
    for (;;) {
        __syncthreads();
        if (F.tid == 0) slot[0] = c_lo + atomicAdd(ctr, 1u);
        __syncthreads();
        const unsigned chunk = slot[0];
        if (chunk >= c_hi) break;
        const int it = (int)chunk * NTHR + F.tid;
        const int c0 = (it & 127) * 8, t0 = (it >> 7) * TSEG, s0 = t0 & (SEQ - 1);
        const int gi = c0 >> 8, w = 2 << gi;
        F8 w0, w1, w2;
        w0.a = *(const f32x4*)(cw + c0); w0.b = *(const f32x4*)(cw + c0 + 4); w1.a = *(const f32x4*)(cw + D + c0); w1.b = *(const f32x4*)(cw + D + c0 + 4); w2.a = *(const f32x4*)(cw + 2 * D + c0); w2.b = *(const f32x4*)(cw + 2 * D + c0 + 4);
        const bf16_t* zr0 = Z + (size_t)t0 * INCOLS + c0;
        F8 u1, u2, run;
        u1.a = u1.b = u2.a = u2.b = run.a = run.b = (f32x4){0.f, 0.f, 0.f, 0.f};
        if (s0 > 0) {
            u1 = up8(*(const u32x4*)(zr0 - INCOLS + D)); u2 = up8(*(const u32x4*)(zr0 - 2 * INCOLS + D));
            for (int i = 1; i < w; ++i) { const F8 pp = up8(*(const u32x4*)(zr0 - (size_t)i * INCOLS + 3 * D)); run.a += pp.a; run.b += pp.b; }
        }
        for (int tb = 0; tb < TSEG; tb += 4) {
            u32x4 lcb[4], lcc[4], lp[4], lold[4];
#pragma unroll
            for (int j = 0; j < 4; ++j) { const bf16_t* zr = zr0 + (size_t)(tb + j) * INCOLS;
                lcb[j] = *(const u32x4*)(zr); lcc[j] = *(const u32x4*)(zr + D); lp[j] = *(const u32x4*)(zr + 3 * D);
                lold[j] = (s0 + tb + j - (w - 1) >= 0) ? *(const u32x4*)(zr - (size_t)(w - 1) * INCOLS + 3 * D) : (u32x4){0u, 0u, 0u, 0u}; }
#pragma unroll
            for (int j = 0; j < 4; ++j) {
                const F8 cb = up8(lcb[j]), u0 = up8(lcc[j]);
                F8 v; v.a = (w0.a * u2.a + w1.a * u1.a + w2.a * u0.a) * cb.a; v.b = (w0.b * u2.b + w1.b * u1.b + w2.b * u0.b) * cb.b;
                *(u32x4*)(AC + (size_t)(t0 + tb + j) * D + c0) = pk8(v);
                u2 = u1; u1 = u0;
                const F8 pp = up8(lp[j]), po = up8(lold[j]);
                run.a += pp.a; run.b += pp.b;
                const int s = s0 + tb + j; const int cnt = (s + 1) < w ? (s + 1) : w; const float inv = 1.0f / (float)cnt;
                F8 d; d.a = run.a * inv - pp.a; d.b = run.b * inv - pp.b;
                *(u32x4*)(DP + (size_t)(t0 + tb + j) * D + c0) = pk8(d);
                run.a -= po.a; run.b -= po.b;
            }
        }
    }
}

typedef float f32x16 __attribute__((ext_vector_type(16)));
typedef float f32x2_t __attribute__((ext_vector_type(2))); typedef __bf16 bf16x2_t __attribute__((ext_vector_type(2)));
__device__ __forceinline__ unsigned cvtpk(float lo, float hi) { f32x2_t v = {lo, hi}; bf16x2_t b = __builtin_convertvector(v, bf16x2_t); return __builtin_bit_cast(unsigned, b); }
#define MFMA32(a, b, c) __builtin_amdgcn_mfma_f32_32x32x16_bf16((a), (b), (c), 0, 0, 0)
template <int VAR> __device__ __forceinline__ void phase_attn(const Frame& F, int u0, int ustride) {
    const Params& P = *F.p; unsigned char* ws = P.ws;
    const bf16_t* Z = (const bf16_t*)(ws + WS_Z); bf16_t* O = (bf16_t*)(ws + (VAR ? WS_MERGED : WS_O));
    const int tid = F.tid, lane = F.lane, wave = F.wave, r = lane & 31, hh = lane >> 5;
    const int prow = tid >> 5, pc = (tid & 31) ^ prow;
    LAS unsigned char* lds = F.lds;
    int rb[8];
#pragma unroll
    for (int t = 0; t < 8; ++t) rb[t] = r * 512 + (((2 * t + hh) ^ (r & 15)) << 4);
#define AT_WAIT_BAR(N) asm volatile("s_waitcnt vmcnt(" #N ")\n\ts_barrier" ::: "memory")
#define AT_ISSUE(i) do { if (VAR == 2) break; const char* _s = ((i) < 8) ? ksrc + (size_t)(32 * (i)) * 2048 : vsrc + (size_t)(32 * ((i) - 8)) * 512; const size_t _rs = ((i) < 8) ? 2048 : 512; \
        _Pragma("unroll") for (int _it = 0; _it < 2; ++_it) \
        __builtin_amdgcn_global_load_lds((const unsigned*)(_s + (size_t)(16 * _it) * _rs), (LAS unsigned*)(lds + ((i) & 7) * 16384 + _it * 8192 + wave * 1024), 16, 0, 0); } while (0)
#define AT_FRAG(slot, s) (*(const LAS pg8::bf16x8*)(lds + rb[(s) & 7] + (slot) * 16384 + ((s) >> 3) * 256))
#define AT_DSR(dst, s, slot) asm volatile("ds_read_b128 %0, %1 offset:%2" : "=v"(dst) : "v"(((slot) & 4) ? rbh[(s) & 7] : rbv[(s) & 7]), "n"(((slot) & 3) * 16384 + ((s) >> 3) * 256) : "memory")
#define AT_LW(dst, n) asm volatile("s_waitcnt lgkmcnt(%1)" : "+v"(dst) : "n"(n) : "memory")
#define AT_PIPE(slot, STMT) do { asm volatile("s_waitcnt lgkmcnt(0)" ::: "memory"); \
        AT_DSR(fr[0], 0, slot); AT_DSR(fr[1], 1, slot); AT_DSR(fr[2], 2, slot); AT_DSR(fr[3], 3, slot); \
        _Pragma("unroll") for (int s = 0; s < 16; ++s) { AT_LW(fr[s & 7], (15 - s) < 3 ? (15 - s) : 3); if (VAR != 1 && VAR != 4) { STMT; } if (s + 4 < 16 && VAR != 3 && VAR != 4) AT_DSR(fr[(s + 4) & 7], s + 4, slot); } } while (0)
    pg8::bf16x8 fr[8]; unsigned rbv[8], rbh[8];
#pragma unroll
    for (int t = 0; t < 8; ++t) { rbv[t] = (unsigned)(size_t)lds + (unsigned)rb[t]; rbh[t] = rbv[t] + 65536u; }
    for (int ui = u0; ui < (NTOK / 256) * 4; ui += ustride) {
        const int h = ui & 3, t0 = (ui >> 2) * 256, b = t0 / SEQ;
        const bf16_t* qrow = Z + (size_t)(t0 + 32 * wave + r) * INCOLS + 4 * D + h * 256 + 8 * hh;
        pg8::bf16x8 qf[16];
#pragma unroll
        for (int s = 0; s < 16; ++s) qf[s] = *(const pg8::bf16x8*)(qrow + 16 * s);
        const char* ksrc = (const char*)(ws + WS_KB) + ((size_t)(b * 256 + prow) * D + h * 256) * 2 + pc * 16;
        const char* vsrc = (const char*)(ws + WS_VT) + ((size_t)(b * D + h * 256 + prow) * 256) * 2 + pc * 16;
        asm volatile("s_barrier" ::: "memory");
        AT_ISSUE(0); AT_ISSUE(1); AT_ISSUE(2); AT_ISSUE(3); AT_ISSUE(4); AT_ISSUE(5);
        f32x16 S[8];
#pragma unroll
        for (int i = 0; i < 8; ++i)
#pragma unroll
            for (int j = 0; j < 16; ++j) S[i][j] = 0.f;
#pragma unroll
        for (int sp = 0; sp < 4; ++sp) {
            AT_WAIT_BAR(8);
            AT_ISSUE(2 * sp + 6); AT_ISSUE(2 * sp + 7);
            AT_PIPE((2 * sp) & 7, S[2 * sp] = MFMA32(fr[s & 7], qf[s], S[2 * sp]));
            AT_PIPE((2 * sp + 1) & 7, S[2 * sp + 1] = MFMA32(fr[s & 7], qf[s], S[2 * sp + 1]));
        }
        float mx = S[0][0];
#pragma unroll
        for (int i = 0; i < 8; ++i)
#pragma unroll
            for (int j = 0; j < 16; ++j) mx = fmaxf(mx, S[i][j]);
        mx = fmaxf(mx, __shfl_xor(mx, 32));
        const float c2 = 0.0625f * 1.4426950408889634f;
        float sum = 0.f;
        pg8::bf16x8 pf[8][2];
#pragma unroll
        for (int i = 0; i < 8; ++i) {
#pragma unroll
            for (int j = 0; j < 16; ++j) { const float e = __builtin_amdgcn_exp2f((S[i][j] - mx) * c2); S[i][j] = e; sum += e; }
#pragma unroll
            for (int s2 = 0; s2 < 2; ++s2) { u32x4 w; w.x = cvtpk(S[i][8 * s2], S[i][8 * s2 + 1]); w.y = cvtpk(S[i][8 * s2 + 2], S[i][8 * s2 + 3]); w.z = cvtpk(S[i][8 * s2 + 4], S[i][8 * s2 + 5]); w.w = cvtpk(S[i][8 * s2 + 6], S[i][8 * s2 + 7]);
                pf[i][s2] = __builtin_bit_cast(pg8::bf16x8, w); }
        }
        sum += __shfl_xor(sum, 32);
        const float inv = 1.0f / sum;
        bf16_t* orow = O + (size_t)(t0 + 32 * wave + r) * D + h * 256 + 4 * hh;
#pragma unroll
        for (int sp = 4; sp < 8; ++sp) {
            if (sp == 4) AT_WAIT_BAR(8); else if (sp == 5) AT_WAIT_BAR(14); else if (sp == 6) AT_WAIT_BAR(16); else AT_WAIT_BAR(18);
            if (sp == 4) { AT_ISSUE(14); AT_ISSUE(15); }
#pragma unroll
            for (int hf = 0; hf < 2; ++hf) { const int i = 2 * sp + hf;
                f32x16 o;
#pragma unroll
                for (int j = 0; j < 16; ++j) o[j] = 0.f;
                AT_PIPE(i & 7, o = MFMA32(fr[s & 7], pf[s >> 1][s & 1], o));
#pragma unroll
                for (int g = 0; g < 4; ++g) { u32x2 w; w.x = cvtpk(o[4 * g] * inv, o[4 * g + 1] * inv); w.y = cvtpk(o[4 * g + 2] * inv, o[4 * g + 3] * inv);
                    *(u32x2*)(orow + 32 * (i - 8) + 8 * g) = w; }
            }
        }
    }
    asm volatile("s_waitcnt vmcnt(0)\n\ts_barrier" ::: "memory");
#undef AT_WAIT_BAR
#undef AT_ISSUE
#undef AT_FRAG
#undef AT_DSR
#undef AT_LW
#undef AT_PIPE
}

__device__ __forceinline__ void phase_ln1_router(const Frame& F) {
    const Params& P = *F.p; unsigned char* ws = P.ws;
    const bf16_t* H1 = (const bf16_t*)(ws + WS_H1); bf16_t* H1B = (bf16_t*)(ws + WS_H1B); const bf16_t* WRB = (const bf16_t*)(ws + WS_WR);
    unsigned* ctl = (unsigned*)(ws + WS_CTL);
    int* tok_e = (int*)(ws + WS_MISC + MS_TOKE); int* tok_pos = (int*)(ws + WS_MISC + MS_TOKPOS); float* tok_w = (float*)(ws + WS_MISC + MS_TOKW);
    LAS float* lg = (LAS float*)(F.lds + F.wave * 5120);
    LAS unsigned* lcnt = (LAS unsigned*)(F.lds + 8 * 5120);
    const int lane = F.lane;
    const float* g1 = P.in[I_LN1G]; const float* b1 = P.in[I_LN1B];
    f32x4 gg[4], bb[4];
#pragma unroll
    for (int j = 0; j < 4; ++j) { gg[j] = *((const f32x4*)g1 + 2 * lane + 128 * (j >> 1) + (j & 1)); bb[j] = *((const f32x4*)b1 + 2 * lane + 128 * (j >> 1) + (j & 1)); }
    for (int grp0 = F.bid * NWAVES; grp0 < NTOK / 16; grp0 += F.G * NWAVES) {
        const int row0 = (grp0 + F.wave) * 16;
        if (F.tid < 128) lcnt[F.tid] = 0u;
        for (int rb = 0; rb < 16; rb += 4) {
            f32x4 v[4][4]; float s[4], q[4];
#pragma unroll
            for (int a = 0; a < 4; ++a) { const u32x4* xr = (const u32x4*)(H1 + (size_t)(row0 + rb + a) * D) + lane;
#pragma unroll
                for (int jj = 0; jj < 2; ++jj) { const u32x4 p = xr[64 * jj]; v[a][2 * jj] = (f32x4){bf_lo(p.x), bf_hi(p.x), bf_lo(p.y), bf_hi(p.y)}; v[a][2 * jj + 1] = (f32x4){bf_lo(p.z), bf_hi(p.z), bf_lo(p.w), bf_hi(p.w)}; } }
#pragma unroll
            for (int a = 0; a < 4; ++a) { s[a] = 0.f;
#pragma unroll
                for (int j = 0; j < 4; ++j) s[a] += (v[a][j][0] + v[a][j][1]) + (v[a][j][2] + v[a][j][3]); }
#pragma unroll
            for (int o = 1; o < 64; o <<= 1) {
#pragma unroll
                for (int a = 0; a < 4; ++a) s[a] += __shfl_xor(s[a], o); }
#pragma unroll
            for (int a = 0; a < 4; ++a) { const float mean = s[a] * (1.f / D); q[a] = 0.f;
#pragma unroll
                for (int j = 0; j < 4; ++j) { v[a][j] = v[a][j] - mean; q[a] += (v[a][j][0] * v[a][j][0] + v[a][j][1] * v[a][j][1]) + (v[a][j][2] * v[a][j][2] + v[a][j][3] * v[a][j][3]); } }
#pragma unroll
            for (int o = 1; o < 64; o <<= 1) {
#pragma unroll
                for (int a = 0; a < 4; ++a) q[a] += __shfl_xor(q[a], o); }
            float am[4];
#pragma unroll
            for (int a = 0; a < 4; ++a) { const float rstd = 1.f / sqrtf(q[a] * (1.f / D) + LN_EPS); am[a] = 0.f;
#pragma unroll
                for (int j = 0; j < 4; ++j) { const f32x4 y = v[a][j] * rstd * gg[j] + bb[j]; v[a][j] = y;
                    am[a] = fmaxf(am[a], fmaxf(fmaxf(fabsf(y[0]), fabsf(y[1])), fmaxf(fabsf(y[2]), fabsf(y[3]))));
                    }
#pragma unroll
                for (int jj = 0; jj < 2; ++jj) { const f32x4 y0 = v[a][2 * jj], y1 = v[a][2 * jj + 1];
                    u32x4 o; o.x = cvt_pk_bf16(y0[0], y0[1]); o.y = cvt_pk_bf16(y0[2], y0[3]); o.z = cvt_pk_bf16(y1[0], y1[1]); o.w = cvt_pk_bf16(y1[2], y1[3]); *((u32x4*)(H1B + (size_t)(row0 + rb + a) * D) + lane + 64 * jj) = o; } }
#pragma unroll
            for (int o = 1; o < 64; o <<= 1) {
#pragma unroll
                for (int a = 0; a < 4; ++a) am[a] = fmaxf(am[a], __shfl_xor(am[a], o)); }
#pragma unroll
            for (int a = 0; a < 4; ++a) { const float inv = am[a] > 0.f ? 127.0f / am[a] : 0.f;
                if (lane == 0) ((float*)(ws + WS_H1S))[row0 + rb + a] = am[a] > 0.f ? am[a] * (1.0f / 127.0f) : 1.0f;
#pragma unroll
                for (int jj = 0; jj < 2; ++jj) { u32x2 w2;
#pragma unroll
                    for (int k = 0; k < 2; ++k) { const f32x4 z = v[a][2 * jj + k] * inv;
                        w2[k] = ((unsigned)(int)__builtin_rintf(z[0]) & 0xffu) | (((unsigned)(int)__builtin_rintf(z[1]) & 0xffu) << 8) | (((unsigned)(int)__builtin_rintf(z[2]) & 0xffu) << 16) | ((unsigned)(int)__builtin_rintf(z[3]) << 24); }
                    *((u32x2*)(ws + WS_H1F8 + (size_t)(row0 + rb + a) * D) + lane + 64 * jj) = w2; } }
        }
        asm volatile("s_waitcnt vmcnt(0)" ::: "memory");
        f32x4 acc[5];
#pragma unroll
        for (int n = 0; n < 5; ++n) acc[n] = (f32x4){0.f, 0.f, 0.f, 0.f};
        const bf16_t* ap = H1B + (size_t)(row0 + (lane & 15)) * D + 8 * (lane >> 4);
        const bf16_t* bp = WRB + (size_t)(lane & 15) * D + 8 * (lane >> 4);
#pragma unroll 8
        for (int ks = 0; ks < 32; ++ks) {
            const pg8::bf16x8 a = *(const pg8::bf16x8*)(ap + 32 * ks);
#pragma unroll
            for (int n = 0; n < 5; ++n) { const pg8::bf16x8 bw = *(const pg8::bf16x8*)(bp + (size_t)n * 16 * D + 32 * ks); acc[n] = __builtin_amdgcn_mfma_f32_16x16x32_bf16(a, bw, acc[n], 0, 0, 0); }
        }
#pragma unroll
        for (int n = 0; n < 5; ++n)
#pragma unroll
            for (int i = 0; i < 4; ++i) lg[(4 * (lane >> 4) + i) * 80 + 16 * n + (lane & 15)] = acc[n][i];
        __syncthreads();
        int ea = 0, eb = 0; unsigned la = 0, lb = 0; float w1 = 0.f, w2 = 0.f;
        if (lane < 16) {
            const LAS float* l = lg + lane * 80;
            const float* brg = P.in[I_BRG]; const float* bre = P.in[I_BRE];
            int gs = 0; float gm = l[0] + brg[0];
            for (int i = 1; i < 8; ++i) { const float x = l[i] + brg[i]; if (x > gm) { gm = x; gs = i; } }
            float den = 0.f; for (int i = 0; i < 8; ++i) den += __expf(l[i] + brg[i] - gm);
            const float gwt = 1.0f / den;
            int i1 = 0; float l1 = l[8 + gs * 8] + bre[gs * 8];
            for (int i = 1; i < 8; ++i) { const float x = l[8 + gs * 8 + i] + bre[gs * 8 + i]; if (x > l1) { l1 = x; i1 = i; } }
            int i2 = -1; float l2 = 0.f;
            for (int i = 0; i < 8; ++i) { if (i == i1) continue; const float x = l[8 + gs * 8 + i] + bre[gs * 8 + i]; if (i2 < 0 || x > l2) { l2 = x; i2 = i; } }
            const float e2 = __expf(l2 - l1); w1 = gwt / (1.0f + e2); w2 = gwt * e2 / (1.0f + e2);
            ea = gs * 8 + i1; eb = gs * 8 + i2;
            la = atomicAdd((unsigned*)(lcnt + ea), 1u); lb = atomicAdd((unsigned*)(lcnt + eb), 1u);
        }
        __syncthreads();
        if (F.tid < 64) { const unsigned c = lcnt[F.tid]; lcnt[64 + F.tid] = c ? atomicAdd(ctl + CW_COUNTS + F.tid, c) : 0u; }
        __syncthreads();
        if (lane < 16) { const int row = row0 + lane;
            tok_e[2 * row] = ea; tok_e[2 * row + 1] = eb; tok_pos[2 * row] = (int)(lcnt[64 + ea] + la); tok_pos[2 * row + 1] = (int)(lcnt[64 + eb] + lb); tok_w[2 * row] = w1; tok_w[2 * row + 1] = w2; }
        __syncthreads();
    }
}

__device__ __forceinline__ void phase_gather(const Frame& F) {
    const Params& P = *F.p; unsigned char* ws = P.ws;
    const int* tok_e = (const int*)(ws + WS_MISC + MS_TOKE); const int* tok_pos = (const int*)(ws + WS_MISC + MS_TOKPOS); int* tok_dest = (int*)(ws + WS_MISC + MS_TOKDEST);
    const unsigned char* H1F = ws + WS_H1F8; unsigned char* XB = ws + WS_XBUF;
    LAS int* ps = (LAS int*)F.lds;
    if (F.tid == 0) {
        const unsigned* cnt = (const unsigned*)(ws + WS_CTL) + CW_COUNTS;
        int* tile_e = (int*)(ws + WS_MISC + MS_TILEE); int* ntl = (int*)(ws + WS_MISC + MS_NTILES);
        int run = 0;
        for (int e = 0; e < NEXP; ++e) { const int c = (int)cnt[e]; ps[e] = run * 256; const int nte = (c + 255) / 256; if (F.bid == 0) for (int k = 0; k < nte; ++k) tile_e[run + k] = e; run += nte; }
        if (F.bid == 0) ntl[0] = run;
    }
    __syncthreads();
    const int gw = F.bid * NWAVES + F.wave, NGW = F.G * NWAVES;
    for (int a0 = gw * 8; a0 < NASSIGN; a0 += NGW * 8) {
        int dest[8]; u32x4 rowv[4]; float sc[4];
#pragma unroll
        for (int k = 0; k < 8; ++k) dest[k] = ps[tok_e[a0 + k]] + tok_pos[a0 + k];
#pragma unroll
        for (int t = 0; t < 4; ++t) { rowv[t] = *((const u32x4*)(H1F + (size_t)((a0 >> 1) + t) * D) + F.lane); sc[t] = ((const float*)(ws + WS_H1S))[(a0 >> 1) + t]; }
#pragma unroll
        for (int k = 0; k < 8; ++k) { *((u32x4*)(XB + (size_t)dest[k] * D) + F.lane) = rowv[k >> 1];
            if (F.lane == 0) { tok_dest[a0 + k] = dest[k]; ((float*)(ws + WS_XSB))[dest[k]] = sc[k >> 1]; } }
    }
    __syncthreads();
}

__device__ __forceinline__ void phase_combine(const Frame& F) {
    const Params& P = *F.p; unsigned char* ws = P.ws;
    const bf16_t* H1B = (const bf16_t*)(ws + WS_H1B); const bf16_t* YB = (const bf16_t*)(ws + WS_YBUF);
    const int* tok_dest = (const int*)(ws + WS_MISC + MS_TOKDEST); const float* tok_w = (const float*)(ws + WS_MISC + MS_TOKW);
    const int gw = F.bid * NWAVES + F.wave, NGW = F.G * NWAVES, lane = F.lane;
    const float* g2 = P.in[I_LN2G]; const float* b2 = P.in[I_LN2B];
    f32x4 gg[4], bb[4];
#pragma unroll
    for (int j = 0; j < 4; ++j) { gg[j] = *((const f32x4*)g2 + 2 * lane + 128 * (j >> 1) + (j & 1)); bb[j] = *((const f32x4*)b2 + 2 * lane + 128 * (j >> 1) + (j & 1)); }
    for (int row0 = gw * 4; row0 < NTOK; row0 += NGW * 4) {
        f32x4 v[4][4]; float s[4], q[4];
        u32x4 lx[4][2]; u32x2 la[4][2], lb[4][2]; float w0[4], w1[4];
#pragma unroll
        for (int a = 0; a < 4; ++a) { const int row = row0 + a; const int d0 = tok_dest[2 * row], d1 = tok_dest[2 * row + 1]; w0[a] = tok_w[2 * row]; w1[a] = tok_w[2 * row + 1];
            const u32x4* xr = (const u32x4*)(H1B + (size_t)row * D) + lane;
            const u32x2* y0 = (const u32x2*)((const unsigned char*)YB + (size_t)d0 * D) + lane; const u32x2* y1 = (const u32x2*)((const unsigned char*)YB + (size_t)d1 * D) + lane;
            w0[a] *= 0.0625f; w1[a] *= 0.0625f;
#pragma unroll
            for (int jj = 0; jj < 2; ++jj) { lx[a][jj] = xr[64 * jj]; la[a][jj] = y0[64 * jj]; lb[a][jj] = y1[64 * jj]; } }
#pragma unroll
        for (int a = 0; a < 4; ++a) { s[a] = 0.f;
#pragma unroll
            for (int j = 0; j < 4; ++j) { u32x2 x; x.x = (j & 1) ? lx[a][j >> 1].z : lx[a][j >> 1].x; x.y = (j & 1) ? lx[a][j >> 1].w : lx[a][j >> 1].y;
                const unsigned ya = (j & 1) ? la[a][j >> 1].y : la[a][j >> 1].x, yb = (j & 1) ? lb[a][j >> 1].y : lb[a][j >> 1].x;
                const f32x2 a01 = __builtin_amdgcn_cvt_pk_f32_fp8((int)ya, false), a23 = __builtin_amdgcn_cvt_pk_f32_fp8((int)ya, true), b01 = __builtin_amdgcn_cvt_pk_f32_fp8((int)yb, false), b23 = __builtin_amdgcn_cvt_pk_f32_fp8((int)yb, true);
                v[a][j][0] = ALPHA * bf_lo(x.x) + (w0[a] * a01[0] + w1[a] * b01[0]); v[a][j][1] = ALPHA * bf_hi(x.x) + (w0[a] * a01[1] + w1[a] * b01[1]);
                v[a][j][2] = ALPHA * bf_lo(x.y) + (w0[a] * a23[0] + w1[a] * b23[0]); v[a][j][3] = ALPHA * bf_hi(x.y) + (w0[a] * a23[1] + w1[a] * b23[1]);
                s[a] += (v[a][j][0] + v[a][j][1]) + (v[a][j][2] + v[a][j][3]); } }
#pragma unroll
        for (int o = 1; o < 64; o <<= 1) {
#pragma unroll
            for (int a = 0; a < 4; ++a) s[a] += __shfl_xor(s[a], o); }
#pragma unroll
        for (int a = 0; a < 4; ++a) { const float mean = s[a] * (1.f / D); q[a] = 0.f;
#pragma unroll
            for (int j = 0; j < 4; ++j) { v[a][j] = v[a][j] - mean; q[a] += (v[a][j][0] * v[a][j][0] + v[a][j][1] * v[a][j][1]) + (v[a][j][2] * v[a][j][2] + v[a][j][3] * v[a][j][3]); } }
#pragma unroll
        for (int o = 1; o < 64; o <<= 1) {
#pragma unroll
            for (int a = 0; a < 4; ++a) q[a] += __shfl_xor(q[a], o); }
#pragma unroll
        for (int a = 0; a < 4; ++a) { const float rstd = 1.f / sqrtf(q[a] * (1.f / D) + LN_EPS);
            f32x4* orow = (f32x4*)(P.out + (size_t)(row0 + a) * D) + 2 * lane;
#pragma unroll
            for (int j = 0; j < 4; ++j) __builtin_nontemporal_store(v[a][j] * rstd * gg[j] + bb[j], orow + 128 * (j >> 1) + (j & 1)); }
    }
}

constexpr int NPHASE = 15;
__global__ void __launch_bounds__(NTHR, 2) fwd_kernel(Params prm) {
    extern __shared__ __attribute__((aligned(16))) unsigned char lds_raw[];
    Frame F; F.lds = (LAS unsigned char*)lds_raw; F.tid = threadIdx.x; F.lane = F.tid & 63; F.wave = __builtin_amdgcn_readfirstlane(F.tid >> 6); F.G = gridDim.x; F.bid = blockIdx.x; F.p = &prm;
    unsigned char* ws = prm.ws;
    const int lo = prm.ph_lo, hi = prm.ph_hi;
    volatile LAS unsigned* MISC = (volatile LAS unsigned*)(F.lds + MISC_OFF);
    if (F.tid < 32) MISC[F.tid] = 0u;
    __syncthreads();
    if (lo < 0) cg::this_grid().sync();
    XcdBarrier bar; bar.bar = (unsigned*)(ws + WS_CTL) + CW_BAR; bar.x = 0; bar.st = nullptr;
    if (hi - lo > 1) bar = xcd_barrier_post((unsigned*)(ws + WS_CTL) + CW_BAR, MISC + 8);
#define IN(k) (lo <= (k) && (k) < hi)
#define SEAM(k) do { if (IN(k) && IN((k) + 1)) { xcd_barrier(bar); } } while (0)
#define PHASE(k, ...) do { if (IN(k)) { __VA_ARGS__ if (PROBE_PH == (k)) { xcd_barrier(bar); __VA_ARGS__ } } SEAM(k); } while (0);
    const bf16_t* Zc = (const bf16_t*)(ws + WS_Z);

    PHASE(0, { phase_prep(F); })
    PHASE(1, {
        pg8::StaticOrder S{NTOK / 256, INCOLS / 256, F.G, F.bid, (const char*)(ws + WS_XB), (const char*)(ws + WS_WIN), (size_t)256 * D, (size_t)256 * D, 0};
        EpiBf16 E{(bf16_t*)(ws + WS_Z), INCOLS, prm.in[I_BGATE], GATE0 / 256, GATE0, 1.0f, 4, 12, D, (const float*)(ws + WS_XS), (const float*)(ws + WS_SW), 0};
        pg8::gemm_phase<EpiBf16, pg8::StaticOrder, true, true, 2>(F.lds, D / 2, D / 2, D / 2, S, E);
    })
    PHASE(2, {
        pg8::KVOrder S{F.G, F.bid, (const char*)(ws + WS_MEMB), (const char*)(ws + WS_WKV)};
        EpiKV E{(bf16_t*)(ws + WS_KB), (bf16_t*)(ws + WS_VT)};
        pg8::gemm_phase<EpiKV, pg8::KVOrder, true, true>(F.lds, D, D, D, S, E);
        if (F.bid >= 64) phase_convpool(F, CW_CPCTR, 0u, (unsigned)CP_EARLY);
    })
    PHASE(4, {
        if (F.bid < NATT) phase_attn<0>(F, F.bid, NATT);
        phase_convpool(F, CW_CPCTR2, (unsigned)CP_EARLY, (unsigned)CP_CHUNKS);
        { constexpr int I_DN0 = 16 * 256 + 3 * 16 * 32 + 16 * 64 + 4 * 4 * 8 + NEXP * 16 * 32; convert_items_dyn(F, I_DN0, PREP_NIT, CW_WDCTR); }
    })
    PHASE(7, {
        pg8::SegOrder S{NTOK / 256, D / 256, F.G, F.bid, (const char*)(ws + WS_ACONV), (const char*)(ws + WS_DPOOL), (const char*)(ws + WS_O), (const char*)(ws + WS_WCAT), (size_t)256 * D * 2, (size_t)256 * KCAT * 2, (size_t)256 * 2};
        EpiMix3 E{(bf16_t*)(ws + WS_MERGED), Zc, prm.in[I_PSCALE], 0};
        pg8::gemm_phase<EpiMix3, pg8::SegOrder, true, true>(F.lds, KCAT, D, KCAT, S, E);
        if (PROBE_PH == 207) { xcd_barrier(bar); EpiMix3 E2{(bf16_t*)(ws + WS_XBUF), Zc, prm.in[I_PSCALE], 1}; pg8::gemm_phase<EpiMix3, pg8::SegOrder, true, true>(F.lds, KCAT, D, KCAT, S, E2); }
    })
    PHASE(8, {
        pg8::StaticOrder S{NTOK / 256, D / 256, F.G, F.bid, (const char*)(ws + WS_MERGED), (const char*)(ws + WS_WO), (size_t)256 * D * 2, (size_t)256 * D * 2, 0};
        EpiResBf16 E{(bf16_t*)(ws + WS_H1), prm.in[I_X], ALPHA};
        pg8::gemm_phase<EpiResBf16, pg8::StaticOrder, true, true>(F.lds, D, D, D, S, E);
    })
    PHASE(9, { phase_ln1_router(F); if (PROBE_PH == 300) { xcd_barrier(bar); xcd_barrier(bar); xcd_barrier(bar); xcd_barrier(bar); } })
    PHASE(11, { phase_gather(F); })
    PHASE(12, {
        const int ntl = *(const int*)(ws + WS_MISC + MS_NTILES);
        pg8::MoeOrder S{ntl, 4, F.G, F.bid, (const char*)(ws + WS_XBUF), (const char*)(ws + WS_WUP), (size_t)256 * D, (size_t)256 * D, (size_t)D * D, (const int*)(ws + WS_MISC + MS_TILEE)};
        EpiAct E{ws + WS_ACT, (const float*)(ws + WS_XSB), (const float*)(ws + WS_SWU)};
        pg8::gemm_phase<EpiAct, pg8::MoeOrder, true, true, 2>(F.lds, D / 2, D / 2, D / 2, S, E);
    })
    PHASE(13, {
        const int ntl = *(const int*)(ws + WS_MISC + MS_NTILES);
        pg8::MoeOrder S{ntl, 4, F.G, F.bid, (const char*)(ws + WS_ACT), (const char*)(ws + WS_WDN), (size_t)256 * DEXP, (size_t)256 * DEXP, (size_t)D * DEXP, (const int*)(ws + WS_MISC + MS_TILEE)};
        EpiBf16 E{(bf16_t*)(ws + WS_YBUF), D, nullptr, 1 << 30, 0, 0.03125f * 16.0f, 0, 0, 0, nullptr, nullptr, 1};
        pg8::gemm_phase<EpiBf16, pg8::MoeOrder, true, true, 1>(F.lds, DEXP / 2, DEXP / 2, DEXP / 2, S, E);
    })
    PHASE(14, { phase_combine(F); })
#undef IN
#undef SEAM
}

extern "C" void kernel_launch(void* const* d_in, const int* in_sizes, int n_in, void* d_out, int out_size, void* d_ws, size_t ws_size, hipStream_t stream) {
    static int grid = 0;
    if (grid == 0) {
        if (n_in != 21 || out_size != NTOK * D || ws_size < WS_END) { fprintf(stderr, "kernel_launch: unexpected shapes (n_in %d out %d ws %zu, need ws >= %zu)\n", n_in, out_size, ws_size, (size_t)WS_END); grid = -1; return; }
        int dev = 0, cus = 0, per_cu = 0;
        if (hipGetDevice(&dev) != hipSuccess || hipDeviceGetAttribute(&cus, hipDeviceAttributeMultiprocessorCount, dev) != hipSuccess) { grid = -1; return; }
        if (hipFuncSetAttribute((const void*)fwd_kernel, hipFuncAttributeMaxDynamicSharedMemorySize, LDS_BYTES) != hipSuccess) { fprintf(stderr, "kernel_launch: hipFuncSetAttribute failed\n"); grid = -1; return; }
        if (hipOccupancyMaxActiveBlocksPerMultiprocessor(&per_cu, (const void*)fwd_kernel, NTHR, LDS_BYTES) != hipSuccess || per_cu < 1) { fprintf(stderr, "kernel_launch: occupancy query says %d\n", per_cu); (void)hipGetLastError(); per_cu = 1; }
        grid = cus * 1;
        fprintf(stderr, "kernel_launch: cus %d per_cu %d grid %d\n", cus, per_cu, grid);
    }
    if (grid < 0) return;
    (void)hipMemsetAsync((char*)d_ws + WS_CTL, 0, CTL_ZERO_BYTES, stream);
    Params a{};
    for (int i = 0; i < 21; ++i) a.in[i] = (const float*)d_in[i];
    a.out = (float*)d_out; a.ws = (unsigned char*)d_ws;
#if MK_ONE_LAUNCH
    a.ph_lo = 0; a.ph_hi = NPHASE;
    void* args[] = {&a};
    hipError_t e = hipLaunchCooperativeKernel((const void*)fwd_kernel, dim3(grid), dim3(NTHR), args, LDS_BYTES, stream);
    if (e != hipSuccess) fprintf(stderr, "cooperative launch failed: %s (grid %d)\n", hipGetErrorString(e), grid);
#else
    for (int ph = 0; ph < NPHASE; ++ph) {
        a.ph_lo = ph; a.ph_hi = ph + 1;
        hipLaunchKernelGGL(fwd_kernel, dim3(grid), dim3(NTHR), LDS_BYTES, stream, a);
    }
#endif
}
```
